# Optimizing an MI355X kernel written in HIP

```python
import jax, jax.numpy as jnp
from jax import lax
import numpy as np

D_MODEL = 1024
BATCH = 2
SEQ = 16384
DEPTH = 2
DEC_BATCH = 32
DEC_SEQ = 2048
PAST_LEN = 128

HEAD_DIM = 64
A_HEADS = 8
A_WIDTH = A_HEADS * HEAD_DIM
A_PATTERNS = ((128, 1), (512, 4), (2048, 16))
ROPE_THETA = 500000.0
ROPE_DIM = HEAD_DIM // 4
B_HEADS = 4
B_KDIM = 32
B_VDIM = 64
B_QK = B_HEADS * B_KDIM
B_WIDTH = B_HEADS * B_VDIM
B_GATE_RANK = 16
B_GATE_TAU = 16.0
B_CHUNK = 64
C_HEADS = 4
C_DIM = 64
C_WIDTH = C_HEADS * C_DIM
C_CHUNK = 128
RET_THETA = 10000.0
IN_SPLITS = (A_WIDTH, A_WIDTH, A_WIDTH,
             B_QK, B_QK, B_WIDTH, B_WIDTH, 2 * B_GATE_RANK,
             C_WIDTH, C_WIDTH, C_WIDTH, C_WIDTH)
N_IN = 3 * A_WIDTH + 2 * B_QK + 2 * B_WIDTH + 2 * B_GATE_RANK + 4 * C_WIDTH
MIX_WIDTH = A_WIDTH + B_WIDTH + C_WIDTH
D_FF = 4 * D_MODEL
PLE_DIM = 256
EPS = 1e-6
NEG = -1e30

kernel_name = 'hybrid_bidir_dilated_gla_retention_encoder'


def rmsnorm(x, g):
    xf = x.astype(jnp.float32)
    y = xf * lax.rsqrt(jnp.mean(xf * xf, axis=-1, keepdims=True) + EPS)
    return (y * g.astype(jnp.float32)).astype(x.dtype)


def head_rmsnorm(x, g):
    b, s, h, d = x.shape
    return rmsnorm(x, g.reshape(h, d)).reshape(b, s, h * d)


def rotary(x, pos, rot_dim, theta):
    half = rot_dim // 2
    inv_freq = 1.0 / (theta ** (jnp.arange(half, dtype=jnp.float32) * (2.0 / rot_dim)))
    ang = pos[:, None] * inv_freq[None, :]
    cos = jnp.cos(ang)[None, :, None, :]
    sin = jnp.sin(ang)[None, :, None, :]
    x1 = x[..., :half]
    x2 = x[..., half:rot_dim]
    return jnp.concatenate([x1 * cos - x2 * sin, x2 * cos + x1 * sin, x[..., rot_dim:]], axis=-1)


def banded_attention(q, k, v, radius):
    n, L, h, d = q.shape
    w = radius
    nb = -(-L // w)
    lp = nb * w
    qb = jnp.pad(q, ((0, 0), (0, lp - L), (0, 0), (0, 0))).reshape(n, nb, w, h, d)

    def windows(t):
        tb = jnp.pad(t, ((0, 0), (w, lp - L + w), (0, 0), (0, 0))).reshape(n, nb + 2, w, h, d)
        return jnp.concatenate([tb[:, :-2], tb[:, 1:-1], tb[:, 2:]], axis=2)

    kw = windows(k)
    vw = windows(v)
    qpos = jnp.arange(nb)[:, None] * w + jnp.arange(w)[None, :]
    kpos = jnp.arange(nb)[:, None] * w - w + jnp.arange(3 * w)[None, :]
    rel = qpos[:, :, None] - kpos[:, None, :]
    mask = (jnp.abs(rel) <= radius) & (kpos[:, None, :] >= 0) & (kpos[:, None, :] < L)
    s = jnp.einsum('nbqhd,nbkhd->nbhqk', qb, kw)
    s = jnp.where(mask[None, :, None], s, NEG)
    m = jnp.max(s, axis=-1, keepdims=True)
    p = jnp.exp(s - m)
    den = jnp.sum(p, axis=-1, keepdims=True)
    o = jnp.einsum('nbhqk,nbkhd->nbqhd', p, vw) / jnp.swapaxes(den, 2, 3)
    lse = jnp.swapaxes((m + jnp.log(den))[..., 0], 2, 3)
    return o.reshape(n, lp, h, d)[:, :L], lse.reshape(n, lp, h)[:, :L]


def dilated_attention(q, k, v):
    b, s, h, d = q.shape
    outs = []
    lses = []
    for window, dil in A_PATTERNS:
        radius = window // (2 * dil)
        n_sub = s // dil

        def to_res(t):
            return t.reshape(b, n_sub, dil, h, d).transpose(0, 2, 1, 3, 4).reshape(b * dil, n_sub, h, d)

        o, lse = banded_attention(to_res(q), to_res(k), to_res(v), radius)
        outs.append(o.reshape(b, dil, n_sub, h, d).transpose(0, 2, 1, 3, 4).reshape(b, s, h, d))
        lses.append(lse.reshape(b, dil, n_sub, h).transpose(0, 2, 1, 3).reshape(b, s, h))
    wts = jax.nn.softmax(jnp.stack(lses), axis=0)
    return jnp.einsum('gbsh,gbshd->bshd', wts, jnp.stack(outs))


def gla_chunked(q, k, v, log_a, strict):
    bn, s, h, kd = q.shape
    vd = v.shape[-1]
    c = B_CHUNK
    nc = s // c

    def chunks(t):
        return t.reshape(bn, nc, c, h, t.shape[-1]).transpose(1, 0, 3, 2, 4)

    qc, kc, vc = chunks(q), chunks(k), chunks(v)
    bc = jnp.cumsum(chunks(log_a), axis=3)
    idx = jnp.arange(c)
    mask = (idx[None, :] < idx[:, None]) if strict else (idx[None, :] <= idx[:, None])

    def step(state, inp):
        qt, kt, vt, bt = inp
        inter = jnp.einsum('bhtk,bhkv->bhtv', qt * jnp.exp(bt), state)
        diff = bt[:, :, :, None, :] - bt[:, :, None, :, :]
        decay = jnp.exp(jnp.where(mask[:, :, None], diff, NEG))
        att = jnp.einsum('bhtk,bhsk,bhtsk->bhts', qt, kt, decay)
        intra = jnp.einsum('bhts,bhsv->bhtv', att, vt)
        blast = bt[:, :, -1:, :]
        new_state = jnp.exp(blast[:, :, 0, :])[..., None] * state + jnp.einsum(
            'bhsk,bhsv->bhkv', kt * jnp.exp(blast - bt), vt)
        return new_state, inter + intra

    _, o = lax.scan(step, jnp.zeros((bn, h, kd, vd), jnp.float32), (qc, kc, vc, bc))
    return o.transpose(1, 0, 3, 2, 4).reshape(bn, s, h, vd)


def retention_chunked(q, k, v, log_gamma, strict):
    bn, s, h, d = q.shape
    c = C_CHUNK
    nc = s // c
    qc = q.reshape(bn, nc, c, h, d)
    kc = k.reshape(bn, nc, c, h, d)
    vc = v.reshape(bn, nc, c, h, d)
    idx = jnp.arange(c, dtype=jnp.float32)
    rel = idx[:, None] - idx[None, :]
    mask = (rel > 0) if strict else (rel >= 0)
    dmat = jnp.where(mask[None], jnp.exp(jnp.where(mask, rel, 0.0)[None] * log_gamma[:, None, None]), 0.0)
    scores = jnp.einsum('bnthd,bnshd->bnhts', qc, kc) * dmat[None, None]
    intra = jnp.einsum('bnhts,bnshe->bnthe', scores, vc)
    kdec = jnp.exp((c - 1.0 - idx)[None, :] * log_gamma[:, None])
    chunk_kv = jnp.einsum('bnshd,bnshe,hs->nbhde', kc, vc, kdec)
    chunk_decay = jnp.exp(c * log_gamma)[None, :, None, None]

    def step(r, kv):
        return chunk_decay * r + kv, r

    _, r_prev = lax.scan(step, jnp.zeros((bn, h, d, d), jnp.float32), chunk_kv)
    qdec = jnp.exp((idx + 1.0)[None, :] * log_gamma[:, None])
    inter = jnp.einsum('bnthd,nbhde,ht->bnthe', qc, r_prev, qdec)
    return (intra + inter).reshape(bn, s, h, d)


def rev(t):
    return t[:, ::-1]


def trunk_layer(h, ple, ln_mix, w_in, attn_q_norm, attn_k_norm, gla_gate_up, gla_gate_bias,
                gla_out_norm, ret_decay_raw, ret_out_norm, w_out, ln_mlp, w_mlp_in, w_mlp_out,
                ln_pe, w_pe_gate, w_pe_proj):
    bn, s, _ = h.shape
    dt = h.dtype
    f32 = jnp.float32
    u = rmsnorm(h, ln_mix)
    z = (u @ w_in).astype(f32)
    points = []
    acc = 0
    for width in IN_SPLITS[:-1]:
        acc += width
        points.append(acc)
    aq, ak, av, bq, bk, bv, br, bg, cq, ck, cv, cg = jnp.split(z, points, axis=-1)
    pos = jnp.arange(s, dtype=f32)

    aq = rotary(rmsnorm(aq.reshape(bn, s, A_HEADS, HEAD_DIM), attn_q_norm), pos, ROPE_DIM, ROPE_THETA) * (HEAD_DIM ** -0.5)
    ak = rotary(rmsnorm(ak.reshape(bn, s, A_HEADS, HEAD_DIM), attn_k_norm), pos, ROPE_DIM, ROPE_THETA)
    av = av.reshape(bn, s, A_HEADS, HEAD_DIM)
    o_a = dilated_attention(aq, ak, av).reshape(bn, s, A_WIDTH)

    bq = bq.reshape(bn, s, B_HEADS, B_KDIM) * (B_KDIM ** -0.5)
    bk = bk.reshape(bn, s, B_HEADS, B_KDIM)
    bv = bv.reshape(bn, s, B_HEADS, B_VDIM)
    glr = bg.reshape(bn, s, 2, B_GATE_RANK)
    gate_logits = jnp.einsum('bsjr,jrk->jbsk', glr, gla_gate_up.astype(f32)) + gla_gate_bias.astype(f32)[:, None, None, :]
    log_a = (jax.nn.log_sigmoid(gate_logits) / B_GATE_TAU).reshape(2, bn, s, B_HEADS, B_KDIM)
    o_bf = gla_chunked(bq, bk, bv, log_a[0], False)
    o_bb = rev(gla_chunked(rev(bq), rev(bk), rev(bv), rev(log_a[1]), True))
    o_b = head_rmsnorm(o_bf + o_bb, gla_out_norm) * jax.nn.silu(br)

    cq = rotary(cq.reshape(bn, s, C_HEADS, C_DIM), pos, C_DIM, RET_THETA)
    ck = rotary(ck.reshape(bn, s, C_HEADS, C_DIM), pos, C_DIM, RET_THETA) * (C_DIM ** -0.5)
    cv = cv.reshape(bn, s, C_HEADS, C_DIM)
    log_gamma = jax.nn.log_sigmoid(ret_decay_raw.astype(f32))
    o_cf = retention_chunked(cq, ck, cv, log_gamma[0], False)
    o_cb = rev(retention_chunked(rev(cq), rev(ck), rev(cv), log_gamma[1], True))
    o_c = head_rmsnorm(o_cf + o_cb, ret_out_norm) * jax.nn.silu(cg)

    mix = jnp.concatenate([o_a, o_b, o_c], axis=-1).astype(dt)
    h = h + mix @ w_out

    m = rmsnorm(h, ln_mlp)
    h = h + jnp.square(jax.nn.relu(m @ w_mlp_in)) @ w_mlp_out

    gate = jax.nn.sigmoid(rmsnorm(h, ln_pe) @ w_pe_gate)
    return h + gate * (ple @ w_pe_proj)


def run_trunk(x, p, ln_mix, w_in, attn_q_norm, attn_k_norm, gla_gate_up, gla_gate_bias,
              gla_out_norm, ret_decay_raw, ret_out_norm, w_out, ln_mlp, w_mlp_in, w_mlp_out,
              ln_pe, w_pe_gate, w_pe_proj):
    h = x
    for i in range(DEPTH):
        h = trunk_layer(h, p[i], ln_mix[i], w_in[i], attn_q_norm[i], attn_k_norm[i],
                        gla_gate_up[i], gla_gate_bias[i], gla_out_norm[i], ret_decay_raw[i],
                        ret_out_norm[i], w_out[i], ln_mlp[i], w_mlp_in[i], w_mlp_out[i],
                        ln_pe[i], w_pe_gate[i], w_pe_proj[i])
    return h


def setup_inputs(seed: int = 0) -> dict:
    key = jax.random.key(seed)
    ks = jax.random.split(key, 24)
    f32 = jnp.float32

    def nrm(k, shape, scale):
        return jax.random.normal(k, shape, f32) * scale

    ret_base = jnp.log(2.0 ** (5.0 + jnp.arange(C_HEADS, dtype=f32)) - 1.0)
    return {
        'x_prompt': nrm(ks[0], (BATCH, SEQ, D_MODEL), 1.0),
        'x_sample': nrm(ks[1], (DEC_BATCH, DEC_SEQ, D_MODEL), 1.0),
        'p_prompt': nrm(ks[2], (DEPTH, BATCH, SEQ, PLE_DIM), 1.0),
        'p_sample': nrm(ks[3], (DEPTH, DEC_BATCH, DEC_SEQ, PLE_DIM), 1.0),
        'ln_mix': 1.0 + nrm(ks[4], (DEPTH, D_MODEL), 0.02),
        'w_in': nrm(ks[5], (DEPTH, D_MODEL, N_IN), D_MODEL ** -0.5),
        'attn_q_norm': 1.0 + nrm(ks[6], (DEPTH, HEAD_DIM), 0.02),
        'attn_k_norm': 1.0 + nrm(ks[7], (DEPTH, HEAD_DIM), 0.02),
        'gla_gate_up': nrm(ks[8], (DEPTH, 2, B_GATE_RANK, B_QK), B_GATE_RANK ** -0.5),
        'gla_gate_bias': nrm(ks[9], (DEPTH, 2, B_QK), 0.1),
        'gla_out_norm': 1.0 + nrm(ks[10], (DEPTH, B_WIDTH), 0.02),
        'ret_decay_raw': ret_base[None, None, :] + nrm(ks[11], (DEPTH, 2, C_HEADS), 0.1),
        'ret_out_norm': 1.0 + nrm(ks[12], (DEPTH, C_WIDTH), 0.02),
        'w_out': nrm(ks[13], (DEPTH, MIX_WIDTH, D_MODEL), MIX_WIDTH ** -0.5),
        'ln_mlp': 1.0 + nrm(ks[14], (DEPTH, D_MODEL), 0.02),
        'w_mlp_in': nrm(ks[15], (DEPTH, D_MODEL, D_FF), D_MODEL ** -0.5),
        'w_mlp_out': nrm(ks[16], (DEPTH, D_FF, D_MODEL), D_FF ** -0.5),
        'ln_pe': 1.0 + nrm(ks[17], (DEPTH, D_MODEL), 0.02),
        'w_pe_gate': nrm(ks[18], (DEPTH, D_MODEL, D_MODEL), D_MODEL ** -0.5),
        'w_pe_proj': nrm(ks[19], (DEPTH, PLE_DIM, D_MODEL), PLE_DIM ** -0.5),
    }


def reference(x_prompt, x_sample, p_prompt, p_sample, ln_mix, w_in, attn_q_norm, attn_k_norm,
              gla_gate_up, gla_gate_bias, gla_out_norm, ret_decay_raw, ret_out_norm, w_out,
              ln_mlp, w_mlp_in, w_mlp_out, ln_pe, w_pe_gate, w_pe_proj):
    y_prompt = run_trunk(x_prompt, p_prompt, ln_mix, w_in, attn_q_norm, attn_k_norm,
                         gla_gate_up, gla_gate_bias, gla_out_norm, ret_decay_raw, ret_out_norm,
                         w_out, ln_mlp, w_mlp_in, w_mlp_out, ln_pe, w_pe_gate, w_pe_proj)
    y_sample = run_trunk(x_sample, p_sample, ln_mix, w_in, attn_q_norm, attn_k_norm,
                         gla_gate_up, gla_gate_bias, gla_out_norm, ret_decay_raw, ret_out_norm,
                         w_out, ln_mlp, w_mlp_in, w_mlp_out, ln_pe, w_pe_gate, w_pe_proj)
    return (y_prompt, y_sample)
```

```cpp
#include <hip/hip_runtime.h>
#include <hip/hip_cooperative_groups.h>
#include <cstdio>
#include <cstdint>
namespace cg = cooperative_groups;

typedef unsigned short bf16_t;
typedef short bf16x8 __attribute__((ext_vector_type(8)));
typedef float f32x4 __attribute__((ext_vector_type(4)));
typedef unsigned u32x4 __attribute__((ext_vector_type(4)));
typedef unsigned u32x2 __attribute__((ext_vector_type(2)));

constexpr int D = 1024, MG = 32768, NGROUPS = 3, NLAYER = 2;
constexpr int ZW = 3584, DFF = 4096, PLE = 256, NIN = 3360;
constexpr int NTHR = 512;
constexpr int NCH = MG / 64;
constexpr int NCR = MG / 128;
constexpr float EPS = 1e-6f;
constexpr int ZC_AQ = 0, ZC_AK = 512, ZC_AV = 1024, ZC_BQ = 1536, ZC_BK = 1664, ZC_BV = 1792, ZC_BR = 2048,
              ZC_GF = 2304, ZC_GB = 2432, ZC_CQ = 2560, ZC_CK = 2816, ZC_CV = 3072, ZC_CG = 3328;
constexpr size_t WO_IN = 0, WO_OUT = WO_IN + (size_t)ZW * D, WO_MI = WO_OUT + (size_t)D * D, WO_MO = WO_MI + (size_t)DFF * D,
                 WO_PG = WO_MO + (size_t)D * DFF, WO_PP = WO_PG + (size_t)D * D, W_LAYER = WO_PP + (size_t)D * PLE;
constexpr size_t WS_WT = 0;
constexpr size_t WS_TAB = WS_WT + W_LAYER * 2 * NLAYER;
constexpr size_t WS_HB = WS_TAB + (size_t)16384 * 40 * 2 * 4;
constexpr size_t WS_HB1 = WS_HB + (size_t)MG * D * 2;
constexpr size_t WS_SSQ = WS_HB1 + (size_t)MG * D * 2;
constexpr size_t WS_Z = WS_SSQ + (size_t)3 * MG * 16 * 4;
constexpr size_t WS_MIX = WS_Z + (size_t)MG * ZW * 2;
constexpr size_t WS_HID = WS_MIX + (size_t)MG * D * 2;
constexpr size_t WS_PB = WS_HID + (size_t)MG * DFF * 2;
constexpr size_t WS_PLE = WS_PB + (size_t)MG * D * 2;
constexpr size_t WS_GS = WS_PLE + (size_t)NLAYER * MG * PLE * 2;
constexpr size_t WS_GD = WS_GS + (size_t)2 * NCH * 4 * 2048 * 4;
constexpr size_t WS_RS = WS_GD + (size_t)2 * NCH * 4 * 32 * 4;
constexpr size_t WS_END = WS_RS + (size_t)2 * NCR * 4 * 4096 * 4;

constexpr int LDS_BYTES = 139264;

extern __shared__ __attribute__((aligned(16))) unsigned char g_lds[];

struct Params {
    const float* x_prompt; const float* x_sample; const float* p_prompt; const float* p_sample;
    const float* ln_mix; const float* w_in; const float* attn_q_norm; const float* attn_k_norm;
    const float* gla_gate_up; const float* gla_gate_bias; const float* gla_out_norm; const float* ret_decay_raw;
    const float* ret_out_norm; const float* w_out; const float* ln_mlp; const float* w_mlp_in; const float* w_mlp_out;
    const float* ln_pe; const float* w_pe_gate; const float* w_pe_proj;
    float* out; unsigned char* ws;
};

typedef float f32x2_t __attribute__((ext_vector_type(2)));
typedef __bf16 bf16x2_t __attribute__((ext_vector_type(2)));
__device__ __forceinline__ unsigned cvt_pk_bf16(float lo, float hi) { const f32x2_t v = {lo, hi}; return __builtin_bit_cast(unsigned, __builtin_convertvector(v, bf16x2_t)); }
__device__ __forceinline__ float bf2f(unsigned short b) { return __uint_as_float(((unsigned)b) << 16); }
__device__ __forceinline__ float bflo(unsigned w) { return __uint_as_float(w << 16); }
__device__ __forceinline__ float bfhi(unsigned w) { return __uint_as_float(w & 0xffff0000u); }
__device__ __forceinline__ bf16x8 pack8(const float (&v)[8]) {
    u32x4 w; w.x = cvt_pk_bf16(v[0], v[1]); w.y = cvt_pk_bf16(v[2], v[3]); w.z = cvt_pk_bf16(v[4], v[5]); w.w = cvt_pk_bf16(v[6], v[7]);
    return __builtin_bit_cast(bf16x8, w);
}
__device__ __forceinline__ void unpack8(bf16x8 b, float (&v)[8]) {
    u32x4 w = __builtin_bit_cast(u32x4, b);
    v[0] = bflo(w.x); v[1] = bfhi(w.x); v[2] = bflo(w.y); v[3] = bfhi(w.y); v[4] = bflo(w.z); v[5] = bfhi(w.z); v[6] = bflo(w.w); v[7] = bfhi(w.w);
}
__device__ __forceinline__ bf16x8 gather8(const bf16_t* base, int stride) {
    bf16x8 r;
#pragma unroll
    for (int j = 0; j < 8; ++j) r[j] = (short)base[j * stride];
    return r;
}
__device__ __forceinline__ bf16x8 ld8f_pack(const float* p) {
    f32x4 a = *(const f32x4*)p, b = *(const f32x4*)(p + 4);
    u32x4 w; w.x = cvt_pk_bf16(a.x, a.y); w.y = cvt_pk_bf16(a.z, a.w); w.z = cvt_pk_bf16(b.x, b.y); w.w = cvt_pk_bf16(b.z, b.w);
    return __builtin_bit_cast(bf16x8, w);
}
__device__ __forceinline__ int opaque_tid() { int t = threadIdx.x; asm volatile("" : "+v"(t)); return t; }
#define LDS_FENCE() asm volatile("s_waitcnt lgkmcnt(0)" ::: "memory")
#define MFMA16(a, b, c) __builtin_amdgcn_mfma_f32_16x16x32_bf16((a), (b), (c), 0, 0, 0)

constexpr int BM = 256, BK = 64, HALF = 128, HT = HALF * BK;
__device__ __forceinline__ int lds_byte(int r, int c) {
    int st = (r >> 4) * 2 + (c >> 5), rr = r & 15, cc = c & 31, ob = rr * 64 + cc * 2;
    return st * 1024 + (ob ^ (((ob >> 9) & 1) << 5));
}
__device__ __forceinline__ void stage_rc(int b, int& R, int& C) {
    int st = b / 1024, sb = b % 1024, swz = sb ^ (((sb >> 9) & 1) << 5);
    R = (st >> 1) * 16 + swz / 64; C = (st & 1) * 32 + (swz % 64) / 2;
}
__device__ __forceinline__ bool tile_of(int L, int nM, int nN, int& pm, int& pn) {
    const int nwg = nM * nN; if (L >= nwg) return false;
    int wgid = L; { const int q = nwg / 8, r = nwg % 8, xcd = wgid % 8, off = wgid / 8; wgid = (xcd < r ? xcd * (q + 1) : r * (q + 1) + (xcd - r) * q) + off; }
    const int nig = 8 * nN, gid = wgid / nig, fm = gid * 8, gsz = (nM - fm) < 8 ? (nM - fm) : 8;
    pm = fm + ((wgid % nig) % gsz); pn = (wgid % nig) / gsz; return true;
}

template <class Epi>
__device__ __forceinline__ void gemm_tile(const bf16_t* __restrict__ A, int lda, const bf16_t* __restrict__ Bt, int ldb, int K, int brow, int bcol, const Epi& epi) {
    const int tid = opaque_tid();
    bf16_t* shm = (bf16_t*)g_lds;
#define SA(b, h) (shm + ((b) * 2 + (h)) * HT)
#define SB(b, h) (shm + (4 + (b) * 2 + (h)) * HT)
#define STAGE(P, BASE, LD, br, kt) do { const int _so = ((br) * (LD) + (kt) * BK) * 2; \
    for (int _i = 0; _i < 2; ++_i) { \
      __builtin_amdgcn_raw_ptr_buffer_load_lds(((&(LD) == &lda) ? rsA : rsB), (__attribute__((address_space(3))) void*)((char*)(P) + tid * 16 + _i * 8192), 16, \
          ((&(LD) == &lda) ? offA[_i] : offB[_i]), _so, 0, 0); } } while (0)
#define LDA(dst, b, h) for (int m = 0; m < 4; ++m) for (int k = 0; k < 2; ++k) \
    dst[m][k] = *reinterpret_cast<const bf16x8*>((char*)SA(b, h) + lds_byte(wr * 64 + m * 16 + fr, k * 32 + fq * 8))
#define LDB(dst, b, h) for (int n = 0; n < 2; ++n) for (int k = 0; k < 2; ++k) \
    dst[n][k] = *reinterpret_cast<const bf16x8*>((char*)SB(b, h) + lds_byte(wc * 32 + n * 16 + fr, k * 32 + fq * 8))
#define MMA(ai, bj, At, Bt_) do { __builtin_amdgcn_s_setprio(1); \
    for (int m = 0; m < 4; ++m) for (int n = 0; n < 2; ++n) for (int k = 0; k < 2; ++k) \
      acc[ai][bj][m][n] = __builtin_amdgcn_mfma_f32_16x16x32_bf16(At[m][k], Bt_[n][k], acc[ai][bj][m][n], 0, 0, 0); \
    __builtin_amdgcn_s_setprio(0); } while (0)
#define WAIT_V(n) asm volatile("s_waitcnt vmcnt(" #n ")" ::: "memory")
#define WAIT_L(n) asm volatile("s_waitcnt lgkmcnt(" #n ")" ::: "memory")
#define BAR __builtin_amdgcn_s_barrier()
#define SCHED __builtin_amdgcn_sched_barrier(0)
    const int wid = tid >> 6, lane = tid & 63, wr = wid >> 2, wc = wid & 3, fr = lane & 15, fq = lane >> 4;
    f32x4 acc[2][2][4][2] = {};
    bf16x8 At[4][2], B0[2][2], B1[2][2];
    const int nt = K / BK;
    const __amdgpu_buffer_rsrc_t rsA = __builtin_amdgcn_make_buffer_rsrc((void*)A, (short)0, 0x7ffffff0, 0x00020000);
    const __amdgpu_buffer_rsrc_t rsB = __builtin_amdgcn_make_buffer_rsrc((void*)Bt, (short)0, 0x7ffffff0, 0x00020000);
    unsigned offA[2], offB[2];
    for (int _i = 0; _i < 2; ++_i) { int _r, _c; stage_rc(tid * 16 + _i * 8192, _r, _c); offA[_i] = (unsigned)(_r * lda + _c) * 2u; offB[_i] = (unsigned)(_r * ldb + _c) * 2u; }
    STAGE(SB(0, 0), Bt, ldb, bcol, 0); STAGE(SA(0, 0), A, lda, brow, 0);
    STAGE(SB(0, 1), Bt, ldb, bcol + HALF, 0); STAGE(SA(0, 1), A, lda, brow + HALF, 0);
    if (wr == 1) BAR;
    WAIT_V(4); BAR;
    STAGE(SB(1, 0), Bt, ldb, bcol, 1); STAGE(SA(1, 0), A, lda, brow, 1); STAGE(SB(1, 1), Bt, ldb, bcol + HALF, 1);
    WAIT_V(6); BAR;
#pragma unroll 1
    for (int t = 0; t < nt - 2; t += 2) {
        LDB(B0, 0, 0); SCHED; LDA(At, 0, 0); STAGE(SA(1, 1), A, lda, brow + HALF, t + 1);
        WAIT_L(8); BAR; WAIT_L(0); MMA(0, 0, At, B0); BAR; SCHED;
        LDB(B1, 0, 1); STAGE(SB(0, 0), Bt, ldb, bcol, t + 2);
        BAR; WAIT_L(0); MMA(0, 1, At, B1); BAR;
        LDA(At, 0, 1); STAGE(SA(0, 0), A, lda, brow, t + 2);
        BAR; WAIT_L(0); MMA(1, 0, At, B0); BAR; SCHED;
        STAGE(SB(0, 1), Bt, ldb, bcol + HALF, t + 2);
        WAIT_V(6); BAR; MMA(1, 1, At, B1); BAR;
        LDB(B0, 1, 0); SCHED; LDA(At, 1, 0); STAGE(SA(0, 1), A, lda, brow + HALF, t + 2);
        WAIT_L(8); BAR; WAIT_L(0); MMA(0, 0, At, B0); BAR; SCHED;
        LDB(B1, 1, 1); STAGE(SB(1, 0), Bt, ldb, bcol, t + 3);
        BAR; WAIT_L(0); MMA(0, 1, At, B1); BAR;
        LDA(At, 1, 1); STAGE(SA(1, 0), A, lda, brow, t + 3);
        BAR; WAIT_L(0); MMA(1, 0, At, B0); BAR; SCHED;
        STAGE(SB(1, 1), Bt, ldb, bcol + HALF, t + 3);
        WAIT_V(6); BAR; MMA(1, 1, At, B1); BAR;
    }
    { LDB(B0, 0, 0); LDA(At, 0, 0); STAGE(SA(1, 1), A, lda, brow + HALF, nt - 1);
      BAR; WAIT_L(0); MMA(0, 0, At, B0); BAR;
      LDB(B1, 0, 1); BAR; WAIT_L(0); MMA(0, 1, At, B1); BAR;
      LDA(At, 0, 1); WAIT_V(4); BAR; WAIT_L(0); MMA(1, 0, At, B0); MMA(1, 1, At, B1); BAR; }
    { LDB(B0, 1, 0); LDA(At, 1, 0); WAIT_V(2); BAR; WAIT_L(0); MMA(0, 0, At, B0); BAR;
      LDB(B1, 1, 1); WAIT_V(0); BAR; WAIT_L(0); MMA(0, 1, At, B1); BAR;
      LDA(At, 1, 1); BAR; WAIT_L(0); MMA(1, 0, At, B0); MMA(1, 1, At, B1); BAR; }
    if (wr == 0) BAR;
    float* ep = (float*)g_lds;
    __syncthreads();
#pragma unroll
    for (int ai = 0; ai < 2; ++ai) {
        if (ai) __syncthreads();
#pragma unroll
        for (int bj = 0; bj < 2; ++bj)
#pragma unroll
            for (int m = 0; m < 4; ++m)
#pragma unroll
                for (int n = 0; n < 2; ++n)
#pragma unroll
                    for (int j = 0; j < 4; ++j)
                        ep[(wr * 64 + m * 16 + fq * 4 + j) * 260 + bj * HALF + wc * 32 + n * 16 + fr] = acc[ai][bj][m][n][j];
        __syncthreads();
        int tid_e = tid; asm volatile("" : "+v"(tid_e));
        const int rl = tid_e & 127, seg = tid_e >> 7;
        epi(ep + rl * 260 + seg * 64, brow + ai * HALF + rl, bcol + seg * 64);
    }
    __syncthreads();
#undef SA
#undef SB
#undef STAGE
#undef LDA
#undef LDB
#undef MMA
}

template <class Epi>
__device__ __forceinline__ void gemm_phase(const bf16_t* A, int lda, const bf16_t* Bt, int ldb, int M, int N, int K, const Epi& epi) {
    const int nM = M / BM, nN = N / BM;
    for (int i = 0;; ++i) {
        int pm, pn; if (!tile_of(i * (int)gridDim.x + (int)blockIdx.x, nM, nN, pm, pn)) break;
        gemm_tile(A, lda, Bt, ldb, K, pm * BM, pn * BM, epi);
    }
}

__device__ __forceinline__ void ld8(const float* s, float (&v)[8]) { const f32x4 a = *(const f32x4*)s, b = *(const f32x4*)(s + 4); v[0] = a.x; v[1] = a.y; v[2] = a.z; v[3] = a.w; v[4] = b.x; v[5] = b.y; v[6] = b.z; v[7] = b.w; }
__device__ __forceinline__ void st8_bf16(bf16_t* d, const float (&v)[8]) { *(bf16x8*)d = pack8(v); }
__device__ __forceinline__ float row_rstd(const float* ssq, int row) {
    const f32x4* p = (const f32x4*)(ssq + (size_t)row * 16);
    f32x4 a = p[0], b = p[1], c = p[2], d = p[3];
    float s = ((a.x + a.y) + (a.z + a.w)) + ((b.x + b.y) + (b.z + b.w)) + ((c.x + c.y) + (c.z + c.w)) + ((d.x + d.y) + (d.z + d.w));
    return rsqrtf(s * (1.0f / D) + EPS);
}

struct EpiIn {
    bf16_t* Z; const float* ssq; const float* qn; const float* kn; const float* gbias; const float* tab; int smask;
    __device__ __forceinline__ void operator()(const float* seg, int row, int col0) const {
        const float rstd = row_rstd(ssq, row);
        const int pos = row & smask;
        bf16_t* dst = Z + (size_t)row * ZW + col0;
        if (col0 < ZC_AV) {
            const bool isq = col0 < ZC_AK;
            const float* gn = isq ? qn : kn;
            float ss = 0.f;
#pragma unroll 2
            for (int c = 0; c < 16; ++c) { const f32x4 t = *(const f32x4*)(seg + 4 * c); ss += (t.x * t.x + t.y * t.y) + (t.z * t.z + t.w * t.w); }
            const float r = rsqrtf(ss * rstd * rstd * (1.0f / 64) + EPS) * rstd * (isq ? 0.125f : 1.0f);
            { float a[8], b[8], g0[8], g1[8], cs[16]; ld8(seg, a); ld8(seg + 8, b); ld8(gn, g0); ld8(gn + 8, g1);
              ld8(tab + (size_t)pos * 80, *(float(*)[8])&cs[0]); ld8(tab + (size_t)pos * 80 + 8, *(float(*)[8])&cs[8]);
#pragma unroll
              for (int i = 0; i < 8; ++i) { const float x1 = a[i] * r * g0[i], x2 = b[i] * r * g1[i], c = cs[2 * i], sn = cs[2 * i + 1]; a[i] = x1 * c - x2 * sn; b[i] = x2 * c + x1 * sn; }
              st8_bf16(dst, a); st8_bf16(dst + 8, b); }
#pragma unroll 1
            for (int c = 2; c < 8; ++c) { float a[8], g0[8]; ld8(seg + 8 * c, a); ld8(gn + 8 * c, g0);
#pragma unroll
                for (int i = 0; i < 8; ++i) a[i] = a[i] * r * g0[i];
                st8_bf16(dst + 8 * c, a); }
        } else if (col0 >= ZC_GF && col0 < ZC_CQ) {
            const float* bb = gbias + (col0 - ZC_GF);
#pragma unroll 1
            for (int c = 0; c < 8; ++c) { float a[8], b[8]; ld8(seg + 8 * c, a); ld8(bb + 8 * c, b); unsigned short hb[8];
#pragma unroll
                for (int i = 0; i < 8; ++i) { const float x = a[i] * rstd + b[i]; const float ls = fminf(x, 0.f) - log1pf(__expf(-fabsf(x))); const _Float16 hv = (_Float16)(ls * 0.0625f); hb[i] = __builtin_bit_cast(unsigned short, hv); }
                u32x4 w; w.x = hb[0] | ((unsigned)hb[1] << 16); w.y = hb[2] | ((unsigned)hb[3] << 16); w.z = hb[4] | ((unsigned)hb[5] << 16); w.w = hb[6] | ((unsigned)hb[7] << 16);
                *(u32x4*)(dst + 8 * c) = w; }
        } else if (col0 >= ZC_CQ && col0 < ZC_CV) {
            const float sc = rstd * ((col0 >= ZC_CK) ? 0.125f : 1.0f);
            const float* cs0 = tab + (size_t)pos * 80 + 16;
#pragma unroll 1
            for (int c = 0; c < 4; ++c) { float a[8], b[8], cs[16]; ld8(seg + 8 * c, a); ld8(seg + 32 + 8 * c, b);
                ld8(cs0 + 16 * c, *(float(*)[8])&cs[0]); ld8(cs0 + 16 * c + 8, *(float(*)[8])&cs[8]);
#pragma unroll
                for (int i = 0; i < 8; ++i) { const float x1 = a[i] * sc, x2 = b[i] * sc, cc = cs[2 * i], sn = cs[2 * i + 1]; a[i] = x1 * cc - x2 * sn; b[i] = x2 * cc + x1 * sn; }
                st8_bf16(dst + 8 * c, a); st8_bf16(dst + 32 + 8 * c, b); }
        } else {
            const float sc = rstd * ((col0 >= ZC_BQ && col0 < ZC_BK) ? 0.17677669529663687f : 1.0f);
#pragma unroll 1
            for (int c = 0; c < 8; ++c) { float a[8]; ld8(seg + 8 * c, a);
#pragma unroll
                for (int i = 0; i < 8; ++i) a[i] *= sc;
                st8_bf16(dst + 8 * c, a); }
        }
    }
};

struct EpiRes {
    float* H; bf16_t* HB; float* ssq;
    __device__ __forceinline__ void operator()(const float* seg, int row, int col0) const {
        float* hp = H + (size_t)row * D + col0; bf16_t* hb = HB + (size_t)row * D + col0;
        float ss = 0.f;
#pragma unroll 1
        for (int c = 0; c < 8; ++c) { float a[8], h[8]; ld8(seg + 8 * c, a); ld8(hp + 8 * c, h);
#pragma unroll
            for (int i = 0; i < 8; ++i) { h[i] += a[i]; ss += h[i] * h[i]; }
            *(f32x4*)(hp + 8 * c) = (f32x4){h[0], h[1], h[2], h[3]}; *(f32x4*)(hp + 8 * c + 4) = (f32x4){h[4], h[5], h[6], h[7]};
            st8_bf16(hb + 8 * c, h); }
        ssq[(size_t)row * 16 + (col0 >> 6)] = ss;
    }
};

struct EpiMlpIn {
    bf16_t* HID; const float* ssq;
    __device__ __forceinline__ void operator()(const float* seg, int row, int col0) const {
        const float rstd = row_rstd(ssq, row);
        bf16_t* dst = HID + (size_t)row * DFF + col0;
#pragma unroll 1
        for (int c = 0; c < 8; ++c) { float a[8]; ld8(seg + 8 * c, a);
#pragma unroll
            for (int i = 0; i < 8; ++i) { const float x = fmaxf(a[i] * rstd, 0.f); a[i] = x * x; }
            st8_bf16(dst + 8 * c, a); }
    }
};

struct EpiPlain {
    bf16_t* O; int ldo;
    __device__ __forceinline__ void operator()(const float* seg, int row, int col0) const {
        bf16_t* dst = O + (size_t)row * ldo + col0;
#pragma unroll 1
        for (int c = 0; c < 8; ++c) { float a[8]; ld8(seg + 8 * c, a); st8_bf16(dst + 8 * c, a); }
    }
};

struct EpiPeGate {
    float* H; bf16_t* HB; float* ssq_out; const float* ssq_in; const bf16_t* PB;
    __device__ __forceinline__ void operator()(const float* seg, int row, int col0) const {
        const float rstd = row_rstd(ssq_in, row);
        float* hp = H + (size_t)row * D + col0; const bf16_t* pp = PB + (size_t)row * D + col0; bf16_t* hb = HB + (size_t)row * D + col0;
        float ss = 0.f;
#pragma unroll 1
        for (int c = 0; c < 8; ++c) { float a[8], h[8], pv[8]; ld8(seg + 8 * c, a); ld8(hp + 8 * c, h); unpack8(*(const bf16x8*)(pp + 8 * c), pv);
#pragma unroll
            for (int i = 0; i < 8; ++i) { const float gte = 1.0f / (1.0f + __expf(-a[i] * rstd)); h[i] += gte * pv[i]; ss += h[i] * h[i]; }
            *(f32x4*)(hp + 8 * c) = (f32x4){h[0], h[1], h[2], h[3]}; *(f32x4*)(hp + 8 * c + 4) = (f32x4){h[4], h[5], h[6], h[7]};
            st8_bf16(hb + 8 * c, h); }
        ssq_out[(size_t)row * 16 + (col0 >> 6)] = ss;
    }
};

template <class F>
__device__ __forceinline__ void transpose_item(bf16_t* Wt, int K, int k0, int n0, const F& src) {
    const int tid = opaque_tid();
    float* tile = (float*)g_lds;
#pragma unroll
    for (int i = 0; i < 8; ++i) { const int kk = (tid >> 6) + 8 * i, nn = tid & 63; tile[kk * 65 + nn] = src(k0 + kk, n0 + nn); }
    __syncthreads();
    { const int nn = tid >> 3, kc = tid & 7; float t[8];
#pragma unroll
      for (int j = 0; j < 8; ++j) t[j] = tile[(8 * kc + j) * 65 + nn];
      *(bf16x8*)(Wt + (size_t)(n0 + nn) * K + k0 + 8 * kc) = pack8(t); }
    __syncthreads();
}

__device__ __forceinline__ void phase_weights(const Params& p) {
    bf16_t* WT = (bf16_t*)(p.ws + WS_WT);
    constexpr int I_IN = 16 * (ZW / 64), I_OUT = 16 * 16, I_MI = 16 * 64, I_MO = 64 * 16, I_PG = 16 * 16, I_PP = 4 * 16;
    constexpr int I_L = I_IN + I_OUT + I_MI + I_MO + I_PG + I_PP;
    for (int it = blockIdx.x; it < NLAYER * I_L; it += gridDim.x) {
        const int l = it / I_L; int r = it % I_L;
        bf16_t* W = WT + (size_t)l * W_LAYER;
        if (r < I_IN) {
            const int kb = r / (ZW / 64), nb = r % (ZW / 64);
            const float* w = p.w_in + (size_t)l * D * NIN; const float* g = p.ln_mix + l * D; const float* gu = p.gla_gate_up + (size_t)l * 2 * 16 * 128;
            transpose_item(W + WO_IN, D, kb * 64, nb * 64, [&](int k, int c) -> float {
                float v;
                if (c < ZC_GF) v = w[(size_t)k * NIN + c];
                else if (c < ZC_CQ) { const int j = (c - ZC_GF) >> 7, kk = (c - ZC_GF) & 127; float s = 0.f;
                    for (int rr = 0; rr < 16; ++rr) s += w[(size_t)k * NIN + 2304 + 16 * j + rr] * gu[(j * 16 + rr) * 128 + kk];
                    v = s; }
                else v = w[(size_t)k * NIN + (c - 224)];
                return v * g[k]; });
            continue; }
        r -= I_IN;
        if (r < I_OUT) { const float* w = p.w_out + (size_t)l * D * D;
            transpose_item(W + WO_OUT, D, (r / 16) * 64, (r % 16) * 64, [&](int k, int c) -> float { return w[(size_t)k * D + c]; }); continue; }
        r -= I_OUT;
        if (r < I_MI) { const float* w = p.w_mlp_in + (size_t)l * D * DFF; const float* g = p.ln_mlp + l * D;
            transpose_item(W + WO_MI, D, (r / 64) * 64, (r % 64) * 64, [&](int k, int c) -> float { return w[(size_t)k * DFF + c] * g[k]; }); continue; }
        r -= I_MI;
        if (r < I_MO) { const float* w = p.w_mlp_out + (size_t)l * DFF * D;
            transpose_item(W + WO_MO, DFF, (r / 16) * 64, (r % 16) * 64, [&](int k, int c) -> float { return w[(size_t)k * D + c]; }); continue; }
        r -= I_MO;
        if (r < I_PG) { const float* w = p.w_pe_gate + (size_t)l * D * D; const float* g = p.ln_pe + l * D;
            transpose_item(W + WO_PG, D, (r / 16) * 64, (r % 16) * 64, [&](int k, int c) -> float { return w[(size_t)k * D + c] * g[k]; }); continue; }
        r -= I_PG;
        { const float* w = p.w_pe_proj + (size_t)l * PLE * D;
            transpose_item(W + WO_PP, PLE, (r / 16) * 64, (r % 16) * 64, [&](int k, int c) -> float { return w[(size_t)k * D + c]; }); }
    }
    float* tab = (float*)(p.ws + WS_TAB);
    for (int e = blockIdx.x * NTHR + threadIdx.x; e < 16384 * 40; e += gridDim.x * NTHR) {
        const int pos = e / 40, i = e % 40;
        const double invf = (i < 8) ? exp(-(double)i * (log(500000.0) / 8.0)) : exp(-(double)(i - 8) * (log(10000.0) / 32.0));
        double ang = (double)pos * invf; ang -= 6.283185307179586476925 * floor(ang * 0.15915494309189533577);
        tab[2 * e] = (float)cos(ang); tab[2 * e + 1] = (float)sin(ang);
    }
}

__device__ __forceinline__ void phase_init(const Params& p, int g) {
    const int tid = opaque_tid();
    const float* x = (g == 0) ? p.x_prompt : p.x_sample + (size_t)(g - 1) * MG * D;
    float* H = p.out + (size_t)g * MG * D; bf16_t* HB = (bf16_t*)(p.ws + WS_HB); float* ssq = (float*)(p.ws + WS_SSQ);
    const int lane = tid & 63, gw = blockIdx.x * 8 + (tid >> 6), NGW = gridDim.x * 8;
    for (int row = gw; row < MG; row += NGW) {
#pragma unroll
        for (int j = 0; j < 4; ++j) {
            const f32x4 v = *(const f32x4*)(x + (size_t)row * D + 256 * j + 4 * lane);
            *(f32x4*)(H + (size_t)row * D + 256 * j + 4 * lane) = v;
            u32x2 w; w.x = cvt_pk_bf16(v.x, v.y); w.y = cvt_pk_bf16(v.z, v.w);
            *(u32x2*)(HB + (size_t)row * D + 256 * j + 4 * lane) = w;
            float s = (v.x * v.x + v.y * v.y) + (v.z * v.z + v.w * v.w);
            s += __shfl_xor(s, 1); s += __shfl_xor(s, 2); s += __shfl_xor(s, 4); s += __shfl_xor(s, 8);
            if ((lane & 15) == 0) ssq[(size_t)row * 16 + (lane >> 4) + 4 * j] = s;
        }
    }
    bf16_t* PL = (bf16_t*)(p.ws + WS_PLE);
    for (int l = 0; l < NLAYER; ++l) {
        const float* src = (g == 0) ? p.p_prompt + (size_t)l * MG * PLE : p.p_sample + ((size_t)l * 2 * MG + (size_t)(g - 1) * MG) * PLE;
        bf16_t* dst = PL + (size_t)l * MG * PLE;
        for (size_t e = (size_t)(blockIdx.x * NTHR + tid) * 8; e < (size_t)MG * PLE; e += (size_t)gridDim.x * NTHR * 8)
            *(bf16x8*)(dst + e) = ld8f_pack(src + e);
    }
}

__device__ __forceinline__ void attn_item(const bf16_t* __restrict__ Z, bf16_t* __restrict__ MIX, int S, int it) {
    const int tid = opaque_tid();
    const int wave = tid >> 6, lane = tid & 63, qi = lane & 15, g = lane >> 4;
    const int nbs = S >> 8;
    const int rhalf = it & 1; int t1 = it >> 1; const int nb = t1 % nbs; t1 /= nbs; const int head = t1 & 7, seq = t1 >> 3;
    const int r = rhalf * 8 + wave, n0 = nb * 16;
    const bf16_t* zq = Z + (size_t)seq * S * ZW;
    bf16_t* Vs = (bf16_t*)g_lds + wave * (32 * 68);
    const int pq = r + 16 * (n0 + qi);
    const bf16x8 q0 = *(const bf16x8*)(zq + (size_t)pq * ZW + ZC_AQ + head * 64 + 8 * g);
    const bf16x8 q1 = *(const bf16x8*)(zq + (size_t)pq * ZW + ZC_AQ + head * 64 + 32 + 8 * g);
    float m = -1e30f, lsum = 0.f;
    f32x4 O[4] = {};
#pragma unroll 1
    for (int p = 0; p < 3; ++p) {
        const int dsh = 2 * p, step = 16 >> dsh;
        const int rd = r & ((1 << dsh) - 1), c0 = (r >> dsh) + step * n0, ncls = S >> dsh, cq = c0 + step * qi;
        const int nit = (p == 0) ? 12 : (p == 1 ? 6 : 5);
#pragma unroll 1
        for (int i2 = 0; i2 < nit; ++i2) {
            const int cb = c0 - 64 + 32 * i2;
            const int cA = cb + 8 * (qi >> 2) + (qi & 3), cB = cA + 4;
            const int cAc = min(max(cA, 0), ncls - 1), cBc = min(max(cB, 0), ncls - 1);
            const bf16_t* kA = zq + (size_t)(rd + (cAc << dsh)) * ZW + ZC_AK + head * 64 + 8 * g;
            const bf16_t* kB = zq + (size_t)(rd + (cBc << dsh)) * ZW + ZC_AK + head * 64 + 8 * g;
            const bf16x8 ka0 = *(const bf16x8*)kA, ka1 = *(const bf16x8*)(kA + 32), kb0 = *(const bf16x8*)kB, kb1 = *(const bf16x8*)(kB + 32);
            u32x4 vreg[4];
#pragma unroll
            for (int ps = 0; ps < 4; ++ps) { const int cv = min(max(cb + (lane >> 3) + 8 * ps, 0), ncls - 1);
                vreg[ps] = *(const u32x4*)(zq + (size_t)(rd + (cv << dsh)) * ZW + ZC_AV + head * 64 + 8 * (lane & 7)); }
            f32x4 sA = {0.f, 0.f, 0.f, 0.f}, sB = {0.f, 0.f, 0.f, 0.f};
            sA = MFMA16(ka0, q0, sA); sA = MFMA16(ka1, q1, sA);
            sB = MFMA16(kb0, q0, sB); sB = MFMA16(kb1, q1, sB);
            LDS_FENCE();
#pragma unroll
            for (int ps = 0; ps < 4; ++ps) { bf16_t* d = Vs + ((lane >> 3) + 8 * ps) * 68 + 8 * (lane & 7);
                *(u32x2*)d = (u32x2){vreg[ps].x, vreg[ps].y}; *(u32x2*)(d + 4) = (u32x2){vreg[ps].z, vreg[ps].w}; }
            float s[8]; bool ok[8];
#pragma unroll
            for (int j = 0; j < 8; ++j) { const int c = cb + 8 * g + j; const int dd = c - cq;
                ok[j] = (c >= 0) && (c < ncls) && (dd <= 64) && (dd >= -64);
                s[j] = ok[j] ? (j < 4 ? sA[j] : sB[j - 4]) : -1e30f; }
            float mx = fmaxf(fmaxf(fmaxf(s[0], s[1]), fmaxf(s[2], s[3])), fmaxf(fmaxf(s[4], s[5]), fmaxf(s[6], s[7])));
            mx = fmaxf(mx, __shfl_xor(mx, 16)); mx = fmaxf(mx, __shfl_xor(mx, 32));
            const float mn = fmaxf(m, mx), alpha = __expf(m - mn);
            m = mn;
            float pj[8], ps_ = 0.f;
#pragma unroll
            for (int j = 0; j < 8; ++j) { pj[j] = ok[j] ? __expf(s[j] - mn) : 0.f; ps_ += pj[j]; }
            lsum = lsum * alpha + ps_;
            const bf16x8 P = pack8(pj);
#pragma unroll
            for (int nbk = 0; nbk < 4; ++nbk) O[nbk] *= alpha;
            LDS_FENCE();
#pragma unroll
            for (int nbk = 0; nbk < 4; ++nbk) { const bf16x8 vf = gather8(Vs + (8 * g) * 68 + 16 * nbk + qi, 68); O[nbk] = MFMA16(vf, P, O[nbk]); }
        }
    }
    lsum += __shfl_xor(lsum, 16); lsum += __shfl_xor(lsum, 32);
    const float inv = 1.0f / lsum;
    bf16_t* op = MIX + ((size_t)seq * S + pq) * D + head * 64 + 4 * g;
#pragma unroll
    for (int nbk = 0; nbk < 4; ++nbk) { u32x2 w; w.x = cvt_pk_bf16(O[nbk].x * inv, O[nbk].y * inv); w.y = cvt_pk_bf16(O[nbk].z * inv, O[nbk].w * inv); *(u32x2*)(op + 16 * nbk) = w; }
    LDS_FENCE();
}

__device__ __forceinline__ float h2f(unsigned short b) { return (float)__builtin_bit_cast(_Float16, b); }

__device__ __forceinline__ void stage_v4(const bf16_t* __restrict__ Z, size_t tok0, int zc, bf16_t* Vt, int nrows) {
    const int tid = opaque_tid();
    for (int idx = tid; idx < nrows * 32; idx += NTHR) {
        const int t = idx >> 5, ch = idx & 31, hh = ch >> 3, c8 = ch & 7;
        const u32x4 v = *(const u32x4*)(Z + (tok0 + t) * ZW + zc + ch * 8);
        bf16_t* d = Vt + ((size_t)hh * nrows + t) * 68 + c8 * 8;
        *(u32x2*)d = (u32x2){v.x, v.y}; *(u32x2*)(d + 4) = (u32x2){v.z, v.w};
    }
}

__device__ __forceinline__ void gla_cum(const bf16_t* __restrict__ Z, size_t tok0, int h, int dir, int lane, float (&cum)[32], float& tot) {
    const int kk = lane & 31, hf = lane >> 5;
    const bf16_t* src = Z + (tok0 + 32 * hf) * ZW + ZC_GF + dir * 128 + h * 32 + kk;
    float part = 0.f;
#pragma unroll
    for (int i = 0; i < 32; ++i) { cum[i] = h2f(src[(size_t)i * ZW]); part += cum[i]; }
    const float other = __shfl_xor(part, 32);
    tot = part + other;
    if (dir == 0) { float run = hf ? other : 0.f;
#pragma unroll
        for (int i = 0; i < 32; ++i) { run += cum[i]; cum[i] = run; } }
    else { float run = hf ? 0.f : other;
#pragma unroll
        for (int i = 31; i >= 0; --i) { run += cum[i]; cum[i] = run; } }
}

__device__ __forceinline__ void gla1_item(const bf16_t* __restrict__ Z, float* __restrict__ GS, float* __restrict__ GD, int ci) {
    const int tid = opaque_tid();
    __syncthreads();
    const int wave = tid >> 6, lane = tid & 63, qi = lane & 15, g = lane >> 4;
    const int h = wave >> 1, dir = wave & 1;
    const size_t tok0 = (size_t)ci * 64;
    bf16_t* Vt = (bf16_t*)g_lds;
    bf16_t* Ks = (bf16_t*)g_lds + 4 * 64 * 68 + wave * (64 * 36);
    stage_v4(Z, tok0, ZC_BV, Vt, 64);
    float cum[32], tot;
    gla_cum(Z, tok0, h, dir, lane, cum, tot);
    { const int kk = lane & 31, hf = lane >> 5;
      const bf16_t* ksrc = Z + (tok0 + 32 * hf) * ZW + ZC_BK + h * 32 + kk;
#pragma unroll
      for (int i = 0; i < 32; ++i) { const float kv = bf2f(ksrc[(size_t)i * ZW]) * __expf(tot - cum[i]);
          Ks[(32 * hf + i) * 36 + kk] = (bf16_t)(cvt_pk_bf16(kv, 0.f) & 0xffffu); }
      if (hf == 0) GD[(((size_t)dir * NCH + ci) * 4 + h) * 32 + kk] = __expf(tot); }
    __syncthreads();
    f32x4 acc[4][2] = {};
#pragma unroll
    for (int ks = 0; ks < 2; ++ks) {
        bf16x8 bfr[2];
#pragma unroll
        for (int kb = 0; kb < 2; ++kb) bfr[kb] = gather8(Ks + (32 * ks + 8 * g) * 36 + 16 * kb + qi, 36);
#pragma unroll
        for (int eb = 0; eb < 4; ++eb) { const bf16x8 af = gather8(Vt + ((size_t)h * 64 + 32 * ks + 8 * g) * 68 + 16 * eb + qi, 68);
#pragma unroll
            for (int kb = 0; kb < 2; ++kb) acc[eb][kb] = MFMA16(af, bfr[kb], acc[eb][kb]); }
    }
    float* dst = GS + (((size_t)dir * NCH + ci) * 4 + h) * 2048;
#pragma unroll
    for (int eb = 0; eb < 4; ++eb)
#pragma unroll
        for (int kb = 0; kb < 2; ++kb)
#pragma unroll
            for (int i = 0; i < 4; ++i) dst[(16 * eb + 4 * g + i) * 32 + 16 * kb + qi] = acc[eb][kb][i];
    __syncthreads();
}

__device__ __forceinline__ void gla3_item(const bf16_t* __restrict__ Z, const float* __restrict__ GS, bf16_t* __restrict__ MIX, const float* __restrict__ gnorm, int ci) {
    const int tid = opaque_tid();
    __syncthreads();
    const int wave = tid >> 6, lane = tid & 63, qi = lane & 15, g = lane >> 4;
    const size_t tok0 = (size_t)ci * 64;
    bf16_t* Vt = (bf16_t*)g_lds;
    float* CUM = (float*)(g_lds + 4 * 64 * 68 * 2);
    stage_v4(Z, tok0, ZC_BV, Vt, 64);
    { const int h = wave >> 1, dir = wave & 1; float cum[32], tot;
      gla_cum(Z, tok0, h, dir, lane, cum, tot);
      const int kk = lane & 31, hf = lane >> 5; float* cd = CUM + ((size_t)(h * 2 + dir) * 64 + 32 * hf) * 32 + kk;
#pragma unroll
      for (int i = 0; i < 32; ++i) cd[i * 32] = cum[i]; }
    __syncthreads();
    const int h = wave >> 1;
    const float* cF = CUM + (size_t)(h * 2 + 0) * 64 * 32; const float* cB = CUM + (size_t)(h * 2 + 1) * 64 * 32;
#pragma unroll 1
    for (int tbi = 0; tbi < 2; ++tbi) {
        const int t = 16 * (2 * (wave & 1) + tbi) + qi;
        bf16x8 Qf, Qb;
        { float qv[8], a[8], b[8]; unpack8(*(const bf16x8*)(Z + (tok0 + t) * ZW + ZC_BQ + h * 32 + 8 * g), qv);
#pragma unroll
          for (int j = 0; j < 8; ++j) { a[j] = qv[j] * __expf(cF[t * 32 + 8 * g + j]); b[j] = qv[j] * __expf(cB[t * 32 + 8 * g + j]); }
          Qf = pack8(a); Qb = pack8(b); }
        f32x4 acc[4] = {};
        const float* sF = GS + (((size_t)0 * NCH + ci) * 4 + h) * 2048; const float* sB = GS + (((size_t)1 * NCH + ci) * 4 + h) * 2048;
#pragma unroll
        for (int eb = 0; eb < 4; ++eb) { acc[eb] = MFMA16(ld8f_pack(sF + (16 * eb + qi) * 32 + 8 * g), Qf, acc[eb]); acc[eb] = MFMA16(ld8f_pack(sB + (16 * eb + qi) * 32 + 8 * g), Qb, acc[eb]); }
#pragma unroll
        for (int sg = 0; sg < 2; ++sg) {
            f32x4 aF[2], aB[2];
#pragma unroll
            for (int blk = 0; blk < 2; ++blk) {
                const int s = 32 * sg + 8 * (qi >> 2) + (qi & 3) + 4 * blk;
                float kv[8], a[8], b[8]; unpack8(*(const bf16x8*)(Z + (tok0 + s) * ZW + ZC_BK + h * 32 + 8 * g), kv);
#pragma unroll
                for (int j = 0; j < 8; ++j) { a[j] = kv[j] * __expf(-cF[s * 32 + 8 * g + j]); b[j] = kv[j] * __expf(-cB[s * 32 + 8 * g + j]); }
                const f32x4 z4 = {0.f, 0.f, 0.f, 0.f};
                aF[blk] = MFMA16(pack8(a), Qf, z4); aB[blk] = MFMA16(pack8(b), Qb, z4);
            }
            float pj[8];
#pragma unroll
            for (int j = 0; j < 8; ++j) { const int s = 32 * sg + 8 * g + j; pj[j] = (s <= t) ? (j < 4 ? aF[0][j] : aF[1][j - 4]) : (j < 4 ? aB[0][j] : aB[1][j - 4]); }
            const bf16x8 P = pack8(pj);
#pragma unroll
            for (int eb = 0; eb < 4; ++eb) acc[eb] = MFMA16(gather8(Vt + ((size_t)h * 64 + 32 * sg + 8 * g) * 68 + 16 * eb + qi, 68), P, acc[eb]);
        }
        float ss = 0.f;
#pragma unroll
        for (int eb = 0; eb < 4; ++eb) ss += (acc[eb].x * acc[eb].x + acc[eb].y * acc[eb].y) + (acc[eb].z * acc[eb].z + acc[eb].w * acc[eb].w);
        ss += __shfl_xor(ss, 16); ss += __shfl_xor(ss, 32);
        const float rn = rsqrtf(ss * (1.0f / 64) + EPS);
#pragma unroll
        for (int eb = 0; eb < 4; ++eb) { const int e = 16 * eb + 4 * g;
            const u32x2 brw = *(const u32x2*)(Z + (tok0 + t) * ZW + ZC_BR + h * 64 + e);
            const f32x4 gn = *(const f32x4*)(gnorm + h * 64 + e);
            const float b0 = bflo(brw.x), b1 = bfhi(brw.x), b2 = bflo(brw.y), b3 = bfhi(brw.y);
            const float o0 = acc[eb].x * rn * gn.x * (b0 / (1.f + __expf(-b0))), o1 = acc[eb].y * rn * gn.y * (b1 / (1.f + __expf(-b1)));
            const float o2 = acc[eb].z * rn * gn.z * (b2 / (1.f + __expf(-b2))), o3 = acc[eb].w * rn * gn.w * (b3 / (1.f + __expf(-b3)));
            u32x2 w; w.x = cvt_pk_bf16(o0, o1); w.y = cvt_pk_bf16(o2, o3);
            *(u32x2*)(MIX + (tok0 + t) * D + 512 + h * 64 + e) = w; }
    }
    __syncthreads();
}

__device__ __forceinline__ void ret1_item(const bf16_t* __restrict__ Z, float* __restrict__ RS, const float* __restrict__ lgam, int item) {
    const int tid = opaque_tid();
    __syncthreads();
    const int wave = tid >> 6, lane = tid & 63, qi = lane & 15, g = lane >> 4;
    const int ci = item >> 1, hp = item & 1;
    const size_t tok0 = (size_t)ci * 128;
    bf16_t* Vt = (bf16_t*)g_lds;
    bf16_t* Kt = Vt + 2 * 128 * 68;
    for (int idx = tid; idx < 128 * 16 * 2; idx += NTHR) {
        const int which = idx >> 11, r = idx & 2047, t = r >> 4, ch = r & 15, hh = ch >> 3, c8 = ch & 7;
        const u32x4 v = *(const u32x4*)(Z + (tok0 + t) * ZW + (which ? ZC_CK : ZC_CV) + hp * 128 + ch * 8);
        bf16_t* d = (which ? Kt : Vt) + ((size_t)hh * 128 + t) * 68 + c8 * 8;
        *(u32x2*)d = (u32x2){v.x, v.y}; *(u32x2*)(d + 4) = (u32x2){v.z, v.w};
    }
    __syncthreads();
    const int hh = wave >> 2, dir = (wave >> 1) & 1, eh = wave & 1, head = 2 * hp + hh;
    const float lg = lgam[dir * 4 + head];
    f32x4 acc[2][4] = {};
#pragma unroll 1
    for (int ks = 0; ks < 4; ++ks) {
        float w[8];
#pragma unroll
        for (int j = 0; j < 8; ++j) { const int s = 32 * ks + 8 * g + j; w[j] = __expf(lg * (float)(dir ? s : 127 - s)); }
        bf16x8 bfr[4];
#pragma unroll
        for (int db = 0; db < 4; ++db) { float kv[8]; unpack8(gather8(Kt + ((size_t)hh * 128 + 32 * ks + 8 * g) * 68 + 16 * db + qi, 68), kv);
#pragma unroll
            for (int j = 0; j < 8; ++j) kv[j] *= w[j];
            bfr[db] = pack8(kv); }
#pragma unroll
        for (int ebi = 0; ebi < 2; ++ebi) { const bf16x8 af = gather8(Vt + ((size_t)hh * 128 + 32 * ks + 8 * g) * 68 + 16 * (2 * eh + ebi) + qi, 68);
#pragma unroll
            for (int db = 0; db < 4; ++db) acc[ebi][db] = MFMA16(af, bfr[db], acc[ebi][db]); }
    }
    float* dst = RS + (((size_t)dir * NCR + ci) * 4 + head) * 4096;
#pragma unroll
    for (int ebi = 0; ebi < 2; ++ebi)
#pragma unroll
        for (int db = 0; db < 4; ++db)
#pragma unroll
            for (int i = 0; i < 4; ++i) dst[(16 * (2 * eh + ebi) + 4 * g + i) * 64 + 16 * db + qi] = acc[ebi][db][i];
    __syncthreads();
}

__device__ __forceinline__ void ret3_item(const bf16_t* __restrict__ Z, const float* __restrict__ RS, bf16_t* __restrict__ MIX, const float* __restrict__ rnorm, const float* __restrict__ lgam, int ci) {
    const int tid = opaque_tid();
    __syncthreads();
    const int wave = tid >> 6, lane = tid & 63, qi = lane & 15, g = lane >> 4;
    const size_t tok0 = (size_t)ci * 128;
    bf16_t* Vt = (bf16_t*)g_lds;
    stage_v4(Z, tok0, ZC_CV, Vt, 128);
    __syncthreads();
    const int h = wave >> 1;
    const float lg0 = lgam[h], lg1 = lgam[4 + h];
    const float* rF = RS + (((size_t)0 * NCR + ci) * 4 + h) * 4096; const float* rB = RS + (((size_t)1 * NCR + ci) * 4 + h) * 4096;
#pragma unroll 1
    for (int tbi = 0; tbi < 4; ++tbi) {
        const int t = 16 * (4 * (wave & 1) + tbi) + qi;
        const bf16_t* qp = Z + (tok0 + t) * ZW + ZC_CQ + h * 64 + 8 * g;
        const bf16x8 q0 = *(const bf16x8*)qp, q1 = *(const bf16x8*)(qp + 32);
        f32x4 aI[4] = {}, aF[4] = {}, aB[4] = {};
#pragma unroll
        for (int eb = 0; eb < 4; ++eb) {
            const float* pf = rF + (16 * eb + qi) * 64 + 8 * g; const float* pb = rB + (16 * eb + qi) * 64 + 8 * g;
            aF[eb] = MFMA16(ld8f_pack(pf), q0, aF[eb]); aF[eb] = MFMA16(ld8f_pack(pf + 32), q1, aF[eb]);
            aB[eb] = MFMA16(ld8f_pack(pb), q0, aB[eb]); aB[eb] = MFMA16(ld8f_pack(pb + 32), q1, aB[eb]);
        }
#pragma unroll 1
        for (int sg = 0; sg < 4; ++sg) {
            f32x4 sc[2];
#pragma unroll
            for (int blk = 0; blk < 2; ++blk) {
                const int s = 32 * sg + 8 * (qi >> 2) + (qi & 3) + 4 * blk;
                const bf16_t* kp = Z + (tok0 + s) * ZW + ZC_CK + h * 64 + 8 * g;
                f32x4 z4 = {0.f, 0.f, 0.f, 0.f};
                z4 = MFMA16(*(const bf16x8*)kp, q0, z4); z4 = MFMA16(*(const bf16x8*)(kp + 32), q1, z4); sc[blk] = z4;
            }
            float pj[8];
#pragma unroll
            for (int j = 0; j < 8; ++j) { const int s = 32 * sg + 8 * g + j; const int dd = t - s;
                const float dec = (dd >= 0) ? __expf(lg0 * (float)dd) : __expf(lg1 * (float)(-dd));
                pj[j] = (j < 4 ? sc[0][j] : sc[1][j - 4]) * dec; }
            const bf16x8 P = pack8(pj);
#pragma unroll
            for (int eb = 0; eb < 4; ++eb) aI[eb] = MFMA16(gather8(Vt + ((size_t)h * 128 + 32 * sg + 8 * g) * 68 + 16 * eb + qi, 68), P, aI[eb]);
        }
        const float wf = __expf(lg0 * (float)(t + 1)), wb = __expf(lg1 * (float)(128 - t));
        float ss = 0.f;
#pragma unroll
        for (int eb = 0; eb < 4; ++eb) { aI[eb] = aI[eb] + aF[eb] * wf + aB[eb] * wb;
            ss += (aI[eb].x * aI[eb].x + aI[eb].y * aI[eb].y) + (aI[eb].z * aI[eb].z + aI[eb].w * aI[eb].w); }
        ss += __shfl_xor(ss, 16); ss += __shfl_xor(ss, 32);
        const float rn = rsqrtf(ss * (1.0f / 64) + EPS);
#pragma unroll
        for (int eb = 0; eb < 4; ++eb) { const int e = 16 * eb + 4 * g;
            const u32x2 gw = *(const u32x2*)(Z + (tok0 + t) * ZW + ZC_CG + h * 64 + e);
            const f32x4 gn = *(const f32x4*)(rnorm + h * 64 + e);
            const float b0 = bflo(gw.x), b1 = bfhi(gw.x), b2 = bflo(gw.y), b3 = bfhi(gw.y);
            const float o0 = aI[eb].x * rn * gn.x * (b0 / (1.f + __expf(-b0))), o1 = aI[eb].y * rn * gn.y * (b1 / (1.f + __expf(-b1)));
            const float o2 = aI[eb].z * rn * gn.z * (b2 / (1.f + __expf(-b2))), o3 = aI[eb].w * rn * gn.w * (b3 / (1.f + __expf(-b3)));
            u32x2 w; w.x = cvt_pk_bf16(o0, o1); w.y = cvt_pk_bf16(o2, o3);
            *(u32x2*)(MIX + (tok0 + t) * D + 768 + h * 64 + e) = w; }
    }
    __syncthreads();
}

__device__ __forceinline__ void phase_scan(float* __restrict__ GS, const float* __restrict__ GD, float* __restrict__ RS, const float* __restrict__ lgam, int S) {
    const int tid = opaque_tid();
    const int nseq = MG / S, ncg = S / 64, ncr = S / 128;
    const int gtid = blockIdx.x * NTHR + tid, gth = gridDim.x * NTHR;
    const int n_gla = 2 * nseq * 4 * 2048, n_ret = 2 * nseq * 4 * 4096;
    for (int idx = gtid; idx < n_gla + n_ret; idx += gth) {
        if (idx < n_gla) {
            const int el = idx & 2047, hh = (idx >> 11) & 3, sq = (idx >> 13) % nseq, dir = (idx >> 13) / nseq, kk = el & 31;
            float st = 0.f;
#pragma unroll 8
            for (int i = 0; i < ncg; ++i) { const int c = dir ? ncg - 1 - i : i; const size_t cgi = (size_t)sq * ncg + c;
                float* a = GS + (((size_t)dir * NCH + cgi) * 4 + hh) * 2048 + el; const float dec = GD[(((size_t)dir * NCH + cgi) * 4 + hh) * 32 + kk];
                const float tmp = *a; *a = st; st = dec * st + tmp; }
        } else {
            const int j = idx - n_gla; const int el = j & 4095, hh = (j >> 12) & 3, sq = (j >> 14) % nseq, dir = (j >> 14) / nseq;
            const float dec = __expf(128.f * lgam[dir * 4 + hh]);
            float st = 0.f;
#pragma unroll 8
            for (int i = 0; i < ncr; ++i) { const int c = dir ? ncr - 1 - i : i; const size_t cgi = (size_t)sq * ncr + c;
                float* a = RS + (((size_t)dir * NCR + cgi) * 4 + hh) * 4096 + el;
                const float tmp = *a; *a = st; st = dec * st + tmp; }
        }
    }
}

__global__ void __launch_bounds__(NTHR, 2) fwd_mega(Params p) {
    cg::grid_group grid = cg::this_grid();
    unsigned char* ws = p.ws;
    bf16_t* WT = (bf16_t*)(ws + WS_WT); const float* tab = (const float*)(ws + WS_TAB);
    bf16_t* HB0 = (bf16_t*)(ws + WS_HB); bf16_t* HB1 = (bf16_t*)(ws + WS_HB1);
    float* SSQ0 = (float*)(ws + WS_SSQ); float* SSQ1 = SSQ0 + (size_t)MG * 16; float* SSQ2 = SSQ1 + (size_t)MG * 16;
    bf16_t* Z = (bf16_t*)(ws + WS_Z); bf16_t* MIX = (bf16_t*)(ws + WS_MIX); bf16_t* HID = (bf16_t*)(ws + WS_HID);
    bf16_t* PB = (bf16_t*)(ws + WS_PB); bf16_t* PL = (bf16_t*)(ws + WS_PLE);
    float* GS = (float*)(ws + WS_GS); float* GD = (float*)(ws + WS_GD); float* RS = (float*)(ws + WS_RS);
    float* lgam = (float*)(g_lds + LDS_BYTES - 64);

#ifndef NO_P0
    phase_weights(p);
#endif
    grid.sync();
#pragma unroll 1
    for (int g = 0; g < NGROUPS; ++g) {
        const int S = (g == 0) ? 16384 : 2048;
        float* H = p.out + (size_t)g * MG * D;
#ifndef NO_PI
        phase_init(p, g);
#endif
        grid.sync();
#pragma unroll 1
        for (int l = 0; l < NLAYER; ++l) {
            const bf16_t* W = WT + (size_t)l * W_LAYER;
            { const int t8 = opaque_tid(); if (t8 < 8) { const float x = p.ret_decay_raw[l * 8 + t8]; lgam[t8] = fminf(x, 0.f) - log1pf(__expf(-fabsf(x))); } }
            __syncthreads();
            { EpiIn e{Z, SSQ0, p.attn_q_norm + l * 64, p.attn_k_norm + l * 64, p.gla_gate_bias + l * 256, tab, S - 1};
#ifndef NO_P1
              gemm_phase(HB0, D, W + WO_IN, D, MG, ZW, D, e);
#endif
 }
            grid.sync();
            { const int nA = 2048, nG = NCH, nR = 2 * NCR;
              for (int it = blockIdx.x; it < nA + nG + nR; it += gridDim.x) {
#ifndef NO_AT
                  if (it < nA) attn_item(Z, MIX, S, it);
#endif
#ifndef NO_G1
                  if (it >= nA && it < nA + nG) gla1_item(Z, GS, GD, it - nA);
#endif
#ifndef NO_R1
                  if (it >= nA + nG) ret1_item(Z, RS, lgam, it - nA - nG);
#endif
              } }
            grid.sync();
#ifndef NO_P3
            phase_scan(GS, GD, RS, lgam, S);
#endif
            grid.sync();
            { for (int it = blockIdx.x; it < NCH + NCR; it += gridDim.x) {
#ifndef NO_G3
                  if (it < NCH) gla3_item(Z, GS, MIX, p.gla_out_norm + l * 256, it);
#endif
#ifndef NO_R3
                  if (it >= NCH) ret3_item(Z, RS, MIX, p.ret_out_norm + l * 256, lgam, it - NCH);
#endif
              } }
            grid.sync();
#ifndef NO_P5
            { EpiRes e{H, HB1, SSQ1}; gemm_phase(MIX, D, W + WO_OUT, D, MG, D, D, e); }
#endif
            grid.sync();
#ifndef NO_P6
            { EpiMlpIn e{HID, SSQ1}; gemm_phase(HB1, D, W + WO_MI, D, MG, DFF, D, e); }
#endif
#ifndef NO_P6B
            { EpiPlain e{PB, D}; gemm_phase(PL + (size_t)l * MG * PLE, PLE, W + WO_PP, PLE, MG, D, PLE, e); }
#endif
            grid.sync();
#ifndef NO_P7
            { EpiRes e{H, HB1, SSQ2}; gemm_phase(HID, DFF, W + WO_MO, DFF, MG, D, DFF, e); }
#endif
            grid.sync();
#ifndef NO_P9
            { EpiPeGate e{H, HB0, SSQ0, SSQ2, PB}; gemm_phase(HB1, D, W + WO_PG, D, MG, D, D, e); }
#endif
            grid.sync();
        }
    }
}

extern "C" void kernel_launch(void* const* d_in, const int* in_sizes, int n_in, void* d_out, int out_size, void* d_ws, size_t ws_size, hipStream_t stream) {
    static int grid_blocks = 0;
    if (!grid_blocks) {
        int dev = 0, cus = 0, per_cu = 0;
        hipGetDevice(&dev);
        hipDeviceGetAttribute(&cus, hipDeviceAttributeMultiprocessorCount, dev);
        hipFuncSetAttribute((const void*)fwd_mega, hipFuncAttributeMaxDynamicSharedMemorySize, LDS_BYTES);
        hipOccupancyMaxActiveBlocksPerMultiprocessor(&per_cu, (const void*)fwd_mega, NTHR, LDS_BYTES);
        if (per_cu < 1) per_cu = 1;
        grid_blocks = cus * 1;
        if (ws_size < WS_END) fprintf(stderr, "kernel_launch: workspace too small: %zu < %zu\n", ws_size, (size_t)WS_END);
    }
    Params p{};
    p.x_prompt = (const float*)d_in[0]; p.x_sample = (const float*)d_in[1]; p.p_prompt = (const float*)d_in[2]; p.p_sample = (const float*)d_in[3];
    p.ln_mix = (const float*)d_in[4]; p.w_in = (const float*)d_in[5]; p.attn_q_norm = (const float*)d_in[6]; p.attn_k_norm = (const float*)d_in[7];
    p.gla_gate_up = (const float*)d_in[8]; p.gla_gate_bias = (const float*)d_in[9]; p.gla_out_norm = (const float*)d_in[10]; p.ret_decay_raw = (const float*)d_in[11];
    p.ret_out_norm = (const float*)d_in[12]; p.w_out = (const float*)d_in[13]; p.ln_mlp = (const float*)d_in[14]; p.w_mlp_in = (const float*)d_in[15]; p.w_mlp_out = (const float*)d_in[16];
    p.ln_pe = (const float*)d_in[17]; p.w_pe_gate = (const float*)d_in[18]; p.w_pe_proj = (const float*)d_in[19];
    p.out = (float*)d_out; p.ws = (unsigned char*)d_ws;
    void* args[] = {&p};
    hipError_t e = hipLaunchCooperativeKernel((const void*)fwd_mega, dim3(grid_blocks), dim3(NTHR), args, LDS_BYTES, stream);
    if (e != hipSuccess) fprintf(stderr, "cooperative launch failed: %s (grid %d)\n", hipGetErrorString(e), grid_blocks);
}
```

```cpp
#include <hip/hip_runtime.h>
#include <hip/hip_cooperative_groups.h>
#include <cstdio>
#include <cstdint>
namespace cg = cooperative_groups;

typedef unsigned short bf16_t;
typedef short bf16x8 __attribute__((ext_vector_type(8)));
typedef float f32x4 __attribute__((ext_vector_type(4)));
typedef unsigned u32x4 __attribute__((ext_vector_type(4)));
typedef unsigned u32x2 __attribute__((ext_vector_type(2)));

constexpr int D = 1024, MG = 32768, NGROUPS = 3, NLAYER = 2;
constexpr int ZW = 3584, DFF = 4096, PLE = 256, NIN = 3360;
constexpr int NTHR = 512;
constexpr int NCH = MG / 64;
constexpr int NCR = MG / 128;
constexpr float EPS = 1e-6f;
constexpr int ZC_AQ = 0, ZC_AK = 512, ZC_AV = 1024, ZC_BQ = 1536, ZC_BK = 1664, ZC_BV = 1792, ZC_BR = 2048,
              ZC_GF = 2304, ZC_GB = 2432, ZC_CQ = 2560, ZC_CK = 2816, ZC_CV = 3072, ZC_CG = 3328;
constexpr size_t WO_IN = 0, WO_OUT = WO_IN + (size_t)ZW * D, WO_MI = WO_OUT + (size_t)D * D, WO_MO = WO_MI + (size_t)DFF * D,
                 WO_PG = WO_MO + (size_t)D * DFF, WO_PP = WO_PG + (size_t)D * D, W_LAYER = WO_PP + (size_t)D * PLE;
constexpr size_t WS_WT = 0;
constexpr size_t WS_TAB = WS_WT + W_LAYER * 2 * NLAYER;
constexpr size_t WS_HB = WS_TAB + (size_t)16384 * 40 * 2 * 4;
constexpr size_t WS_HB1 = WS_HB + (size_t)MG * D * 2;
constexpr size_t WS_SSQ = WS_HB1 + (size_t)MG * D * 2;
constexpr size_t WS_Z = WS_SSQ + (size_t)3 * MG * 16 * 4;
constexpr size_t WS_MIX = WS_Z + (size_t)MG * ZW * 2;
constexpr size_t WS_HID = WS_MIX + (size_t)MG * D * 2;
constexpr size_t WS_PB = WS_HID + (size_t)MG * DFF * 2;
constexpr size_t WS_PLE = WS_PB + (size_t)MG * D * 2;
constexpr size_t WS_GS = WS_PLE + (size_t)NLAYER * MG * PLE * 2;
constexpr size_t WS_GD = WS_GS + (size_t)2 * NCH * 4 * 2048 * 4;
constexpr size_t WS_RS = WS_GD + (size_t)2 * NCH * 4 * 32 * 4;
constexpr size_t WS_BAR = WS_RS + (size_t)2 * NCR * 4 * 4096 * 4;
constexpr size_t WS_END = WS_BAR + 16384;

constexpr int LDS_BYTES = 139264;

extern __shared__ __attribute__((aligned(16))) unsigned char g_lds[];

struct Params {
    const float* x_prompt; const float* x_sample; const float* p_prompt; const float* p_sample;
    const float* ln_mix; const float* w_in; const float* attn_q_norm; const float* attn_k_norm;
    const float* gla_gate_up; const float* gla_gate_bias; const float* gla_out_norm; const float* ret_decay_raw;
    const float* ret_out_norm; const float* w_out; const float* ln_mlp; const float* w_mlp_in; const float* w_mlp_out;
    const float* ln_pe; const float* w_pe_gate; const float* w_pe_proj;
    float* out; unsigned char* ws;
};

typedef float f32x2_t __attribute__((ext_vector_type(2)));
typedef __bf16 bf16x2_t __attribute__((ext_vector_type(2)));
__device__ __forceinline__ unsigned cvt_pk_bf16(float lo, float hi) { const f32x2_t v = {lo, hi}; return __builtin_bit_cast(unsigned, __builtin_convertvector(v, bf16x2_t)); }
__device__ __forceinline__ float bf2f(unsigned short b) { return __uint_as_float(((unsigned)b) << 16); }
__device__ __forceinline__ float bflo(unsigned w) { return __uint_as_float(w << 16); }
__device__ __forceinline__ float bfhi(unsigned w) { return __uint_as_float(w & 0xffff0000u); }
__device__ __forceinline__ bf16x8 pack8(const float (&v)[8]) {
    u32x4 w; w.x = cvt_pk_bf16(v[0], v[1]); w.y = cvt_pk_bf16(v[2], v[3]); w.z = cvt_pk_bf16(v[4], v[5]); w.w = cvt_pk_bf16(v[6], v[7]);
    return __builtin_bit_cast(bf16x8, w);
}
__device__ __forceinline__ void unpack8(bf16x8 b, float (&v)[8]) {
    u32x4 w = __builtin_bit_cast(u32x4, b);
    v[0] = bflo(w.x); v[1] = bfhi(w.x); v[2] = bflo(w.y); v[3] = bfhi(w.y); v[4] = bflo(w.z); v[5] = bfhi(w.z); v[6] = bflo(w.w); v[7] = bfhi(w.w);
}
__device__ __forceinline__ bf16x8 gather8(const bf16_t* base, int stride) {
    bf16x8 r;
#pragma unroll
    for (int j = 0; j < 8; ++j) r[j] = (short)base[j * stride];
    return r;
}
__device__ __forceinline__ bf16x8 ld8f_pack(const float* p) {
    f32x4 a = *(const f32x4*)p, b = *(const f32x4*)(p + 4);
    u32x4 w; w.x = cvt_pk_bf16(a.x, a.y); w.y = cvt_pk_bf16(a.z, a.w); w.z = cvt_pk_bf16(b.x, b.y); w.w = cvt_pk_bf16(b.z, b.w);
    return __builtin_bit_cast(bf16x8, w);
}
__device__ __forceinline__ int opaque_tid() { int t = threadIdx.x; asm volatile("" : "+v"(t)); return t; }
#define LDS_FENCE() asm volatile("s_waitcnt lgkmcnt(0)" ::: "memory")
#define MFMA16(a, b, c) __builtin_amdgcn_mfma_f32_16x16x32_bf16((a), (b), (c), 0, 0, 0)

constexpr int BM = 256, BK = 64, HALF = 128, HT = HALF * BK;
__device__ __forceinline__ int lds_byte(int r, int c) {
    int st = (r >> 4) * 2 + (c >> 5), rr = r & 15, cc = c & 31, ob = rr * 64 + cc * 2;
    return st * 1024 + (ob ^ (((ob >> 9) & 1) << 5));
}
__device__ __forceinline__ void stage_rc(int b, int& R, int& C) {
    int st = b / 1024, sb = b % 1024, swz = sb ^ (((sb >> 9) & 1) << 5);
    R = (st >> 1) * 16 + swz / 64; C = (st & 1) * 32 + (swz % 64) / 2;
}
__device__ __forceinline__ bool tile_of(int L, int nM, int nN, int& pm, int& pn) {
    const int nwg = nM * nN; if (L >= nwg) return false;
    int wgid = L; { const int q = nwg / 8, r = nwg % 8, xcd = wgid % 8, off = wgid / 8; wgid = (xcd < r ? xcd * (q + 1) : r * (q + 1) + (xcd - r) * q) + off; }
    const int nig = 8 * nN, gid = wgid / nig, fm = gid * 8, gsz = (nM - fm) < 8 ? (nM - fm) : 8;
    pm = fm + ((wgid % nig) % gsz); pn = (wgid % nig) / gsz; return true;
}

template <class Epi>
__device__ __forceinline__ void gemm_tile(const bf16_t* __restrict__ A, int lda, const bf16_t* __restrict__ Bt, int ldb, int K, int brow, int bcol, const Epi& epi) {
    const int tid = opaque_tid();
    bf16_t* shm = (bf16_t*)g_lds;
#define SA(b, h) (shm + ((b) * 2 + (h)) * HT)
#define SB(b, h) (shm + (4 + (b) * 2 + (h)) * HT)
#define STAGE(P, BASE, LD, br, kt) do { const int _so = ((br) * (LD) + (kt) * BK) * 2; \
    for (int _i = 0; _i < 2; ++_i) { \
      __builtin_amdgcn_raw_ptr_buffer_load_lds(((&(LD) == &lda) ? rsA : rsB), (__attribute__((address_space(3))) void*)((char*)(P) + wid * 1024 + _i * 8192), 16, \
          ((&(LD) == &lda) ? offA[_i] : offB[_i]), _so, 0, 0); } } while (0)
#define LDA(dst, b, h) for (int m = 0; m < 4; ++m) for (int k = 0; k < 2; ++k) \
    dst[m][k] = *reinterpret_cast<const bf16x8*>((char*)SA(b, h) + lds_byte(wr * 64 + m * 16 + fr, k * 32 + fq * 8))
#define LDB(dst, b, h) for (int n = 0; n < 2; ++n) for (int k = 0; k < 2; ++k) \
    dst[n][k] = *reinterpret_cast<const bf16x8*>((char*)SB(b, h) + lds_byte(wc * 32 + n * 16 + fr, k * 32 + fq * 8))
#define MMA(ai, bj, At, Bt_) do { __builtin_amdgcn_s_setprio(1); \
    for (int m = 0; m < 4; ++m) for (int n = 0; n < 2; ++n) for (int k = 0; k < 2; ++k) \
      acc[ai][bj][m][n] = __builtin_amdgcn_mfma_f32_16x16x32_bf16(At[m][k], Bt_[n][k], acc[ai][bj][m][n], 0, 0, 0); \
    __builtin_amdgcn_s_setprio(0); } while (0)
#define WAIT_V(n) asm volatile("s_waitcnt vmcnt(" #n ")" ::: "memory")
#define WAIT_L(n) asm volatile("s_waitcnt lgkmcnt(" #n ")" ::: "memory")
#define BAR __builtin_amdgcn_s_barrier()
#define SCHED __builtin_amdgcn_sched_barrier(0)
    const int wid = __builtin_amdgcn_readfirstlane(tid >> 6), lane = tid & 63, wr = wid >> 2, wc = wid & 3, fr = lane & 15, fq = lane >> 4;
    f32x4 acc[2][2][4][2] = {};
    bf16x8 At[4][2], B0[2][2], B1[2][2];
    const int nt = K / BK;
    const __amdgpu_buffer_rsrc_t rsA = __builtin_amdgcn_make_buffer_rsrc((void*)A, (short)0, 0x7ffffff0, 0x00020000);
    const __amdgpu_buffer_rsrc_t rsB = __builtin_amdgcn_make_buffer_rsrc((void*)Bt, (short)0, 0x7ffffff0, 0x00020000);
    unsigned offA[2], offB[2];
    for (int _i = 0; _i < 2; ++_i) { int _r, _c; stage_rc(tid * 16 + _i * 8192, _r, _c); offA[_i] = (unsigned)(_r * lda + _c) * 2u; offB[_i] = (unsigned)(_r * ldb + _c) * 2u; }
    STAGE(SB(0, 0), Bt, ldb, bcol, 0); STAGE(SA(0, 0), A, lda, brow, 0);
    STAGE(SB(0, 1), Bt, ldb, bcol + HALF, 0); STAGE(SA(0, 1), A, lda, brow + HALF, 0);
    if (wr == 1) BAR;
    WAIT_V(4); BAR;
    STAGE(SB(1, 0), Bt, ldb, bcol, 1); STAGE(SA(1, 0), A, lda, brow, 1); STAGE(SB(1, 1), Bt, ldb, bcol + HALF, 1);
    WAIT_V(6); BAR;
#pragma unroll 1
    for (int t = 0; t < nt - 2; t += 2) {
        LDB(B0, 0, 0); SCHED; LDA(At, 0, 0); STAGE(SA(1, 1), A, lda, brow + HALF, t + 1);
        WAIT_L(8); BAR; WAIT_L(0); MMA(0, 0, At, B0); BAR; SCHED;
        LDB(B1, 0, 1); STAGE(SB(0, 0), Bt, ldb, bcol, t + 2);
        BAR; WAIT_L(0); MMA(0, 1, At, B1); BAR;
        LDA(At, 0, 1); STAGE(SA(0, 0), A, lda, brow, t + 2);
        BAR; WAIT_L(0); MMA(1, 0, At, B0); BAR; SCHED;
        STAGE(SB(0, 1), Bt, ldb, bcol + HALF, t + 2);
        WAIT_V(6); BAR; MMA(1, 1, At, B1); BAR;
        LDB(B0, 1, 0); SCHED; LDA(At, 1, 0); STAGE(SA(0, 1), A, lda, brow + HALF, t + 2);
        WAIT_L(8); BAR; WAIT_L(0); MMA(0, 0, At, B0); BAR; SCHED;
        LDB(B1, 1, 1); STAGE(SB(1, 0), Bt, ldb, bcol, t + 3);
        BAR; WAIT_L(0); MMA(0, 1, At, B1); BAR;
        LDA(At, 1, 1); STAGE(SA(1, 0), A, lda, brow, t + 3);
        BAR; WAIT_L(0); MMA(1, 0, At, B0); BAR; SCHED;
        STAGE(SB(1, 1), Bt, ldb, bcol + HALF, t + 3);
        WAIT_V(6); BAR; MMA(1, 1, At, B1); BAR;
    }
    { LDB(B0, 0, 0); LDA(At, 0, 0); STAGE(SA(1, 1), A, lda, brow + HALF, nt - 1);
      BAR; WAIT_L(0); MMA(0, 0, At, B0); BAR;
      LDB(B1, 0, 1); BAR; WAIT_L(0); MMA(0, 1, At, B1); BAR;
      LDA(At, 0, 1); WAIT_V(4); BAR; WAIT_L(0); MMA(1, 0, At, B0); MMA(1, 1, At, B1); BAR; }
    { LDB(B0, 1, 0); LDA(At, 1, 0); WAIT_V(2); BAR; WAIT_L(0); MMA(0, 0, At, B0); BAR;
      LDB(B1, 1, 1); WAIT_V(0); BAR; WAIT_L(0); MMA(0, 1, At, B1); BAR;
      LDA(At, 1, 1); BAR; WAIT_L(0); MMA(1, 0, At, B0); MMA(1, 1, At, B1); BAR; }
    if (wr == 0) BAR;
    float* ep = (float*)g_lds;
    __syncthreads();
#pragma unroll
    for (int ai = 0; ai < 2; ++ai) {
        if (ai) __syncthreads();
#pragma unroll
        for (int bj = 0; bj < 2; ++bj)
#pragma unroll
            for (int m = 0; m < 4; ++m)
#pragma unroll
                for (int n = 0; n < 2; ++n)
#pragma unroll
                    for (int j = 0; j < 4; ++j)
                        ep[(wr * 64 + m * 16 + fq * 4 + j) * 260 + bj * HALF + wc * 32 + n * 16 + fr] = acc[ai][bj][m][n][j];
        __syncthreads();
        int tid_e = tid; asm volatile("" : "+v"(tid_e));
        const int rl = tid_e & 127, seg = tid_e >> 7;
        epi(ep + rl * 260 + seg * 64, brow + ai * HALF + rl, bcol + seg * 64);
    }
    __syncthreads();
#undef SA
#undef SB
#undef STAGE
#undef LDA
#undef LDB
#undef MMA
}

template <class Epi>
__device__ __forceinline__ void gemm_phase(const bf16_t* A, int lda, const bf16_t* Bt, int ldb, int M, int N, int K, const Epi& epi) {
    const int nM = M / BM, nN = N / BM;
    for (int i = 0;; ++i) {
        int pm, pn; if (!tile_of(i * (int)gridDim.x + (int)blockIdx.x, nM, nN, pm, pn)) break;
        gemm_tile(A, lda, Bt, ldb, K, pm * BM, pn * BM, epi);
    }
}

__device__ __forceinline__ void ld8(const float* s, float (&v)[8]) { const f32x4 a = *(const f32x4*)s, b = *(const f32x4*)(s + 4); v[0] = a.x; v[1] = a.y; v[2] = a.z; v[3] = a.w; v[4] = b.x; v[5] = b.y; v[6] = b.z; v[7] = b.w; }
__device__ __forceinline__ void st8_bf16(bf16_t* d, const float (&v)[8]) { *(bf16x8*)d = pack8(v); }
__device__ __forceinline__ float row_rstd(const float* ssq, int row) {
    const f32x4* p = (const f32x4*)(ssq + (size_t)row * 16);
    f32x4 a = p[0], b = p[1], c = p[2], d = p[3];
    float s = ((a.x + a.y) + (a.z + a.w)) + ((b.x + b.y) + (b.z + b.w)) + ((c.x + c.y) + (c.z + c.w)) + ((d.x + d.y) + (d.z + d.w));
    return rsqrtf(s * (1.0f / D) + EPS);
}

struct EpiIn {
    bf16_t* Z; const float* ssq; const float* qn; const float* kn; const float* gbias; const float* tab; int smask;
    __device__ __forceinline__ void operator()(const float* seg, int row, int col0) const {
        const float rstd = row_rstd(ssq, row);
        const int pos = row & smask;
        bf16_t* dst = Z + (size_t)row * ZW + col0;
        if (col0 < ZC_AV) {
            const bool isq = col0 < ZC_AK;
            const float* gn = isq ? qn : kn;
            float ss = 0.f;
#pragma unroll 2
            for (int c = 0; c < 16; ++c) { const f32x4 t = *(const f32x4*)(seg + 4 * c); ss += (t.x * t.x + t.y * t.y) + (t.z * t.z + t.w * t.w); }
            const float r = rsqrtf(ss * rstd * rstd * (1.0f / 64) + EPS) * rstd * (isq ? 0.125f : 1.0f);
            { float a[8], b[8], g0[8], g1[8], cs[16]; ld8(seg, a); ld8(seg + 8, b); ld8(gn, g0); ld8(gn + 8, g1);
              ld8(tab + (size_t)pos * 80, *(float(*)[8])&cs[0]); ld8(tab + (size_t)pos * 80 + 8, *(float(*)[8])&cs[8]);
#pragma unroll
              for (int i = 0; i < 8; ++i) { const float x1 = a[i] * r * g0[i], x2 = b[i] * r * g1[i], c = cs[2 * i], sn = cs[2 * i + 1]; a[i] = x1 * c - x2 * sn; b[i] = x2 * c + x1 * sn; }
              st8_bf16(dst, a); st8_bf16(dst + 8, b); }
#pragma unroll 1
            for (int c = 2; c < 8; ++c) { float a[8], g0[8]; ld8(seg + 8 * c, a); ld8(gn + 8 * c, g0);
#pragma unroll
                for (int i = 0; i < 8; ++i) a[i] = a[i] * r * g0[i];
                st8_bf16(dst + 8 * c, a); }
        } else if (col0 >= ZC_GF && col0 < ZC_CQ) {
            const float* bb = gbias + (col0 - ZC_GF);
#pragma unroll 1
            for (int c = 0; c < 8; ++c) { float a[8], b[8]; ld8(seg + 8 * c, a); ld8(bb + 8 * c, b); unsigned short hb[8];
#pragma unroll
                for (int i = 0; i < 8; ++i) { const float x = a[i] * rstd + b[i]; const float ls = fminf(x, 0.f) - log1pf(__expf(-fabsf(x))); const _Float16 hv = (_Float16)(ls * 0.0625f); hb[i] = __builtin_bit_cast(unsigned short, hv); }
                u32x4 w; w.x = hb[0] | ((unsigned)hb[1] << 16); w.y = hb[2] | ((unsigned)hb[3] << 16); w.z = hb[4] | ((unsigned)hb[5] << 16); w.w = hb[6] | ((unsigned)hb[7] << 16);
                *(u32x4*)(dst + 8 * c) = w; }
        } else if (col0 >= ZC_CQ && col0 < ZC_CV) {
            const float sc = rstd * ((col0 >= ZC_CK) ? 0.125f : 1.0f);
            const float* cs0 = tab + (size_t)pos * 80 + 16;
#pragma unroll 1
            for (int c = 0; c < 4; ++c) { float a[8], b[8], cs[16]; ld8(seg + 8 * c, a); ld8(seg + 32 + 8 * c, b);
                ld8(cs0 + 16 * c, *(float(*)[8])&cs[0]); ld8(cs0 + 16 * c + 8, *(float(*)[8])&cs[8]);
#pragma unroll
                for (int i = 0; i < 8; ++i) { const float x1 = a[i] * sc, x2 = b[i] * sc, cc = cs[2 * i], sn = cs[2 * i + 1]; a[i] = x1 * cc - x2 * sn; b[i] = x2 * cc + x1 * sn; }
                st8_bf16(dst + 8 * c, a); st8_bf16(dst + 32 + 8 * c, b); }
        } else {
            const float sc = rstd * ((col0 >= ZC_BQ && col0 < ZC_BK) ? 0.17677669529663687f : 1.0f);
#pragma unroll 1
            for (int c = 0; c < 8; ++c) { float a[8]; ld8(seg + 8 * c, a);
#pragma unroll
                for (int i = 0; i < 8; ++i) a[i] *= sc;
                st8_bf16(dst + 8 * c, a); }
        }
    }
};

struct EpiRes {
    float* H; bf16_t* HB; float* ssq;
    __device__ __forceinline__ void operator()(const float* seg, int row, int col0) const {
        float* hp = H + (size_t)row * D + col0; bf16_t* hb = HB + (size_t)row * D + col0;
        float ss = 0.f;
#pragma unroll 1
        for (int c = 0; c < 8; ++c) { float a[8], h[8]; ld8(seg + 8 * c, a); ld8(hp + 8 * c, h);
#pragma unroll
            for (int i = 0; i < 8; ++i) { h[i] += a[i]; ss += h[i] * h[i]; }
            *(f32x4*)(hp + 8 * c) = (f32x4){h[0], h[1], h[2], h[3]}; *(f32x4*)(hp + 8 * c + 4) = (f32x4){h[4], h[5], h[6], h[7]};
            st8_bf16(hb + 8 * c, h); }
        ssq[(size_t)row * 16 + (col0 >> 6)] = ss;
    }
};

struct EpiMlpIn {
    bf16_t* HID; const float* ssq;
    __device__ __forceinline__ void operator()(const float* seg, int row, int col0) const {
        const float rstd = row_rstd(ssq, row);
        bf16_t* dst = HID + (size_t)row * DFF + col0;
#pragma unroll 1
        for (int c = 0; c < 8; ++c) { float a[8]; ld8(seg + 8 * c, a);
#pragma unroll
            for (int i = 0; i < 8; ++i) { const float x = fmaxf(a[i] * rstd, 0.f); a[i] = x * x; }
            st8_bf16(dst + 8 * c, a); }
    }
};

struct EpiPlain {
    bf16_t* O; int ldo;
    __device__ __forceinline__ void operator()(const float* seg, int row, int col0) const {
        bf16_t* dst = O + (size_t)row * ldo + col0;
#pragma unroll 1
        for (int c = 0; c < 8; ++c) { float a[8]; ld8(seg + 8 * c, a); st8_bf16(dst + 8 * c, a); }
    }
};

struct EpiPeGate {
    float* H; bf16_t* HB; float* ssq_out; const float* ssq_in; const bf16_t* PB;
    __device__ __forceinline__ void operator()(const float* seg, int row, int col0) const {
        const float rstd = row_rstd(ssq_in, row);
        float* hp = H + (size_t)row * D + col0; const bf16_t* pp = PB + (size_t)row * D + col0; bf16_t* hb = HB + (size_t)row * D + col0;
        float ss = 0.f;
#pragma unroll 1
        for (int c = 0; c < 8; ++c) { float a[8], h[8], pv[8]; ld8(seg + 8 * c, a); ld8(hp + 8 * c, h); unpack8(*(const bf16x8*)(pp + 8 * c), pv);
#pragma unroll
            for (int i = 0; i < 8; ++i) { const float gte = 1.0f / (1.0f + __expf(-a[i] * rstd)); h[i] += gte * pv[i]; ss += h[i] * h[i]; }
            *(f32x4*)(hp + 8 * c) = (f32x4){h[0], h[1], h[2], h[3]}; *(f32x4*)(hp + 8 * c + 4) = (f32x4){h[4], h[5], h[6], h[7]};
            st8_bf16(hb + 8 * c, h); }
        ssq_out[(size_t)row * 16 + (col0 >> 6)] = ss;
    }
};

template <class F>
__device__ __forceinline__ void transpose_item(bf16_t* Wt, int K, int k0, int n0, const F& src) {
    const int tid = opaque_tid();
    float* tile = (float*)g_lds;
#pragma unroll
    for (int i = 0; i < 8; ++i) { const int kk = (tid >> 6) + 8 * i, nn = tid & 63; tile[kk * 65 + nn] = src(k0 + kk, n0 + nn); }
    __syncthreads();
    { const int nn = tid >> 3, kc = tid & 7; float t[8];
#pragma unroll
      for (int j = 0; j < 8; ++j) t[j] = tile[(8 * kc + j) * 65 + nn];
      *(bf16x8*)(Wt + (size_t)(n0 + nn) * K + k0 + 8 * kc) = pack8(t); }
    __syncthreads();
}

__device__ __forceinline__ void phase_weights(const Params& p) {
    bf16_t* WT = (bf16_t*)(p.ws + WS_WT);
    constexpr int I_IN = 16 * (ZW / 64), I_OUT = 16 * 16, I_MI = 16 * 64, I_MO = 64 * 16, I_PG = 16 * 16, I_PP = 4 * 16;
    constexpr int I_L = I_IN + I_OUT + I_MI + I_MO + I_PG + I_PP;
    for (int it = blockIdx.x; it < NLAYER * I_L; it += gridDim.x) {
        const int l = it / I_L; int r = it % I_L;
        bf16_t* W = WT + (size_t)l * W_LAYER;
        if (r < I_IN) {
            const int kb = r / (ZW / 64), nb = r % (ZW / 64);
            const float* w = p.w_in + (size_t)l * D * NIN; const float* g = p.ln_mix + l * D; const float* gu = p.gla_gate_up + (size_t)l * 2 * 16 * 128;
            transpose_item(W + WO_IN, D, kb * 64, nb * 64, [&](int k, int c) -> float {
                float v;
                if (c < ZC_GF) v = w[(size_t)k * NIN + c];
                else if (c < ZC_CQ) { const int j = (c - ZC_GF) >> 7, kk = (c - ZC_GF) & 127; float s = 0.f;
                    for (int rr = 0; rr < 16; ++rr) s += w[(size_t)k * NIN + 2304 + 16 * j + rr] * gu[(j * 16 + rr) * 128 + kk];
                    v = s; }
                else v = w[(size_t)k * NIN + (c - 224)];
                return v * g[k]; });
            continue; }
        r -= I_IN;
        if (r < I_OUT) { const float* w = p.w_out + (size_t)l * D * D;
            transpose_item(W + WO_OUT, D, (r / 16) * 64, (r % 16) * 64, [&](int k, int c) -> float { return w[(size_t)k * D + c]; }); continue; }
        r -= I_OUT;
        if (r < I_MI) { const float* w = p.w_mlp_in + (size_t)l * D * DFF; const float* g = p.ln_mlp + l * D;
            transpose_item(W + WO_MI, D, (r / 64) * 64, (r % 64) * 64, [&](int k, int c) -> float { return w[(size_t)k * DFF + c] * g[k]; }); continue; }
        r -= I_MI;
        if (r < I_MO) { const float* w = p.w_mlp_out + (size_t)l * DFF * D;
            transpose_item(W + WO_MO, DFF, (r / 16) * 64, (r % 16) * 64, [&](int k, int c) -> float { return w[(size_t)k * D + c]; }); continue; }
        r -= I_MO;
        if (r < I_PG) { const float* w = p.w_pe_gate + (size_t)l * D * D; const float* g = p.ln_pe + l * D;
            transpose_item(W + WO_PG, D, (r / 16) * 64, (r % 16) * 64, [&](int k, int c) -> float { return w[(size_t)k * D + c] * g[k]; }); continue; }
        r -= I_PG;
        { const float* w = p.w_pe_proj + (size_t)l * PLE * D;
            transpose_item(W + WO_PP, PLE, (r / 16) * 64, (r % 16) * 64, [&](int k, int c) -> float { return w[(size_t)k * D + c]; }); }
    }
    float* tab = (float*)(p.ws + WS_TAB);
    for (int e = blockIdx.x * NTHR + threadIdx.x; e < 16384 * 40; e += gridDim.x * NTHR) {
        const int pos = e / 40, i = e % 40;
        const double invf = (i < 8) ? exp(-(double)i * (log(500000.0) / 8.0)) : exp(-(double)(i - 8) * (log(10000.0) / 32.0));
        double ang = (double)pos * invf; ang -= 6.283185307179586476925 * floor(ang * 0.15915494309189533577);
        tab[2 * e] = (float)cos(ang); tab[2 * e + 1] = (float)sin(ang);
    }
}

__device__ __forceinline__ void phase_init(const Params& p, int g) {
    const int tid = opaque_tid();
    const float* x = (g == 0) ? p.x_prompt : p.x_sample + (size_t)(g - 1) * MG * D;
    float* H = p.out + (size_t)g * MG * D; bf16_t* HB = (bf16_t*)(p.ws + WS_HB); float* ssq = (float*)(p.ws + WS_SSQ);
    const int lane = tid & 63, gw = blockIdx.x * 8 + (tid >> 6), NGW = gridDim.x * 8;
    for (int row = gw; row < MG; row += NGW) {
#pragma unroll
        for (int j = 0; j < 4; ++j) {
            const f32x4 v = *(const f32x4*)(x + (size_t)row * D + 256 * j + 4 * lane);
            *(f32x4*)(H + (size_t)row * D + 256 * j + 4 * lane) = v;
            u32x2 w; w.x = cvt_pk_bf16(v.x, v.y); w.y = cvt_pk_bf16(v.z, v.w);
            *(u32x2*)(HB + (size_t)row * D + 256 * j + 4 * lane) = w;
            float s = (v.x * v.x + v.y * v.y) + (v.z * v.z + v.w * v.w);
            s += __shfl_xor(s, 1); s += __shfl_xor(s, 2); s += __shfl_xor(s, 4); s += __shfl_xor(s, 8);
            if ((lane & 15) == 0) ssq[(size_t)row * 16 + (lane >> 4) + 4 * j] = s;
        }
    }
    bf16_t* PL = (bf16_t*)(p.ws + WS_PLE);
    for (int l = 0; l < NLAYER; ++l) {
        const float* src = (g == 0) ? p.p_prompt + (size_t)l * MG * PLE : p.p_sample + ((size_t)l * 2 * MG + (size_t)(g - 1) * MG) * PLE;
        bf16_t* dst = PL + (size_t)l * MG * PLE;
        for (size_t e = (size_t)(blockIdx.x * NTHR + tid) * 8; e < (size_t)MG * PLE; e += (size_t)gridDim.x * NTHR * 8)
            *(bf16x8*)(dst + e) = ld8f_pack(src + e);
    }
}

struct AttnLd { bf16x8 ka0, ka1, kb0, kb1; u32x4 v0, v1, v2, v3; };
__device__ __forceinline__ void attn_geom(int f, int r, int n0, int& dsh, int& cb) {
    const int p = f < 12 ? 0 : (f < 18 ? 1 : 2); const int i2 = f - (p == 0 ? 0 : (p == 1 ? 12 : 18));
    dsh = 2 * p; cb = (r >> dsh) + (16 >> dsh) * n0 - 64 + 32 * i2;
}
__device__ __forceinline__ AttnLd attn_load(const bf16_t* __restrict__ zq, int S, int head, int r, int n0, int lane, int f) {
    int dsh, cb; attn_geom(f, r, n0, dsh, cb);
    const int qi = lane & 15, g = lane >> 4, rd = r & ((1 << dsh) - 1), ncls = S >> dsh;
    const int cA = cb + 8 * (qi >> 2) + (qi & 3), cB = cA + 4;
    const int cAc = min(max(cA, 0), ncls - 1), cBc = min(max(cB, 0), ncls - 1);
    const bf16_t* kA = zq + (size_t)(rd + (cAc << dsh)) * ZW + ZC_AK + head * 64 + 8 * g;
    const bf16_t* kB = zq + (size_t)(rd + (cBc << dsh)) * ZW + ZC_AK + head * 64 + 8 * g;
    AttnLd L;
    L.ka0 = *(const bf16x8*)kA; L.ka1 = *(const bf16x8*)(kA + 32); L.kb0 = *(const bf16x8*)kB; L.kb1 = *(const bf16x8*)(kB + 32);
    const int cv0 = cb + (lane >> 3);
    const bf16_t* vb = zq + ZC_AV + head * 64 + 8 * (lane & 7);
    L.v0 = *(const u32x4*)(vb + (size_t)(rd + (min(max(cv0, 0), ncls - 1) << dsh)) * ZW);
    L.v1 = *(const u32x4*)(vb + (size_t)(rd + (min(max(cv0 + 8, 0), ncls - 1) << dsh)) * ZW);
    L.v2 = *(const u32x4*)(vb + (size_t)(rd + (min(max(cv0 + 16, 0), ncls - 1) << dsh)) * ZW);
    L.v3 = *(const u32x4*)(vb + (size_t)(rd + (min(max(cv0 + 24, 0), ncls - 1) << dsh)) * ZW);
    return L;
}
__device__ __forceinline__ void attn_item(const bf16_t* __restrict__ Z, bf16_t* __restrict__ MIX, int S, int it) {
    const int tid = opaque_tid();
    const int wave = tid >> 6, lane = tid & 63, qi = lane & 15, g = lane >> 4;
    const int nbs = S >> 8;
    const int rhalf = it & 1; int t1 = it >> 1; const int nb = t1 % nbs; t1 /= nbs; const int head = t1 & 7, seq = t1 >> 3;
    const int r = rhalf * 8 + wave, n0 = nb * 16;
    const bf16_t* zq = Z + (size_t)seq * S * ZW;
    bf16_t* Vs = (bf16_t*)g_lds + wave * (32 * 68);
    const int pq = r + 16 * (n0 + qi);
    AttnLd cur = attn_load(zq, S, head, r, n0, lane, 0);
    const bf16x8 q0 = *(const bf16x8*)(zq + (size_t)pq * ZW + ZC_AQ + head * 64 + 8 * g);
    const bf16x8 q1 = *(const bf16x8*)(zq + (size_t)pq * ZW + ZC_AQ + head * 64 + 32 + 8 * g);
    float m = -1e30f, lsum = 0.f;
    f32x4 O[4] = {};
#pragma unroll 1
    for (int f = 0; f < 23; ++f) {
        const AttnLd nxt = attn_load(zq, S, head, r, n0, lane, f < 22 ? f + 1 : 22);
        int dsh, cb; attn_geom(f, r, n0, dsh, cb);
        const int ncls = S >> dsh, cq = (r >> dsh) + (16 >> dsh) * (n0 + qi);
        f32x4 sA = {0.f, 0.f, 0.f, 0.f}, sB = {0.f, 0.f, 0.f, 0.f};
        sA = MFMA16(cur.ka0, q0, sA); sA = MFMA16(cur.ka1, q1, sA);
        sB = MFMA16(cur.kb0, q0, sB); sB = MFMA16(cur.kb1, q1, sB);
        LDS_FENCE();
        { bf16_t* d = Vs + (lane >> 3) * 68 + 8 * (lane & 7);
          *(u32x2*)d = (u32x2){cur.v0.x, cur.v0.y}; *(u32x2*)(d + 4) = (u32x2){cur.v0.z, cur.v0.w};
          *(u32x2*)(d + 8 * 68) = (u32x2){cur.v1.x, cur.v1.y}; *(u32x2*)(d + 8 * 68 + 4) = (u32x2){cur.v1.z, cur.v1.w};
          *(u32x2*)(d + 16 * 68) = (u32x2){cur.v2.x, cur.v2.y}; *(u32x2*)(d + 16 * 68 + 4) = (u32x2){cur.v2.z, cur.v2.w};
          *(u32x2*)(d + 24 * 68) = (u32x2){cur.v3.x, cur.v3.y}; *(u32x2*)(d + 24 * 68 + 4) = (u32x2){cur.v3.z, cur.v3.w}; }
        float s[8]; bool ok[8];
#pragma unroll
        for (int j = 0; j < 8; ++j) { const int c = cb + 8 * g + j; const int dd = c - cq;
            ok[j] = (c >= 0) && (c < ncls) && (dd <= 64) && (dd >= -64);
            s[j] = ok[j] ? (j < 4 ? sA[j] : sB[j - 4]) : -1e30f; }
        float mx = fmaxf(fmaxf(fmaxf(s[0], s[1]), fmaxf(s[2], s[3])), fmaxf(fmaxf(s[4], s[5]), fmaxf(s[6], s[7])));
        mx = fmaxf(mx, __shfl_xor(mx, 16)); mx = fmaxf(mx, __shfl_xor(mx, 32));
        const float mn = fmaxf(m, mx), alpha = __expf(m - mn);
        m = mn;
        float pj[8], ps_ = 0.f;
#pragma unroll
        for (int j = 0; j < 8; ++j) { pj[j] = ok[j] ? __expf(s[j] - mn) : 0.f; ps_ += pj[j]; }
        lsum = lsum * alpha + ps_;
        const bf16x8 P = pack8(pj);
#pragma unroll
        for (int nbk = 0; nbk < 4; ++nbk) O[nbk] *= alpha;
        LDS_FENCE();
#pragma unroll
        for (int nbk = 0; nbk < 4; ++nbk) { const bf16x8 vf = gather8(Vs + (8 * g) * 68 + 16 * nbk + qi, 68); O[nbk] = MFMA16(vf, P, O[nbk]); }
        cur = nxt;
    }
    lsum += __shfl_xor(lsum, 16); lsum += __shfl_xor(lsum, 32);
    const float inv = 1.0f / lsum;
    bf16_t* op = MIX + ((size_t)seq * S + pq) * D + head * 64 + 4 * g;
#pragma unroll
    for (int nbk = 0; nbk < 4; ++nbk) { u32x2 w; w.x = cvt_pk_bf16(O[nbk].x * inv, O[nbk].y * inv); w.y = cvt_pk_bf16(O[nbk].z * inv, O[nbk].w * inv); *(u32x2*)(op + 16 * nbk) = w; }
    LDS_FENCE();
}

__device__ __forceinline__ float h2f(unsigned short b) { return (float)__builtin_bit_cast(_Float16, b); }

__device__ __forceinline__ void stage_v4(const bf16_t* __restrict__ Z, size_t tok0, int zc, bf16_t* Vt, int nrows) {
    const int tid = opaque_tid();
    for (int idx = tid; idx < nrows * 32; idx += NTHR) {
        const int t = idx >> 5, ch = idx & 31, hh = ch >> 3, c8 = ch & 7;
        const u32x4 v = *(const u32x4*)(Z + (tok0 + t) * ZW + zc + ch * 8);
        bf16_t* d = Vt + ((size_t)hh * nrows + t) * 68 + c8 * 8;
        *(u32x2*)d = (u32x2){v.x, v.y}; *(u32x2*)(d + 4) = (u32x2){v.z, v.w};
    }
}

__device__ __forceinline__ void gla_cum(const bf16_t* __restrict__ Z, size_t tok0, int h, int dir, int lane, float (&cum)[32], float& tot) {
    const int kk = lane & 31, hf = lane >> 5;
    const bf16_t* src = Z + (tok0 + 32 * hf) * ZW + ZC_GF + dir * 128 + h * 32 + kk;
    float part = 0.f;
#pragma unroll
    for (int i = 0; i < 32; ++i) { cum[i] = h2f(src[(size_t)i * ZW]); part += cum[i]; }
    const float other = __shfl_xor(part, 32);
    tot = part + other;
    if (dir == 0) { float run = hf ? other : 0.f;
#pragma unroll
        for (int i = 0; i < 32; ++i) { run += cum[i]; cum[i] = run; } }
    else { float run = hf ? 0.f : other;
#pragma unroll
        for (int i = 31; i >= 0; --i) { run += cum[i]; cum[i] = run; } }
}

__device__ __forceinline__ void gla1_item(const bf16_t* __restrict__ Z, float* __restrict__ GS, float* __restrict__ GD, int ci) {
    const int tid = opaque_tid();
    __syncthreads();
    const int wave = tid >> 6, lane = tid & 63, qi = lane & 15, g = lane >> 4;
    const int h = wave >> 1, dir = wave & 1;
    const size_t tok0 = (size_t)ci * 64;
    bf16_t* Vt = (bf16_t*)g_lds;
    bf16_t* Ks = (bf16_t*)g_lds + 4 * 64 * 68 + wave * (64 * 36);
    stage_v4(Z, tok0, ZC_BV, Vt, 64);
    float cum[32], tot;
    gla_cum(Z, tok0, h, dir, lane, cum, tot);
    { const int kk = lane & 31, hf = lane >> 5;
      const bf16_t* ksrc = Z + (tok0 + 32 * hf) * ZW + ZC_BK + h * 32 + kk;
#pragma unroll
      for (int i = 0; i < 32; ++i) { const float kv = bf2f(ksrc[(size_t)i * ZW]) * __expf(tot - cum[i]);
          Ks[(32 * hf + i) * 36 + kk] = (bf16_t)(cvt_pk_bf16(kv, 0.f) & 0xffffu); }
      if (hf == 0) GD[(((size_t)dir * NCH + ci) * 4 + h) * 32 + kk] = __expf(tot); }
    __syncthreads();
    f32x4 acc[4][2] = {};
#pragma unroll
    for (int ks = 0; ks < 2; ++ks) {
        bf16x8 bfr[2];
#pragma unroll
        for (int kb = 0; kb < 2; ++kb) bfr[kb] = gather8(Ks + (32 * ks + 8 * g) * 36 + 16 * kb + qi, 36);
#pragma unroll
        for (int eb = 0; eb < 4; ++eb) { const bf16x8 af = gather8(Vt + ((size_t)h * 64 + 32 * ks + 8 * g) * 68 + 16 * eb + qi, 68);
#pragma unroll
            for (int kb = 0; kb < 2; ++kb) acc[eb][kb] = MFMA16(af, bfr[kb], acc[eb][kb]); }
    }
    float* dst = GS + (((size_t)dir * NCH + ci) * 4 + h) * 2048;
#pragma unroll
    for (int eb = 0; eb < 4; ++eb)
#pragma unroll
        for (int kb = 0; kb < 2; ++kb)
#pragma unroll
            for (int i = 0; i < 4; ++i) dst[(16 * eb + 4 * g + i) * 32 + 16 * kb + qi] = acc[eb][kb][i];
    __syncthreads();
}

__device__ __forceinline__ void gla3_item(const bf16_t* __restrict__ Z, const float* __restrict__ GS, bf16_t* __restrict__ MIX, const float* __restrict__ gnorm, int ci) {
    const int tid = opaque_tid();
    __syncthreads();
    const int wave = tid >> 6, lane = tid & 63, qi = lane & 15, g = lane >> 4;
    const size_t tok0 = (size_t)ci * 64;
    bf16_t* Vt = (bf16_t*)g_lds;
    float* CUM = (float*)(g_lds + 4 * 64 * 68 * 2);
    stage_v4(Z, tok0, ZC_BV, Vt, 64);
    { const int h = wave >> 1, dir = wave & 1; float cum[32], tot;
      gla_cum(Z, tok0, h, dir, lane, cum, tot);
      const int kk = lane & 31, hf = lane >> 5; float* cd = CUM + ((size_t)(h * 2 + dir) * 64 + 32 * hf) * 32 + kk;
#pragma unroll
      for (int i = 0; i < 32; ++i) cd[i * 32] = cum[i]; }
    __syncthreads();
    const int h = wave >> 1;
    const float* cF = CUM + (size_t)(h * 2 + 0) * 64 * 32; const float* cB = CUM + (size_t)(h * 2 + 1) * 64 * 32;
#pragma unroll 1
    for (int tbi = 0; tbi < 2; ++tbi) {
        const int t = 16 * (2 * (wave & 1) + tbi) + qi;
        bf16x8 Qf, Qb;
        { float qv[8], a[8], b[8]; unpack8(*(const bf16x8*)(Z + (tok0 + t) * ZW + ZC_BQ + h * 32 + 8 * g), qv);
#pragma unroll
          for (int j = 0; j < 8; ++j) { a[j] = qv[j] * __expf(cF[t * 32 + 8 * g + j]); b[j] = qv[j] * __expf(cB[t * 32 + 8 * g + j]); }
          Qf = pack8(a); Qb = pack8(b); }
        f32x4 acc[4] = {};
        const float* sF = GS + (((size_t)0 * NCH + ci) * 4 + h) * 2048; const float* sB = GS + (((size_t)1 * NCH + ci) * 4 + h) * 2048;
#pragma unroll
        for (int eb = 0; eb < 4; ++eb) { acc[eb] = MFMA16(ld8f_pack(sF + (16 * eb + qi) * 32 + 8 * g), Qf, acc[eb]); acc[eb] = MFMA16(ld8f_pack(sB + (16 * eb + qi) * 32 + 8 * g), Qb, acc[eb]); }
#pragma unroll
        for (int sg = 0; sg < 2; ++sg) {
            f32x4 aF[2], aB[2];
#pragma unroll
            for (int blk = 0; blk < 2; ++blk) {
                const int s = 32 * sg + 8 * (qi >> 2) + (qi & 3) + 4 * blk;
                float kv[8], a[8], b[8]; unpack8(*(const bf16x8*)(Z + (tok0 + s) * ZW + ZC_BK + h * 32 + 8 * g), kv);
#pragma unroll
                for (int j = 0; j < 8; ++j) { a[j] = kv[j] * __expf(-cF[s * 32 + 8 * g + j]); b[j] = kv[j] * __expf(-cB[s * 32 + 8 * g + j]); }
                const f32x4 z4 = {0.f, 0.f, 0.f, 0.f};
                aF[blk] = MFMA16(pack8(a), Qf, z4); aB[blk] = MFMA16(pack8(b), Qb, z4);
            }
            float pj[8];
#pragma unroll
            for (int j = 0; j < 8; ++j) { const int s = 32 * sg + 8 * g + j; pj[j] = (s <= t) ? (j < 4 ? aF[0][j] : aF[1][j - 4]) : (j < 4 ? aB[0][j] : aB[1][j - 4]); }
            const bf16x8 P = pack8(pj);
#pragma unroll
            for (int eb = 0; eb < 4; ++eb) acc[eb] = MFMA16(gather8(Vt + ((size_t)h * 64 + 32 * sg + 8 * g) * 68 + 16 * eb + qi, 68), P, acc[eb]);
        }
        float ss = 0.f;
#pragma unroll
        for (int eb = 0; eb < 4; ++eb) ss += (acc[eb].x * acc[eb].x + acc[eb].y * acc[eb].y) + (acc[eb].z * acc[eb].z + acc[eb].w * acc[eb].w);
        ss += __shfl_xor(ss, 16); ss += __shfl_xor(ss, 32);
        const float rn = rsqrtf(ss * (1.0f / 64) + EPS);
#pragma unroll
        for (int eb = 0; eb < 4; ++eb) { const int e = 16 * eb + 4 * g;
            const u32x2 brw = *(const u32x2*)(Z + (tok0 + t) * ZW + ZC_BR + h * 64 + e);
            const f32x4 gn = *(const f32x4*)(gnorm + h * 64 + e);
            const float b0 = bflo(brw.x), b1 = bfhi(brw.x), b2 = bflo(brw.y), b3 = bfhi(brw.y);
            const float o0 = acc[eb].x * rn * gn.x * (b0 / (1.f + __expf(-b0))), o1 = acc[eb].y * rn * gn.y * (b1 / (1.f + __expf(-b1)));
            const float o2 = acc[eb].z * rn * gn.z * (b2 / (1.f + __expf(-b2))), o3 = acc[eb].w * rn * gn.w * (b3 / (1.f + __expf(-b3)));
            u32x2 w; w.x = cvt_pk_bf16(o0, o1); w.y = cvt_pk_bf16(o2, o3);
            *(u32x2*)(MIX + (tok0 + t) * D + 512 + h * 64 + e) = w; }
    }
    __syncthreads();
}

__device__ __forceinline__ void ret1_item(const bf16_t* __restrict__ Z, float* __restrict__ RS, const float* __restrict__ lgam, int item) {
    const int tid = opaque_tid();
    __syncthreads();
    const int wave = tid >> 6, lane = tid & 63, qi = lane & 15, g = lane >> 4;
    const int ci = item >> 1, hp = item & 1;
    const size_t tok0 = (size_t)ci * 128;
    bf16_t* Vt = (bf16_t*)g_lds;
    bf16_t* Kt = Vt + 2 * 128 * 68;
    for (int idx = tid; idx < 128 * 16 * 2; idx += NTHR) {
        const int which = idx >> 11, r = idx & 2047, t = r >> 4, ch = r & 15, hh = ch >> 3, c8 = ch & 7;
        const u32x4 v = *(const u32x4*)(Z + (tok0 + t) * ZW + (which ? ZC_CK : ZC_CV) + hp * 128 + ch * 8);
        bf16_t* d = (which ? Kt : Vt) + ((size_t)hh * 128 + t) * 68 + c8 * 8;
        *(u32x2*)d = (u32x2){v.x, v.y}; *(u32x2*)(d + 4) = (u32x2){v.z, v.w};
    }
    __syncthreads();
    const int hh = wave >> 2, dir = (wave >> 1) & 1, eh = wave & 1, head = 2 * hp + hh;
    const float lg = lgam[dir * 4 + head];
    f32x4 acc[2][4] = {};
#pragma unroll 1
    for (int ks = 0; ks < 4; ++ks) {
        float w[8];
#pragma unroll
        for (int j = 0; j < 8; ++j) { const int s = 32 * ks + 8 * g + j; w[j] = __expf(lg * (float)(dir ? s : 127 - s)); }
        bf16x8 bfr[4];
#pragma unroll
        for (int db = 0; db < 4; ++db) { float kv[8]; unpack8(gather8(Kt + ((size_t)hh * 128 + 32 * ks + 8 * g) * 68 + 16 * db + qi, 68), kv);
#pragma unroll
            for (int j = 0; j < 8; ++j) kv[j] *= w[j];
            bfr[db] = pack8(kv); }
#pragma unroll
        for (int ebi = 0; ebi < 2; ++ebi) { const bf16x8 af = gather8(Vt + ((size_t)hh * 128 + 32 * ks + 8 * g) * 68 + 16 * (2 * eh + ebi) + qi, 68);
#pragma unroll
            for (int db = 0; db < 4; ++db) acc[ebi][db] = MFMA16(af, bfr[db], acc[ebi][db]); }
    }
    float* dst = RS + (((size_t)dir * NCR + ci) * 4 + head) * 4096;
#pragma unroll
    for (int ebi = 0; ebi < 2; ++ebi)
#pragma unroll
        for (int db = 0; db < 4; ++db)
#pragma unroll
            for (int i = 0; i < 4; ++i) dst[(16 * (2 * eh + ebi) + 4 * g + i) * 64 + 16 * db + qi] = acc[ebi][db][i];
    __syncthreads();
}

__device__ __forceinline__ void ret3_item(const bf16_t* __restrict__ Z, const float* __restrict__ RS, bf16_t* __restrict__ MIX, const float* __restrict__ rnorm, const float* __restrict__ lgam, int ci) {
    const int tid = opaque_tid();
    __syncthreads();
    const int wave = tid >> 6, lane = tid & 63, qi = lane & 15, g = lane >> 4;
    const size_t tok0 = (size_t)ci * 128;
    bf16_t* Vt = (bf16_t*)g_lds;
    stage_v4(Z, tok0, ZC_CV, Vt, 128);
    __syncthreads();
    const int h = wave >> 1;
    const float lg0 = lgam[h], lg1 = lgam[4 + h];
    const float* rF = RS + (((size_t)0 * NCR + ci) * 4 + h) * 4096; const float* rB = RS + (((size_t)1 * NCR + ci) * 4 + h) * 4096;
#pragma unroll 1
    for (int tbi = 0; tbi < 4; ++tbi) {
        const int t = 16 * (4 * (wave & 1) + tbi) + qi;
        const bf16_t* qp = Z + (tok0 + t) * ZW + ZC_CQ + h * 64 + 8 * g;
        const bf16x8 q0 = *(const bf16x8*)qp, q1 = *(const bf16x8*)(qp + 32);
        f32x4 aI[4] = {}, aF[4] = {}, aB[4] = {};
#pragma unroll
        for (int eb = 0; eb < 4; ++eb) {
            const float* pf = rF + (16 * eb + qi) * 64 + 8 * g; const float* pb = rB + (16 * eb + qi) * 64 + 8 * g;
            aF[eb] = MFMA16(ld8f_pack(pf), q0, aF[eb]); aF[eb] = MFMA16(ld8f_pack(pf + 32), q1, aF[eb]);
            aB[eb] = MFMA16(ld8f_pack(pb), q0, aB[eb]); aB[eb] = MFMA16(ld8f_pack(pb + 32), q1, aB[eb]);
        }
#pragma unroll 1
        for (int sg = 0; sg < 4; ++sg) {
            f32x4 sc[2];
#pragma unroll
            for (int blk = 0; blk < 2; ++blk) {
                const int s = 32 * sg + 8 * (qi >> 2) + (qi & 3) + 4 * blk;
                const bf16_t* kp = Z + (tok0 + s) * ZW + ZC_CK + h * 64 + 8 * g;
                f32x4 z4 = {0.f, 0.f, 0.f, 0.f};
                z4 = MFMA16(*(const bf16x8*)kp, q0, z4); z4 = MFMA16(*(const bf16x8*)(kp + 32), q1, z4); sc[blk] = z4;
            }
            float pj[8];
#pragma unroll
            for (int j = 0; j < 8; ++j) { const int s = 32 * sg + 8 * g + j; const int dd = t - s;
                const float dec = (dd >= 0) ? __expf(lg0 * (float)dd) : __expf(lg1 * (float)(-dd));
                pj[j] = (j < 4 ? sc[0][j] : sc[1][j - 4]) * dec; }
            const bf16x8 P = pack8(pj);
#pragma unroll
            for (int eb = 0; eb < 4; ++eb) aI[eb] = MFMA16(gather8(Vt + ((size_t)h * 128 + 32 * sg + 8 * g) * 68 + 16 * eb + qi, 68), P, aI[eb]);
        }
        const float wf = __expf(lg0 * (float)(t + 1)), wb = __expf(lg1 * (float)(128 - t));
        float ss = 0.f;
#pragma unroll
        for (int eb = 0; eb < 4; ++eb) { aI[eb] = aI[eb] + aF[eb] * wf + aB[eb] * wb;
            ss += (aI[eb].x * aI[eb].x + aI[eb].y * aI[eb].y) + (aI[eb].z * aI[eb].z + aI[eb].w * aI[eb].w); }
        ss += __shfl_xor(ss, 16); ss += __shfl_xor(ss, 32);
        const float rn = rsqrtf(ss * (1.0f / 64) + EPS);
#pragma unroll
        for (int eb = 0; eb < 4; ++eb) { const int e = 16 * eb + 4 * g;
            const u32x2 gw = *(const u32x2*)(Z + (tok0 + t) * ZW + ZC_CG + h * 64 + e);
            const f32x4 gn = *(const f32x4*)(rnorm + h * 64 + e);
            const float b0 = bflo(gw.x), b1 = bfhi(gw.x), b2 = bflo(gw.y), b3 = bfhi(gw.y);
            const float o0 = aI[eb].x * rn * gn.x * (b0 / (1.f + __expf(-b0))), o1 = aI[eb].y * rn * gn.y * (b1 / (1.f + __expf(-b1)));
            const float o2 = aI[eb].z * rn * gn.z * (b2 / (1.f + __expf(-b2))), o3 = aI[eb].w * rn * gn.w * (b3 / (1.f + __expf(-b3)));
            u32x2 w; w.x = cvt_pk_bf16(o0, o1); w.y = cvt_pk_bf16(o2, o3);
            *(u32x2*)(MIX + (tok0 + t) * D + 768 + h * 64 + e) = w; }
    }
    __syncthreads();
}

__device__ __forceinline__ void phase_scan(float* __restrict__ GS, const float* __restrict__ GD, float* __restrict__ RS, const float* __restrict__ lgam, int S) {
    const int tid = opaque_tid();
    const int nseq = MG / S, ncg = S / 64, ncr = S / 128;
    const int gtid = blockIdx.x * NTHR + tid, gth = gridDim.x * NTHR;
    const int n_gla = 2 * nseq * 4 * 2048, n_ret = 2 * nseq * 4 * 4096;
    for (int idx = gtid; idx < n_gla + n_ret; idx += gth) {
        if (idx < n_gla) {
            const int el = idx & 2047, hh = (idx >> 11) & 3, sq = (idx >> 13) % nseq, dir = (idx >> 13) / nseq, kk = el & 31;
            float st = 0.f;
#pragma unroll 8
            for (int i = 0; i < ncg; ++i) { const int c = dir ? ncg - 1 - i : i; const size_t cgi = (size_t)sq * ncg + c;
                float* a = GS + (((size_t)dir * NCH + cgi) * 4 + hh) * 2048 + el; const float dec = GD[(((size_t)dir * NCH + cgi) * 4 + hh) * 32 + kk];
                const float tmp = *a; *a = st; st = dec * st + tmp; }
        } else {
            const int j = idx - n_gla; const int el = j & 4095, hh = (j >> 12) & 3, sq = (j >> 14) % nseq, dir = (j >> 14) / nseq;
            const float dec = __expf(128.f * lgam[dir * 4 + hh]);
            float st = 0.f;
#pragma unroll 8
            for (int i = 0; i < ncr; ++i) { const int c = dir ? ncr - 1 - i : i; const size_t cgi = (size_t)sq * ncr + c;
                float* a = RS + (((size_t)dir * NCR + cgi) * 4 + hh) * 4096 + el;
                const float tmp = *a; *a = st; st = dec * st + tmp; }
        }
    }
}

#define XB_TMO      128
#define XB_XCNT(j)  (256  + 64 * (j))
#define XB_XSUB(j)  (1280 + 64 * (j))
#define XB_XGEN(j)  (2304 + 64 * (j))
#define XB_TOP      3328
#define XB_TOPGEN   3392
#define XCD_BAR_WORDS 3456
#define XB_SPIN_CAP (1u << 22)
#define LAS __attribute__((address_space(3)))
__device__ __forceinline__ unsigned xb_ld(unsigned* p)              { return __hip_atomic_load(p, __ATOMIC_RELAXED, __HIP_MEMORY_SCOPE_AGENT); }
__device__ __forceinline__ unsigned xb_add(unsigned* p, unsigned v) { return __hip_atomic_fetch_add(p, v, __ATOMIC_RELAXED, __HIP_MEMORY_SCOPE_AGENT); }
__device__ __forceinline__ unsigned xb_xcc_id() { return (unsigned)__builtin_amdgcn_s_getreg((3 << 11) | 20) & 0xFu; }
#define XB_SPIN(cond, bar) do { unsigned _sp = 0; while (cond) { __builtin_amdgcn_s_sleep(1); \
    if ((++_sp & 255u) == 0u) { if (xb_ld(&(bar)[XB_TMO])) break; if (_sp > XB_SPIN_CAP) { atomicAdd(&(bar)[XB_TMO], 1u); break; } } } } while (0)
struct XcdBarrier { unsigned* bar; unsigned x; volatile LAS unsigned* st; };
__device__ __forceinline__ XcdBarrier xcd_barrier_post(unsigned* bar, volatile LAS unsigned* st) {
    XcdBarrier b; b.bar = bar; b.x = xb_xcc_id(); b.st = st;
    if (threadIdx.x == 0) (void)xb_add(&bar[XB_XCNT(b.x)], 1u);
    return b;
}
__device__ __forceinline__ void xcd_barrier_complete(unsigned* bar, unsigned x, unsigned& nloc, unsigned& nx) {
    const unsigned G = gridDim.x * gridDim.y * gridDim.z;
    unsigned sum, cnt, mine, sp = 0u;
    for (;;) {
        sum = 0u; cnt = 0u; mine = 0u;
#pragma unroll
        for (unsigned j = 0; j < 16; ++j) { const unsigned c = xb_ld(&bar[XB_XCNT(j)]); sum += c; cnt += (c > 0u) ? 1u : 0u; mine = (j == x) ? c : mine; }
        if (sum == G) break;
        __builtin_amdgcn_s_sleep(1);
        if ((++sp & 255u) == 0u) { if (xb_ld(&bar[XB_TMO])) break; if (sp > XB_SPIN_CAP) { atomicAdd(&bar[XB_TMO], 1u); break; } }
    }
    nloc = mine > 0u ? mine : 1u; nx = cnt > 0u ? cnt : 1u;
}
__device__ __forceinline__ void xcd_barrier(const XcdBarrier& b) {
    asm volatile("s_waitcnt vmcnt(0)" ::: "memory");
    __syncthreads();
    if (threadIdx.x == 0) {
        unsigned* bar = b.bar;
        __builtin_amdgcn_s_waitcnt(0);
        unsigned nloc = b.st[0], nx = b.st[1];
        if (nloc == 0u) { xcd_barrier_complete(bar, b.x, nloc, nx); b.st[0] = nloc; b.st[1] = nx; }
        const unsigned old = xb_add(&bar[XB_XSUB(b.x)], 1u);
        const unsigned gen = old / nloc;
        if (old + 1u == (gen + 1u) * nloc) {
            __builtin_amdgcn_fence(__ATOMIC_RELEASE, "agent");
            asm volatile("s_waitcnt vmcnt(0)" ::: "memory");
            const unsigned og = xb_add(&bar[XB_TOP], 1u);
            const unsigned tg = og / nx;
            if (og + 1u == (tg + 1u) * nx) xb_add(&bar[XB_TOPGEN], 1u);
            else XB_SPIN(xb_ld(&bar[XB_TOPGEN]) == tg, bar);
            __builtin_amdgcn_fence(__ATOMIC_ACQUIRE, "agent");
            xb_add(&bar[XB_XGEN(b.x)], 1u);
            asm volatile("s_waitcnt vmcnt(0)" ::: "memory");
        } else {
            XB_SPIN(xb_ld(&bar[XB_XGEN(b.x)]) == gen, bar);
            __builtin_amdgcn_fence(__ATOMIC_ACQUIRE, "agent");
            asm volatile("s_waitcnt vmcnt(0)" ::: "memory");
        }
    }
    __syncthreads();
}

__global__ void __launch_bounds__(NTHR, 2) fwd_mega(Params p) {
    cg::grid_group grid = cg::this_grid();
    unsigned char* ws = p.ws;
    bf16_t* WT = (bf16_t*)(ws + WS_WT); const float* tab = (const float*)(ws + WS_TAB);
    bf16_t* HB0 = (bf16_t*)(ws + WS_HB); bf16_t* HB1 = (bf16_t*)(ws + WS_HB1);
    float* SSQ0 = (float*)(ws + WS_SSQ); float* SSQ1 = SSQ0 + (size_t)MG * 16; float* SSQ2 = SSQ1 + (size_t)MG * 16;
    bf16_t* Z = (bf16_t*)(ws + WS_Z); bf16_t* MIX = (bf16_t*)(ws + WS_MIX); bf16_t* HID = (bf16_t*)(ws + WS_HID);
    bf16_t* PB = (bf16_t*)(ws + WS_PB); bf16_t* PL = (bf16_t*)(ws + WS_PLE);
    float* GS = (float*)(ws + WS_GS); float* GD = (float*)(ws + WS_GD); float* RS = (float*)(ws + WS_RS);
    float* lgam = (float*)(g_lds + LDS_BYTES - 64);

#ifndef NO_P0
    phase_weights(p);
#endif
    unsigned* barw = (unsigned*)(ws + WS_BAR);
    volatile LAS unsigned* bst = (volatile LAS unsigned*)(g_lds + LDS_BYTES - 32);
    if (blockIdx.x == 0) for (int i = threadIdx.x; i < XCD_BAR_WORDS; i += NTHR) barw[i] = 0u;
    if (threadIdx.x < 2) bst[threadIdx.x] = 0u;
    grid.sync();
    const XcdBarrier xb = xcd_barrier_post(barw, bst);
#pragma unroll 1
    for (int g = 0; g < NGROUPS; ++g) {
        const int S = (g == 0) ? 16384 : 2048;
        float* H = p.out + (size_t)g * MG * D;
#ifndef NO_PI
        phase_init(p, g);
#endif
        xcd_barrier(xb);
#pragma unroll 1
        for (int l = 0; l < NLAYER; ++l) {
            const bf16_t* W = WT + (size_t)l * W_LAYER;
            { const int t8 = opaque_tid(); if (t8 < 8) { const float x = p.ret_decay_raw[l * 8 + t8]; lgam[t8] = fminf(x, 0.f) - log1pf(__expf(-fabsf(x))); } }
            __syncthreads();
            { EpiIn e{Z, SSQ0, p.attn_q_norm + l * 64, p.attn_k_norm + l * 64, p.gla_gate_bias + l * 256, tab, S - 1};
#ifndef NO_P1
#ifndef REP_P1
#define REP_P1 1
#endif
              gemm_phase(HB0, D, W + WO_IN, D, MG, ZW, D, e);
#if REP_P1 > 1
              xcd_barrier(xb); gemm_phase(HB0, D, W + WO_IN, D, MG, ZW, D, e);
#endif
#endif
 }
            xcd_barrier(xb);
#ifndef REP_MIX
#define REP_MIX 1
#endif
            for (int rep_mix = 0; rep_mix < REP_MIX; ++rep_mix) {
            { const int nA = 2048, nG = NCH, nR = 2 * NCR;
              for (int it = blockIdx.x; it < nA + nG + nR; it += gridDim.x) {
#ifndef NO_AT
                  if (it < nA) attn_item(Z, MIX, S, it);
#endif
#ifndef NO_G1
                  if (it >= nA && it < nA + nG) gla1_item(Z, GS, GD, it - nA);
#endif
#ifndef NO_R1
                  if (it >= nA + nG) ret1_item(Z, RS, lgam, it - nA - nG);
#endif
              } }
            xcd_barrier(xb);
#ifndef NO_P3
            phase_scan(GS, GD, RS, lgam, S);
#endif
            xcd_barrier(xb);
            { for (int it = blockIdx.x; it < NCH + NCR; it += gridDim.x) {
#ifndef NO_G3
                  if (it < NCH) gla3_item(Z, GS, MIX, p.gla_out_norm + l * 256, it);
#endif
#ifndef NO_R3
                  if (it >= NCH) ret3_item(Z, RS, MIX, p.ret_out_norm + l * 256, lgam, it - NCH);
#endif
              } }
            xcd_barrier(xb);
            }
#ifndef NO_P5
            { EpiRes e{H, HB1, SSQ1}; gemm_phase(MIX, D, W + WO_OUT, D, MG, D, D, e); }
#endif
            xcd_barrier(xb);
#ifndef NO_P6
            { EpiMlpIn e{HID, SSQ1}; gemm_phase(HB1, D, W + WO_MI, D, MG, DFF, D, e); }
#endif
#ifndef NO_P6B
            { EpiPlain e{PB, D}; gemm_phase(PL + (size_t)l * MG * PLE, PLE, W + WO_PP, PLE, MG, D, PLE, e); }
#endif
            xcd_barrier(xb);
#ifndef NO_P7
            { EpiRes e{H, HB1, SSQ2}; gemm_phase(HID, DFF, W + WO_MO, DFF, MG, D, DFF, e); }
#endif
            xcd_barrier(xb);
#ifndef NO_P9
            { EpiPeGate e{H, HB0, SSQ0, SSQ2, PB}; gemm_phase(HB1, D, W + WO_PG, D, MG, D, D, e); }
#endif
            xcd_barrier(xb);
        }
    }
}

extern "C" void kernel_launch(void* const* d_in, const int* in_sizes, int n_in, void* d_out, int out_size, void* d_ws, size_t ws_size, hipStream_t stream) {
    static int grid_blocks = 0;
    if (!grid_blocks) {
        int dev = 0, cus = 0, per_cu = 0;
        hipGetDevice(&dev);
        hipDeviceGetAttribute(&cus, hipDeviceAttributeMultiprocessorCount, dev);
        hipFuncSetAttribute((const void*)fwd_mega, hipFuncAttributeMaxDynamicSharedMemorySize, LDS_BYTES);
        hipOccupancyMaxActiveBlocksPerMultiprocessor(&per_cu, (const void*)fwd_mega, NTHR, LDS_BYTES);
        if (per_cu < 1) per_cu = 1;
        grid_blocks = cus * 1;
        if (ws_size < WS_END) fprintf(stderr, "kernel_launch: workspace too small: %zu < %zu\n", ws_size, (size_t)WS_END);
    }
    Params p{};
    p.x_prompt = (const float*)d_in[0]; p.x_sample = (const float*)d_in[1]; p.p_prompt = (const float*)d_in[2]; p.p_sample = (const float*)d_in[3];
    p.ln_mix = (const float*)d_in[4]; p.w_in = (const float*)d_in[5]; p.attn_q_norm = (const float*)d_in[6]; p.attn_k_norm = (const float*)d_in[7];
    p.gla_gate_up = (const float*)d_in[8]; p.gla_gate_bias = (const float*)d_in[9]; p.gla_out_norm = (const float*)d_in[10]; p.ret_decay_raw = (const float*)d_in[11];
    p.ret_out_norm = (const float*)d_in[12]; p.w_out = (const float*)d_in[13]; p.ln_mlp = (const float*)d_in[14]; p.w_mlp_in = (const float*)d_in[15]; p.w_mlp_out = (const float*)d_in[16];
    p.ln_pe = (const float*)d_in[17]; p.w_pe_gate = (const float*)d_in[18]; p.w_pe_proj = (const float*)d_in[19];
    p.out = (float*)d_out; p.ws = (unsigned char*)d_ws;
    void* args[] = {&p};
    hipError_t e = hipLaunchCooperativeKernel((const void*)fwd_mega, dim3(grid_blocks), dim3(NTHR), args, LDS_BYTES, stream);
    if (e != hipSuccess) fprintf(stderr, "cooperative launch failed: %s (grid %d)\n", hipGetErrorString(e), grid_blocks);
}
```

```cpp
#include <hip/hip_runtime.h>
#include <hip/hip_cooperative_groups.h>
#include <cstdio>
#include <cstdint>
namespace cg = cooperative_groups;

typedef unsigned short bf16_t;
typedef short bf16x8 __attribute__((ext_vector_type(8)));
typedef float f32x4 __attribute__((ext_vector_type(4)));
typedef unsigned u32x4 __attribute__((ext_vector_type(4)));
typedef unsigned u32x2 __attribute__((ext_vector_type(2)));

constexpr int D = 1024, MG = 32768, NGROUPS = 3, NLAYER = 2;
constexpr int ZW = 3584, DFF = 4096, PLE = 256, NIN = 3360;
constexpr int NTHR = 512;
constexpr int NCH = MG / 64;
constexpr int NCR = MG / 128;
constexpr float EPS = 1e-6f;
constexpr int ZC_AQ = 0, ZC_AK = 512, ZC_AV = 1024, ZC_BQ = 1536, ZC_BK = 1664, ZC_BV = 1792, ZC_BR = 2048,
              ZC_GF = 2304, ZC_GB = 2432, ZC_CQ = 2560, ZC_CK = 2816, ZC_CV = 3072, ZC_CG = 3328;
constexpr size_t WO_IN = 0, WO_OUT = WO_IN + (size_t)ZW * D, WO_MI = WO_OUT + (size_t)D * D, WO_MO = WO_MI + (size_t)DFF * D,
                 WO_PG = WO_MO + (size_t)D * DFF, WO_PP = WO_PG + (size_t)D * D, W_LAYER = WO_PP + (size_t)D * PLE;
constexpr size_t WS_WT = 0;
constexpr size_t WS_TAB = WS_WT + W_LAYER * 2 * NLAYER;
constexpr size_t WS_HB = WS_TAB + (size_t)16384 * 40 * 2 * 4;
constexpr size_t WS_HB1 = WS_HB + (size_t)MG * D * 2;
constexpr size_t WS_SSQ = WS_HB1 + (size_t)MG * D * 2;
constexpr size_t WS_Z = WS_SSQ + (size_t)3 * MG * 16 * 4;
constexpr size_t WS_MIX = WS_Z + (size_t)MG * ZW * 2;
constexpr size_t WS_HID = WS_MIX + (size_t)MG * D * 2;
constexpr size_t WS_PB = WS_HID + (size_t)MG * DFF * 2;
constexpr size_t WS_PLE = WS_PB + (size_t)MG * D * 2;
constexpr size_t WS_GS = WS_PLE + (size_t)NLAYER * MG * PLE * 2;
constexpr size_t WS_GD = WS_GS + (size_t)2 * NCH * 4 * 2048 * 4;
constexpr size_t WS_RS = WS_GD + (size_t)2 * NCH * 4 * 32 * 4;
constexpr size_t WS_BAR = WS_RS + (size_t)2 * NCR * 4 * 4096 * 4;
constexpr size_t WS_END = WS_BAR + 16384;

constexpr int LDS_BYTES = 139264;

extern __shared__ __attribute__((aligned(16))) unsigned char g_lds[];

struct Params {
    const float* x_prompt; const float* x_sample; const float* p_prompt; const float* p_sample;
    const float* ln_mix; const float* w_in; const float* attn_q_norm; const float* attn_k_norm;
    const float* gla_gate_up; const float* gla_gate_bias; const float* gla_out_norm; const float* ret_decay_raw;
    const float* ret_out_norm; const float* w_out; const float* ln_mlp; const float* w_mlp_in; const float* w_mlp_out;
    const float* ln_pe; const float* w_pe_gate; const float* w_pe_proj;
    float* out; unsigned char* ws;
};

typedef float f32x2_t __attribute__((ext_vector_type(2)));
typedef __bf16 bf16x2_t __attribute__((ext_vector_type(2)));
__device__ __forceinline__ unsigned cvt_pk_bf16(float lo, float hi) { const f32x2_t v = {lo, hi}; return __builtin_bit_cast(unsigned, __builtin_convertvector(v, bf16x2_t)); }
__device__ __forceinline__ float bf2f(unsigned short b) { return __uint_as_float(((unsigned)b) << 16); }
__device__ __forceinline__ float bflo(unsigned w) { return __uint_as_float(w << 16); }
__device__ __forceinline__ float bfhi(unsigned w) { return __uint_as_float(w & 0xffff0000u); }
__device__ __forceinline__ bf16x8 pack8(const float (&v)[8]) {
    u32x4 w; w.x = cvt_pk_bf16(v[0], v[1]); w.y = cvt_pk_bf16(v[2], v[3]); w.z = cvt_pk_bf16(v[4], v[5]); w.w = cvt_pk_bf16(v[6], v[7]);
    return __builtin_bit_cast(bf16x8, w);
}
__device__ __forceinline__ void unpack8(bf16x8 b, float (&v)[8]) {
    u32x4 w = __builtin_bit_cast(u32x4, b);
    v[0] = bflo(w.x); v[1] = bfhi(w.x); v[2] = bflo(w.y); v[3] = bfhi(w.y); v[4] = bflo(w.z); v[5] = bfhi(w.z); v[6] = bflo(w.w); v[7] = bfhi(w.w);
}
__device__ __forceinline__ bf16x8 gather8(const bf16_t* base, int stride) {
    bf16x8 r;
#pragma unroll
    for (int j = 0; j < 8; ++j) r[j] = (short)base[j * stride];
    return r;
}
__device__ __forceinline__ bf16x8 ld8f_pack(const float* p) {
    f32x4 a = *(const f32x4*)p, b = *(const f32x4*)(p + 4);
    u32x4 w; w.x = cvt_pk_bf16(a.x, a.y); w.y = cvt_pk_bf16(a.z, a.w); w.z = cvt_pk_bf16(b.x, b.y); w.w = cvt_pk_bf16(b.z, b.w);
    return __builtin_bit_cast(bf16x8, w);
}
__device__ __forceinline__ int opaque_tid() { int t = threadIdx.x; asm volatile("" : "+v"(t)); return t; }
#define LDS_FENCE() asm volatile("s_waitcnt lgkmcnt(0)" ::: "memory")
#define MFMA16(a, b, c) __builtin_amdgcn_mfma_f32_16x16x32_bf16((a), (b), (c), 0, 0, 0)

constexpr int BM = 256, BK = 64, HALF = 128, HT = HALF * BK;
__device__ __forceinline__ int lds_byte(int r, int c) {
    int st = (r >> 4) * 2 + (c >> 5), rr = r & 15, cc = c & 31, ob = rr * 64 + cc * 2;
    return st * 1024 + (ob ^ (((ob >> 9) & 1) << 5));
}
__device__ __forceinline__ void stage_rc(int b, int& R, int& C) {
    int st = b / 1024, sb = b % 1024, swz = sb ^ (((sb >> 9) & 1) << 5);
    R = (st >> 1) * 16 + swz / 64; C = (st & 1) * 32 + (swz % 64) / 2;
}
__device__ __forceinline__ bool tile_of(int L, int nM, int nN, int& pm, int& pn) {
    const int nwg = nM * nN; if (L >= nwg) return false;
    int wgid = L; { const int q = nwg / 8, r = nwg % 8, xcd = wgid % 8, off = wgid / 8; wgid = (xcd < r ? xcd * (q + 1) : r * (q + 1) + (xcd - r) * q) + off; }
    const int nig = 8 * nN, gid = wgid / nig, fm = gid * 8, gsz = (nM - fm) < 8 ? (nM - fm) : 8;
    pm = fm + ((wgid % nig) % gsz); pn = (wgid % nig) / gsz; return true;
}

template <class Epi>
__device__ __forceinline__ void gemm_tile(const bf16_t* __restrict__ A, int lda, const bf16_t* __restrict__ Bt, int ldb, int K, int brow, int bcol, const Epi& epi) {
    const int tid = opaque_tid();
    bf16_t* shm = (bf16_t*)g_lds;
#define SA(b, h) (shm + ((b) * 2 + (h)) * HT)
#define SB(b, h) (shm + (4 + (b) * 2 + (h)) * HT)
#define STAGE(P, BASE, LD, br, kt) do { const int _so = ((br) * (LD) + (kt) * BK) * 2; \
    for (int _i = 0; _i < 2; ++_i) { \
      __builtin_amdgcn_raw_ptr_buffer_load_lds(((&(LD) == &lda) ? rsA : rsB), (__attribute__((address_space(3))) void*)((char*)(P) + wid * 1024 + _i * 8192), 16, \
          ((&(LD) == &lda) ? offA[_i] : offB[_i]), _so, 0, 0); } } while (0)
#define LDA(dst, b, h) for (int m = 0; m < 4; ++m) for (int k = 0; k < 2; ++k) \
    dst[m][k] = *reinterpret_cast<const bf16x8*>((char*)SA(b, h) + lds_byte(wr * 64 + m * 16 + fr, k * 32 + fq * 8))
#define LDB(dst, b, h) for (int n = 0; n < 2; ++n) for (int k = 0; k < 2; ++k) \
    dst[n][k] = *reinterpret_cast<const bf16x8*>((char*)SB(b, h) + lds_byte(wc * 32 + n * 16 + fr, k * 32 + fq * 8))
#define MMA(ai, bj, At, Bt_) do { __builtin_amdgcn_s_setprio(1); \
    for (int m = 0; m < 4; ++m) for (int n = 0; n < 2; ++n) for (int k = 0; k < 2; ++k) \
      acc[ai][bj][m][n] = __builtin_amdgcn_mfma_f32_16x16x32_bf16(At[m][k], Bt_[n][k], acc[ai][bj][m][n], 0, 0, 0); \
    __builtin_amdgcn_s_setprio(0); } while (0)
#define WAIT_V(n) asm volatile("s_waitcnt vmcnt(" #n ")" ::: "memory")
#define WAIT_L(n) asm volatile("s_waitcnt lgkmcnt(" #n ")" ::: "memory")
#define BAR __builtin_amdgcn_s_barrier()
#define SCHED __builtin_amdgcn_sched_barrier(0)
    const int wid = __builtin_amdgcn_readfirstlane(tid >> 6), lane = tid & 63, wr = wid >> 2, wc = wid & 3, fr = lane & 15, fq = lane >> 4;
    f32x4 acc[2][2][4][2] = {};
    bf16x8 At[4][2], B0[2][2], B1[2][2];
    const int nt = K / BK;
    const __amdgpu_buffer_rsrc_t rsA = __builtin_amdgcn_make_buffer_rsrc((void*)A, (short)0, 0x7ffffff0, 0x00020000);
    const __amdgpu_buffer_rsrc_t rsB = __builtin_amdgcn_make_buffer_rsrc((void*)Bt, (short)0, 0x7ffffff0, 0x00020000);
    unsigned offA[2], offB[2];
    for (int _i = 0; _i < 2; ++_i) { int _r, _c; stage_rc(tid * 16 + _i * 8192, _r, _c); offA[_i] = (unsigned)(_r * lda + _c) * 2u; offB[_i] = (unsigned)(_r * ldb + _c) * 2u; }
    STAGE(SB(0, 0), Bt, ldb, bcol, 0); STAGE(SA(0, 0), A, lda, brow, 0);
    STAGE(SB(0, 1), Bt, ldb, bcol + HALF, 0); STAGE(SA(0, 1), A, lda, brow + HALF, 0);
    if (wr == 1) BAR;
    WAIT_V(4); BAR;
    STAGE(SB(1, 0), Bt, ldb, bcol, 1); STAGE(SA(1, 0), A, lda, brow, 1); STAGE(SB(1, 1), Bt, ldb, bcol + HALF, 1);
    WAIT_V(6); BAR;
#pragma unroll 1
    for (int t = 0; t < nt - 2; t += 2) {
        LDB(B0, 0, 0); SCHED; LDA(At, 0, 0); STAGE(SA(1, 1), A, lda, brow + HALF, t + 1);
        WAIT_L(8); BAR; WAIT_L(0); MMA(0, 0, At, B0); BAR; SCHED;
        LDB(B1, 0, 1); STAGE(SB(0, 0), Bt, ldb, bcol, t + 2);
        BAR; WAIT_L(0); MMA(0, 1, At, B1); BAR;
        LDA(At, 0, 1); STAGE(SA(0, 0), A, lda, brow, t + 2);
        BAR; WAIT_L(0); MMA(1, 0, At, B0); BAR; SCHED;
        STAGE(SB(0, 1), Bt, ldb, bcol + HALF, t + 2);
        WAIT_V(6); BAR; MMA(1, 1, At, B1); BAR;
        LDB(B0, 1, 0); SCHED; LDA(At, 1, 0); STAGE(SA(0, 1), A, lda, brow + HALF, t + 2);
        WAIT_L(8); BAR; WAIT_L(0); MMA(0, 0, At, B0); BAR; SCHED;
        LDB(B1, 1, 1); STAGE(SB(1, 0), Bt, ldb, bcol, t + 3);
        BAR; WAIT_L(0); MMA(0, 1, At, B1); BAR;
        LDA(At, 1, 1); STAGE(SA(1, 0), A, lda, brow, t + 3);
        BAR; WAIT_L(0); MMA(1, 0, At, B0); BAR; SCHED;
        STAGE(SB(1, 1), Bt, ldb, bcol + HALF, t + 3);
        WAIT_V(6); BAR; MMA(1, 1, At, B1); BAR;
    }
    { LDB(B0, 0, 0); LDA(At, 0, 0); STAGE(SA(1, 1), A, lda, brow + HALF, nt - 1);
      BAR; WAIT_L(0); MMA(0, 0, At, B0); BAR;
      LDB(B1, 0, 1); BAR; WAIT_L(0); MMA(0, 1, At, B1); BAR;
      LDA(At, 0, 1); WAIT_V(4); BAR; WAIT_L(0); MMA(1, 0, At, B0); MMA(1, 1, At, B1); BAR; }
    { LDB(B0, 1, 0); LDA(At, 1, 0); WAIT_V(2); BAR; WAIT_L(0); MMA(0, 0, At, B0); BAR;
      LDB(B1, 1, 1); WAIT_V(0); BAR; WAIT_L(0); MMA(0, 1, At, B1); BAR;
      LDA(At, 1, 1); BAR; WAIT_L(0); MMA(1, 0, At, B0); MMA(1, 1, At, B1); BAR; }
    if (wr == 0) BAR;
    float* ep = (float*)g_lds;
    __syncthreads();
#pragma unroll
    for (int ai = 0; ai < 2; ++ai) {
        if (ai) __syncthreads();
#pragma unroll
        for (int bj = 0; bj < 2; ++bj)
#pragma unroll
            for (int m = 0; m < 4; ++m)
#pragma unroll
                for (int n = 0; n < 2; ++n)
#pragma unroll
                    for (int j = 0; j < 4; ++j)
                        ep[(wr * 64 + m * 16 + fq * 4 + j) * 260 + bj * HALF + wc * 32 + n * 16 + fr] = acc[ai][bj][m][n][j];
        __syncthreads();
        int lane_e = tid & 63; asm volatile("" : "+v"(lane_e));
        const int row0 = brow + ai * HALF + wid * 16;
        const float rsv = epi.begin(row0, lane_e);
#pragma unroll 4
        for (int i = 0; i < 16; ++i) {
            const f32x4 v = *(const f32x4*)(ep + (wid * 16 + i) * 260 + 4 * lane_e);
            epi.row(v, row0 + i, bcol + 4 * lane_e, lane_e, __shfl(rsv, 4 * i));
        }
    }
    __syncthreads();
#undef SA
#undef SB
#undef STAGE
#undef LDA
#undef LDB
#undef MMA
}

template <class Epi>
__device__ __forceinline__ void gemm_phase(const bf16_t* A, int lda, const bf16_t* Bt, int ldb, int M, int N, int K, const Epi& epi) {
    const int nM = M / BM, nN = N / BM;
    for (int i = 0;; ++i) {
        int pm, pn; if (!tile_of(i * (int)gridDim.x + (int)blockIdx.x, nM, nN, pm, pn)) break;
        gemm_tile(A, lda, Bt, ldb, K, pm * BM, pn * BM, epi);
    }
}

__device__ __forceinline__ float rstd16(const float* ssq, int row0, int lane) {
    const f32x4 q = *(const f32x4*)(ssq + (size_t)(row0 + (lane >> 2)) * 16 + 4 * (lane & 3));
    float s = (q.x + q.y) + (q.z + q.w); s += __shfl_xor(s, 1); s += __shfl_xor(s, 2);
    return rsqrtf(s * (1.0f / D) + EPS);
}
__device__ __forceinline__ float seg_sum16(float s) { s += __shfl_xor(s, 1); s += __shfl_xor(s, 2); s += __shfl_xor(s, 4); s += __shfl_xor(s, 8); return s; }
__device__ __forceinline__ void st4_bf16(bf16_t* d, float a, float b, float c, float e) { u32x2 w; w.x = cvt_pk_bf16(a, b); w.y = cvt_pk_bf16(c, e); *(u32x2*)d = w; }

struct EpiIn {
    bf16_t* Z; const float* ssq; const float* qn; const float* kn; const float* gbias; const float* tab; int smask;
    __device__ __forceinline__ float begin(int row0, int lane) const { return rstd16(ssq, row0, lane); }
    __device__ __forceinline__ void row(f32x4 v, int row, int col, int lane, float rstd) const {
        const int pos = row & smask, c = col & 63, sl = lane & 15;
        bf16_t* dst = Z + (size_t)row * ZW + col;
        if (col < ZC_AV) {
            const bool isq = col < ZC_AK;
            const f32x4 gn = *(const f32x4*)((isq ? qn : kn) + c);
            const float ss = seg_sum16((v.x * v.x + v.y * v.y) + (v.z * v.z + v.w * v.w));
            const float r = rsqrtf(ss * rstd * rstd * (1.0f / 64) + EPS) * rstd * (isq ? 0.125f : 1.0f);
            v.x *= r * gn.x; v.y *= r * gn.y; v.z *= r * gn.z; v.w *= r * gn.w;
            f32x4 pv; pv.x = __shfl_xor(v.x, 2); pv.y = __shfl_xor(v.y, 2); pv.z = __shfl_xor(v.z, 2); pv.w = __shfl_xor(v.w, 2);
            if (sl < 4) {
                const float* cs = tab + (size_t)pos * 80 + 2 * (c & 7);
                const f32x4 t0 = *(const f32x4*)cs, t1 = *(const f32x4*)(cs + 4);
                if (sl < 2) { v.x = v.x * t0.x - pv.x * t0.y; v.y = v.y * t0.z - pv.y * t0.w; v.z = v.z * t1.x - pv.z * t1.y; v.w = v.w * t1.z - pv.w * t1.w; }
                else        { v.x = v.x * t0.x + pv.x * t0.y; v.y = v.y * t0.z + pv.y * t0.w; v.z = v.z * t1.x + pv.z * t1.y; v.w = v.w * t1.z + pv.w * t1.w; }
            }
            st4_bf16(dst, v.x, v.y, v.z, v.w);
        } else if (col >= ZC_GF && col < ZC_CQ) {
            const f32x4 bb = *(const f32x4*)(gbias + (col - ZC_GF));
            float x[4] = {v.x * rstd + bb.x, v.y * rstd + bb.y, v.z * rstd + bb.z, v.w * rstd + bb.w}; unsigned short hb[4];
#pragma unroll
            for (int i = 0; i < 4; ++i) { const float ls = fminf(x[i], 0.f) - __logf(1.0f + __expf(-fabsf(x[i]))); const _Float16 hv = (_Float16)(ls * 0.0625f); hb[i] = __builtin_bit_cast(unsigned short, hv); }
            u32x2 w; w.x = hb[0] | ((unsigned)hb[1] << 16); w.y = hb[2] | ((unsigned)hb[3] << 16);
            *(u32x2*)dst = w;
        } else if (col >= ZC_CQ && col < ZC_CV) {
            const float sc = rstd * ((col >= ZC_CK) ? 0.125f : 1.0f);
            v.x *= sc; v.y *= sc; v.z *= sc; v.w *= sc;
            f32x4 pv; pv.x = __shfl_xor(v.x, 8); pv.y = __shfl_xor(v.y, 8); pv.z = __shfl_xor(v.z, 8); pv.w = __shfl_xor(v.w, 8);
            const float* cs = tab + (size_t)pos * 80 + 16 + 2 * (c & 31);
            const f32x4 t0 = *(const f32x4*)cs, t1 = *(const f32x4*)(cs + 4);
            if (sl < 8) { v.x = v.x * t0.x - pv.x * t0.y; v.y = v.y * t0.z - pv.y * t0.w; v.z = v.z * t1.x - pv.z * t1.y; v.w = v.w * t1.z - pv.w * t1.w; }
            else        { v.x = v.x * t0.x + pv.x * t0.y; v.y = v.y * t0.z + pv.y * t0.w; v.z = v.z * t1.x + pv.z * t1.y; v.w = v.w * t1.z + pv.w * t1.w; }
            st4_bf16(dst, v.x, v.y, v.z, v.w);
        } else {
            const float sc = rstd * ((col >= ZC_BQ && col < ZC_BK) ? 0.17677669529663687f : 1.0f);
            st4_bf16(dst, v.x * sc, v.y * sc, v.z * sc, v.w * sc);
        }
    }
};

struct EpiRes {
    float* H; bf16_t* HB; float* ssq;
    __device__ __forceinline__ float begin(int, int) const { return 0.f; }
    __device__ __forceinline__ void row(f32x4 v, int row, int col, int lane, float) const {
        float* hp = H + (size_t)row * D + col;
        f32x4 h = *(const f32x4*)hp; h += v; *(f32x4*)hp = h;
        st4_bf16(HB + (size_t)row * D + col, h.x, h.y, h.z, h.w);
        const float ss = seg_sum16((h.x * h.x + h.y * h.y) + (h.z * h.z + h.w * h.w));
        if ((lane & 15) == 0) ssq[(size_t)row * 16 + (col >> 6)] = ss;
    }
};

struct EpiMlpIn {
    bf16_t* HID; const float* ssq;
    __device__ __forceinline__ float begin(int row0, int lane) const { return rstd16(ssq, row0, lane); }
    __device__ __forceinline__ void row(f32x4 v, int row, int col, int, float rstd) const {
        const float a = fmaxf(v.x * rstd, 0.f), b = fmaxf(v.y * rstd, 0.f), c = fmaxf(v.z * rstd, 0.f), e = fmaxf(v.w * rstd, 0.f);
        st4_bf16(HID + (size_t)row * DFF + col, a * a, b * b, c * c, e * e);
    }
};

struct EpiPlain {
    bf16_t* O; int ldo;
    __device__ __forceinline__ float begin(int, int) const { return 0.f; }
    __device__ __forceinline__ void row(f32x4 v, int row, int col, int, float) const { st4_bf16(O + (size_t)row * ldo + col, v.x, v.y, v.z, v.w); }
};

struct EpiPeGate {
    float* H; bf16_t* HB; float* ssq_out; const float* ssq_in; const bf16_t* PB;
    __device__ __forceinline__ float begin(int row0, int lane) const { return rstd16(ssq_in, row0, lane); }
    __device__ __forceinline__ void row(f32x4 v, int row, int col, int lane, float rstd) const {
        float* hp = H + (size_t)row * D + col;
        const u32x2 pw = *(const u32x2*)(PB + (size_t)row * D + col);
        f32x4 h = *(const f32x4*)hp;
        h.x += bflo(pw.x) / (1.0f + __expf(-v.x * rstd)); h.y += bfhi(pw.x) / (1.0f + __expf(-v.y * rstd));
        h.z += bflo(pw.y) / (1.0f + __expf(-v.z * rstd)); h.w += bfhi(pw.y) / (1.0f + __expf(-v.w * rstd));
        *(f32x4*)hp = h;
        st4_bf16(HB + (size_t)row * D + col, h.x, h.y, h.z, h.w);
        const float ss = seg_sum16((h.x * h.x + h.y * h.y) + (h.z * h.z + h.w * h.w));
        if ((lane & 15) == 0) ssq_out[(size_t)row * 16 + (col >> 6)] = ss;
    }
};

template <class F>
__device__ __forceinline__ void transpose_item(bf16_t* Wt, int K, int k0, int n0, const F& src) {
    const int tid = opaque_tid();
    float* tile = (float*)g_lds;
#pragma unroll
    for (int i = 0; i < 8; ++i) { const int kk = (tid >> 6) + 8 * i, nn = tid & 63; tile[kk * 65 + nn] = src(k0 + kk, n0 + nn); }
    __syncthreads();
    { const int nn = tid >> 3, kc = tid & 7; float t[8];
#pragma unroll
      for (int j = 0; j < 8; ++j) t[j] = tile[(8 * kc + j) * 65 + nn];
      *(bf16x8*)(Wt + (size_t)(n0 + nn) * K + k0 + 8 * kc) = pack8(t); }
    __syncthreads();
}

__device__ __forceinline__ void phase_weights(const Params& p) {
    bf16_t* WT = (bf16_t*)(p.ws + WS_WT);
    constexpr int I_IN = 16 * (ZW / 64), I_OUT = 16 * 16, I_MI = 16 * 64, I_MO = 64 * 16, I_PG = 16 * 16, I_PP = 4 * 16;
    constexpr int I_L = I_IN + I_OUT + I_MI + I_MO + I_PG + I_PP;
    for (int it = blockIdx.x; it < NLAYER * I_L; it += gridDim.x) {
        const int l = it / I_L; int r = it % I_L;
        bf16_t* W = WT + (size_t)l * W_LAYER;
        if (r < I_IN) {
            const int kb = r / (ZW / 64), nb = r % (ZW / 64);
            const float* w = p.w_in + (size_t)l * D * NIN; const float* g = p.ln_mix + l * D; const float* gu = p.gla_gate_up + (size_t)l * 2 * 16 * 128;
            transpose_item(W + WO_IN, D, kb * 64, nb * 64, [&](int k, int c) -> float {
                float v;
                if (c < ZC_GF) v = w[(size_t)k * NIN + c];
                else if (c < ZC_CQ) { const int j = (c - ZC_GF) >> 7, kk = (c - ZC_GF) & 127; float s = 0.f;
                    for (int rr = 0; rr < 16; ++rr) s += w[(size_t)k * NIN + 2304 + 16 * j + rr] * gu[(j * 16 + rr) * 128 + kk];
                    v = s; }
                else v = w[(size_t)k * NIN + (c - 224)];
                return v * g[k]; });
            continue; }
        r -= I_IN;
        if (r < I_OUT) { const float* w = p.w_out + (size_t)l * D * D;
            transpose_item(W + WO_OUT, D, (r / 16) * 64, (r % 16) * 64, [&](int k, int c) -> float { return w[(size_t)k * D + c]; }); continue; }
        r -= I_OUT;
        if (r < I_MI) { const float* w = p.w_mlp_in + (size_t)l * D * DFF; const float* g = p.ln_mlp + l * D;
            transpose_item(W + WO_MI, D, (r / 64) * 64, (r % 64) * 64, [&](int k, int c) -> float { return w[(size_t)k * DFF + c] * g[k]; }); continue; }
        r -= I_MI;
        if (r < I_MO) { const float* w = p.w_mlp_out + (size_t)l * DFF * D;
            transpose_item(W + WO_MO, DFF, (r / 16) * 64, (r % 16) * 64, [&](int k, int c) -> float { return w[(size_t)k * D + c]; }); continue; }
        r -= I_MO;
        if (r < I_PG) { const float* w = p.w_pe_gate + (size_t)l * D * D; const float* g = p.ln_pe + l * D;
            transpose_item(W + WO_PG, D, (r / 16) * 64, (r % 16) * 64, [&](int k, int c) -> float { return w[(size_t)k * D + c] * g[k]; }); continue; }
        r -= I_PG;
        { const float* w = p.w_pe_proj + (size_t)l * PLE * D;
            transpose_item(W + WO_PP, PLE, (r / 16) * 64, (r % 16) * 64, [&](int k, int c) -> float { return w[(size_t)k * D + c]; }); }
    }
    float* tab = (float*)(p.ws + WS_TAB);
    for (int e = blockIdx.x * NTHR + threadIdx.x; e < 16384 * 40; e += gridDim.x * NTHR) {
        const int pos = e / 40, i = e % 40;
        const double invf = (i < 8) ? exp(-(double)i * (log(500000.0) / 8.0)) : exp(-(double)(i - 8) * (log(10000.0) / 32.0));
        double ang = (double)pos * invf; ang -= 6.283185307179586476925 * floor(ang * 0.15915494309189533577);
        tab[2 * e] = (float)cos(ang); tab[2 * e + 1] = (float)sin(ang);
    }
}

__device__ __forceinline__ void phase_init(const Params& p, int g) {
    const int tid = opaque_tid();
    const float* x = (g == 0) ? p.x_prompt : p.x_sample + (size_t)(g - 1) * MG * D;
    float* H = p.out + (size_t)g * MG * D; bf16_t* HB = (bf16_t*)(p.ws + WS_HB); float* ssq = (float*)(p.ws + WS_SSQ);
    const int lane = tid & 63, gw = blockIdx.x * 8 + (tid >> 6), NGW = gridDim.x * 8;
    for (int row = gw; row < MG; row += NGW) {
#pragma unroll
        for (int j = 0; j < 4; ++j) {
            const f32x4 v = *(const f32x4*)(x + (size_t)row * D + 256 * j + 4 * lane);
            *(f32x4*)(H + (size_t)row * D + 256 * j + 4 * lane) = v;
            u32x2 w; w.x = cvt_pk_bf16(v.x, v.y); w.y = cvt_pk_bf16(v.z, v.w);
            *(u32x2*)(HB + (size_t)row * D + 256 * j + 4 * lane) = w;
            float s = (v.x * v.x + v.y * v.y) + (v.z * v.z + v.w * v.w);
            s += __shfl_xor(s, 1); s += __shfl_xor(s, 2); s += __shfl_xor(s, 4); s += __shfl_xor(s, 8);
            if ((lane & 15) == 0) ssq[(size_t)row * 16 + (lane >> 4) + 4 * j] = s;
        }
    }
    bf16_t* PL = (bf16_t*)(p.ws + WS_PLE);
    for (int l = 0; l < NLAYER; ++l) {
        const float* src = (g == 0) ? p.p_prompt + (size_t)l * MG * PLE : p.p_sample + ((size_t)l * 2 * MG + (size_t)(g - 1) * MG) * PLE;
        bf16_t* dst = PL + (size_t)l * MG * PLE;
        for (size_t e = (size_t)(blockIdx.x * NTHR + tid) * 8; e < (size_t)MG * PLE; e += (size_t)gridDim.x * NTHR * 8)
            *(bf16x8*)(dst + e) = ld8f_pack(src + e);
    }
}

struct AttnLd { bf16x8 ka0, ka1, kb0, kb1; u32x4 v0, v1, v2, v3; };
__device__ __forceinline__ void attn_geom(int f, int r, int n0, int& dsh, int& cb) {
    const int p = f < 12 ? 0 : (f < 18 ? 1 : 2); const int i2 = f - (p == 0 ? 0 : (p == 1 ? 12 : 18));
    dsh = 2 * p; cb = (r >> dsh) + (16 >> dsh) * n0 - 64 + 32 * i2;
}
__device__ __forceinline__ AttnLd attn_load(const bf16_t* __restrict__ zq, int S, int head, int r, int n0, int lane, int f) {
    int dsh, cb; attn_geom(f, r, n0, dsh, cb);
    const int qi = lane & 15, g = lane >> 4, rd = r & ((1 << dsh) - 1), ncls = S >> dsh;
    const int cA = cb + 8 * (qi >> 2) + (qi & 3), cB = cA + 4;
    const int cAc = min(max(cA, 0), ncls - 1), cBc = min(max(cB, 0), ncls - 1);
    const bf16_t* kA = zq + (size_t)(rd + (cAc << dsh)) * ZW + ZC_AK + head * 64 + 8 * g;
    const bf16_t* kB = zq + (size_t)(rd + (cBc << dsh)) * ZW + ZC_AK + head * 64 + 8 * g;
    AttnLd L;
    L.ka0 = *(const bf16x8*)kA; L.ka1 = *(const bf16x8*)(kA + 32); L.kb0 = *(const bf16x8*)kB; L.kb1 = *(const bf16x8*)(kB + 32);
    const int cv0 = cb + (lane >> 3);
    const bf16_t* vb = zq + ZC_AV + head * 64 + 8 * (lane & 7);
    L.v0 = *(const u32x4*)(vb + (size_t)(rd + (min(max(cv0, 0), ncls - 1) << dsh)) * ZW);
    L.v1 = *(const u32x4*)(vb + (size_t)(rd + (min(max(cv0 + 8, 0), ncls - 1) << dsh)) * ZW);
    L.v2 = *(const u32x4*)(vb + (size_t)(rd + (min(max(cv0 + 16, 0), ncls - 1) << dsh)) * ZW);
    L.v3 = *(const u32x4*)(vb + (size_t)(rd + (min(max(cv0 + 24, 0), ncls - 1) << dsh)) * ZW);
    return L;
}
__device__ __forceinline__ void attn_item(const bf16_t* __restrict__ Z, bf16_t* __restrict__ MIX, int S, int it) {
    const int tid = opaque_tid();
    const int wave = tid >> 6, lane = tid & 63, qi = lane & 15, g = lane >> 4;
    const int nbs = S >> 8;
    const int rhalf = it & 1; int t1 = it >> 1; const int nb = t1 % nbs; t1 /= nbs; const int head = t1 & 7, seq = t1 >> 3;
    const int r = rhalf * 8 + wave, n0 = nb * 16;
    const bf16_t* zq = Z + (size_t)seq * S * ZW;
    bf16_t* Vs = (bf16_t*)g_lds + wave * (32 * 68);
    const int pq = r + 16 * (n0 + qi);
    AttnLd cur = attn_load(zq, S, head, r, n0, lane, 0);
    const bf16x8 q0 = *(const bf16x8*)(zq + (size_t)pq * ZW + ZC_AQ + head * 64 + 8 * g);
    const bf16x8 q1 = *(const bf16x8*)(zq + (size_t)pq * ZW + ZC_AQ + head * 64 + 32 + 8 * g);
    float m = -1e30f, lsum = 0.f;
    f32x4 O[4] = {};
#pragma unroll 1
    for (int f = 0; f < 23; ++f) {
        const AttnLd nxt = attn_load(zq, S, head, r, n0, lane, f < 22 ? f + 1 : 22);
        int dsh, cb; attn_geom(f, r, n0, dsh, cb);
        const int ncls = S >> dsh, cq = (r >> dsh) + (16 >> dsh) * (n0 + qi);
        f32x4 sA = {0.f, 0.f, 0.f, 0.f}, sB = {0.f, 0.f, 0.f, 0.f};
        sA = MFMA16(cur.ka0, q0, sA); sA = MFMA16(cur.ka1, q1, sA);
        sB = MFMA16(cur.kb0, q0, sB); sB = MFMA16(cur.kb1, q1, sB);
        LDS_FENCE();
        { bf16_t* d = Vs + (lane >> 3) * 68 + 8 * (lane & 7);
          *(u32x2*)d = (u32x2){cur.v0.x, cur.v0.y}; *(u32x2*)(d + 4) = (u32x2){cur.v0.z, cur.v0.w};
          *(u32x2*)(d + 8 * 68) = (u32x2){cur.v1.x, cur.v1.y}; *(u32x2*)(d + 8 * 68 + 4) = (u32x2){cur.v1.z, cur.v1.w};
          *(u32x2*)(d + 16 * 68) = (u32x2){cur.v2.x, cur.v2.y}; *(u32x2*)(d + 16 * 68 + 4) = (u32x2){cur.v2.z, cur.v2.w};
          *(u32x2*)(d + 24 * 68) = (u32x2){cur.v3.x, cur.v3.y}; *(u32x2*)(d + 24 * 68 + 4) = (u32x2){cur.v3.z, cur.v3.w}; }
        float s[8]; bool ok[8];
#pragma unroll
        for (int j = 0; j < 8; ++j) { const int c = cb + 8 * g + j; const int dd = c - cq;
            ok[j] = (c >= 0) && (c < ncls) && (dd <= 64) && (dd >= -64);
            s[j] = ok[j] ? (j < 4 ? sA[j] : sB[j - 4]) : -1e30f; }
        float mx = fmaxf(fmaxf(fmaxf(s[0], s[1]), fmaxf(s[2], s[3])), fmaxf(fmaxf(s[4], s[5]), fmaxf(s[6], s[7])));
        mx = fmaxf(mx, __shfl_xor(mx, 16)); mx = fmaxf(mx, __shfl_xor(mx, 32));
        const float mn = fmaxf(m, mx), alpha = __expf(m - mn);
        m = mn;
        float pj[8], ps_ = 0.f;
#pragma unroll
        for (int j = 0; j < 8; ++j) { pj[j] = ok[j] ? __expf(s[j] - mn) : 0.f; ps_ += pj[j]; }
        lsum = lsum * alpha + ps_;
        const bf16x8 P = pack8(pj);
#pragma unroll
        for (int nbk = 0; nbk < 4; ++nbk) O[nbk] *= alpha;
        LDS_FENCE();
#pragma unroll
        for (int nbk = 0; nbk < 4; ++nbk) { const bf16x8 vf = gather8(Vs + (8 * g) * 68 + 16 * nbk + qi, 68); O[nbk] = MFMA16(vf, P, O[nbk]); }
        cur = nxt;
    }
    lsum += __shfl_xor(lsum, 16); lsum += __shfl_xor(lsum, 32);
    const float inv = 1.0f / lsum;
    bf16_t* op = MIX + ((size_t)seq * S + pq) * D + head * 64 + 4 * g;
#pragma unroll
    for (int nbk = 0; nbk < 4; ++nbk) { u32x2 w; w.x = cvt_pk_bf16(O[nbk].x * inv, O[nbk].y * inv); w.y = cvt_pk_bf16(O[nbk].z * inv, O[nbk].w * inv); *(u32x2*)(op + 16 * nbk) = w; }
    LDS_FENCE();
}

__device__ __forceinline__ float h2f(unsigned short b) { return (float)__builtin_bit_cast(_Float16, b); }

__device__ __forceinline__ void stage_v4(const bf16_t* __restrict__ Z, size_t tok0, int zc, bf16_t* Vt, int nrows) {
    const int tid = opaque_tid();
    for (int idx = tid; idx < nrows * 32; idx += NTHR) {
        const int t = idx >> 5, ch = idx & 31, hh = ch >> 3, c8 = ch & 7;
        const u32x4 v = *(const u32x4*)(Z + (tok0 + t) * ZW + zc + ch * 8);
        bf16_t* d = Vt + ((size_t)hh * nrows + t) * 68 + c8 * 8;
        *(u32x2*)d = (u32x2){v.x, v.y}; *(u32x2*)(d + 4) = (u32x2){v.z, v.w};
    }
}

__device__ __forceinline__ void gla_cum(const bf16_t* __restrict__ Z, size_t tok0, int h, int dir, int lane, float (&cum)[32], float& tot) {
    const int kk = lane & 31, hf = lane >> 5;
    const bf16_t* src = Z + (tok0 + 32 * hf) * ZW + ZC_GF + dir * 128 + h * 32 + kk;
    float part = 0.f;
#pragma unroll
    for (int i = 0; i < 32; ++i) { cum[i] = h2f(src[(size_t)i * ZW]); part += cum[i]; }
    const float other = __shfl_xor(part, 32);
    tot = part + other;
    if (dir == 0) { float run = hf ? other : 0.f;
#pragma unroll
        for (int i = 0; i < 32; ++i) { run += cum[i]; cum[i] = run; } }
    else { float run = hf ? 0.f : other;
#pragma unroll
        for (int i = 31; i >= 0; --i) { run += cum[i]; cum[i] = run; } }
}

__device__ __forceinline__ void gla1_item(const bf16_t* __restrict__ Z, float* __restrict__ GS, float* __restrict__ GD, int ci) {
    const int tid = opaque_tid();
    __syncthreads();
    const int wave = tid >> 6, lane = tid & 63, qi = lane & 15, g = lane >> 4;
    const int h = wave >> 1, dir = wave & 1;
    const size_t tok0 = (size_t)ci * 64;
    bf16_t* Vt = (bf16_t*)g_lds;
    bf16_t* Ks = (bf16_t*)g_lds + 4 * 64 * 68 + wave * (64 * 36);
    stage_v4(Z, tok0, ZC_BV, Vt, 64);
    float cum[32], tot;
    gla_cum(Z, tok0, h, dir, lane, cum, tot);
    { const int kk = lane & 31, hf = lane >> 5;
      const bf16_t* ksrc = Z + (tok0 + 32 * hf) * ZW + ZC_BK + h * 32 + kk;
#pragma unroll
      for (int i = 0; i < 32; ++i) { const float kv = bf2f(ksrc[(size_t)i * ZW]) * __expf(tot - cum[i]);
          Ks[(32 * hf + i) * 36 + kk] = (bf16_t)(cvt_pk_bf16(kv, 0.f) & 0xffffu); }
      if (hf == 0) GD[(((size_t)dir * NCH + ci) * 4 + h) * 32 + kk] = __expf(tot); }
    __syncthreads();
    f32x4 acc[4][2] = {};
#pragma unroll
    for (int ks = 0; ks < 2; ++ks) {
        bf16x8 bfr[2];
#pragma unroll
        for (int kb = 0; kb < 2; ++kb) bfr[kb] = gather8(Ks + (32 * ks + 8 * g) * 36 + 16 * kb + qi, 36);
#pragma unroll
        for (int eb = 0; eb < 4; ++eb) { const bf16x8 af = gather8(Vt + ((size_t)h * 64 + 32 * ks + 8 * g) * 68 + 16 * eb + qi, 68);
#pragma unroll
            for (int kb = 0; kb < 2; ++kb) acc[eb][kb] = MFMA16(af, bfr[kb], acc[eb][kb]); }
    }
    float* dst = GS + (((size_t)dir * NCH + ci) * 4 + h) * 2048;
#pragma unroll
    for (int eb = 0; eb < 4; ++eb)
#pragma unroll
        for (int kb = 0; kb < 2; ++kb)
#pragma unroll
            for (int i = 0; i < 4; ++i) dst[(16 * eb + 4 * g + i) * 32 + 16 * kb + qi] = acc[eb][kb][i];
    __syncthreads();
}

__device__ __forceinline__ void gla3_item(const bf16_t* __restrict__ Z, const float* __restrict__ GS, bf16_t* __restrict__ MIX, const float* __restrict__ gnorm, int ci) {
    const int tid = opaque_tid();
    __syncthreads();
    const int wave = tid >> 6, lane = tid & 63, qi = lane & 15, g = lane >> 4;
    const size_t tok0 = (size_t)ci * 64;
    bf16_t* Vt = (bf16_t*)g_lds;
    float* CUM = (float*)(g_lds + 4 * 64 * 68 * 2);
    stage_v4(Z, tok0, ZC_BV, Vt, 64);
    { const int h = wave >> 1, dir = wave & 1; float cum[32], tot;
      gla_cum(Z, tok0, h, dir, lane, cum, tot);
      const int kk = lane & 31, hf = lane >> 5; float* cd = CUM + ((size_t)(h * 2 + dir) * 64 + 32 * hf) * 32 + kk;
#pragma unroll
      for (int i = 0; i < 32; ++i) cd[i * 32] = cum[i]; }
    __syncthreads();
    const int h = wave >> 1;
    const float* cF = CUM + (size_t)(h * 2 + 0) * 64 * 32; const float* cB = CUM + (size_t)(h * 2 + 1) * 64 * 32;
#pragma unroll 1
    for (int tbi = 0; tbi < 2; ++tbi) {
        const int t = 16 * (2 * (wave & 1) + tbi) + qi;
        bf16x8 Qf, Qb;
        { float qv[8], a[8], b[8]; unpack8(*(const bf16x8*)(Z + (tok0 + t) * ZW + ZC_BQ + h * 32 + 8 * g), qv);
#pragma unroll
          for (int j = 0; j < 8; ++j) { a[j] = qv[j] * __expf(cF[t * 32 + 8 * g + j]); b[j] = qv[j] * __expf(cB[t * 32 + 8 * g + j]); }
          Qf = pack8(a); Qb = pack8(b); }
        f32x4 acc[4] = {};
        const float* sF = GS + (((size_t)0 * NCH + ci) * 4 + h) * 2048; const float* sB = GS + (((size_t)1 * NCH + ci) * 4 + h) * 2048;
#pragma unroll
        for (int eb = 0; eb < 4; ++eb) { acc[eb] = MFMA16(ld8f_pack(sF + (16 * eb + qi) * 32 + 8 * g), Qf, acc[eb]); acc[eb] = MFMA16(ld8f_pack(sB + (16 * eb + qi) * 32 + 8 * g), Qb, acc[eb]); }
#pragma unroll
        for (int sg = 0; sg < 2; ++sg) {
            f32x4 aF[2], aB[2];
#pragma unroll
            for (int blk = 0; blk < 2; ++blk) {
                const int s = 32 * sg + 8 * (qi >> 2) + (qi & 3) + 4 * blk;
                float kv[8], a[8], b[8]; unpack8(*(const bf16x8*)(Z + (tok0 + s) * ZW + ZC_BK + h * 32 + 8 * g), kv);
#pragma unroll
                for (int j = 0; j < 8; ++j) { a[j] = kv[j] * __expf(-cF[s * 32 + 8 * g + j]); b[j] = kv[j] * __expf(-cB[s * 32 + 8 * g + j]); }
                const f32x4 z4 = {0.f, 0.f, 0.f, 0.f};
                aF[blk] = MFMA16(pack8(a), Qf, z4); aB[blk] = MFMA16(pack8(b), Qb, z4);
            }
            float pj[8];
#pragma unroll
            for (int j = 0; j < 8; ++j) { const int s = 32 * sg + 8 * g + j; pj[j] = (s <= t) ? (j < 4 ? aF[0][j] : aF[1][j - 4]) : (j < 4 ? aB[0][j] : aB[1][j - 4]); }
            const bf16x8 P = pack8(pj);
#pragma unroll
            for (int eb = 0; eb < 4; ++eb) acc[eb] = MFMA16(gather8(Vt + ((size_t)h * 64 + 32 * sg + 8 * g) * 68 + 16 * eb + qi, 68), P, acc[eb]);
        }
        float ss = 0.f;
#pragma unroll
        for (int eb = 0; eb < 4; ++eb) ss += (acc[eb].x * acc[eb].x + acc[eb].y * acc[eb].y) + (acc[eb].z * acc[eb].z + acc[eb].w * acc[eb].w);
        ss += __shfl_xor(ss, 16); ss += __shfl_xor(ss, 32);
        const float rn = rsqrtf(ss * (1.0f / 64) + EPS);
#pragma unroll
        for (int eb = 0; eb < 4; ++eb) { const int e = 16 * eb + 4 * g;
            const u32x2 brw = *(const u32x2*)(Z + (tok0 + t) * ZW + ZC_BR + h * 64 + e);
            const f32x4 gn = *(const f32x4*)(gnorm + h * 64 + e);
            const float b0 = bflo(brw.x), b1 = bfhi(brw.x), b2 = bflo(brw.y), b3 = bfhi(brw.y);
            const float o0 = acc[eb].x * rn * gn.x * (b0 / (1.f + __expf(-b0))), o1 = acc[eb].y * rn * gn.y * (b1 / (1.f + __expf(-b1)));
            const float o2 = acc[eb].z * rn * gn.z * (b2 / (1.f + __expf(-b2))), o3 = acc[eb].w * rn * gn.w * (b3 / (1.f + __expf(-b3)));
            u32x2 w; w.x = cvt_pk_bf16(o0, o1); w.y = cvt_pk_bf16(o2, o3);
            *(u32x2*)(MIX + (tok0 + t) * D + 512 + h * 64 + e) = w; }
    }
    __syncthreads();
}

__device__ __forceinline__ void ret1_item(const bf16_t* __restrict__ Z, float* __restrict__ RS, const float* __restrict__ lgam, int item) {
    const int tid = opaque_tid();
    __syncthreads();
    const int wave = tid >> 6, lane = tid & 63, qi = lane & 15, g = lane >> 4;
    const int ci = item >> 1, hp = item & 1;
    const size_t tok0 = (size_t)ci * 128;
    bf16_t* Vt = (bf16_t*)g_lds;
    bf16_t* Kt = Vt + 2 * 128 * 68;
    for (int idx = tid; idx < 128 * 16 * 2; idx += NTHR) {
        const int which = idx >> 11, r = idx & 2047, t = r >> 4, ch = r & 15, hh = ch >> 3, c8 = ch & 7;
        const u32x4 v = *(const u32x4*)(Z + (tok0 + t) * ZW + (which ? ZC_CK : ZC_CV) + hp * 128 + ch * 8);
        bf16_t* d = (which ? Kt : Vt) + ((size_t)hh * 128 + t) * 68 + c8 * 8;
        *(u32x2*)d = (u32x2){v.x, v.y}; *(u32x2*)(d + 4) = (u32x2){v.z, v.w};
    }
    __syncthreads();
    const int hh = wave >> 2, dir = (wave >> 1) & 1, eh = wave & 1, head = 2 * hp + hh;
    const float lg = lgam[dir * 4 + head];
    f32x4 acc[2][4] = {};
#pragma unroll 1
    for (int ks = 0; ks < 4; ++ks) {
        float w[8];
#pragma unroll
        for (int j = 0; j < 8; ++j) { const int s = 32 * ks + 8 * g + j; w[j] = __expf(lg * (float)(dir ? s : 127 - s)); }
        bf16x8 bfr[4];
#pragma unroll
        for (int db = 0; db < 4; ++db) { float kv[8]; unpack8(gather8(Kt + ((size_t)hh * 128 + 32 * ks + 8 * g) * 68 + 16 * db + qi, 68), kv);
#pragma unroll
            for (int j = 0; j < 8; ++j) kv[j] *= w[j];
            bfr[db] = pack8(kv); }
#pragma unroll
        for (int ebi = 0; ebi < 2; ++ebi) { const bf16x8 af = gather8(Vt + ((size_t)hh * 128 + 32 * ks + 8 * g) * 68 + 16 * (2 * eh + ebi) + qi, 68);
#pragma unroll
            for (int db = 0; db < 4; ++db) acc[ebi][db] = MFMA16(af, bfr[db], acc[ebi][db]); }
    }
    float* dst = RS + (((size_t)dir * NCR + ci) * 4 + head) * 4096;
#pragma unroll
    for (int ebi = 0; ebi < 2; ++ebi)
#pragma unroll
        for (int db = 0; db < 4; ++db)
#pragma unroll
            for (int i = 0; i < 4; ++i) dst[(16 * (2 * eh + ebi) + 4 * g + i) * 64 + 16 * db + qi] = acc[ebi][db][i];
    __syncthreads();
}

__device__ __forceinline__ void ret3_item(const bf16_t* __restrict__ Z, const float* __restrict__ RS, bf16_t* __restrict__ MIX, const float* __restrict__ rnorm, const float* __restrict__ lgam, int ci) {
    const int tid = opaque_tid();
    __syncthreads();
    const int wave = tid >> 6, lane = tid & 63, qi = lane & 15, g = lane >> 4;
    const size_t tok0 = (size_t)ci * 128;
    bf16_t* Vt = (bf16_t*)g_lds;
    stage_v4(Z, tok0, ZC_CV, Vt, 128);
    __syncthreads();
    const int h = wave >> 1;
    const float lg0 = lgam[h], lg1 = lgam[4 + h];
    const float* rF = RS + (((size_t)0 * NCR + ci) * 4 + h) * 4096; const float* rB = RS + (((size_t)1 * NCR + ci) * 4 + h) * 4096;
#pragma unroll 1
    for (int tbi = 0; tbi < 4; ++tbi) {
        const int t = 16 * (4 * (wave & 1) + tbi) + qi;
        const bf16_t* qp = Z + (tok0 + t) * ZW + ZC_CQ + h * 64 + 8 * g;
        const bf16x8 q0 = *(const bf16x8*)qp, q1 = *(const bf16x8*)(qp + 32);
        f32x4 aI[4] = {}, aF[4] = {}, aB[4] = {};
#pragma unroll
        for (int eb = 0; eb < 4; ++eb) {
            const float* pf = rF + (16 * eb + qi) * 64 + 8 * g; const float* pb = rB + (16 * eb + qi) * 64 + 8 * g;
            aF[eb] = MFMA16(ld8f_pack(pf), q0, aF[eb]); aF[eb] = MFMA16(ld8f_pack(pf + 32), q1, aF[eb]);
            aB[eb] = MFMA16(ld8f_pack(pb), q0, aB[eb]); aB[eb] = MFMA16(ld8f_pack(pb + 32), q1, aB[eb]);
        }
#pragma unroll 1
        for (int sg = 0; sg < 4; ++sg) {
            f32x4 sc[2];
#pragma unroll
            for (int blk = 0; blk < 2; ++blk) {
                const int s = 32 * sg + 8 * (qi >> 2) + (qi & 3) + 4 * blk;
                const bf16_t* kp = Z + (tok0 + s) * ZW + ZC_CK + h * 64 + 8 * g;
                f32x4 z4 = {0.f, 0.f, 0.f, 0.f};
                z4 = MFMA16(*(const bf16x8*)kp, q0, z4); z4 = MFMA16(*(const bf16x8*)(kp + 32), q1, z4); sc[blk] = z4;
            }
            float pj[8];
#pragma unroll
            for (int j = 0; j < 8; ++j) { const int s = 32 * sg + 8 * g + j; const int dd = t - s;
                const float dec = (dd >= 0) ? __expf(lg0 * (float)dd) : __expf(lg1 * (float)(-dd));
                pj[j] = (j < 4 ? sc[0][j] : sc[1][j - 4]) * dec; }
            const bf16x8 P = pack8(pj);
#pragma unroll
            for (int eb = 0; eb < 4; ++eb) aI[eb] = MFMA16(gather8(Vt + ((size_t)h * 128 + 32 * sg + 8 * g) * 68 + 16 * eb + qi, 68), P, aI[eb]);
        }
        const float wf = __expf(lg0 * (float)(t + 1)), wb = __expf(lg1 * (float)(128 - t));
        float ss = 0.f;
#pragma unroll
        for (int eb = 0; eb < 4; ++eb) { aI[eb] = aI[eb] + aF[eb] * wf + aB[eb] * wb;
            ss += (aI[eb].x * aI[eb].x + aI[eb].y * aI[eb].y) + (aI[eb].z * aI[eb].z + aI[eb].w * aI[eb].w); }
        ss += __shfl_xor(ss, 16); ss += __shfl_xor(ss, 32);
        const float rn = rsqrtf(ss * (1.0f / 64) + EPS);
#pragma unroll
        for (int eb = 0; eb < 4; ++eb) { const int e = 16 * eb + 4 * g;
            const u32x2 gw = *(const u32x2*)(Z + (tok0 + t) * ZW + ZC_CG + h * 64 + e);
            const f32x4 gn = *(const f32x4*)(rnorm + h * 64 + e);
            const float b0 = bflo(gw.x), b1 = bfhi(gw.x), b2 = bflo(gw.y), b3 = bfhi(gw.y);
            const float o0 = aI[eb].x * rn * gn.x * (b0 / (1.f + __expf(-b0))), o1 = aI[eb].y * rn * gn.y * (b1 / (1.f + __expf(-b1)));
            const float o2 = aI[eb].z * rn * gn.z * (b2 / (1.f + __expf(-b2))), o3 = aI[eb].w * rn * gn.w * (b3 / (1.f + __expf(-b3)));
            u32x2 w; w.x = cvt_pk_bf16(o0, o1); w.y = cvt_pk_bf16(o2, o3);
            *(u32x2*)(MIX + (tok0 + t) * D + 768 + h * 64 + e) = w; }
    }
    __syncthreads();
}

__device__ __forceinline__ void phase_scan(float* __restrict__ GS, const float* __restrict__ GD, float* __restrict__ RS, const float* __restrict__ lgam, int S) {
    const int tid = opaque_tid();
    const int lgn = (S == 16384) ? 1 : 4, nseq = 1 << lgn, ncg = S / 64, ncr = S / 128;
    const int gtid = blockIdx.x * NTHR + tid, gth = gridDim.x * NTHR;
    const int n_gla = 2 * nseq * 4 * 2048, n_ret = 2 * nseq * 4 * 4096;
    for (int idx = gtid; idx < n_gla + n_ret; idx += gth) {
        if (idx < n_gla) {
            const int el = idx & 2047, hh = (idx >> 11) & 3, sq = (idx >> 13) & (nseq - 1), dir = (idx >> 13) >> lgn, kk = el & 31;
            float st = 0.f;
#pragma unroll 8
            for (int i = 0; i < ncg; ++i) { const int c = dir ? ncg - 1 - i : i; const size_t cgi = (size_t)sq * ncg + c;
                float* a = GS + (((size_t)dir * NCH + cgi) * 4 + hh) * 2048 + el; const float dec = GD[(((size_t)dir * NCH + cgi) * 4 + hh) * 32 + kk];
                const float tmp = *a; *a = st; st = dec * st + tmp; }
        } else {
            const int j = idx - n_gla; const int el = j & 4095, hh = (j >> 12) & 3, sq = (j >> 14) & (nseq - 1), dir = (j >> 14) >> lgn;
            const float dec = __expf(128.f * lgam[dir * 4 + hh]);
            float st = 0.f;
#pragma unroll 8
            for (int i = 0; i < ncr; ++i) { const int c = dir ? ncr - 1 - i : i; const size_t cgi = (size_t)sq * ncr + c;
                float* a = RS + (((size_t)dir * NCR + cgi) * 4 + hh) * 4096 + el;
                const float tmp = *a; *a = st; st = dec * st + tmp; }
        }
    }
}

#define XB_TMO      128
#define XB_XCNT(j)  (256  + 64 * (j))
#define XB_XSUB(j)  (1280 + 64 * (j))
#define XB_XGEN(j)  (2304 + 64 * (j))
#define XB_TOP      3328
#define XB_TOPGEN   3392
#define XCD_BAR_WORDS 3456
#define XB_SPIN_CAP (1u << 22)
#define LAS __attribute__((address_space(3)))
__device__ __forceinline__ unsigned xb_ld(unsigned* p)              { return __hip_atomic_load(p, __ATOMIC_RELAXED, __HIP_MEMORY_SCOPE_AGENT); }
__device__ __forceinline__ unsigned xb_add(unsigned* p, unsigned v) { return __hip_atomic_fetch_add(p, v, __ATOMIC_RELAXED, __HIP_MEMORY_SCOPE_AGENT); }
__device__ __forceinline__ unsigned xb_xcc_id() { return (unsigned)__builtin_amdgcn_s_getreg((3 << 11) | 20) & 0xFu; }
#define XB_SPIN(cond, bar) do { unsigned _sp = 0; while (cond) { __builtin_amdgcn_s_sleep(1); \
    if ((++_sp & 255u) == 0u) { if (xb_ld(&(bar)[XB_TMO])) break; if (_sp > XB_SPIN_CAP) { atomicAdd(&(bar)[XB_TMO], 1u); break; } } } } while (0)
struct XcdBarrier { unsigned* bar; unsigned x; volatile LAS unsigned* st; };
__device__ __forceinline__ XcdBarrier xcd_barrier_post(unsigned* bar, volatile LAS unsigned* st) {
    XcdBarrier b; b.bar = bar; b.x = xb_xcc_id(); b.st = st;
    if (threadIdx.x == 0) (void)xb_add(&bar[XB_XCNT(b.x)], 1u);
    return b;
}
__device__ __forceinline__ void xcd_barrier_complete(unsigned* bar, unsigned x, unsigned& nloc, unsigned& nx) {
    const unsigned G = gridDim.x * gridDim.y * gridDim.z;
    unsigned sum, cnt, mine, sp = 0u;
    for (;;) {
        sum = 0u; cnt = 0u; mine = 0u;
#pragma unroll
        for (unsigned j = 0; j < 16; ++j) { const unsigned c = xb_ld(&bar[XB_XCNT(j)]); sum += c; cnt += (c > 0u) ? 1u : 0u; mine = (j == x) ? c : mine; }
        if (sum == G) break;
        __builtin_amdgcn_s_sleep(1);
        if ((++sp & 255u) == 0u) { if (xb_ld(&bar[XB_TMO])) break; if (sp > XB_SPIN_CAP) { atomicAdd(&bar[XB_TMO], 1u); break; } }
    }
    nloc = mine > 0u ? mine : 1u; nx = cnt > 0u ? cnt : 1u;
}
__device__ __forceinline__ void xcd_barrier(const XcdBarrier& b) {
    asm volatile("s_waitcnt vmcnt(0)" ::: "memory");
    __syncthreads();
    if (threadIdx.x == 0) {
        unsigned* bar = b.bar;
        __builtin_amdgcn_s_waitcnt(0);
        unsigned nloc = b.st[0], nx = b.st[1];
        if (nloc == 0u) { xcd_barrier_complete(bar, b.x, nloc, nx); b.st[0] = nloc; b.st[1] = nx; }
        const unsigned old = xb_add(&bar[XB_XSUB(b.x)], 1u);
        const unsigned gen = old / nloc;
        if (old + 1u == (gen + 1u) * nloc) {
            __builtin_amdgcn_fence(__ATOMIC_RELEASE, "agent");
            asm volatile("s_waitcnt vmcnt(0)" ::: "memory");
            const unsigned og = xb_add(&bar[XB_TOP], 1u);
            const unsigned tg = og / nx;
            if (og + 1u == (tg + 1u) * nx) xb_add(&bar[XB_TOPGEN], 1u);
            else XB_SPIN(xb_ld(&bar[XB_TOPGEN]) == tg, bar);
            __builtin_amdgcn_fence(__ATOMIC_ACQUIRE, "agent");
            xb_add(&bar[XB_XGEN(b.x)], 1u);
            asm volatile("s_waitcnt vmcnt(0)" ::: "memory");
        } else {
            XB_SPIN(xb_ld(&bar[XB_XGEN(b.x)]) == gen, bar);
            __builtin_amdgcn_fence(__ATOMIC_ACQUIRE, "agent");
            asm volatile("s_waitcnt vmcnt(0)" ::: "memory");
        }
    }
    __syncthreads();
}

__global__ void __launch_bounds__(NTHR, 2) fwd_mega(Params p) {
    cg::grid_group grid = cg::this_grid();
    unsigned char* ws = p.ws;
    bf16_t* WT = (bf16_t*)(ws + WS_WT); const float* tab = (const float*)(ws + WS_TAB);
    bf16_t* HB0 = (bf16_t*)(ws + WS_HB); bf16_t* HB1 = (bf16_t*)(ws + WS_HB1);
    float* SSQ0 = (float*)(ws + WS_SSQ); float* SSQ1 = SSQ0 + (size_t)MG * 16; float* SSQ2 = SSQ1 + (size_t)MG * 16;
    bf16_t* Z = (bf16_t*)(ws + WS_Z); bf16_t* MIX = (bf16_t*)(ws + WS_MIX); bf16_t* HID = (bf16_t*)(ws + WS_HID);
    bf16_t* PB = (bf16_t*)(ws + WS_PB); bf16_t* PL = (bf16_t*)(ws + WS_PLE);
    float* GS = (float*)(ws + WS_GS); float* GD = (float*)(ws + WS_GD); float* RS = (float*)(ws + WS_RS);
    float* lgam = (float*)(g_lds + LDS_BYTES - 64);

#ifndef NO_P0
    phase_weights(p);
#endif
    unsigned* barw = (unsigned*)(ws + WS_BAR);
    volatile LAS unsigned* bst = (volatile LAS unsigned*)(g_lds + LDS_BYTES - 32);
    if (blockIdx.x == 0) for (int i = threadIdx.x; i < XCD_BAR_WORDS; i += NTHR) barw[i] = 0u;
    if (threadIdx.x < 2) bst[threadIdx.x] = 0u;
    grid.sync();
    const XcdBarrier xb = xcd_barrier_post(barw, bst);
#pragma unroll 1
    for (int g = 0; g < NGROUPS; ++g) {
        const int S = (g == 0) ? 16384 : 2048;
        float* H = p.out + (size_t)g * MG * D;
#ifndef NO_PI
        phase_init(p, g);
#endif
        xcd_barrier(xb);
#pragma unroll 1
        for (int l = 0; l < NLAYER; ++l) {
            const bf16_t* W = WT + (size_t)l * W_LAYER;
            { const int t8 = opaque_tid(); if (t8 < 8) { const float x = p.ret_decay_raw[l * 8 + t8]; lgam[t8] = fminf(x, 0.f) - __logf(1.0f + __expf(-fabsf(x))); } }
            __syncthreads();
            { EpiIn e{Z, SSQ0, p.attn_q_norm + l * 64, p.attn_k_norm + l * 64, p.gla_gate_bias + l * 256, tab, S - 1};
#ifndef NO_P1
#ifndef REP_P1
#define REP_P1 1
#endif
              gemm_phase(HB0, D, W + WO_IN, D, MG, ZW, D, e);
#if REP_P1 > 1
              xcd_barrier(xb); gemm_phase(HB0, D, W + WO_IN, D, MG, ZW, D, e);
#endif
#endif
 }
            xcd_barrier(xb);
#ifndef REP_MIX
#define REP_MIX 1
#endif
            for (int rep_mix = 0; rep_mix < REP_MIX; ++rep_mix) {
            { const int nA = 2048, nG = NCH, nR = 2 * NCR;
              for (int it = blockIdx.x; it < nA + nG + nR; it += gridDim.x) {
#ifndef NO_AT
                  if (it < nA) attn_item(Z, MIX, S, it);
#endif
#ifndef NO_G1
                  if (it >= nA && it < nA + nG) gla1_item(Z, GS, GD, it - nA);
#endif
#ifndef NO_R1
                  if (it >= nA + nG) ret1_item(Z, RS, lgam, it - nA - nG);
#endif
              } }
            xcd_barrier(xb);
#ifndef NO_P3
            phase_scan(GS, GD, RS, lgam, S);
#endif
            xcd_barrier(xb);
            { for (int it = blockIdx.x; it < NCH + NCR; it += gridDim.x) {
#ifndef NO_G3
                  if (it < NCH) gla3_item(Z, GS, MIX, p.gla_out_norm + l * 256, it);
#endif
#ifndef NO_R3
                  if (it >= NCH) ret3_item(Z, RS, MIX, p.ret_out_norm + l * 256, lgam, it - NCH);
#endif
              } }
            xcd_barrier(xb);
            }
#ifndef NO_P5
            { EpiRes e{H, HB1, SSQ1}; gemm_phase(MIX, D, W + WO_OUT, D, MG, D, D, e); }
#endif
            xcd_barrier(xb);
#ifndef NO_P6
            { EpiMlpIn e{HID, SSQ1}; gemm_phase(HB1, D, W + WO_MI, D, MG, DFF, D, e); }
#endif
#ifndef NO_P6B
            { EpiPlain e{PB, D}; gemm_phase(PL + (size_t)l * MG * PLE, PLE, W + WO_PP, PLE, MG, D, PLE, e); }
#endif
            xcd_barrier(xb);
#ifndef NO_P7
            { EpiRes e{H, HB1, SSQ2}; gemm_phase(HID, DFF, W + WO_MO, DFF, MG, D, DFF, e); }
#endif
            xcd_barrier(xb);
#ifndef NO_P9
            { EpiPeGate e{H, HB0, SSQ0, SSQ2, PB}; gemm_phase(HB1, D, W + WO_PG, D, MG, D, D, e); }
#endif
            xcd_barrier(xb);
        }
    }
}

extern "C" void kernel_launch(void* const* d_in, const int* in_sizes, int n_in, void* d_out, int out_size, void* d_ws, size_t ws_size, hipStream_t stream) {
    static int grid_blocks = 0;
    if (!grid_blocks) {
        int dev = 0, cus = 0, per_cu = 0;
        hipGetDevice(&dev);
        hipDeviceGetAttribute(&cus, hipDeviceAttributeMultiprocessorCount, dev);
        hipFuncSetAttribute((const void*)fwd_mega, hipFuncAttributeMaxDynamicSharedMemorySize, LDS_BYTES);
        hipOccupancyMaxActiveBlocksPerMultiprocessor(&per_cu, (const void*)fwd_mega, NTHR, LDS_BYTES);
        if (per_cu < 1) per_cu = 1;
        grid_blocks = cus * 1;
        if (ws_size < WS_END) fprintf(stderr, "kernel_launch: workspace too small: %zu < %zu\n", ws_size, (size_t)WS_END);
    }
    Params p{};
    p.x_prompt = (const float*)d_in[0]; p.x_sample = (const float*)d_in[1]; p.p_prompt = (const float*)d_in[2]; p.p_sample = (const float*)d_in[3];
    p.ln_mix = (const float*)d_in[4]; p.w_in = (const float*)d_in[5]; p.attn_q_norm = (const float*)d_in[6]; p.attn_k_norm = (const float*)d_in[7];
    p.gla_gate_up = (const float*)d_in[8]; p.gla_gate_bias = (const float*)d_in[9]; p.gla_out_norm = (const float*)d_in[10]; p.ret_decay_raw = (const float*)d_in[11];
    p.ret_out_norm = (const float*)d_in[12]; p.w_out = (const float*)d_in[13]; p.ln_mlp = (const float*)d_in[14]; p.w_mlp_in = (const float*)d_in[15]; p.w_mlp_out = (const float*)d_in[16];
    p.ln_pe = (const float*)d_in[17]; p.w_pe_gate = (const float*)d_in[18]; p.w_pe_proj = (const float*)d_in[19];
    p.out = (float*)d_out; p.ws = (unsigned char*)d_ws;
    void* args[] = {&p};
    hipError_t e = hipLaunchCooperativeKernel((const void*)fwd_mega, dim3(grid_blocks), dim3(NTHR), args, LDS_BYTES, stream);
    if (e != hipSuccess) fprintf(stderr, "cooperative launch failed: %s (grid %d)\n", hipGetErrorString(e), grid_blocks);
}
```

```cpp
#include <hip/hip_runtime.h>
#include <hip/hip_cooperative_groups.h>
#include <cstdio>
#include <cstdint>
namespace cg = cooperative_groups;

typedef unsigned short bf16_t;
typedef short bf16x8 __attribute__((ext_vector_type(8)));
typedef float f32x4 __attribute__((ext_vector_type(4)));
typedef unsigned u32x4 __attribute__((ext_vector_type(4)));
typedef unsigned u32x2 __attribute__((ext_vector_type(2)));

constexpr int D = 1024, MG = 32768, NGROUPS = 3, NLAYER = 2;
constexpr int ZW = 3584, DFF = 4096, PLE = 256, NIN = 3360;
constexpr int NTHR = 512;
constexpr int NCH = MG / 64;
constexpr int NCR = MG / 128;
constexpr float EPS = 1e-6f;
constexpr int ZC_AQ = 0, ZC_AK = 512, ZC_AV = 1024, ZC_BQ = 1536, ZC_BK = 1664, ZC_BV = 1792, ZC_BR = 2048,
              ZC_GF = 2304, ZC_GB = 2432, ZC_CQ = 2560, ZC_CK = 2816, ZC_CV = 3072, ZC_CG = 3328;
constexpr size_t WO_IN = 0, WO_OUT = WO_IN + (size_t)ZW * D, WO_MI = WO_OUT + (size_t)D * D, WO_MO = WO_MI + (size_t)DFF * D,
                 WO_PG = WO_MO + (size_t)D * DFF, WO_PP = WO_PG + (size_t)D * D, W_LAYER = WO_PP + (size_t)D * PLE;
constexpr size_t WS_WT = 0;
constexpr size_t WS_TAB = WS_WT + W_LAYER * 2 * NLAYER;
constexpr size_t WS_HB = WS_TAB + (size_t)16384 * 40 * 2 * 4;
constexpr size_t WS_HB1 = WS_HB + (size_t)MG * D * 2;
constexpr size_t WS_SSQ = WS_HB1 + (size_t)MG * D * 2;
constexpr size_t WS_Z = WS_SSQ + (size_t)3 * MG * 16 * 4;
constexpr size_t WS_MIX = WS_Z + (size_t)MG * ZW * 2;
constexpr size_t WS_HID = WS_MIX + (size_t)MG * D * 2;
constexpr size_t WS_PB = WS_HID + (size_t)MG * DFF * 2;
constexpr size_t WS_PLE = WS_PB + (size_t)MG * D * 2;
constexpr size_t WS_GS = WS_PLE + (size_t)NLAYER * MG * PLE * 2;
constexpr size_t WS_GD = WS_GS + (size_t)2 * NCH * 4 * 2048 * 4;
constexpr size_t WS_RS = WS_GD + (size_t)2 * NCH * 4 * 32 * 4;
constexpr size_t WS_BAR = WS_RS + (size_t)2 * NCR * 4 * 4096 * 4;
constexpr size_t WS_END = WS_BAR + 16384;

constexpr int LDS_BYTES = 139264;

extern __shared__ __attribute__((aligned(16))) unsigned char g_lds[];

struct Params {
    const float* x_prompt; const float* x_sample; const float* p_prompt; const float* p_sample;
    const float* ln_mix; const float* w_in; const float* attn_q_norm; const float* attn_k_norm;
    const float* gla_gate_up; const float* gla_gate_bias; const float* gla_out_norm; const float* ret_decay_raw;
    const float* ret_out_norm; const float* w_out; const float* ln_mlp; const float* w_mlp_in; const float* w_mlp_out;
    const float* ln_pe; const float* w_pe_gate; const float* w_pe_proj;
    float* out; unsigned char* ws;
};

typedef float f32x2_t __attribute__((ext_vector_type(2)));
typedef __bf16 bf16x2_t __attribute__((ext_vector_type(2)));
__device__ __forceinline__ unsigned cvt_pk_bf16(float lo, float hi) { const f32x2_t v = {lo, hi}; return __builtin_bit_cast(unsigned, __builtin_convertvector(v, bf16x2_t)); }
__device__ __forceinline__ float bf2f(unsigned short b) { return __uint_as_float(((unsigned)b) << 16); }
__device__ __forceinline__ float bflo(unsigned w) { return __uint_as_float(w << 16); }
__device__ __forceinline__ float bfhi(unsigned w) { return __uint_as_float(w & 0xffff0000u); }
__device__ __forceinline__ bf16x8 pack8(const float (&v)[8]) {
    u32x4 w; w.x = cvt_pk_bf16(v[0], v[1]); w.y = cvt_pk_bf16(v[2], v[3]); w.z = cvt_pk_bf16(v[4], v[5]); w.w = cvt_pk_bf16(v[6], v[7]);
    return __builtin_bit_cast(bf16x8, w);
}
__device__ __forceinline__ void unpack8(bf16x8 b, float (&v)[8]) {
    u32x4 w = __builtin_bit_cast(u32x4, b);
    v[0] = bflo(w.x); v[1] = bfhi(w.x); v[2] = bflo(w.y); v[3] = bfhi(w.y); v[4] = bflo(w.z); v[5] = bfhi(w.z); v[6] = bflo(w.w); v[7] = bfhi(w.w);
}
typedef short v4i16_t __attribute__((ext_vector_type(4)));
__device__ __forceinline__ bf16x8 gather8(const bf16_t* tile  , int stride, int qi) {
    const bf16_t* p = tile + (qi >> 2) * stride + 4 * (qi & 3);
    const v4i16_t lo = __builtin_amdgcn_ds_read_tr16_b64_v4i16((__attribute__((address_space(3))) v4i16_t*)p);
    const v4i16_t hi = __builtin_amdgcn_ds_read_tr16_b64_v4i16((__attribute__((address_space(3))) v4i16_t*)(p + 4 * stride));
    bf16x8 r; r[0] = lo[0]; r[1] = lo[1]; r[2] = lo[2]; r[3] = lo[3]; r[4] = hi[0]; r[5] = hi[1]; r[6] = hi[2]; r[7] = hi[3];
    return r;
}
__device__ __forceinline__ bf16x8 ld8f_pack(const float* p) {
    f32x4 a = *(const f32x4*)p, b = *(const f32x4*)(p + 4);
    u32x4 w; w.x = cvt_pk_bf16(a.x, a.y); w.y = cvt_pk_bf16(a.z, a.w); w.z = cvt_pk_bf16(b.x, b.y); w.w = cvt_pk_bf16(b.z, b.w);
    return __builtin_bit_cast(bf16x8, w);
}
__device__ __forceinline__ int opaque_tid() { int t = threadIdx.x; asm volatile("" : "+v"(t)); return t; }
#define LDS_FENCE() asm volatile("s_waitcnt lgkmcnt(0)" ::: "memory")
#define MFMA16(a, b, c) __builtin_amdgcn_mfma_f32_16x16x32_bf16((a), (b), (c), 0, 0, 0)

constexpr int BM = 256, BK = 64, HALF = 128, HT = HALF * BK;
__device__ __forceinline__ int lds_byte(int r, int c) {
    int st = (r >> 4) * 2 + (c >> 5), rr = r & 15, cc = c & 31, ob = rr * 64 + cc * 2;
    return st * 1024 + (ob ^ (((ob >> 9) & 1) << 5));
}
__device__ __forceinline__ void stage_rc(int b, int& R, int& C) {
    int st = b / 1024, sb = b % 1024, swz = sb ^ (((sb >> 9) & 1) << 5);
    R = (st >> 1) * 16 + swz / 64; C = (st & 1) * 32 + (swz % 64) / 2;
}
__device__ __forceinline__ bool tile_of(int L, int nM, int nN, int& pm, int& pn) {
    const int nwg = nM * nN; if (L >= nwg) return false;
    int wgid = L; { const int q = nwg / 8, r = nwg % 8, xcd = wgid % 8, off = wgid / 8; wgid = (xcd < r ? xcd * (q + 1) : r * (q + 1) + (xcd - r) * q) + off; }
    const int nig = 8 * nN, gid = wgid / nig, fm = gid * 8, gsz = (nM - fm) < 8 ? (nM - fm) : 8;
    pm = fm + ((wgid % nig) % gsz); pn = (wgid % nig) / gsz; return true;
}

template <class Epi>
__device__ __forceinline__ void gemm_tile(const bf16_t* __restrict__ A, int lda, const bf16_t* __restrict__ Bt, int ldb, int K, int brow, int bcol, const Epi& epi) {
    const int tid = opaque_tid();
    bf16_t* shm = (bf16_t*)g_lds;
#define SA(b, h) (shm + ((b) * 2 + (h)) * HT)
#define SB(b, h) (shm + (4 + (b) * 2 + (h)) * HT)
#define STAGE(P, BASE, LD, br, kt) do { const int _so = ((br) * (LD) + (kt) * BK) * 2; \
    for (int _i = 0; _i < 2; ++_i) { \
      __builtin_amdgcn_raw_ptr_buffer_load_lds(((&(LD) == &lda) ? rsA : rsB), (__attribute__((address_space(3))) void*)((char*)(P) + wid * 1024 + _i * 8192), 16, \
          ((&(LD) == &lda) ? offA[_i] : offB[_i]), _so, 0, 0); } } while (0)
#define LDA(dst, b, h) for (int m = 0; m < 4; ++m) for (int k = 0; k < 2; ++k) \
    dst[m][k] = *reinterpret_cast<const bf16x8*>((char*)SA(b, h) + lds_byte(wr * 64 + m * 16 + fr, k * 32 + fq * 8))
#define LDB(dst, b, h) for (int n = 0; n < 2; ++n) for (int k = 0; k < 2; ++k) \
    dst[n][k] = *reinterpret_cast<const bf16x8*>((char*)SB(b, h) + lds_byte(wc * 32 + n * 16 + fr, k * 32 + fq * 8))
#define MMA(ai, bj, At, Bt_) do { __builtin_amdgcn_s_setprio(1); \
    for (int m = 0; m < 4; ++m) for (int n = 0; n < 2; ++n) for (int k = 0; k < 2; ++k) \
      acc[ai][bj][m][n] = __builtin_amdgcn_mfma_f32_16x16x32_bf16(At[m][k], Bt_[n][k], acc[ai][bj][m][n], 0, 0, 0); \
    __builtin_amdgcn_s_setprio(0); } while (0)
#define WAIT_V(n) asm volatile("s_waitcnt vmcnt(" #n ")" ::: "memory")
#define WAIT_L(n) asm volatile("s_waitcnt lgkmcnt(" #n ")" ::: "memory")
#define BAR __builtin_amdgcn_s_barrier()
#define SCHED __builtin_amdgcn_sched_barrier(0)
    const int wid = __builtin_amdgcn_readfirstlane(tid >> 6), lane = tid & 63, wr = wid >> 2, wc = wid & 3, fr = lane & 15, fq = lane >> 4;
    f32x4 acc[2][2][4][2] = {};
    bf16x8 At[4][2], B0[2][2], B1[2][2];
    const int nt = K / BK;
    const __amdgpu_buffer_rsrc_t rsA = __builtin_amdgcn_make_buffer_rsrc((void*)A, (short)0, 0x7ffffff0, 0x00020000);
    const __amdgpu_buffer_rsrc_t rsB = __builtin_amdgcn_make_buffer_rsrc((void*)Bt, (short)0, 0x7ffffff0, 0x00020000);
    unsigned offA[2], offB[2];
    for (int _i = 0; _i < 2; ++_i) { int _r, _c; stage_rc(tid * 16 + _i * 8192, _r, _c); offA[_i] = (unsigned)(_r * lda + _c) * 2u; offB[_i] = (unsigned)(_r * ldb + _c) * 2u; }
    STAGE(SB(0, 0), Bt, ldb, bcol, 0); STAGE(SA(0, 0), A, lda, brow, 0);
    STAGE(SB(0, 1), Bt, ldb, bcol + HALF, 0); STAGE(SA(0, 1), A, lda, brow + HALF, 0);
    if (wr == 1) BAR;
    WAIT_V(4); BAR;
    STAGE(SB(1, 0), Bt, ldb, bcol, 1); STAGE(SA(1, 0), A, lda, brow, 1); STAGE(SB(1, 1), Bt, ldb, bcol + HALF, 1);
    WAIT_V(6); BAR;
#pragma unroll 1
    for (int t = 0; t < nt - 2; t += 2) {
        LDB(B0, 0, 0); SCHED; LDA(At, 0, 0); STAGE(SA(1, 1), A, lda, brow + HALF, t + 1);
        WAIT_L(8); BAR; WAIT_L(0); MMA(0, 0, At, B0); BAR; SCHED;
        LDB(B1, 0, 1); STAGE(SB(0, 0), Bt, ldb, bcol, t + 2);
        BAR; WAIT_L(0); MMA(0, 1, At, B1); BAR;
        LDA(At, 0, 1); STAGE(SA(0, 0), A, lda, brow, t + 2);
        BAR; WAIT_L(0); MMA(1, 0, At, B0); BAR; SCHED;
        STAGE(SB(0, 1), Bt, ldb, bcol + HALF, t + 2);
        WAIT_V(6); BAR; MMA(1, 1, At, B1); BAR;
        LDB(B0, 1, 0); SCHED; LDA(At, 1, 0); STAGE(SA(0, 1), A, lda, brow + HALF, t + 2);
        WAIT_L(8); BAR; WAIT_L(0); MMA(0, 0, At, B0); BAR; SCHED;
        LDB(B1, 1, 1); STAGE(SB(1, 0), Bt, ldb, bcol, t + 3);
        BAR; WAIT_L(0); MMA(0, 1, At, B1); BAR;
        LDA(At, 1, 1); STAGE(SA(1, 0), A, lda, brow, t + 3);
        BAR; WAIT_L(0); MMA(1, 0, At, B0); BAR; SCHED;
        STAGE(SB(1, 1), Bt, ldb, bcol + HALF, t + 3);
        WAIT_V(6); BAR; MMA(1, 1, At, B1); BAR;
    }
    { LDB(B0, 0, 0); LDA(At, 0, 0); STAGE(SA(1, 1), A, lda, brow + HALF, nt - 1);
      BAR; WAIT_L(0); MMA(0, 0, At, B0); BAR;
      LDB(B1, 0, 1); BAR; WAIT_L(0); MMA(0, 1, At, B1); BAR;
      LDA(At, 0, 1); WAIT_V(4); BAR; WAIT_L(0); MMA(1, 0, At, B0); MMA(1, 1, At, B1); BAR; }
    { LDB(B0, 1, 0); LDA(At, 1, 0); WAIT_V(2); BAR; WAIT_L(0); MMA(0, 0, At, B0); BAR;
      LDB(B1, 1, 1); WAIT_V(0); BAR; WAIT_L(0); MMA(0, 1, At, B1); BAR;
      LDA(At, 1, 1); BAR; WAIT_L(0); MMA(1, 0, At, B0); MMA(1, 1, At, B1); BAR; }
    if (wr == 0) BAR;
    float* ep = (float*)g_lds;
    __syncthreads();
#pragma unroll
    for (int ai = 0; ai < 2; ++ai) {
        if (ai) __syncthreads();
#pragma unroll
        for (int bj = 0; bj < 2; ++bj)
#pragma unroll
            for (int m = 0; m < 4; ++m)
#pragma unroll
                for (int n = 0; n < 2; ++n)
#pragma unroll
                    for (int j = 0; j < 4; ++j)
                        ep[(wr * 64 + m * 16 + fq * 4 + j) * 260 + bj * HALF + wc * 32 + n * 16 + fr] = acc[ai][bj][m][n][j];
        __syncthreads();
        int lane_e = tid & 63; asm volatile("" : "+v"(lane_e));
        const int row0 = brow + ai * HALF + wid * 16;
        const float rsv = epi.begin(row0, lane_e);
#pragma unroll 4
        for (int i = 0; i < 16; ++i) {
            const f32x4 v = *(const f32x4*)(ep + (wid * 16 + i) * 260 + 4 * lane_e);
            epi.row(v, row0 + i, bcol + 4 * lane_e, lane_e, __shfl(rsv, 4 * i));
        }
    }
    __syncthreads();
#undef SA
#undef SB
#undef STAGE
#undef LDA
#undef LDB
#undef MMA
}

template <class Epi>
__device__ __forceinline__ void gemm_phase(const bf16_t* A, int lda, const bf16_t* Bt, int ldb, int M, int N, int K, const Epi& epi) {
    const int nM = M / BM, nN = N / BM;
    for (int i = 0;; ++i) {
        int pm, pn; if (!tile_of(i * (int)gridDim.x + (int)blockIdx.x, nM, nN, pm, pn)) break;
        gemm_tile(A, lda, Bt, ldb, K, pm * BM, pn * BM, epi);
    }
}

__device__ __forceinline__ float rstd16(const float* ssq, int row0, int lane) {
    const f32x4 q = *(const f32x4*)(ssq + (size_t)(row0 + (lane >> 2)) * 16 + 4 * (lane & 3));
    float s = (q.x + q.y) + (q.z + q.w); s += __shfl_xor(s, 1); s += __shfl_xor(s, 2);
    return rsqrtf(s * (1.0f / D) + EPS);
}
__device__ __forceinline__ float seg_sum16(float s) { s += __shfl_xor(s, 1); s += __shfl_xor(s, 2); s += __shfl_xor(s, 4); s += __shfl_xor(s, 8); return s; }
__device__ __forceinline__ void st4_bf16(bf16_t* d, float a, float b, float c, float e) { u32x2 w; w.x = cvt_pk_bf16(a, b); w.y = cvt_pk_bf16(c, e); *(u32x2*)d = w; }

struct EpiIn {
    bf16_t* Z; const float* ssq; const float* qn; const float* kn; const float* gbias; const float* tab; int smask;
    __device__ __forceinline__ float begin(int row0, int lane) const { return rstd16(ssq, row0, lane); }
    __device__ __forceinline__ void row(f32x4 v, int row, int col, int lane, float rstd) const {
        const int pos = row & smask, c = col & 63, sl = lane & 15;
        bf16_t* dst = Z + (size_t)row * ZW + col;
        if (col < ZC_AV) {
            const bool isq = col < ZC_AK;
            const f32x4 gn = *(const f32x4*)((isq ? qn : kn) + c);
            const float ss = seg_sum16((v.x * v.x + v.y * v.y) + (v.z * v.z + v.w * v.w));
            const float r = rsqrtf(ss * rstd * rstd * (1.0f / 64) + EPS) * rstd * (isq ? 0.125f : 1.0f);
            v.x *= r * gn.x; v.y *= r * gn.y; v.z *= r * gn.z; v.w *= r * gn.w;
            f32x4 pv; pv.x = __shfl_xor(v.x, 2); pv.y = __shfl_xor(v.y, 2); pv.z = __shfl_xor(v.z, 2); pv.w = __shfl_xor(v.w, 2);
            if (sl < 4) {
                const float* cs = tab + (size_t)pos * 80 + 2 * (c & 7);
                const f32x4 t0 = *(const f32x4*)cs, t1 = *(const f32x4*)(cs + 4);
                if (sl < 2) { v.x = v.x * t0.x - pv.x * t0.y; v.y = v.y * t0.z - pv.y * t0.w; v.z = v.z * t1.x - pv.z * t1.y; v.w = v.w * t1.z - pv.w * t1.w; }
                else        { v.x = v.x * t0.x + pv.x * t0.y; v.y = v.y * t0.z + pv.y * t0.w; v.z = v.z * t1.x + pv.z * t1.y; v.w = v.w * t1.z + pv.w * t1.w; }
            }
            st4_bf16(dst, v.x, v.y, v.z, v.w);
        } else if (col >= ZC_GF && col < ZC_CQ) {
            const f32x4 bb = *(const f32x4*)(gbias + (col - ZC_GF));
            float x[4] = {v.x * rstd + bb.x, v.y * rstd + bb.y, v.z * rstd + bb.z, v.w * rstd + bb.w}; unsigned short hb[4];
#pragma unroll
            for (int i = 0; i < 4; ++i) { const float ls = fminf(x[i], 0.f) - __logf(1.0f + __expf(-fabsf(x[i]))); const _Float16 hv = (_Float16)(ls * 0.0625f); hb[i] = __builtin_bit_cast(unsigned short, hv); }
            u32x2 w; w.x = hb[0] | ((unsigned)hb[1] << 16); w.y = hb[2] | ((unsigned)hb[3] << 16);
            *(u32x2*)dst = w;
        } else if (col >= ZC_CQ && col < ZC_CV) {
            const float sc = rstd * ((col >= ZC_CK) ? 0.125f : 1.0f);
            v.x *= sc; v.y *= sc; v.z *= sc; v.w *= sc;
            f32x4 pv; pv.x = __shfl_xor(v.x, 8); pv.y = __shfl_xor(v.y, 8); pv.z = __shfl_xor(v.z, 8); pv.w = __shfl_xor(v.w, 8);
            const float* cs = tab + (size_t)pos * 80 + 16 + 2 * (c & 31);
            const f32x4 t0 = *(const f32x4*)cs, t1 = *(const f32x4*)(cs + 4);
            if (sl < 8) { v.x = v.x * t0.x - pv.x * t0.y; v.y = v.y * t0.z - pv.y * t0.w; v.z = v.z * t1.x - pv.z * t1.y; v.w = v.w * t1.z - pv.w * t1.w; }
            else        { v.x = v.x * t0.x + pv.x * t0.y; v.y = v.y * t0.z + pv.y * t0.w; v.z = v.z * t1.x + pv.z * t1.y; v.w = v.w * t1.z + pv.w * t1.w; }
            st4_bf16(dst, v.x, v.y, v.z, v.w);
        } else {
            const float sc = rstd * ((col >= ZC_BQ && col < ZC_BK) ? 0.17677669529663687f : 1.0f);
            st4_bf16(dst, v.x * sc, v.y * sc, v.z * sc, v.w * sc);
        }
    }
};

struct EpiRes {
    const bf16_t* HBin; bf16_t* HBout; float* ssq;
    __device__ __forceinline__ float begin(int, int) const { return 0.f; }
    __device__ __forceinline__ void row(f32x4 v, int row, int col, int lane, float) const {
        const u32x2 hw = *(const u32x2*)(HBin + (size_t)row * D + col);
        f32x4 h = {bflo(hw.x) + v.x, bfhi(hw.x) + v.y, bflo(hw.y) + v.z, bfhi(hw.y) + v.w};
        u32x2 w; w.x = cvt_pk_bf16(h.x, h.y); w.y = cvt_pk_bf16(h.z, h.w);
        *(u32x2*)(HBout + (size_t)row * D + col) = w;
        h.x = bflo(w.x); h.y = bfhi(w.x); h.z = bflo(w.y); h.w = bfhi(w.y);
        const float ss = seg_sum16((h.x * h.x + h.y * h.y) + (h.z * h.z + h.w * h.w));
        if ((lane & 15) == 0) ssq[(size_t)row * 16 + (col >> 6)] = ss;
    }
};

struct EpiMlpIn {
    bf16_t* HID; const float* ssq;
    __device__ __forceinline__ float begin(int row0, int lane) const { return rstd16(ssq, row0, lane); }
    __device__ __forceinline__ void row(f32x4 v, int row, int col, int, float rstd) const {
        const float a = fmaxf(v.x * rstd, 0.f), b = fmaxf(v.y * rstd, 0.f), c = fmaxf(v.z * rstd, 0.f), e = fmaxf(v.w * rstd, 0.f);
        st4_bf16(HID + (size_t)row * DFF + col, a * a, b * b, c * c, e * e);
    }
};

struct EpiPlain {
    bf16_t* O; int ldo;
    __device__ __forceinline__ float begin(int, int) const { return 0.f; }
    __device__ __forceinline__ void row(f32x4 v, int row, int col, int, float) const { st4_bf16(O + (size_t)row * ldo + col, v.x, v.y, v.z, v.w); }
};

struct EpiPeGate {
    float* Hout; const bf16_t* HBin; bf16_t* HBout; float* ssq_out; const float* ssq_in; const bf16_t* PB; int write_f32;
    __device__ __forceinline__ float begin(int row0, int lane) const { return rstd16(ssq_in, row0, lane); }
    __device__ __forceinline__ void row(f32x4 v, int row, int col, int lane, float rstd) const {
        const u32x2 pw = *(const u32x2*)(PB + (size_t)row * D + col);
        const u32x2 hw = *(const u32x2*)(HBin + (size_t)row * D + col);
        f32x4 h;
        h.x = bflo(hw.x) + bflo(pw.x) / (1.0f + __expf(-v.x * rstd)); h.y = bfhi(hw.x) + bfhi(pw.x) / (1.0f + __expf(-v.y * rstd));
        h.z = bflo(hw.y) + bflo(pw.y) / (1.0f + __expf(-v.z * rstd)); h.w = bfhi(hw.y) + bfhi(pw.y) / (1.0f + __expf(-v.w * rstd));
        if (write_f32) *(f32x4*)(Hout + (size_t)row * D + col) = h;
        u32x2 w; w.x = cvt_pk_bf16(h.x, h.y); w.y = cvt_pk_bf16(h.z, h.w);
        *(u32x2*)(HBout + (size_t)row * D + col) = w;
        h.x = bflo(w.x); h.y = bfhi(w.x); h.z = bflo(w.y); h.w = bfhi(w.y);
        const float ss = seg_sum16((h.x * h.x + h.y * h.y) + (h.z * h.z + h.w * h.w));
        if ((lane & 15) == 0) ssq_out[(size_t)row * 16 + (col >> 6)] = ss;
    }
};

template <class F>
__device__ __forceinline__ void transpose_item(bf16_t* Wt, int K, int k0, int n0, const F& src) {
    const int tid = opaque_tid();
    float* tile = (float*)g_lds;
#pragma unroll
    for (int i = 0; i < 8; ++i) { const int kk = (tid >> 6) + 8 * i, nn = tid & 63; tile[kk * 65 + nn] = src(k0 + kk, n0 + nn); }
    __syncthreads();
    { const int nn = tid >> 3, kc = tid & 7; float t[8];
#pragma unroll
      for (int j = 0; j < 8; ++j) t[j] = tile[(8 * kc + j) * 65 + nn];
      *(bf16x8*)(Wt + (size_t)(n0 + nn) * K + k0 + 8 * kc) = pack8(t); }
    __syncthreads();
}

__device__ __forceinline__ void phase_weights(const Params& p) {
    bf16_t* WT = (bf16_t*)(p.ws + WS_WT);
    constexpr int I_IN = 16 * (ZW / 64), I_OUT = 16 * 16, I_MI = 16 * 64, I_MO = 64 * 16, I_PG = 16 * 16, I_PP = 4 * 16;
    constexpr int I_L = I_IN + I_OUT + I_MI + I_MO + I_PG + I_PP;
    for (int it = blockIdx.x; it < NLAYER * I_L; it += gridDim.x) {
        const int l = it / I_L; int r = it % I_L;
        bf16_t* W = WT + (size_t)l * W_LAYER;
        if (r < I_IN) {
            const int kb = r / (ZW / 64), nb = r % (ZW / 64);
            const float* w = p.w_in + (size_t)l * D * NIN; const float* g = p.ln_mix + l * D; const float* gu = p.gla_gate_up + (size_t)l * 2 * 16 * 128;
            transpose_item(W + WO_IN, D, kb * 64, nb * 64, [&](int k, int c) -> float {
                float v;
                if (c < ZC_GF) v = w[(size_t)k * NIN + c];
                else if (c < ZC_CQ) { const int j = (c - ZC_GF) >> 7, kk = (c - ZC_GF) & 127; float s = 0.f;
                    for (int rr = 0; rr < 16; ++rr) s += w[(size_t)k * NIN + 2304 + 16 * j + rr] * gu[(j * 16 + rr) * 128 + kk];
                    v = s; }
                else v = w[(size_t)k * NIN + (c - 224)];
                return v * g[k]; });
            continue; }
        r -= I_IN;
        if (r < I_OUT) { const float* w = p.w_out + (size_t)l * D * D;
            transpose_item(W + WO_OUT, D, (r / 16) * 64, (r % 16) * 64, [&](int k, int c) -> float { return w[(size_t)k * D + c]; }); continue; }
        r -= I_OUT;
        if (r < I_MI) { const float* w = p.w_mlp_in + (size_t)l * D * DFF; const float* g = p.ln_mlp + l * D;
            transpose_item(W + WO_MI, D, (r / 64) * 64, (r % 64) * 64, [&](int k, int c) -> float { return w[(size_t)k * DFF + c] * g[k]; }); continue; }
        r -= I_MI;
        if (r < I_MO) { const float* w = p.w_mlp_out + (size_t)l * DFF * D;
            transpose_item(W + WO_MO, DFF, (r / 16) * 64, (r % 16) * 64, [&](int k, int c) -> float { return w[(size_t)k * D + c]; }); continue; }
        r -= I_MO;
        if (r < I_PG) { const float* w = p.w_pe_gate + (size_t)l * D * D; const float* g = p.ln_pe + l * D;
            transpose_item(W + WO_PG, D, (r / 16) * 64, (r % 16) * 64, [&](int k, int c) -> float { return w[(size_t)k * D + c] * g[k]; }); continue; }
        r -= I_PG;
        { const float* w = p.w_pe_proj + (size_t)l * PLE * D;
            transpose_item(W + WO_PP, PLE, (r / 16) * 64, (r % 16) * 64, [&](int k, int c) -> float { return w[(size_t)k * D + c]; }); }
    }
    float* tab = (float*)(p.ws + WS_TAB);
    for (int e = blockIdx.x * NTHR + threadIdx.x; e < 16384 * 40; e += gridDim.x * NTHR) {
        const int pos = e / 40, i = e % 40;
        const double invf = (i < 8) ? exp(-(double)i * (log(500000.0) / 8.0)) : exp(-(double)(i - 8) * (log(10000.0) / 32.0));
        double ang = (double)pos * invf; ang -= 6.283185307179586476925 * floor(ang * 0.15915494309189533577);
        tab[2 * e] = (float)cos(ang); tab[2 * e + 1] = (float)sin(ang);
    }
}

__device__ __forceinline__ void phase_init(const Params& p, int g) {
    const int tid = opaque_tid();
    const float* x = (g == 0) ? p.x_prompt : p.x_sample + (size_t)(g - 1) * MG * D;
    bf16_t* HB = (bf16_t*)(p.ws + WS_HB); float* ssq = (float*)(p.ws + WS_SSQ);
    const int lane = tid & 63, gw = blockIdx.x * 8 + (tid >> 6), NGW = gridDim.x * 8;
    for (int row = gw; row < MG; row += NGW) {
#pragma unroll
        for (int j = 0; j < 4; ++j) {
            f32x4 v = *(const f32x4*)(x + (size_t)row * D + 256 * j + 4 * lane);
            u32x2 w; w.x = cvt_pk_bf16(v.x, v.y); w.y = cvt_pk_bf16(v.z, v.w);
            *(u32x2*)(HB + (size_t)row * D + 256 * j + 4 * lane) = w;
            v.x = bflo(w.x); v.y = bfhi(w.x); v.z = bflo(w.y); v.w = bfhi(w.y);
            float s = (v.x * v.x + v.y * v.y) + (v.z * v.z + v.w * v.w);
            s += __shfl_xor(s, 1); s += __shfl_xor(s, 2); s += __shfl_xor(s, 4); s += __shfl_xor(s, 8);
            if ((lane & 15) == 0) ssq[(size_t)row * 16 + (lane >> 4) + 4 * j] = s;
        }
    }
    bf16_t* PL = (bf16_t*)(p.ws + WS_PLE);
    for (int l = 0; l < NLAYER; ++l) {
        const float* src = (g == 0) ? p.p_prompt + (size_t)l * MG * PLE : p.p_sample + ((size_t)l * 2 * MG + (size_t)(g - 1) * MG) * PLE;
        bf16_t* dst = PL + (size_t)l * MG * PLE;
        for (size_t e = (size_t)(blockIdx.x * NTHR + tid) * 8; e < (size_t)MG * PLE; e += (size_t)gridDim.x * NTHR * 8)
            *(bf16x8*)(dst + e) = ld8f_pack(src + e);
    }
}

struct AttnLd { bf16x8 ka0, ka1, kb0, kb1; u32x4 v0, v1, v2, v3; };
__device__ __forceinline__ void attn_geom(int f, int r, int n0, int& dsh, int& cb) {
    const int p = f < 12 ? 0 : (f < 18 ? 1 : 2); const int i2 = f - (p == 0 ? 0 : (p == 1 ? 12 : 18));
    dsh = 2 * p; cb = (r >> dsh) + (16 >> dsh) * n0 - 64 + 32 * i2;
}
__device__ __forceinline__ AttnLd attn_load(const bf16_t* __restrict__ zq, int S, int head, int r, int n0, int lane, int f) {
    int dsh, cb; attn_geom(f, r, n0, dsh, cb);
    const int qi = lane & 15, g = lane >> 4, rd = r & ((1 << dsh) - 1), ncls = S >> dsh;
    const int cA = cb + 8 * (qi >> 2) + (qi & 3), cB = cA + 4;
    const int cAc = min(max(cA, 0), ncls - 1), cBc = min(max(cB, 0), ncls - 1);
    const bf16_t* kA = zq + (size_t)(rd + (cAc << dsh)) * ZW + ZC_AK + head * 64 + 8 * g;
    const bf16_t* kB = zq + (size_t)(rd + (cBc << dsh)) * ZW + ZC_AK + head * 64 + 8 * g;
    AttnLd L;
    L.ka0 = *(const bf16x8*)kA; L.ka1 = *(const bf16x8*)(kA + 32); L.kb0 = *(const bf16x8*)kB; L.kb1 = *(const bf16x8*)(kB + 32);
    const int cv0 = cb + (lane >> 3);
    const bf16_t* vb = zq + ZC_AV + head * 64 + 8 * (lane & 7);
    L.v0 = *(const u32x4*)(vb + (size_t)(rd + (min(max(cv0, 0), ncls - 1) << dsh)) * ZW);
    L.v1 = *(const u32x4*)(vb + (size_t)(rd + (min(max(cv0 + 8, 0), ncls - 1) << dsh)) * ZW);
    L.v2 = *(const u32x4*)(vb + (size_t)(rd + (min(max(cv0 + 16, 0), ncls - 1) << dsh)) * ZW);
    L.v3 = *(const u32x4*)(vb + (size_t)(rd + (min(max(cv0 + 24, 0), ncls - 1) << dsh)) * ZW);
    return L;
}
__device__ __forceinline__ bf16x8 attn_softmax_step(const f32x4& sA, const f32x4& sB, int cb, int cq, int ncls, int g, float& m, float& lsum, f32x4 (&O)[4]) {
    float s[8]; bool ok[8];
#pragma unroll
    for (int j = 0; j < 8; ++j) { const int c = cb + 8 * g + j; const int dd = c - cq;
        ok[j] = (c >= 0) && (c < ncls) && (dd <= 64) && (dd >= -64);
        s[j] = ok[j] ? (j < 4 ? sA[j] : sB[j - 4]) : -1e30f; }
    float mx = fmaxf(fmaxf(fmaxf(s[0], s[1]), fmaxf(s[2], s[3])), fmaxf(fmaxf(s[4], s[5]), fmaxf(s[6], s[7])));
    mx = fmaxf(mx, __shfl_xor(mx, 16)); mx = fmaxf(mx, __shfl_xor(mx, 32));
    const float mn = fmaxf(m, mx), alpha = __expf(m - mn);
    m = mn;
    float pj[8], ps_ = 0.f;
#pragma unroll
    for (int j = 0; j < 8; ++j) { pj[j] = ok[j] ? __expf(s[j] - mn) : 0.f; ps_ += pj[j]; }
    lsum = lsum * alpha + ps_;
#pragma unroll
    for (int nbk = 0; nbk < 4; ++nbk) O[nbk] *= alpha;
    return pack8(pj);
}
__device__ __forceinline__ void attn_lds_step(const bf16_t* Kt, const bf16_t* Vt, int rowb, const bf16x8& q0, const bf16x8& q1, int cb, int cq, int ncls,
                                              int qi, int g, float& m, float& lsum, f32x4 (&O)[4]) {
    const bf16_t* kA = Kt + (rowb + 8 * (qi >> 2) + (qi & 3)) * 72 + 8 * g;
    const bf16x8 ka0 = *(const bf16x8*)kA, ka1 = *(const bf16x8*)(kA + 32), kb0 = *(const bf16x8*)(kA + 4 * 72), kb1 = *(const bf16x8*)(kA + 4 * 72 + 32);
    f32x4 sA = {0.f, 0.f, 0.f, 0.f}, sB = {0.f, 0.f, 0.f, 0.f};
    sA = MFMA16(ka0, q0, sA); sA = MFMA16(ka1, q1, sA);
    sB = MFMA16(kb0, q0, sB); sB = MFMA16(kb1, q1, sB);
    const bf16x8 P = attn_softmax_step(sA, sB, cb, cq, ncls, g, m, lsum, O);
#pragma unroll
    for (int nbk = 0; nbk < 4; ++nbk) O[nbk] = MFMA16(gather8(Vt + (rowb + 8 * g) * 68 + 16 * nbk, 68, qi), P, O[nbk]);
}
__device__ __forceinline__ void attn_stage(const bf16_t* __restrict__ zq, int head, bf16_t* Kt, bf16_t* Vt, int nrows, int c0, int ncls, int rd, int dsh, int tid) {
    for (int idx = tid; idx < nrows * 16; idx += NTHR) {
        const int i = idx >> 4, ch = idx & 15, isv = ch >> 3, c8 = ch & 7;
        const int c = min(max(c0 + i, 0), ncls - 1);
        const u32x4 v = *(const u32x4*)(zq + (size_t)(rd + (c << dsh)) * ZW + (isv ? ZC_AV : ZC_AK) + head * 64 + 8 * c8);
        if (isv) { bf16_t* d = Vt + i * 68 + 8 * c8; *(u32x2*)d = (u32x2){v.x, v.y}; *(u32x2*)(d + 4) = (u32x2){v.z, v.w}; }
        else *(u32x4*)(Kt + i * 72 + 8 * c8) = v;
    }
}
__device__ __forceinline__ void attn_item(const bf16_t* __restrict__ Z, bf16_t* __restrict__ MIX, int S, int it) {
    const int tid = opaque_tid();
    __syncthreads();
    const int wave = tid >> 6, lane = tid & 63, qi = lane & 15, g = lane >> 4;
    const int nblk = S >> 8;
    const int pb = it % nblk; const int t1 = it / nblk; const int head = t1 & 7, seq = t1 >> 3;
    const int P0 = pb * 256, n0 = pb * 16;
    const bf16_t* zq = Z + (size_t)seq * S * ZW;
    bf16_t* Kt = (bf16_t*)g_lds;
    bf16_t* Vt = (bf16_t*)(g_lds + 57600);
    bf16_t* Vs = (bf16_t*)g_lds + wave * (32 * 68);
    int rt[2]; rt[0] = 4 * (wave >> 1) + (wave & 1); rt[1] = rt[0] + 2;
    bf16x8 q0[2], q1[2]; float m[2] = {-1e30f, -1e30f}, lsum[2] = {0.f, 0.f}; f32x4 O[2][4] = {};
#pragma unroll
    for (int ti = 0; ti < 2; ++ti) { const bf16_t* qp = zq + (size_t)(P0 + rt[ti] + 16 * qi) * ZW + ZC_AQ + head * 64 + 8 * g; q0[ti] = *(const bf16x8*)qp; q1[ti] = *(const bf16x8*)(qp + 32); }
    {
        bf16_t* Vs1 = Vs + 8 * (32 * 68);
        AttnLd cur0 = attn_load(zq, S, head, rt[0], n0, lane, 18), cur1 = attn_load(zq, S, head, rt[1], n0, lane, 18);
#pragma unroll 1
        for (int f = 18; f < 23; ++f) {
            const AttnLd nxt0 = attn_load(zq, S, head, rt[0], n0, lane, f < 22 ? f + 1 : 22), nxt1 = attn_load(zq, S, head, rt[1], n0, lane, f < 22 ? f + 1 : 22);
            const int cb = n0 - 64 + 32 * (f - 18), ncls = S >> 4, cq = n0 + qi;
            f32x4 sA0 = {0.f, 0.f, 0.f, 0.f}, sB0 = {0.f, 0.f, 0.f, 0.f}, sA1 = {0.f, 0.f, 0.f, 0.f}, sB1 = {0.f, 0.f, 0.f, 0.f};
            sA0 = MFMA16(cur0.ka0, q0[0], sA0); sA1 = MFMA16(cur1.ka0, q0[1], sA1); sB0 = MFMA16(cur0.kb0, q0[0], sB0); sB1 = MFMA16(cur1.kb0, q0[1], sB1);
            sA0 = MFMA16(cur0.ka1, q1[0], sA0); sA1 = MFMA16(cur1.ka1, q1[1], sA1); sB0 = MFMA16(cur0.kb1, q1[0], sB0); sB1 = MFMA16(cur1.kb1, q1[1], sB1);
            LDS_FENCE();
            { bf16_t* d = Vs + (lane >> 3) * 68 + 8 * (lane & 7);
              *(u32x2*)d = (u32x2){cur0.v0.x, cur0.v0.y}; *(u32x2*)(d + 4) = (u32x2){cur0.v0.z, cur0.v0.w};
              *(u32x2*)(d + 8 * 68) = (u32x2){cur0.v1.x, cur0.v1.y}; *(u32x2*)(d + 8 * 68 + 4) = (u32x2){cur0.v1.z, cur0.v1.w};
              *(u32x2*)(d + 16 * 68) = (u32x2){cur0.v2.x, cur0.v2.y}; *(u32x2*)(d + 16 * 68 + 4) = (u32x2){cur0.v2.z, cur0.v2.w};
              *(u32x2*)(d + 24 * 68) = (u32x2){cur0.v3.x, cur0.v3.y}; *(u32x2*)(d + 24 * 68 + 4) = (u32x2){cur0.v3.z, cur0.v3.w};
              d = Vs1 + (lane >> 3) * 68 + 8 * (lane & 7);
              *(u32x2*)d = (u32x2){cur1.v0.x, cur1.v0.y}; *(u32x2*)(d + 4) = (u32x2){cur1.v0.z, cur1.v0.w};
              *(u32x2*)(d + 8 * 68) = (u32x2){cur1.v1.x, cur1.v1.y}; *(u32x2*)(d + 8 * 68 + 4) = (u32x2){cur1.v1.z, cur1.v1.w};
              *(u32x2*)(d + 16 * 68) = (u32x2){cur1.v2.x, cur1.v2.y}; *(u32x2*)(d + 16 * 68 + 4) = (u32x2){cur1.v2.z, cur1.v2.w};
              *(u32x2*)(d + 24 * 68) = (u32x2){cur1.v3.x, cur1.v3.y}; *(u32x2*)(d + 24 * 68 + 4) = (u32x2){cur1.v3.z, cur1.v3.w}; }
            const bf16x8 P0_ = attn_softmax_step(sA0, sB0, cb, cq, ncls, g, m[0], lsum[0], O[0]);
            const bf16x8 P1_ = attn_softmax_step(sA1, sB1, cb, cq, ncls, g, m[1], lsum[1], O[1]);
            LDS_FENCE();
#pragma unroll
            for (int nbk = 0; nbk < 4; ++nbk) { O[0][nbk] = MFMA16(gather8(Vs + (8 * g) * 68 + 16 * nbk, 68, qi), P0_, O[0][nbk]); O[1][nbk] = MFMA16(gather8(Vs1 + (8 * g) * 68 + 16 * nbk, 68, qi), P1_, O[1][nbk]); }
            cur0 = nxt0; cur1 = nxt1;
        }
        LDS_FENCE();
    }
    __syncthreads();
    attn_stage(zq, head, Kt, Vt, 400, P0 - 64, S, 0, 0, tid);
    __syncthreads();
#pragma unroll 1
    for (int i2 = 0; i2 < 12; ++i2) {
        attn_lds_step(Kt, Vt, rt[0] + 32 * i2, q0[0], q1[0], P0 + rt[0] - 64 + 32 * i2, P0 + rt[0] + 16 * qi, S, qi, g, m[0], lsum[0], O[0]);
        attn_lds_step(Kt, Vt, rt[1] + 32 * i2, q0[1], q1[1], P0 + rt[1] - 64 + 32 * i2, P0 + rt[1] + 16 * qi, S, qi, g, m[1], lsum[1], O[1]);
    }
#pragma unroll
    for (int rho = 0; rho < 2; ++rho) {
        __syncthreads();
        attn_stage(zq, head, Kt, Vt, 200, (P0 >> 2) - 64, S >> 2, 2 * rho, 2, tid);
        attn_stage(zq, head, Kt + 200 * 72, Vt + 200 * 68, 200, (P0 >> 2) - 64, S >> 2, 2 * rho + 1, 2, tid);
        __syncthreads();
        const int r = rt[rho], cls = (r & 3) - 2 * rho, c0 = (P0 >> 2) + (r >> 2);
#pragma unroll 2
        for (int i2 = 0; i2 < 6; ++i2)
            attn_lds_step(Kt + cls * 200 * 72, Vt + cls * 200 * 68, (r >> 2) + 32 * i2, q0[rho], q1[rho], c0 - 64 + 32 * i2, c0 + 4 * qi, S >> 2, qi, g, m[rho], lsum[rho], O[rho]);
    }
#pragma unroll
    for (int ti = 0; ti < 2; ++ti) {
        float l = lsum[ti]; l += __shfl_xor(l, 16); l += __shfl_xor(l, 32);
        const float inv = 1.0f / l;
        bf16_t* op = MIX + ((size_t)seq * S + P0 + rt[ti] + 16 * qi) * D + head * 64 + 4 * g;
#pragma unroll
        for (int nbk = 0; nbk < 4; ++nbk) st4_bf16(op + 16 * nbk, O[ti][nbk].x * inv, O[ti][nbk].y * inv, O[ti][nbk].z * inv, O[ti][nbk].w * inv);
    }
    __syncthreads();
}

__device__ __forceinline__ float h2f(unsigned short b) { return (float)__builtin_bit_cast(_Float16, b); }

__device__ __forceinline__ void stage_v4(const bf16_t* __restrict__ Z, size_t tok0, int zc, bf16_t* Vt, int nrows) {
    const int tid = opaque_tid();
    for (int idx = tid; idx < nrows * 32; idx += NTHR) {
        const int t = idx >> 5, ch = idx & 31, hh = ch >> 3, c8 = ch & 7;
        const u32x4 v = *(const u32x4*)(Z + (tok0 + t) * ZW + zc + ch * 8);
        bf16_t* d = Vt + ((size_t)hh * nrows + t) * 68 + c8 * 8;
        *(u32x2*)d = (u32x2){v.x, v.y}; *(u32x2*)(d + 4) = (u32x2){v.z, v.w};
    }
}

__device__ __forceinline__ void gla_cum(const bf16_t* __restrict__ Z, size_t tok0, int h, int dir, int lane, float (&cum)[32], float& tot) {
    const int kk = lane & 31, hf = lane >> 5;
    const bf16_t* src = Z + (tok0 + 32 * hf) * ZW + ZC_GF + dir * 128 + h * 32 + kk;
    float part = 0.f;
#pragma unroll
    for (int i = 0; i < 32; ++i) { cum[i] = h2f(src[(size_t)i * ZW]); part += cum[i]; }
    const float other = __shfl_xor(part, 32);
    tot = part + other;
    if (dir == 0) { float run = hf ? other : 0.f;
#pragma unroll
        for (int i = 0; i < 32; ++i) { run += cum[i]; cum[i] = run; } }
    else { float run = hf ? 0.f : other;
#pragma unroll
        for (int i = 31; i >= 0; --i) { run += cum[i]; cum[i] = run; } }
}

__device__ __forceinline__ void gla1_item(const bf16_t* __restrict__ Z, float* __restrict__ GS, float* __restrict__ GD, int ci) {
    const int tid = opaque_tid();
    __syncthreads();
    const int wave = tid >> 6, lane = tid & 63, qi = lane & 15, g = lane >> 4;
    const int h = wave >> 1, dir = wave & 1;
    const size_t tok0 = (size_t)ci * 64;
    bf16_t* Vt = (bf16_t*)g_lds;
    bf16_t* Ks = (bf16_t*)g_lds + 4 * 64 * 68 + wave * (64 * 36);
    stage_v4(Z, tok0, ZC_BV, Vt, 64);
    float cum[32], tot;
    gla_cum(Z, tok0, h, dir, lane, cum, tot);
    { const int kk = lane & 31, hf = lane >> 5;
      const bf16_t* ksrc = Z + (tok0 + 32 * hf) * ZW + ZC_BK + h * 32 + kk;
#pragma unroll
      for (int i = 0; i < 32; ++i) { const float kv = bf2f(ksrc[(size_t)i * ZW]) * __expf(tot - cum[i]);
          Ks[(32 * hf + i) * 36 + kk] = (bf16_t)(cvt_pk_bf16(kv, 0.f) & 0xffffu); }
      if (hf == 0) GD[(((size_t)dir * NCH + ci) * 4 + h) * 32 + kk] = __expf(tot); }
    __syncthreads();
    f32x4 acc[4][2] = {};
#pragma unroll
    for (int ks = 0; ks < 2; ++ks) {
        bf16x8 bfr[2];
#pragma unroll
        for (int kb = 0; kb < 2; ++kb) bfr[kb] = gather8(Ks + (32 * ks + 8 * g) * 36 + 16 * kb , 36, qi);
#pragma unroll
        for (int eb = 0; eb < 4; ++eb) { const bf16x8 af = gather8(Vt + ((size_t)h * 64 + 32 * ks + 8 * g) * 68 + 16 * eb , 68, qi);
#pragma unroll
            for (int kb = 0; kb < 2; ++kb) acc[eb][kb] = MFMA16(af, bfr[kb], acc[eb][kb]); }
    }
    float* dst = GS + (((size_t)dir * NCH + ci) * 4 + h) * 2048;
#pragma unroll
    for (int eb = 0; eb < 4; ++eb)
#pragma unroll
        for (int kb = 0; kb < 2; ++kb)
#pragma unroll
            for (int i = 0; i < 4; ++i) dst[(16 * eb + 4 * g + i) * 32 + 16 * kb + qi] = acc[eb][kb][i];
    __syncthreads();
}

__device__ __forceinline__ void gla3_item(const bf16_t* __restrict__ Z, const float* __restrict__ GS, bf16_t* __restrict__ MIX, const float* __restrict__ gnorm, int ci) {
    const int tid = opaque_tid();
    __syncthreads();
    const int wave = tid >> 6, lane = tid & 63, qi = lane & 15, g = lane >> 4;
    const size_t tok0 = (size_t)ci * 64;
    bf16_t* Vt = (bf16_t*)g_lds;
    float* CUM = (float*)(g_lds + 4 * 64 * 68 * 2);
    stage_v4(Z, tok0, ZC_BV, Vt, 64);
    { const int h = wave >> 1, dir = wave & 1; float cum[32], tot;
      gla_cum(Z, tok0, h, dir, lane, cum, tot);
      const int kk = lane & 31, hf = lane >> 5; float* cd = CUM + ((size_t)(h * 2 + dir) * 64 + 32 * hf) * 32 + kk;
#pragma unroll
      for (int i = 0; i < 32; ++i) cd[i * 32] = cum[i]; }
    __syncthreads();
    const int h = wave >> 1;
    const float* cF = CUM + (size_t)(h * 2 + 0) * 64 * 32; const float* cB = CUM + (size_t)(h * 2 + 1) * 64 * 32;
    const float* sF = GS + (((size_t)0 * NCH + ci) * 4 + h) * 2048; const float* sB = GS + (((size_t)1 * NCH + ci) * 4 + h) * 2048;
    bf16x8 SFf[4], SBf[4];
#pragma unroll
    for (int eb = 0; eb < 4; ++eb) { SFf[eb] = ld8f_pack(sF + (16 * eb + qi) * 32 + 8 * g); SBf[eb] = ld8f_pack(sB + (16 * eb + qi) * 32 + 8 * g); }
    bf16x8 KFf[2][2], KBf[2][2];
#pragma unroll
    for (int sg = 0; sg < 2; ++sg)
#pragma unroll
        for (int blk = 0; blk < 2; ++blk) {
            const int s = 32 * sg + 8 * (qi >> 2) + (qi & 3) + 4 * blk;
            float kv[8], a[8], b[8]; unpack8(*(const bf16x8*)(Z + (tok0 + s) * ZW + ZC_BK + h * 32 + 8 * g), kv);
#pragma unroll
            for (int j = 0; j < 8; ++j) { a[j] = kv[j] * __expf(-cF[s * 32 + 8 * g + j]); b[j] = kv[j] * __expf(-cB[s * 32 + 8 * g + j]); }
            KFf[sg][blk] = pack8(a); KBf[sg][blk] = pack8(b);
        }
#pragma unroll 1
    for (int tbi = 0; tbi < 2; ++tbi) {
        const int t = 16 * (2 * (wave & 1) + tbi) + qi;
        bf16x8 Qf, Qb;
        { float qv[8], a[8], b[8]; unpack8(*(const bf16x8*)(Z + (tok0 + t) * ZW + ZC_BQ + h * 32 + 8 * g), qv);
#pragma unroll
          for (int j = 0; j < 8; ++j) { a[j] = qv[j] * __expf(cF[t * 32 + 8 * g + j]); b[j] = qv[j] * __expf(cB[t * 32 + 8 * g + j]); }
          Qf = pack8(a); Qb = pack8(b); }
        f32x4 acc[4] = {};
#pragma unroll
        for (int eb = 0; eb < 4; ++eb) { acc[eb] = MFMA16(SFf[eb], Qf, acc[eb]); acc[eb] = MFMA16(SBf[eb], Qb, acc[eb]); }
#pragma unroll
        for (int sg = 0; sg < 2; ++sg) {
            f32x4 aF[2], aB[2];
#pragma unroll
            for (int blk = 0; blk < 2; ++blk) {
                const f32x4 z4 = {0.f, 0.f, 0.f, 0.f};
                aF[blk] = MFMA16(KFf[sg][blk], Qf, z4); aB[blk] = MFMA16(KBf[sg][blk], Qb, z4);
            }
            float pj[8];
#pragma unroll
            for (int j = 0; j < 8; ++j) { const int s = 32 * sg + 8 * g + j; pj[j] = (s <= t) ? (j < 4 ? aF[0][j] : aF[1][j - 4]) : (j < 4 ? aB[0][j] : aB[1][j - 4]); }
            const bf16x8 P = pack8(pj);
#pragma unroll
            for (int eb = 0; eb < 4; ++eb) acc[eb] = MFMA16(gather8(Vt + ((size_t)h * 64 + 32 * sg + 8 * g) * 68 + 16 * eb , 68, qi), P, acc[eb]);
        }
        float ss = 0.f;
#pragma unroll
        for (int eb = 0; eb < 4; ++eb) ss += (acc[eb].x * acc[eb].x + acc[eb].y * acc[eb].y) + (acc[eb].z * acc[eb].z + acc[eb].w * acc[eb].w);
        ss += __shfl_xor(ss, 16); ss += __shfl_xor(ss, 32);
        const float rn = rsqrtf(ss * (1.0f / 64) + EPS);
#pragma unroll
        for (int eb = 0; eb < 4; ++eb) { const int e = 16 * eb + 4 * g;
            const u32x2 brw = *(const u32x2*)(Z + (tok0 + t) * ZW + ZC_BR + h * 64 + e);
            const f32x4 gn = *(const f32x4*)(gnorm + h * 64 + e);
            const float b0 = bflo(brw.x), b1 = bfhi(brw.x), b2 = bflo(brw.y), b3 = bfhi(brw.y);
            const float o0 = acc[eb].x * rn * gn.x * (b0 / (1.f + __expf(-b0))), o1 = acc[eb].y * rn * gn.y * (b1 / (1.f + __expf(-b1)));
            const float o2 = acc[eb].z * rn * gn.z * (b2 / (1.f + __expf(-b2))), o3 = acc[eb].w * rn * gn.w * (b3 / (1.f + __expf(-b3)));
            u32x2 w; w.x = cvt_pk_bf16(o0, o1); w.y = cvt_pk_bf16(o2, o3);
            *(u32x2*)(MIX + (tok0 + t) * D + 512 + h * 64 + e) = w; }
    }
    __syncthreads();
}

__device__ __forceinline__ void ret1_item(const bf16_t* __restrict__ Z, float* __restrict__ RS, const float* __restrict__ lgam, int item) {
    const int tid = opaque_tid();
    __syncthreads();
    const int wave = tid >> 6, lane = tid & 63, qi = lane & 15, g = lane >> 4;
    const int ci = item >> 1, hp = item & 1;
    const size_t tok0 = (size_t)ci * 128;
    bf16_t* Vt = (bf16_t*)g_lds;
    bf16_t* Kt = Vt + 2 * 128 * 68;
    for (int idx = tid; idx < 128 * 16 * 2; idx += NTHR) {
        const int which = idx >> 11, r = idx & 2047, t = r >> 4, ch = r & 15, hh = ch >> 3, c8 = ch & 7;
        const u32x4 v = *(const u32x4*)(Z + (tok0 + t) * ZW + (which ? ZC_CK : ZC_CV) + hp * 128 + ch * 8);
        bf16_t* d = (which ? Kt : Vt) + ((size_t)hh * 128 + t) * 68 + c8 * 8;
        *(u32x2*)d = (u32x2){v.x, v.y}; *(u32x2*)(d + 4) = (u32x2){v.z, v.w};
    }
    __syncthreads();
    const int hh = wave >> 2, dir = (wave >> 1) & 1, eh = wave & 1, head = 2 * hp + hh;
    const float lg = lgam[dir * 4 + head];
    f32x4 acc[2][4] = {};
#pragma unroll 1
    for (int ks = 0; ks < 4; ++ks) {
        float w[8];
#pragma unroll
        for (int j = 0; j < 8; ++j) { const int s = 32 * ks + 8 * g + j; w[j] = __expf(lg * (float)(dir ? s : 127 - s)); }
        bf16x8 bfr[4];
#pragma unroll
        for (int db = 0; db < 4; ++db) { float kv[8]; unpack8(gather8(Kt + ((size_t)hh * 128 + 32 * ks + 8 * g) * 68 + 16 * db , 68, qi), kv);
#pragma unroll
            for (int j = 0; j < 8; ++j) kv[j] *= w[j];
            bfr[db] = pack8(kv); }
#pragma unroll
        for (int ebi = 0; ebi < 2; ++ebi) { const bf16x8 af = gather8(Vt + ((size_t)hh * 128 + 32 * ks + 8 * g) * 68 + 16 * (2 * eh + ebi) , 68, qi);
#pragma unroll
            for (int db = 0; db < 4; ++db) acc[ebi][db] = MFMA16(af, bfr[db], acc[ebi][db]); }
    }
    float* dst = RS + (((size_t)dir * NCR + ci) * 4 + head) * 4096;
#pragma unroll
    for (int ebi = 0; ebi < 2; ++ebi)
#pragma unroll
        for (int db = 0; db < 4; ++db)
#pragma unroll
            for (int i = 0; i < 4; ++i) dst[(16 * (2 * eh + ebi) + 4 * g + i) * 64 + 16 * db + qi] = acc[ebi][db][i];
    __syncthreads();
}

__device__ __forceinline__ void ret3_item(const bf16_t* __restrict__ Z, const float* __restrict__ RS, bf16_t* __restrict__ MIX, const float* __restrict__ rnorm, const float* __restrict__ lgam, int ci) {
    const int tid = opaque_tid();
    __syncthreads();
    const int wave = tid >> 6, lane = tid & 63, qi = lane & 15, g = lane >> 4;
    const size_t tok0 = (size_t)ci * 128;
    bf16_t* Vt = (bf16_t*)g_lds;
    stage_v4(Z, tok0, ZC_CV, Vt, 128);
    __syncthreads();
    const int h = wave >> 1;
    const float lg0 = lgam[h], lg1 = lgam[4 + h];
    const float* rF = RS + (((size_t)0 * NCR + ci) * 4 + h) * 4096; const float* rB = RS + (((size_t)1 * NCR + ci) * 4 + h) * 4096;
    bf16x8 RF[4][2], RB[4][2];
#pragma unroll
    for (int eb = 0; eb < 4; ++eb) { const float* pf = rF + (16 * eb + qi) * 64 + 8 * g; const float* pb = rB + (16 * eb + qi) * 64 + 8 * g;
        RF[eb][0] = ld8f_pack(pf); RF[eb][1] = ld8f_pack(pf + 32); RB[eb][0] = ld8f_pack(pb); RB[eb][1] = ld8f_pack(pb + 32); }
#pragma unroll 1
    for (int tbi = 0; tbi < 4; ++tbi) {
        const int t = 16 * (4 * (wave & 1) + tbi) + qi;
        const bf16_t* qp = Z + (tok0 + t) * ZW + ZC_CQ + h * 64 + 8 * g;
        const bf16x8 q0 = *(const bf16x8*)qp, q1 = *(const bf16x8*)(qp + 32);
        f32x4 aI[4] = {}, aF[4] = {}, aB[4] = {};
#pragma unroll
        for (int eb = 0; eb < 4; ++eb) {
            aF[eb] = MFMA16(RF[eb][0], q0, aF[eb]); aF[eb] = MFMA16(RF[eb][1], q1, aF[eb]);
            aB[eb] = MFMA16(RB[eb][0], q0, aB[eb]); aB[eb] = MFMA16(RB[eb][1], q1, aB[eb]);
        }
#pragma unroll 1
        for (int sg = 0; sg < 4; ++sg) {
            f32x4 sc[2];
#pragma unroll
            for (int blk = 0; blk < 2; ++blk) {
                const int s = 32 * sg + 8 * (qi >> 2) + (qi & 3) + 4 * blk;
                const bf16_t* kp = Z + (tok0 + s) * ZW + ZC_CK + h * 64 + 8 * g;
                f32x4 z4 = {0.f, 0.f, 0.f, 0.f};
                z4 = MFMA16(*(const bf16x8*)kp, q0, z4); z4 = MFMA16(*(const bf16x8*)(kp + 32), q1, z4); sc[blk] = z4;
            }
            float pj[8];
#pragma unroll
            for (int j = 0; j < 8; ++j) { const int s = 32 * sg + 8 * g + j; const int dd = t - s;
                const float dec = (dd >= 0) ? __expf(lg0 * (float)dd) : __expf(lg1 * (float)(-dd));
                pj[j] = (j < 4 ? sc[0][j] : sc[1][j - 4]) * dec; }
            const bf16x8 P = pack8(pj);
#pragma unroll
            for (int eb = 0; eb < 4; ++eb) aI[eb] = MFMA16(gather8(Vt + ((size_t)h * 128 + 32 * sg + 8 * g) * 68 + 16 * eb , 68, qi), P, aI[eb]);
        }
        const float wf = __expf(lg0 * (float)(t + 1)), wb = __expf(lg1 * (float)(128 - t));
        float ss = 0.f;
#pragma unroll
        for (int eb = 0; eb < 4; ++eb) { aI[eb] = aI[eb] + aF[eb] * wf + aB[eb] * wb;
            ss += (aI[eb].x * aI[eb].x + aI[eb].y * aI[eb].y) + (aI[eb].z * aI[eb].z + aI[eb].w * aI[eb].w); }
        ss += __shfl_xor(ss, 16); ss += __shfl_xor(ss, 32);
        const float rn = rsqrtf(ss * (1.0f / 64) + EPS);
#pragma unroll
        for (int eb = 0; eb < 4; ++eb) { const int e = 16 * eb + 4 * g;
            const u32x2 gw = *(const u32x2*)(Z + (tok0 + t) * ZW + ZC_CG + h * 64 + e);
            const f32x4 gn = *(const f32x4*)(rnorm + h * 64 + e);
            const float b0 = bflo(gw.x), b1 = bfhi(gw.x), b2 = bflo(gw.y), b3 = bfhi(gw.y);
            const float o0 = aI[eb].x * rn * gn.x * (b0 / (1.f + __expf(-b0))), o1 = aI[eb].y * rn * gn.y * (b1 / (1.f + __expf(-b1)));
            const float o2 = aI[eb].z * rn * gn.z * (b2 / (1.f + __expf(-b2))), o3 = aI[eb].w * rn * gn.w * (b3 / (1.f + __expf(-b3)));
            u32x2 w; w.x = cvt_pk_bf16(o0, o1); w.y = cvt_pk_bf16(o2, o3);
            *(u32x2*)(MIX + (tok0 + t) * D + 768 + h * 64 + e) = w; }
    }
    __syncthreads();
}

__device__ __forceinline__ void phase_scan(float* __restrict__ GS, const float* __restrict__ GD, float* __restrict__ RS, const float* __restrict__ lgam, int S) {
    const int tid = opaque_tid();
    const int lgn = (S == 16384) ? 1 : 4, nseq = 1 << lgn, ncg = S / 64, ncr = S / 128;
    const int gtid = blockIdx.x * NTHR + tid, gth = gridDim.x * NTHR;
    const int n_gla = 2 * nseq * 4 * 2048, n_ret = 2 * nseq * 4 * 4096;
    for (int idx = gtid; idx < n_gla + n_ret; idx += gth) {
        if (idx < n_gla) {
            const int el = idx & 2047, hh = (idx >> 11) & 3, sq = (idx >> 13) & (nseq - 1), dir = (idx >> 13) >> lgn, kk = el & 31;
            float st = 0.f;
#pragma unroll 16
            for (int i = 0; i < ncg; ++i) { const int c = dir ? ncg - 1 - i : i; const size_t cgi = (size_t)sq * ncg + c;
                float* a = GS + (((size_t)dir * NCH + cgi) * 4 + hh) * 2048 + el; const float dec = GD[(((size_t)dir * NCH + cgi) * 4 + hh) * 32 + kk];
                const float tmp = *a; *a = st; st = dec * st + tmp; }
        } else {
            const int j = idx - n_gla; const int el = j & 4095, hh = (j >> 12) & 3, sq = (j >> 14) & (nseq - 1), dir = (j >> 14) >> lgn;
            const float dec = __expf(128.f * lgam[dir * 4 + hh]);
            float st = 0.f;
#pragma unroll 16
            for (int i = 0; i < ncr; ++i) { const int c = dir ? ncr - 1 - i : i; const size_t cgi = (size_t)sq * ncr + c;
                float* a = RS + (((size_t)dir * NCR + cgi) * 4 + hh) * 4096 + el;
                const float tmp = *a; *a = st; st = dec * st + tmp; }
        }
    }
}

#define XB_TMO      128
#define XB_XCNT(j)  (256  + 64 * (j))
#define XB_XSUB(j)  (1280 + 64 * (j))
#define XB_XGEN(j)  (2304 + 64 * (j))
#define XB_TOP      3328
#define XB_TOPGEN   3392
#define XCD_BAR_WORDS 3456
#define XB_SPIN_CAP (1u << 22)
#define LAS __attribute__((address_space(3)))
__device__ __forceinline__ unsigned xb_ld(unsigned* p)              { return __hip_atomic_load(p, __ATOMIC_RELAXED, __HIP_MEMORY_SCOPE_AGENT); }
__device__ __forceinline__ unsigned xb_add(unsigned* p, unsigned v) { return __hip_atomic_fetch_add(p, v, __ATOMIC_RELAXED, __HIP_MEMORY_SCOPE_AGENT); }
__device__ __forceinline__ unsigned xb_xcc_id() { return (unsigned)__builtin_amdgcn_s_getreg((3 << 11) | 20) & 0xFu; }
#define XB_SPIN(cond, bar) do { unsigned _sp = 0; while (cond) { __builtin_amdgcn_s_sleep(1); \
    if ((++_sp & 255u) == 0u) { if (xb_ld(&(bar)[XB_TMO])) break; if (_sp > XB_SPIN_CAP) { atomicAdd(&(bar)[XB_TMO], 1u); break; } } } } while (0)
struct XcdBarrier { unsigned* bar; unsigned x; volatile LAS unsigned* st; };
__device__ __forceinline__ XcdBarrier xcd_barrier_post(unsigned* bar, volatile LAS unsigned* st) {
    XcdBarrier b; b.bar = bar; b.x = xb_xcc_id(); b.st = st;
    if (threadIdx.x == 0) (void)xb_add(&bar[XB_XCNT(b.x)], 1u);
    return b;
}
__device__ __forceinline__ void xcd_barrier_complete(unsigned* bar, unsigned x, unsigned& nloc, unsigned& nx) {
    const unsigned G = gridDim.x * gridDim.y * gridDim.z;
    unsigned sum, cnt, mine, sp = 0u;
    for (;;) {
        sum = 0u; cnt = 0u; mine = 0u;
#pragma unroll
        for (unsigned j = 0; j < 16; ++j) { const unsigned c = xb_ld(&bar[XB_XCNT(j)]); sum += c; cnt += (c > 0u) ? 1u : 0u; mine = (j == x) ? c : mine; }
        if (sum == G) break;
        __builtin_amdgcn_s_sleep(1);
        if ((++sp & 255u) == 0u) { if (xb_ld(&bar[XB_TMO])) break; if (sp > XB_SPIN_CAP) { atomicAdd(&bar[XB_TMO], 1u); break; } }
    }
    nloc = mine > 0u ? mine : 1u; nx = cnt > 0u ? cnt : 1u;
}
__device__ __forceinline__ void xcd_barrier(const XcdBarrier& b) {
    asm volatile("s_waitcnt vmcnt(0)" ::: "memory");
    __syncthreads();
    if (threadIdx.x == 0) {
        unsigned* bar = b.bar;
        __builtin_amdgcn_s_waitcnt(0);
        unsigned nloc = b.st[0], nx = b.st[1];
        if (nloc == 0u) { xcd_barrier_complete(bar, b.x, nloc, nx); b.st[0] = nloc; b.st[1] = nx; }
        const unsigned old = xb_add(&bar[XB_XSUB(b.x)], 1u);
        const unsigned gen = old / nloc;
        if (old + 1u == (gen + 1u) * nloc) {
            __builtin_amdgcn_fence(__ATOMIC_RELEASE, "agent");
            asm volatile("s_waitcnt vmcnt(0)" ::: "memory");
            const unsigned og = xb_add(&bar[XB_TOP], 1u);
            const unsigned tg = og / nx;
            if (og + 1u == (tg + 1u) * nx) xb_add(&bar[XB_TOPGEN], 1u);
            else XB_SPIN(xb_ld(&bar[XB_TOPGEN]) == tg, bar);
            __builtin_amdgcn_fence(__ATOMIC_ACQUIRE, "agent");
            xb_add(&bar[XB_XGEN(b.x)], 1u);
            asm volatile("s_waitcnt vmcnt(0)" ::: "memory");
        } else {
            XB_SPIN(xb_ld(&bar[XB_XGEN(b.x)]) == gen, bar);
            __builtin_amdgcn_fence(__ATOMIC_ACQUIRE, "agent");
            asm volatile("s_waitcnt vmcnt(0)" ::: "memory");
        }
    }
    __syncthreads();
}

__global__ void __launch_bounds__(NTHR, 2) fwd_mega(Params p) {
    cg::grid_group grid = cg::this_grid();
    unsigned char* ws = p.ws;
    bf16_t* WT = (bf16_t*)(ws + WS_WT); const float* tab = (const float*)(ws + WS_TAB);
    bf16_t* HB0 = (bf16_t*)(ws + WS_HB); bf16_t* HB1 = (bf16_t*)(ws + WS_HB1);
    float* SSQ0 = (float*)(ws + WS_SSQ); float* SSQ1 = SSQ0 + (size_t)MG * 16; float* SSQ2 = SSQ1 + (size_t)MG * 16;
    bf16_t* Z = (bf16_t*)(ws + WS_Z); bf16_t* MIX = (bf16_t*)(ws + WS_MIX); bf16_t* HID = (bf16_t*)(ws + WS_HID);
    bf16_t* PB = (bf16_t*)(ws + WS_PB); bf16_t* PL = (bf16_t*)(ws + WS_PLE);
    float* GS = (float*)(ws + WS_GS); float* GD = (float*)(ws + WS_GD); float* RS = (float*)(ws + WS_RS);
    float* lgam = (float*)(g_lds + LDS_BYTES - 64);

#ifndef NO_P0
    phase_weights(p);
#endif
    unsigned* barw = (unsigned*)(ws + WS_BAR);
    volatile LAS unsigned* bst = (volatile LAS unsigned*)(g_lds + LDS_BYTES - 32);
    if (blockIdx.x == 0) for (int i = threadIdx.x; i < XCD_BAR_WORDS; i += NTHR) barw[i] = 0u;
    if (threadIdx.x < 2) bst[threadIdx.x] = 0u;
    grid.sync();
    const XcdBarrier xb = xcd_barrier_post(barw, bst);
#pragma unroll 1
    for (int g = 0; g < NGROUPS; ++g) {
        const int S = (g == 0) ? 16384 : 2048;
        float* H = p.out + (size_t)g * MG * D;
#ifndef NO_PI
        phase_init(p, g);
#endif
        xcd_barrier(xb);
#pragma unroll 1
        for (int l = 0; l < NLAYER; ++l) {
            const bf16_t* W = WT + (size_t)l * W_LAYER;
            { const int t8 = opaque_tid(); if (t8 < 8) { const float x = p.ret_decay_raw[l * 8 + t8]; lgam[t8] = fminf(x, 0.f) - __logf(1.0f + __expf(-fabsf(x))); } }
            __syncthreads();
            { EpiIn e{Z, SSQ0, p.attn_q_norm + l * 64, p.attn_k_norm + l * 64, p.gla_gate_bias + l * 256, tab, S - 1};
#ifndef NO_P1
#ifndef REP_P1
#define REP_P1 1
#endif
              gemm_phase(HB0, D, W + WO_IN, D, MG, ZW, D, e);
#if REP_P1 > 1
              xcd_barrier(xb); gemm_phase(HB0, D, W + WO_IN, D, MG, ZW, D, e);
#endif
#endif
 }
            xcd_barrier(xb);
#ifndef REP_MIX
#define REP_MIX 1
#endif
            for (int rep_mix = 0; rep_mix < REP_MIX; ++rep_mix) {
            { const int nA = 1024, nG = NCH, nR = 2 * NCR;
#ifndef NO_AT
              if ((gridDim.x & 7) == 0) {
                  const int per = nA / 8, slots = gridDim.x / 8;
                  for (int k = blockIdx.x / 8; k < per; k += slots) attn_item(Z, MIX, S, per * (blockIdx.x & 7) + k);
              } else { for (int it = blockIdx.x; it < nA; it += gridDim.x) attn_item(Z, MIX, S, it); }
#endif
              for (int it = nA + blockIdx.x; it < nA + nG + nR; it += gridDim.x) {
#ifndef NO_G1
                  if (it >= nA && it < nA + nG) gla1_item(Z, GS, GD, it - nA);
#endif
#ifndef NO_R1
                  if (it >= nA + nG) ret1_item(Z, RS, lgam, it - nA - nG);
#endif
              } }
            xcd_barrier(xb);
#ifndef NO_P3
            phase_scan(GS, GD, RS, lgam, S);
#endif
            xcd_barrier(xb);
            { for (int it = blockIdx.x; it < NCH + NCR; it += gridDim.x) {
#ifndef NO_G3
                  if (it < NCH) gla3_item(Z, GS, MIX, p.gla_out_norm + l * 256, it);
#endif
#ifndef NO_R3
                  if (it >= NCH) ret3_item(Z, RS, MIX, p.ret_out_norm + l * 256, lgam, it - NCH);
#endif
              } }
            xcd_barrier(xb);
            }
#ifndef NO_P5
            { EpiRes e{HB0, HB1, SSQ1}; gemm_phase(MIX, D, W + WO_OUT, D, MG, D, D, e); }
#endif
            xcd_barrier(xb);
#ifndef NO_P6
            { EpiMlpIn e{HID, SSQ1}; gemm_phase(HB1, D, W + WO_MI, D, MG, DFF, D, e); }
#endif
#ifndef NO_P6B
            { EpiPlain e{PB, D}; gemm_phase(PL + (size_t)l * MG * PLE, PLE, W + WO_PP, PLE, MG, D, PLE, e); }
#endif
            xcd_barrier(xb);
#ifndef NO_P7
            { EpiRes e{HB1, HB1, SSQ2}; gemm_phase(HID, DFF, W + WO_MO, DFF, MG, D, DFF, e); }
#endif
            xcd_barrier(xb);
#ifndef NO_P9
            { EpiPeGate e{H, HB1, HB0, SSQ0, SSQ2, PB, l == NLAYER - 1}; gemm_phase(HB1, D, W + WO_PG, D, MG, D, D, e); }
#endif
            xcd_barrier(xb);
        }
    }
}

extern "C" void kernel_launch(void* const* d_in, const int* in_sizes, int n_in, void* d_out, int out_size, void* d_ws, size_t ws_size, hipStream_t stream) {
    static int grid_blocks = 0;
    if (!grid_blocks) {
        int dev = 0, cus = 0, per_cu = 0;
        hipGetDevice(&dev);
        hipDeviceGetAttribute(&cus, hipDeviceAttributeMultiprocessorCount, dev);
        hipFuncSetAttribute((const void*)fwd_mega, hipFuncAttributeMaxDynamicSharedMemorySize, LDS_BYTES);
        hipOccupancyMaxActiveBlocksPerMultiprocessor(&per_cu, (const void*)fwd_mega, NTHR, LDS_BYTES);
        if (per_cu < 1) per_cu = 1;
        grid_blocks = cus * 1;
        if (ws_size < WS_END) fprintf(stderr, "kernel_launch: workspace too small: %zu < %zu\n", ws_size, (size_t)WS_END);
    }
    Params p{};
    p.x_prompt = (const float*)d_in[0]; p.x_sample = (const float*)d_in[1]; p.p_prompt = (const float*)d_in[2]; p.p_sample = (const float*)d_in[3];
    p.ln_mix = (const float*)d_in[4]; p.w_in = (const float*)d_in[5]; p.attn_q_norm = (const float*)d_in[6]; p.attn_k_norm = (const float*)d_in[7];
    p.gla_gate_up = (const float*)d_in[8]; p.gla_gate_bias = (const float*)d_in[9]; p.gla_out_norm = (const float*)d_in[10]; p.ret_decay_raw = (const float*)d_in[11];
    p.ret_out_norm = (const float*)d_in[12]; p.w_out = (const float*)d_in[13]; p.ln_mlp = (const float*)d_in[14]; p.w_mlp_in = (const float*)d_in[15]; p.w_mlp_out = (const float*)d_in[16];
    p.ln_pe = (const float*)d_in[17]; p.w_pe_gate = (const float*)d_in[18]; p.w_pe_proj = (const float*)d_in[19];
    p.out = (float*)d_out; p.ws = (unsigned char*)d_ws;
    void* args[] = {&p};
    hipError_t e = hipLaunchCooperativeKernel((const void*)fwd_mega, dim3(grid_blocks), dim3(NTHR), args, LDS_BYTES, stream);
    if (e != hipSuccess) fprintf(stderr, "cooperative launch failed: %s (grid %d)\n", hipGetErrorString(e), grid_blocks);
}
```

```cpp
#include <hip/hip_runtime.h>
#include <hip/hip_cooperative_groups.h>
#include <cstdio>
#include <cstdint>
namespace cg = cooperative_groups;

typedef unsigned short bf16_t;
typedef short bf16x8 __attribute__((ext_vector_type(8)));
typedef float f32x4 __attribute__((ext_vector_type(4)));
typedef unsigned u32x4 __attribute__((ext_vector_type(4)));
typedef unsigned u32x2 __attribute__((ext_vector_type(2)));

constexpr int D = 1024, MG = 32768, NGROUPS = 3, NLAYER = 2;
constexpr int ZW = 3584, DFF = 4096, PLE = 256, NIN = 3360;
constexpr int NTHR = 512;
constexpr int NCH = MG / 64;
constexpr int NCR = MG / 128;
constexpr float EPS = 1e-6f;
constexpr int ZC_AQ = 0, ZC_AK = 512, ZC_AV = 1024, ZC_BQ = 1536, ZC_BK = 1664, ZC_BV = 1792, ZC_BR = 2048,
              ZC_GF = 2304, ZC_GB = 2432, ZC_CQ = 2560, ZC_CK = 2816, ZC_CV = 3072, ZC_CG = 3328;
constexpr size_t WO_IN = 0, WO_OUT = WO_IN + (size_t)ZW * D, WO_MI = WO_OUT + (size_t)D * D, WO_MO = WO_MI + (size_t)DFF * D,
                 WO_PG = WO_MO + (size_t)D * DFF, WO_PP = WO_PG + (size_t)D * D, W_LAYER = WO_PP + (size_t)D * PLE;
constexpr size_t WS_WT = 0;
constexpr size_t WS_TAB = WS_WT + W_LAYER * 2 * NLAYER;
constexpr size_t WS_HB = WS_TAB + (size_t)16384 * 40 * 2 * 4;
constexpr size_t WS_HB1 = WS_HB + (size_t)MG * D * 2;
constexpr size_t WS_SSQ = WS_HB1 + (size_t)MG * D * 2;
constexpr size_t WS_Z = WS_SSQ + (size_t)3 * MG * 16 * 4;
constexpr size_t WS_MIX = WS_Z + (size_t)MG * ZW * 2;
constexpr size_t WS_HID = WS_MIX + (size_t)MG * D * 2;
constexpr size_t WS_PB = WS_HID + (size_t)MG * DFF * 2;
constexpr size_t WS_PLE = WS_PB + (size_t)MG * D * 2;
constexpr size_t WS_GS = WS_PLE + (size_t)NLAYER * MG * PLE * 2;
constexpr size_t WS_GD = WS_GS + (size_t)2 * NCH * 4 * 2048 * 4;
constexpr size_t WS_RS = WS_GD + (size_t)2 * NCH * 4 * 32 * 4;
constexpr size_t WS_BAR = WS_RS + (size_t)2 * NCR * 4 * 4096 * 4;
constexpr size_t WS_END = WS_BAR + 16384;

constexpr int LDS_BYTES = 139264;

extern __shared__ __attribute__((aligned(16))) unsigned char g_lds[];

struct Params {
    const float* x_prompt; const float* x_sample; const float* p_prompt; const float* p_sample;
    const float* ln_mix; const float* w_in; const float* attn_q_norm; const float* attn_k_norm;
    const float* gla_gate_up; const float* gla_gate_bias; const float* gla_out_norm; const float* ret_decay_raw;
    const float* ret_out_norm; const float* w_out; const float* ln_mlp; const float* w_mlp_in; const float* w_mlp_out;
    const float* ln_pe; const float* w_pe_gate; const float* w_pe_proj;
    float* out; unsigned char* ws;
};

typedef float f32x2_t __attribute__((ext_vector_type(2)));
typedef __bf16 bf16x2_t __attribute__((ext_vector_type(2)));
__device__ __forceinline__ unsigned cvt_pk_bf16(float lo, float hi) { const f32x2_t v = {lo, hi}; return __builtin_bit_cast(unsigned, __builtin_convertvector(v, bf16x2_t)); }
__device__ __forceinline__ float bf2f(unsigned short b) { return __uint_as_float(((unsigned)b) << 16); }
__device__ __forceinline__ float bflo(unsigned w) { return __uint_as_float(w << 16); }
__device__ __forceinline__ float bfhi(unsigned w) { return __uint_as_float(w & 0xffff0000u); }
__device__ __forceinline__ bf16x8 pack8(const float (&v)[8]) {
    u32x4 w; w.x = cvt_pk_bf16(v[0], v[1]); w.y = cvt_pk_bf16(v[2], v[3]); w.z = cvt_pk_bf16(v[4], v[5]); w.w = cvt_pk_bf16(v[6], v[7]);
    return __builtin_bit_cast(bf16x8, w);
}
__device__ __forceinline__ void unpack8(bf16x8 b, float (&v)[8]) {
    u32x4 w = __builtin_bit_cast(u32x4, b);
    v[0] = bflo(w.x); v[1] = bfhi(w.x); v[2] = bflo(w.y); v[3] = bfhi(w.y); v[4] = bflo(w.z); v[5] = bfhi(w.z); v[6] = bflo(w.w); v[7] = bfhi(w.w);
}
typedef short v4i16_t __attribute__((ext_vector_type(4)));
__device__ __forceinline__ bf16x8 gather8(const bf16_t* tile  , int stride, int qi) {
    const bf16_t* p = tile + (qi >> 2) * stride + 4 * (qi & 3);
    const v4i16_t lo = __builtin_amdgcn_ds_read_tr16_b64_v4i16((__attribute__((address_space(3))) v4i16_t*)p);
    const v4i16_t hi = __builtin_amdgcn_ds_read_tr16_b64_v4i16((__attribute__((address_space(3))) v4i16_t*)(p + 4 * stride));
    bf16x8 r; r[0] = lo[0]; r[1] = lo[1]; r[2] = lo[2]; r[3] = lo[3]; r[4] = hi[0]; r[5] = hi[1]; r[6] = hi[2]; r[7] = hi[3];
    return r;
}
__device__ __forceinline__ bf16x8 ld8f_pack(const float* p) {
    f32x4 a = *(const f32x4*)p, b = *(const f32x4*)(p + 4);
    u32x4 w; w.x = cvt_pk_bf16(a.x, a.y); w.y = cvt_pk_bf16(a.z, a.w); w.z = cvt_pk_bf16(b.x, b.y); w.w = cvt_pk_bf16(b.z, b.w);
    return __builtin_bit_cast(bf16x8, w);
}
__device__ __forceinline__ int opaque_tid() { int t = threadIdx.x; asm volatile("" : "+v"(t)); return t; }
#define LDS_FENCE() asm volatile("s_waitcnt lgkmcnt(0)" ::: "memory")
#define MFMA16(a, b, c) __builtin_amdgcn_mfma_f32_16x16x32_bf16((a), (b), (c), 0, 0, 0)

constexpr int BM = 256, BK = 64, HALF = 128, HT = HALF * BK;
__device__ __forceinline__ int lds_byte(int r, int c) {
    int st = (r >> 4) * 2 + (c >> 5), rr = r & 15, cc = c & 31, ob = rr * 64 + cc * 2;
    return st * 1024 + (ob ^ (((ob >> 9) & 1) << 5));
}
__device__ __forceinline__ void stage_rc(int b, int& R, int& C) {
    int st = b / 1024, sb = b % 1024, swz = sb ^ (((sb >> 9) & 1) << 5);
    R = (st >> 1) * 16 + swz / 64; C = (st & 1) * 32 + (swz % 64) / 2;
}
__device__ __forceinline__ bool tile_of(int L, int nM, int nN, int& pm, int& pn) {
    const int nwg = nM * nN; if (L >= nwg) return false;
    int wgid = L; { const int q = nwg / 8, r = nwg % 8, xcd = wgid % 8, off = wgid / 8; wgid = (xcd < r ? xcd * (q + 1) : r * (q + 1) + (xcd - r) * q) + off; }
    const int nig = 8 * nN, gid = wgid / nig, fm = gid * 8, gsz = (nM - fm) < 8 ? (nM - fm) : 8;
    pm = fm + ((wgid % nig) % gsz); pn = (wgid % nig) / gsz; return true;
}

template <bool TR, class Epi>
__device__ __forceinline__ void gemm_tile(const bf16_t* __restrict__ A, int lda, const bf16_t* __restrict__ Bt, int ldb, int K, int brow, int bcol, const Epi& epi, int parity, bool pre, int nbrow, int nbcol) {
    const int tid = opaque_tid();
    bf16_t* shm = (bf16_t*)g_lds;
#define SA(b, h) (shm + ((b) * 2 + (h)) * HT)
#define SB(b, h) (shm + (4 + (b) * 2 + (h)) * HT)
#define STAGE(P, BASE, LD, br, kt) do { const int _so = ((br) * (LD) + (kt) * BK) * 2; \
    for (int _i = 0; _i < 2; ++_i) { \
      __builtin_amdgcn_raw_ptr_buffer_load_lds(((&(LD) == &lda) ? rsA : rsB), (__attribute__((address_space(3))) void*)((char*)(P) + wid * 1024 + _i * 8192), 16, \
          ((&(LD) == &lda) ? offA[_i] : offB[_i]), _so, 0, 0); } } while (0)
#define LDA(dst, b, h) for (int m = 0; m < 4; ++m) for (int k = 0; k < 2; ++k) \
    dst[m][k] = *reinterpret_cast<const bf16x8*>((char*)SA(b, h) + lds_byte(wr * 64 + m * 16 + fr, k * 32 + fq * 8))
#define LDB(dst, b, h) for (int n = 0; n < 2; ++n) for (int k = 0; k < 2; ++k) \
    dst[n][k] = *reinterpret_cast<const bf16x8*>((char*)SB(b, h) + lds_byte(wc * 32 + n * 16 + fr, k * 32 + fq * 8))
#define MMA(ai, bj, At, Bt_) do { __builtin_amdgcn_s_setprio(1); \
    for (int m = 0; m < 4; ++m) for (int n = 0; n < 2; ++n) for (int k = 0; k < 2; ++k) \
      acc[ai][bj][m][n] = TR ? __builtin_amdgcn_mfma_f32_16x16x32_bf16(Bt_[n][k], At[m][k], acc[ai][bj][m][n], 0, 0, 0) \
                            : __builtin_amdgcn_mfma_f32_16x16x32_bf16(At[m][k], Bt_[n][k], acc[ai][bj][m][n], 0, 0, 0); \
    __builtin_amdgcn_s_setprio(0); } while (0)
#define WAIT_V(n) asm volatile("s_waitcnt vmcnt(" #n ")" ::: "memory")
#define WAIT_L(n) asm volatile("s_waitcnt lgkmcnt(" #n ")" ::: "memory")
#define BAR __builtin_amdgcn_s_barrier()
#define SCHED __builtin_amdgcn_sched_barrier(0)
    const int wid = __builtin_amdgcn_readfirstlane(tid >> 6), lane = tid & 63, wr = wid >> 2, wc = wid & 3, fr = lane & 15, fq = lane >> 4;
    f32x4 acc[2][2][4][2] = {};
    bf16x8 At[4][2], B0[2][2], B1[2][2];
    const int nt = K / BK;
    const __amdgpu_buffer_rsrc_t rsA = __builtin_amdgcn_make_buffer_rsrc((void*)A, (short)0, 0x7ffffff0, 0x00020000);
    const __amdgpu_buffer_rsrc_t rsB = __builtin_amdgcn_make_buffer_rsrc((void*)Bt, (short)0, 0x7ffffff0, 0x00020000);
    unsigned offA[2], offB[2];
    for (int _i = 0; _i < 2; ++_i) { int _r, _c; stage_rc(tid * 16 + _i * 8192, _r, _c); offA[_i] = (unsigned)(_r * lda + _c) * 2u; offB[_i] = (unsigned)(_r * ldb + _c) * 2u; }
    if (!(TR && pre)) {
    STAGE(SB(0, 0), Bt, ldb, bcol, 0); STAGE(SA(0, 0), A, lda, brow, 0);
    STAGE(SB(0, 1), Bt, ldb, bcol + HALF, 0); STAGE(SA(0, 1), A, lda, brow + HALF, 0);
    }
    float* RT = (float*)(g_lds + 131072 + (parity & 1) * 1024);
    if (TR) { if (tid < 256) RT[tid] = epi.rstd_row(brow + tid); }
    if (wr == 1) BAR;
    if (TR && pre) { WAIT_V(8); } else { WAIT_V(4); }
    BAR;
    STAGE(SB(1, 0), Bt, ldb, bcol, 1); STAGE(SA(1, 0), A, lda, brow, 1); STAGE(SB(1, 1), Bt, ldb, bcol + HALF, 1);
    WAIT_V(6); BAR;
#pragma unroll 1
    for (int t = 0; t < nt - 2; t += 2) {
        LDB(B0, 0, 0); SCHED; LDA(At, 0, 0); STAGE(SA(1, 1), A, lda, brow + HALF, t + 1);
        WAIT_L(8); BAR; WAIT_L(0); MMA(0, 0, At, B0); BAR; SCHED;
        LDB(B1, 0, 1); STAGE(SB(0, 0), Bt, ldb, bcol, t + 2);
        BAR; WAIT_L(0); MMA(0, 1, At, B1); BAR;
        LDA(At, 0, 1); STAGE(SA(0, 0), A, lda, brow, t + 2);
        BAR; WAIT_L(0); MMA(1, 0, At, B0); BAR; SCHED;
        STAGE(SB(0, 1), Bt, ldb, bcol + HALF, t + 2);
        WAIT_V(6); BAR; MMA(1, 1, At, B1); BAR;
        LDB(B0, 1, 0); SCHED; LDA(At, 1, 0); STAGE(SA(0, 1), A, lda, brow + HALF, t + 2);
        WAIT_L(8); BAR; WAIT_L(0); MMA(0, 0, At, B0); BAR; SCHED;
        LDB(B1, 1, 1); STAGE(SB(1, 0), Bt, ldb, bcol, t + 3);
        BAR; WAIT_L(0); MMA(0, 1, At, B1); BAR;
        LDA(At, 1, 1); STAGE(SA(1, 0), A, lda, brow, t + 3);
        BAR; WAIT_L(0); MMA(1, 0, At, B0); BAR; SCHED;
        STAGE(SB(1, 1), Bt, ldb, bcol + HALF, t + 3);
        WAIT_V(6); BAR; MMA(1, 1, At, B1); BAR;
    }
    { LDB(B0, 0, 0); LDA(At, 0, 0); STAGE(SA(1, 1), A, lda, brow + HALF, nt - 1);
      BAR; WAIT_L(0); MMA(0, 0, At, B0); BAR;
      LDB(B1, 0, 1); BAR; WAIT_L(0); MMA(0, 1, At, B1); BAR;
      LDA(At, 0, 1); WAIT_V(4); BAR; WAIT_L(0); MMA(1, 0, At, B0); MMA(1, 1, At, B1); BAR; }
    { LDB(B0, 1, 0); LDA(At, 1, 0); WAIT_V(2); BAR; WAIT_L(0); MMA(0, 0, At, B0); BAR;
      LDB(B1, 1, 1); WAIT_V(0); BAR; WAIT_L(0); MMA(0, 1, At, B1); BAR;
      LDA(At, 1, 1); BAR; WAIT_L(0); MMA(1, 0, At, B0); MMA(1, 1, At, B1); BAR; }
    if (wr == 0) BAR;
    if (TR && nbrow >= 0) {
        STAGE(SB(0, 0), Bt, ldb, nbcol, 0); STAGE(SA(0, 0), A, lda, nbrow, 0);
        STAGE(SB(0, 1), Bt, ldb, nbcol + HALF, 0); STAGE(SA(0, 1), A, lda, nbrow + HALF, 0);
        asm volatile("" ::: "memory"); SCHED;
    }
    if (TR) {
        epi.regs(acc, RT, brow, bcol, wr, wc, fr, fq);
        return;
    }
    float* ep = (float*)g_lds;
    __syncthreads();
#pragma unroll
    for (int ai = 0; ai < 2; ++ai) {
        if (ai) __syncthreads();
#pragma unroll
        for (int bj = 0; bj < 2; ++bj)
#pragma unroll
            for (int m = 0; m < 4; ++m)
#pragma unroll
                for (int n = 0; n < 2; ++n)
#pragma unroll
                    for (int j = 0; j < 4; ++j)
                        ep[(wr * 64 + m * 16 + fq * 4 + j) * 260 + bj * HALF + wc * 32 + n * 16 + fr] = acc[ai][bj][m][n][j];
        __syncthreads();
        int lane_e = tid & 63; asm volatile("" : "+v"(lane_e));
        const int row0 = brow + ai * HALF + wid * 16;
        epi.rows(ep, wid, lane_e, row0, bcol);
    }
    __syncthreads();
#undef SA
#undef SB
#undef STAGE
#undef LDA
#undef LDB
#undef MMA
}

template <bool TR, class Epi>
__device__ __forceinline__ void gemm_phase_t(const bf16_t* A, int lda, const bf16_t* Bt, int ldb, int M, int N, int K, const Epi& epi) {
    const int nM = M / BM, nN = N / BM;
    int pm, pn; bool have = tile_of((int)blockIdx.x, nM, nN, pm, pn), pre = false;
    for (int i = 0; have; ++i) {
        int npm = 0, npn = 0; const bool nhave = tile_of((i + 1) * (int)gridDim.x + (int)blockIdx.x, nM, nN, npm, npn);
        gemm_tile<TR>(A, lda, Bt, ldb, K, pm * BM, pn * BM, epi, i, pre, (TR && nhave) ? npm * BM : -1, npn * BM);
        pre = TR && nhave; pm = npm; pn = npn; have = nhave;
    }
    if (TR) __syncthreads();
}
template <class Epi>
__device__ __forceinline__ void gemm_phase(const bf16_t* A, int lda, const bf16_t* Bt, int ldb, int M, int N, int K, const Epi& epi) { gemm_phase_t<false>(A, lda, Bt, ldb, M, N, K, epi); }

__device__ __forceinline__ float row_rstd(const float* ssq, int row) {
    const f32x4* p = (const f32x4*)(ssq + (size_t)row * 16);
    const f32x4 a = p[0], b = p[1], c = p[2], d = p[3];
    const float s = ((a.x + a.y) + (a.z + a.w)) + ((b.x + b.y) + (b.z + b.w)) + ((c.x + c.y) + (c.z + c.w)) + ((d.x + d.y) + (d.z + d.w));
    return rsqrtf(s * (1.0f / D) + EPS);
}
__device__ __forceinline__ float rstd16(const float* ssq, int row0, int lane) {
    const f32x4 q = *(const f32x4*)(ssq + (size_t)(row0 + (lane >> 2)) * 16 + 4 * (lane & 3));
    float s = (q.x + q.y) + (q.z + q.w); s += __shfl_xor(s, 1); s += __shfl_xor(s, 2);
    return rsqrtf(s * (1.0f / D) + EPS);
}
__device__ __forceinline__ float seg_sum16(float s) { s += __shfl_xor(s, 1); s += __shfl_xor(s, 2); s += __shfl_xor(s, 4); s += __shfl_xor(s, 8); return s; }
__device__ __forceinline__ void st4_bf16(bf16_t* d, float a, float b, float c, float e) { u32x2 w; w.x = cvt_pk_bf16(a, b); w.y = cvt_pk_bf16(c, e); *(u32x2*)d = w; }

template <class E> __device__ __forceinline__ void epi_rows_generic(const E& e, const float* ep, int wid, int lane, int row0, int bcol) {
    const float rsv = e.begin(row0, lane);
#pragma unroll 4
    for (int i = 0; i < 16; ++i) {
        const f32x4 v = *(const f32x4*)(ep + (wid * 16 + i) * 260 + 4 * lane);
        e.row(v, row0 + i, bcol + 4 * lane, lane, __shfl(rsv, 4 * i));
    }
}

struct EpiIn {
    bf16_t* Z; const float* ssq; const float* qn; const float* kn; const float* gbias; const float* tab; int smask;
    __device__ __forceinline__ float rstd_row(int) const { return 0.f; }
    __device__ __forceinline__ void regs(const f32x4 (&)[2][2][4][2], const float*, int, int, int, int, int, int) const {}
    template <int T> __device__ __forceinline__ void rows_t(const float* ep, int wid, int lane, int row0, int bcol) const {
        const float rsv = rstd16(ssq, row0, lane);
        const int col = bcol + 4 * lane, c = col & 63, sl = lane & 15;
        f32x4 gn = {1.f, 1.f, 1.f, 1.f}, bb = {0.f, 0.f, 0.f, 0.f};
        if (T == 0) gn = *(const f32x4*)(qn + c);
        if (T == 1) gn = *(const f32x4*)(kn + c);
        if (T == 4) bb = *(const f32x4*)(gbias + (col - ZC_GF));
        const bool rot = (T <= 1) ? (sl < 4) : true;
        const float sgn = (T <= 1) ? (sl < 2 ? -1.f : 1.f) : (sl < 8 ? -1.f : 1.f);
        const int toff = (T <= 1) ? 2 * (c & 7) : 16 + 2 * (c & 31);
        const float psc = (T == 2) ? ((col >= ZC_BQ && col < ZC_BK) ? 0.17677669529663687f : 1.0f) : (T == 0 ? 0.125f * 1.4426950408889634f : (T == 6 ? 0.125f : 1.0f));
#pragma unroll 4
        for (int i = 0; i < 16; ++i) {
            f32x4 v = *(const f32x4*)(ep + (wid * 16 + i) * 260 + 4 * lane);
            const int row = row0 + i; const float rstd = __shfl(rsv, 4 * i);
            bf16_t* dst = Z + (size_t)row * ZW + col;
            if (T == 0 || T == 1 || T == 5 || T == 6) {
                const float* cs = tab + (size_t)(row & smask) * 80 + toff;
                const f32x4 t0 = *(const f32x4*)cs, t1 = *(const f32x4*)(cs + 4);
                float r = rstd * psc;
                if (T <= 1) { const float ss = seg_sum16((v.x * v.x + v.y * v.y) + (v.z * v.z + v.w * v.w)); r *= rsqrtf(ss * rstd * rstd * (1.0f / 64) + EPS); }
                v.x *= r * gn.x; v.y *= r * gn.y; v.z *= r * gn.z; v.w *= r * gn.w;
                f32x4 pv;
                if (T <= 1) { pv.x = __shfl_xor(v.x, 2); pv.y = __shfl_xor(v.y, 2); pv.z = __shfl_xor(v.z, 2); pv.w = __shfl_xor(v.w, 2); }
                else        { pv.x = __shfl_xor(v.x, 8); pv.y = __shfl_xor(v.y, 8); pv.z = __shfl_xor(v.z, 8); pv.w = __shfl_xor(v.w, 8); }
                const float nx = v.x * t0.x + sgn * pv.x * t0.y, ny = v.y * t0.z + sgn * pv.y * t0.w, nz = v.z * t1.x + sgn * pv.z * t1.y, nw = v.w * t1.z + sgn * pv.w * t1.w;
                st4_bf16(dst, rot ? nx : v.x, rot ? ny : v.y, rot ? nz : v.z, rot ? nw : v.w);
            } else if (T == 4) {
                float x[4] = {v.x * rstd + bb.x, v.y * rstd + bb.y, v.z * rstd + bb.z, v.w * rstd + bb.w}; unsigned short hb[4];
#pragma unroll
                for (int k = 0; k < 4; ++k) { const float ls = fminf(x[k], 0.f) - __logf(1.0f + __expf(-fabsf(x[k]))); const _Float16 hv = (_Float16)(ls * 0.0625f); hb[k] = __builtin_bit_cast(unsigned short, hv); }
                u32x2 w; w.x = hb[0] | ((unsigned)hb[1] << 16); w.y = hb[2] | ((unsigned)hb[3] << 16);
                *(u32x2*)dst = w;
            } else {
                const float sc = rstd * psc;
                st4_bf16(dst, v.x * sc, v.y * sc, v.z * sc, v.w * sc);
            }
        }
    }
    __device__ __forceinline__ void rows(const float* ep, int wid, int lane, int row0, int bcol) const {
        if (bcol < ZC_AK) rows_t<0>(ep, wid, lane, row0, bcol);
        else if (bcol < ZC_AV) rows_t<1>(ep, wid, lane, row0, bcol);
        else if (bcol == ZC_GF) rows_t<4>(ep, wid, lane, row0, bcol);
        else if (bcol == ZC_CQ) rows_t<5>(ep, wid, lane, row0, bcol);
        else if (bcol == ZC_CK) rows_t<6>(ep, wid, lane, row0, bcol);
        else rows_t<2>(ep, wid, lane, row0, bcol);
    }
};

struct EpiRes {
    const bf16_t* HBin; bf16_t* HBout; float* ssq;
    __device__ __forceinline__ float rstd_row(int) const { return 0.f; }
    __device__ __forceinline__ void regs(const f32x4 (&)[2][2][4][2], const float*, int, int, int, int, int, int) const {}
    __device__ __forceinline__ void rows(const float* ep, int wid, int lane, int row0, int bcol) const { epi_rows_generic(*this, ep, wid, lane, row0, bcol); }
    __device__ __forceinline__ float begin(int, int) const { return 0.f; }
    __device__ __forceinline__ void row(f32x4 v, int row, int col, int lane, float) const {
        const u32x2 hw = *(const u32x2*)(HBin + (size_t)row * D + col);
        f32x4 h = {bflo(hw.x) + v.x, bfhi(hw.x) + v.y, bflo(hw.y) + v.z, bfhi(hw.y) + v.w};
        u32x2 w; w.x = cvt_pk_bf16(h.x, h.y); w.y = cvt_pk_bf16(h.z, h.w);
        *(u32x2*)(HBout + (size_t)row * D + col) = w;
        h.x = bflo(w.x); h.y = bfhi(w.x); h.z = bflo(w.y); h.w = bfhi(w.y);
        const float ss = seg_sum16((h.x * h.x + h.y * h.y) + (h.z * h.z + h.w * h.w));
        if ((lane & 15) == 0) ssq[(size_t)row * 16 + (col >> 6)] = ss;
    }
};

struct EpiMlpIn {
    bf16_t* HID; const float* ssq;
    __device__ __forceinline__ float rstd_row(int row) const { return row_rstd(ssq, row); }
    __device__ __forceinline__ void regs(const f32x4 (&acc)[2][2][4][2], const float* RT, int brow, int bcol, int wr, int wc, int fr, int fq) const {
#pragma unroll
        for (int ai = 0; ai < 2; ++ai)
#pragma unroll
            for (int m = 0; m < 4; ++m) {
                const int rl = ai * HALF + wr * 64 + m * 16 + fr; const float rstd = RT[rl];
                bf16_t* dst = HID + (size_t)(brow + rl) * DFF + bcol + wc * 32 + 8 * fq;
#pragma unroll
                for (int bj = 0; bj < 2; ++bj) { float t[8];
#pragma unroll
                    for (int n = 0; n < 2; ++n)
#pragma unroll
                        for (int j = 0; j < 4; ++j) { const float x = fmaxf(acc[ai][bj][m][n][j] * rstd, 0.f); t[4 * n + j] = x * x; }
                    *(bf16x8*)(dst + bj * HALF) = pack8(t); }
            }
    }
    __device__ __forceinline__ void rows(const float* ep, int wid, int lane, int row0, int bcol) const { epi_rows_generic(*this, ep, wid, lane, row0, bcol); }
    __device__ __forceinline__ float begin(int row0, int lane) const { return rstd16(ssq, row0, lane); }
    __device__ __forceinline__ void row(f32x4 v, int row, int col, int, float rstd) const {
        const float a = fmaxf(v.x * rstd, 0.f), b = fmaxf(v.y * rstd, 0.f), c = fmaxf(v.z * rstd, 0.f), e = fmaxf(v.w * rstd, 0.f);
        st4_bf16(HID + (size_t)row * DFF + col, a * a, b * b, c * c, e * e);
    }
};

struct EpiPlain {
    bf16_t* O; int ldo;
    __device__ __forceinline__ float rstd_row(int) const { return 0.f; }
    __device__ __forceinline__ void regs(const f32x4 (&)[2][2][4][2], const float*, int, int, int, int, int, int) const {}
    __device__ __forceinline__ void rows(const float* ep, int wid, int lane, int row0, int bcol) const { epi_rows_generic(*this, ep, wid, lane, row0, bcol); }
    __device__ __forceinline__ float begin(int, int) const { return 0.f; }
    __device__ __forceinline__ void row(f32x4 v, int row, int col, int, float) const { st4_bf16(O + (size_t)row * ldo + col, v.x, v.y, v.z, v.w); }
};

struct EpiPeGate {
    float* Hout; const bf16_t* HBin; bf16_t* HBout; float* ssq_out; const float* ssq_in; const bf16_t* PB; int write_f32;
    __device__ __forceinline__ float rstd_row(int) const { return 0.f; }
    __device__ __forceinline__ void regs(const f32x4 (&)[2][2][4][2], const float*, int, int, int, int, int, int) const {}
    __device__ __forceinline__ void rows(const float* ep, int wid, int lane, int row0, int bcol) const { epi_rows_generic(*this, ep, wid, lane, row0, bcol); }
    __device__ __forceinline__ float begin(int row0, int lane) const { return rstd16(ssq_in, row0, lane); }
    __device__ __forceinline__ void row(f32x4 v, int row, int col, int lane, float rstd) const {
        const u32x2 pw = *(const u32x2*)(PB + (size_t)row * D + col);
        const u32x2 hw = *(const u32x2*)(HBin + (size_t)row * D + col);
        f32x4 h;
        h.x = bflo(hw.x) + bflo(pw.x) / (1.0f + __expf(-v.x * rstd)); h.y = bfhi(hw.x) + bfhi(pw.x) / (1.0f + __expf(-v.y * rstd));
        h.z = bflo(hw.y) + bflo(pw.y) / (1.0f + __expf(-v.z * rstd)); h.w = bfhi(hw.y) + bfhi(pw.y) / (1.0f + __expf(-v.w * rstd));
        if (write_f32) *(f32x4*)(Hout + (size_t)row * D + col) = h;
        u32x2 w; w.x = cvt_pk_bf16(h.x, h.y); w.y = cvt_pk_bf16(h.z, h.w);
        *(u32x2*)(HBout + (size_t)row * D + col) = w;
        h.x = bflo(w.x); h.y = bfhi(w.x); h.z = bflo(w.y); h.w = bfhi(w.y);
        const float ss = seg_sum16((h.x * h.x + h.y * h.y) + (h.z * h.z + h.w * h.w));
        if ((lane & 15) == 0) ssq_out[(size_t)row * 16 + (col >> 6)] = ss;
    }
};

template <class F>
__device__ __forceinline__ void transpose_item(bf16_t* Wt, int K, int k0, int n0, const F& src) {
    const int tid = opaque_tid();
    float* tile = (float*)g_lds;
#pragma unroll
    for (int i = 0; i < 8; ++i) { const int kk = (tid >> 6) + 8 * i, nn = tid & 63; tile[kk * 65 + nn] = src(k0 + kk, n0 + nn); }
    __syncthreads();
    { const int nn = tid >> 3, kc = tid & 7; float t[8];
#pragma unroll
      for (int j = 0; j < 8; ++j) t[j] = tile[(8 * kc + j) * 65 + nn];
      *(bf16x8*)(Wt + (size_t)(n0 + nn) * K + k0 + 8 * kc) = pack8(t); }
    __syncthreads();
}

__device__ __forceinline__ void phase_weights(const Params& p) {
    bf16_t* WT = (bf16_t*)(p.ws + WS_WT);
    constexpr int I_IN = 16 * (ZW / 64), I_OUT = 16 * 16, I_MI = 16 * 64, I_MO = 64 * 16, I_PG = 16 * 16, I_PP = 4 * 16;
    constexpr int I_L = I_IN + I_OUT + I_MI + I_MO + I_PG + I_PP;
    for (int it = blockIdx.x; it < NLAYER * I_L; it += gridDim.x) {
        const int l = it / I_L; int r = it % I_L;
        bf16_t* W = WT + (size_t)l * W_LAYER;
        if (r < I_IN) {
            const int kb = r / (ZW / 64), nb = r % (ZW / 64);
            const float* w = p.w_in + (size_t)l * D * NIN; const float* g = p.ln_mix + l * D; const float* gu = p.gla_gate_up + (size_t)l * 2 * 16 * 128;
            transpose_item(W + WO_IN, D, kb * 64, nb * 64, [&](int k, int c) -> float {
                float v;
                if (c < ZC_GF) v = w[(size_t)k * NIN + c];
                else if (c < ZC_CQ) { const int j = (c - ZC_GF) >> 7, kk = (c - ZC_GF) & 127; float s = 0.f;
                    for (int rr = 0; rr < 16; ++rr) s += w[(size_t)k * NIN + 2304 + 16 * j + rr] * gu[(j * 16 + rr) * 128 + kk];
                    v = s; }
                else v = w[(size_t)k * NIN + (c - 224)];
                return v * g[k]; });
            continue; }
        r -= I_IN;
        if (r < I_OUT) { const float* w = p.w_out + (size_t)l * D * D;
            transpose_item(W + WO_OUT, D, (r / 16) * 64, (r % 16) * 64, [&](int k, int c) -> float { return w[(size_t)k * D + c]; }); continue; }
        r -= I_OUT;
        if (r < I_MI) { const float* w = p.w_mlp_in + (size_t)l * D * DFF; const float* g = p.ln_mlp + l * D;
            transpose_item(W + WO_MI, D, (r / 64) * 64, (r % 64) * 64, [&](int k, int c) -> float { const int rho = c & 31; const int cc = (c & ~31) + 8 * ((rho & 15) >> 2) + 4 * (rho >> 4) + (rho & 3);
                return w[(size_t)k * DFF + cc] * g[k]; }); continue; }
        r -= I_MI;
        if (r < I_MO) { const float* w = p.w_mlp_out + (size_t)l * DFF * D;
            transpose_item(W + WO_MO, DFF, (r / 16) * 64, (r % 16) * 64, [&](int k, int c) -> float { return w[(size_t)k * D + c]; }); continue; }
        r -= I_MO;
        if (r < I_PG) { const float* w = p.w_pe_gate + (size_t)l * D * D; const float* g = p.ln_pe + l * D;
            transpose_item(W + WO_PG, D, (r / 16) * 64, (r % 16) * 64, [&](int k, int c) -> float { return w[(size_t)k * D + c] * g[k]; }); continue; }
        r -= I_PG;
        { const float* w = p.w_pe_proj + (size_t)l * PLE * D;
            transpose_item(W + WO_PP, PLE, (r / 16) * 64, (r % 16) * 64, [&](int k, int c) -> float { return w[(size_t)k * D + c]; }); }
    }
    float* tab = (float*)(p.ws + WS_TAB);
    for (int e = blockIdx.x * NTHR + threadIdx.x; e < 16384 * 40; e += gridDim.x * NTHR) {
        const int pos = e / 40, i = e % 40;
        const double invf = (i < 8) ? exp(-(double)i * (log(500000.0) / 8.0)) : exp(-(double)(i - 8) * (log(10000.0) / 32.0));
        double ang = (double)pos * invf; ang -= 6.283185307179586476925 * floor(ang * 0.15915494309189533577);
        tab[2 * e] = (float)cos(ang); tab[2 * e + 1] = (float)sin(ang);
    }
}

__device__ __forceinline__ void phase_init(const Params& p, int g) {
    const int tid = opaque_tid();
    const float* x = (g == 0) ? p.x_prompt : p.x_sample + (size_t)(g - 1) * MG * D;
    bf16_t* HB = (bf16_t*)(p.ws + WS_HB); float* ssq = (float*)(p.ws + WS_SSQ);
    const int lane = tid & 63, gw = blockIdx.x * 8 + (tid >> 6), NGW = gridDim.x * 8;
    for (int row = gw; row < MG; row += NGW) {
#pragma unroll
        for (int j = 0; j < 4; ++j) {
            f32x4 v = *(const f32x4*)(x + (size_t)row * D + 256 * j + 4 * lane);
            u32x2 w; w.x = cvt_pk_bf16(v.x, v.y); w.y = cvt_pk_bf16(v.z, v.w);
            *(u32x2*)(HB + (size_t)row * D + 256 * j + 4 * lane) = w;
            v.x = bflo(w.x); v.y = bfhi(w.x); v.z = bflo(w.y); v.w = bfhi(w.y);
            float s = (v.x * v.x + v.y * v.y) + (v.z * v.z + v.w * v.w);
            s += __shfl_xor(s, 1); s += __shfl_xor(s, 2); s += __shfl_xor(s, 4); s += __shfl_xor(s, 8);
            if ((lane & 15) == 0) ssq[(size_t)row * 16 + (lane >> 4) + 4 * j] = s;
        }
    }
    bf16_t* PL = (bf16_t*)(p.ws + WS_PLE);
    for (int l = 0; l < NLAYER; ++l) {
        const float* src = (g == 0) ? p.p_prompt + (size_t)l * MG * PLE : p.p_sample + ((size_t)l * 2 * MG + (size_t)(g - 1) * MG) * PLE;
        bf16_t* dst = PL + (size_t)l * MG * PLE;
        for (size_t e = (size_t)(blockIdx.x * NTHR + tid) * 8; e < (size_t)MG * PLE; e += (size_t)gridDim.x * NTHR * 8)
            *(bf16x8*)(dst + e) = ld8f_pack(src + e);
    }
}

struct AttnLd { bf16x8 ka0, ka1, kb0, kb1; u32x4 v0, v1, v2, v3; };
__device__ __forceinline__ void attn_geom(int f, int r, int n0, int& dsh, int& cb) {
    const int p = f < 12 ? 0 : (f < 18 ? 1 : 2); const int i2 = f - (p == 0 ? 0 : (p == 1 ? 12 : 18));
    dsh = 2 * p; cb = (r >> dsh) + (16 >> dsh) * n0 - 64 + 32 * i2;
}
__device__ __forceinline__ AttnLd attn_load(const bf16_t* __restrict__ zq, int S, int head, int r, int n0, int lane, int f) {
    int dsh, cb; attn_geom(f, r, n0, dsh, cb);
    const int qi = lane & 15, g = lane >> 4, rd = r & ((1 << dsh) - 1), ncls = S >> dsh;
    const int cA = cb + 8 * (qi >> 2) + (qi & 3), cB = cA + 4;
    const int cAc = min(max(cA, 0), ncls - 1), cBc = min(max(cB, 0), ncls - 1);
    const bf16_t* kA = zq + (size_t)(rd + (cAc << dsh)) * ZW + ZC_AK + head * 64 + 8 * g;
    const bf16_t* kB = zq + (size_t)(rd + (cBc << dsh)) * ZW + ZC_AK + head * 64 + 8 * g;
    AttnLd L;
    L.ka0 = *(const bf16x8*)kA; L.ka1 = *(const bf16x8*)(kA + 32); L.kb0 = *(const bf16x8*)kB; L.kb1 = *(const bf16x8*)(kB + 32);
    const int cv0 = cb + (lane >> 3);
    const bf16_t* vb = zq + ZC_AV + head * 64 + 8 * (lane & 7);
    L.v0 = *(const u32x4*)(vb + (size_t)(rd + (min(max(cv0, 0), ncls - 1) << dsh)) * ZW);
    L.v1 = *(const u32x4*)(vb + (size_t)(rd + (min(max(cv0 + 8, 0), ncls - 1) << dsh)) * ZW);
    L.v2 = *(const u32x4*)(vb + (size_t)(rd + (min(max(cv0 + 16, 0), ncls - 1) << dsh)) * ZW);
    L.v3 = *(const u32x4*)(vb + (size_t)(rd + (min(max(cv0 + 24, 0), ncls - 1) << dsh)) * ZW);
    return L;
}
__device__ __forceinline__ bf16x8 attn_softmax_step(const f32x4& sA, const f32x4& sB, int cb, int cq, int ncls, int g, float& m, float& lsum, f32x4 (&O)[4]) {
    float s[8]; bool ok[8];
    const int c0v = cb + 8 * g, d0 = c0v - cq + 64;
#pragma unroll
    for (int j = 0; j < 8; ++j) {
        ok[j] = ((unsigned)(c0v + j) < (unsigned)ncls) && ((unsigned)(d0 + j) <= 128u);
        s[j] = ok[j] ? (j < 4 ? sA[j] : sB[j - 4]) : -1e30f; }
    float mx = fmaxf(fmaxf(fmaxf(s[0], s[1]), fmaxf(s[2], s[3])), fmaxf(fmaxf(s[4], s[5]), fmaxf(s[6], s[7])));
    mx = fmaxf(mx, __shfl_xor(mx, 16)); mx = fmaxf(mx, __shfl_xor(mx, 32));
    const float mn = fmaxf(m, mx), alpha = __builtin_amdgcn_exp2f(m - mn);
    m = mn;
    float pj[8], ps_ = 0.f;
#pragma unroll
    for (int j = 0; j < 8; ++j) { pj[j] = ok[j] ? __builtin_amdgcn_exp2f(s[j] - mn) : 0.f; ps_ += pj[j]; }
    lsum = lsum * alpha + ps_;
#pragma unroll
    for (int nbk = 0; nbk < 4; ++nbk) O[nbk] *= alpha;
    return pack8(pj);
}
__device__ __forceinline__ void attn_lds_step(const bf16_t* Kt, const bf16_t* Vt, int rowb, const bf16x8& q0, const bf16x8& q1, int cb, int cq, int ncls,
                                              int qi, int g, float& m, float& lsum, f32x4 (&O)[4]) {
    const bf16_t* kA = Kt + (rowb + 8 * (qi >> 2) + (qi & 3)) * 72 + 8 * g;
    const bf16x8 ka0 = *(const bf16x8*)kA, ka1 = *(const bf16x8*)(kA + 32), kb0 = *(const bf16x8*)(kA + 4 * 72), kb1 = *(const bf16x8*)(kA + 4 * 72 + 32);
    f32x4 sA = {0.f, 0.f, 0.f, 0.f}, sB = {0.f, 0.f, 0.f, 0.f};
    sA = MFMA16(ka0, q0, sA); sA = MFMA16(ka1, q1, sA);
    sB = MFMA16(kb0, q0, sB); sB = MFMA16(kb1, q1, sB);
    const bf16x8 P = attn_softmax_step(sA, sB, cb, cq, ncls, g, m, lsum, O);
#pragma unroll
    for (int nbk = 0; nbk < 4; ++nbk) O[nbk] = MFMA16(gather8(Vt + (rowb + 8 * g) * 68 + 16 * nbk, 68, qi), P, O[nbk]);
}
__device__ __forceinline__ void attn_stage(const bf16_t* __restrict__ zq, int head, bf16_t* Kt, bf16_t* Vt, int nrows, int c0, int ncls, int rd, int dsh, int tid) {
    for (int idx = tid; idx < nrows * 16; idx += NTHR) {
        const int i = idx >> 4, ch = idx & 15, isv = ch >> 3, c8 = ch & 7;
        const int c = min(max(c0 + i, 0), ncls - 1);
        const u32x4 v = *(const u32x4*)(zq + (size_t)(rd + (c << dsh)) * ZW + (isv ? ZC_AV : ZC_AK) + head * 64 + 8 * c8);
        if (isv) { bf16_t* d = Vt + i * 68 + 8 * c8; *(u32x2*)d = (u32x2){v.x, v.y}; *(u32x2*)(d + 4) = (u32x2){v.z, v.w}; }
        else *(u32x4*)(Kt + i * 72 + 8 * c8) = v;
    }
}
__device__ __forceinline__ void attn_item(const bf16_t* __restrict__ Z, bf16_t* __restrict__ MIX, int S, int it) {
    const int tid = opaque_tid();
    __syncthreads();
    const int wave = tid >> 6, lane = tid & 63, qi = lane & 15, g = lane >> 4;
    const int nblk = S >> 8;
    const int pb = it % nblk; const int t1 = it / nblk; const int head = t1 & 7, seq = t1 >> 3;
    const int P0 = pb * 256, n0 = pb * 16;
    const bf16_t* zq = Z + (size_t)seq * S * ZW;
    bf16_t* Kt = (bf16_t*)g_lds;
    bf16_t* Vt = (bf16_t*)(g_lds + 57600);
    bf16_t* Vs = (bf16_t*)g_lds + wave * (32 * 68);
    int rt[2]; rt[0] = 4 * (wave >> 1) + (wave & 1); rt[1] = rt[0] + 2;
    bf16x8 q0[2], q1[2]; float m[2] = {-1e30f, -1e30f}, lsum[2] = {0.f, 0.f}; f32x4 O[2][4] = {};
#pragma unroll
    for (int ti = 0; ti < 2; ++ti) { const bf16_t* qp = zq + (size_t)(P0 + rt[ti] + 16 * qi) * ZW + ZC_AQ + head * 64 + 8 * g; q0[ti] = *(const bf16x8*)qp; q1[ti] = *(const bf16x8*)(qp + 32); }
    {
        bf16_t* Vs1 = Vs + 8 * (32 * 68);
        AttnLd cur0 = attn_load(zq, S, head, rt[0], n0, lane, 18), cur1 = attn_load(zq, S, head, rt[1], n0, lane, 18);
#pragma unroll 1
        for (int f = 18; f < 23; ++f) {
            const AttnLd nxt0 = attn_load(zq, S, head, rt[0], n0, lane, f < 22 ? f + 1 : 22), nxt1 = attn_load(zq, S, head, rt[1], n0, lane, f < 22 ? f + 1 : 22);
            const int cb = n0 - 64 + 32 * (f - 18), ncls = S >> 4, cq = n0 + qi;
            f32x4 sA0 = {0.f, 0.f, 0.f, 0.f}, sB0 = {0.f, 0.f, 0.f, 0.f}, sA1 = {0.f, 0.f, 0.f, 0.f}, sB1 = {0.f, 0.f, 0.f, 0.f};
            sA0 = MFMA16(cur0.ka0, q0[0], sA0); sA1 = MFMA16(cur1.ka0, q0[1], sA1); sB0 = MFMA16(cur0.kb0, q0[0], sB0); sB1 = MFMA16(cur1.kb0, q0[1], sB1);
            sA0 = MFMA16(cur0.ka1, q1[0], sA0); sA1 = MFMA16(cur1.ka1, q1[1], sA1); sB0 = MFMA16(cur0.kb1, q1[0], sB0); sB1 = MFMA16(cur1.kb1, q1[1], sB1);
            LDS_FENCE();
            { bf16_t* d = Vs + (lane >> 3) * 68 + 8 * (lane & 7);
              *(u32x2*)d = (u32x2){cur0.v0.x, cur0.v0.y}; *(u32x2*)(d + 4) = (u32x2){cur0.v0.z, cur0.v0.w};
              *(u32x2*)(d + 8 * 68) = (u32x2){cur0.v1.x, cur0.v1.y}; *(u32x2*)(d + 8 * 68 + 4) = (u32x2){cur0.v1.z, cur0.v1.w};
              *(u32x2*)(d + 16 * 68) = (u32x2){cur0.v2.x, cur0.v2.y}; *(u32x2*)(d + 16 * 68 + 4) = (u32x2){cur0.v2.z, cur0.v2.w};
              *(u32x2*)(d + 24 * 68) = (u32x2){cur0.v3.x, cur0.v3.y}; *(u32x2*)(d + 24 * 68 + 4) = (u32x2){cur0.v3.z, cur0.v3.w};
              d = Vs1 + (lane >> 3) * 68 + 8 * (lane & 7);
              *(u32x2*)d = (u32x2){cur1.v0.x, cur1.v0.y}; *(u32x2*)(d + 4) = (u32x2){cur1.v0.z, cur1.v0.w};
              *(u32x2*)(d + 8 * 68) = (u32x2){cur1.v1.x, cur1.v1.y}; *(u32x2*)(d + 8 * 68 + 4) = (u32x2){cur1.v1.z, cur1.v1.w};
              *(u32x2*)(d + 16 * 68) = (u32x2){cur1.v2.x, cur1.v2.y}; *(u32x2*)(d + 16 * 68 + 4) = (u32x2){cur1.v2.z, cur1.v2.w};
              *(u32x2*)(d + 24 * 68) = (u32x2){cur1.v3.x, cur1.v3.y}; *(u32x2*)(d + 24 * 68 + 4) = (u32x2){cur1.v3.z, cur1.v3.w}; }
            const bf16x8 P0_ = attn_softmax_step(sA0, sB0, cb, cq, ncls, g, m[0], lsum[0], O[0]);
            const bf16x8 P1_ = attn_softmax_step(sA1, sB1, cb, cq, ncls, g, m[1], lsum[1], O[1]);
            LDS_FENCE();
#pragma unroll
            for (int nbk = 0; nbk < 4; ++nbk) { O[0][nbk] = MFMA16(gather8(Vs + (8 * g) * 68 + 16 * nbk, 68, qi), P0_, O[0][nbk]); O[1][nbk] = MFMA16(gather8(Vs1 + (8 * g) * 68 + 16 * nbk, 68, qi), P1_, O[1][nbk]); }
            cur0 = nxt0; cur1 = nxt1;
        }
        LDS_FENCE();
    }
    __syncthreads();
    attn_stage(zq, head, Kt, Vt, 400, P0 - 64, S, 0, 0, tid);
    __syncthreads();
#pragma unroll 1
    for (int i2 = 0; i2 < 12; ++i2) {
        attn_lds_step(Kt, Vt, rt[0] + 32 * i2, q0[0], q1[0], P0 + rt[0] - 64 + 32 * i2, P0 + rt[0] + 16 * qi, S, qi, g, m[0], lsum[0], O[0]);
        attn_lds_step(Kt, Vt, rt[1] + 32 * i2, q0[1], q1[1], P0 + rt[1] - 64 + 32 * i2, P0 + rt[1] + 16 * qi, S, qi, g, m[1], lsum[1], O[1]);
    }
#pragma unroll
    for (int rho = 0; rho < 2; ++rho) {
        __syncthreads();
        attn_stage(zq, head, Kt, Vt, 200, (P0 >> 2) - 64, S >> 2, 2 * rho, 2, tid);
        attn_stage(zq, head, Kt + 200 * 72, Vt + 200 * 68, 200, (P0 >> 2) - 64, S >> 2, 2 * rho + 1, 2, tid);
        __syncthreads();
        const int r = rt[rho], cls = (r & 3) - 2 * rho, c0 = (P0 >> 2) + (r >> 2);
#pragma unroll 2
        for (int i2 = 0; i2 < 6; ++i2)
            attn_lds_step(Kt + cls * 200 * 72, Vt + cls * 200 * 68, (r >> 2) + 32 * i2, q0[rho], q1[rho], c0 - 64 + 32 * i2, c0 + 4 * qi, S >> 2, qi, g, m[rho], lsum[rho], O[rho]);
    }
#pragma unroll
    for (int ti = 0; ti < 2; ++ti) {
        float l = lsum[ti]; l += __shfl_xor(l, 16); l += __shfl_xor(l, 32);
        const float inv = 1.0f / l;
        bf16_t* op = MIX + ((size_t)seq * S + P0 + rt[ti] + 16 * qi) * D + head * 64 + 4 * g;
#pragma unroll
        for (int nbk = 0; nbk < 4; ++nbk) st4_bf16(op + 16 * nbk, O[ti][nbk].x * inv, O[ti][nbk].y * inv, O[ti][nbk].z * inv, O[ti][nbk].w * inv);
    }
    __syncthreads();
}

__device__ __forceinline__ float h2f(unsigned short b) { return (float)__builtin_bit_cast(_Float16, b); }

__device__ __forceinline__ void stage_v4(const bf16_t* __restrict__ Z, size_t tok0, int zc, bf16_t* Vt, int nrows) {
    const int tid = opaque_tid();
    for (int idx = tid; idx < nrows * 32; idx += NTHR) {
        const int t = idx >> 5, ch = idx & 31, hh = ch >> 3, c8 = ch & 7;
        const u32x4 v = *(const u32x4*)(Z + (tok0 + t) * ZW + zc + ch * 8);
        bf16_t* d = Vt + ((size_t)hh * nrows + t) * 68 + c8 * 8;
        *(u32x2*)d = (u32x2){v.x, v.y}; *(u32x2*)(d + 4) = (u32x2){v.z, v.w};
    }
}

__device__ __forceinline__ void gla_cum(const bf16_t* __restrict__ Z, size_t tok0, int h, int dir, int lane, float (&cum)[32], float& tot) {
    const int kk = lane & 31, hf = lane >> 5;
    const bf16_t* src = Z + (tok0 + 32 * hf) * ZW + ZC_GF + dir * 128 + h * 32 + kk;
    float part = 0.f;
#pragma unroll
    for (int i = 0; i < 32; ++i) { cum[i] = h2f(src[(size_t)i * ZW]); part += cum[i]; }
    const float other = __shfl_xor(part, 32);
    tot = part + other;
    if (dir == 0) { float run = hf ? other : 0.f;
#pragma unroll
        for (int i = 0; i < 32; ++i) { run += cum[i]; cum[i] = run; } }
    else { float run = hf ? 0.f : other;
#pragma unroll
        for (int i = 31; i >= 0; --i) { run += cum[i]; cum[i] = run; } }
}

__device__ __forceinline__ void gla1_item(const bf16_t* __restrict__ Z, bf16_t* __restrict__ GS, float* __restrict__ GD, int ci) {
    const int tid = opaque_tid();
    __syncthreads();
    const int wave = tid >> 6, lane = tid & 63, qi = lane & 15, g = lane >> 4;
    const int h = wave >> 1, dir = wave & 1;
    const size_t tok0 = (size_t)ci * 64;
    bf16_t* Vt = (bf16_t*)g_lds;
    bf16_t* Ks = (bf16_t*)g_lds + 4 * 64 * 68 + wave * (64 * 36);
    stage_v4(Z, tok0, ZC_BV, Vt, 64);
    float cum[32], tot;
    gla_cum(Z, tok0, h, dir, lane, cum, tot);
    { const int kk = lane & 31, hf = lane >> 5;
      const bf16_t* ksrc = Z + (tok0 + 32 * hf) * ZW + ZC_BK + h * 32 + kk;
#pragma unroll
      for (int i = 0; i < 32; ++i) { const float kv = bf2f(ksrc[(size_t)i * ZW]) * __expf(tot - cum[i]);
          Ks[(32 * hf + i) * 36 + kk] = (bf16_t)(cvt_pk_bf16(kv, 0.f) & 0xffffu); }
      if (hf == 0) GD[(((size_t)dir * NCH + ci) * 4 + h) * 32 + kk] = __expf(tot); }
    __syncthreads();
    f32x4 acc[4][2] = {};
#pragma unroll
    for (int ks = 0; ks < 2; ++ks) {
        bf16x8 bfr[2];
#pragma unroll
        for (int kb = 0; kb < 2; ++kb) bfr[kb] = gather8(Ks + (32 * ks + 8 * g) * 36 + 16 * kb , 36, qi);
#pragma unroll
        for (int eb = 0; eb < 4; ++eb) { const bf16x8 af = gather8(Vt + ((size_t)h * 64 + 32 * ks + 8 * g) * 68 + 16 * eb , 68, qi);
#pragma unroll
            for (int kb = 0; kb < 2; ++kb) acc[eb][kb] = MFMA16(bfr[kb], af, acc[eb][kb]); }
    }
    bf16_t* dst = GS + (((size_t)dir * NCH + ci) * 4 + h) * 2048;
#pragma unroll
    for (int eb = 0; eb < 4; ++eb)
#pragma unroll
        for (int kb = 0; kb < 2; ++kb) st4_bf16(dst + (16 * eb + qi) * 32 + 16 * kb + 4 * g, acc[eb][kb].x, acc[eb][kb].y, acc[eb][kb].z, acc[eb][kb].w);
    __syncthreads();
}

__device__ __forceinline__ void gla3_item(const bf16_t* __restrict__ Z, const bf16_t* __restrict__ GS, bf16_t* __restrict__ MIX, const float* __restrict__ gnorm, int ci) {
    const int tid = opaque_tid();
    __syncthreads();
    const int wave = tid >> 6, lane = tid & 63, qi = lane & 15, g = lane >> 4;
    const size_t tok0 = (size_t)ci * 64;
    bf16_t* Vt = (bf16_t*)g_lds;
    float* CUM = (float*)(g_lds + 4 * 64 * 68 * 2);
    stage_v4(Z, tok0, ZC_BV, Vt, 64);
    { const int h = wave >> 1, dir = wave & 1; float cum[32], tot;
      gla_cum(Z, tok0, h, dir, lane, cum, tot);
      const int kk = lane & 31, hf = lane >> 5; float* cd = CUM + ((size_t)(h * 2 + dir) * 64 + 32 * hf) * 32 + kk;
#pragma unroll
      for (int i = 0; i < 32; ++i) cd[i * 32] = cum[i]; }
    __syncthreads();
    const int h = wave >> 1;
    const float* cF = CUM + (size_t)(h * 2 + 0) * 64 * 32; const float* cB = CUM + (size_t)(h * 2 + 1) * 64 * 32;
    const bf16_t* sF = GS + (((size_t)0 * NCH + ci) * 4 + h) * 2048; const bf16_t* sB = GS + (((size_t)1 * NCH + ci) * 4 + h) * 2048;
    bf16x8 SFf[4], SBf[4];
#pragma unroll
    for (int eb = 0; eb < 4; ++eb) { SFf[eb] = *(const bf16x8*)(sF + (16 * eb + qi) * 32 + 8 * g); SBf[eb] = *(const bf16x8*)(sB + (16 * eb + qi) * 32 + 8 * g); }
    bf16x8 KFf[2][2], KBf[2][2];
#pragma unroll
    for (int sg = 0; sg < 2; ++sg)
#pragma unroll
        for (int blk = 0; blk < 2; ++blk) {
            const int s = 32 * sg + 8 * (qi >> 2) + (qi & 3) + 4 * blk;
            float kv[8], a[8], b[8]; unpack8(*(const bf16x8*)(Z + (tok0 + s) * ZW + ZC_BK + h * 32 + 8 * g), kv);
#pragma unroll
            for (int j = 0; j < 8; ++j) { a[j] = kv[j] * __expf(-cF[s * 32 + 8 * g + j]); b[j] = kv[j] * __expf(-cB[s * 32 + 8 * g + j]); }
            KFf[sg][blk] = pack8(a); KBf[sg][blk] = pack8(b);
        }
#pragma unroll 1
    for (int tbi = 0; tbi < 2; ++tbi) {
        const int t = 16 * (2 * (wave & 1) + tbi) + qi;
        bf16x8 Qf, Qb;
        { float qv[8], a[8], b[8]; unpack8(*(const bf16x8*)(Z + (tok0 + t) * ZW + ZC_BQ + h * 32 + 8 * g), qv);
#pragma unroll
          for (int j = 0; j < 8; ++j) { a[j] = qv[j] * __expf(cF[t * 32 + 8 * g + j]); b[j] = qv[j] * __expf(cB[t * 32 + 8 * g + j]); }
          Qf = pack8(a); Qb = pack8(b); }
        f32x4 acc[4] = {};
#pragma unroll
        for (int eb = 0; eb < 4; ++eb) { acc[eb] = MFMA16(SFf[eb], Qf, acc[eb]); acc[eb] = MFMA16(SBf[eb], Qb, acc[eb]); }
#pragma unroll
        for (int sg = 0; sg < 2; ++sg) {
            f32x4 aF[2], aB[2];
#pragma unroll
            for (int blk = 0; blk < 2; ++blk) {
                const f32x4 z4 = {0.f, 0.f, 0.f, 0.f};
                aF[blk] = MFMA16(KFf[sg][blk], Qf, z4); aB[blk] = MFMA16(KBf[sg][blk], Qb, z4);
            }
            float pj[8];
#pragma unroll
            for (int j = 0; j < 8; ++j) { const int s = 32 * sg + 8 * g + j; pj[j] = (s <= t) ? (j < 4 ? aF[0][j] : aF[1][j - 4]) : (j < 4 ? aB[0][j] : aB[1][j - 4]); }
            const bf16x8 P = pack8(pj);
#pragma unroll
            for (int eb = 0; eb < 4; ++eb) acc[eb] = MFMA16(gather8(Vt + ((size_t)h * 64 + 32 * sg + 8 * g) * 68 + 16 * eb , 68, qi), P, acc[eb]);
        }
        float ss = 0.f;
#pragma unroll
        for (int eb = 0; eb < 4; ++eb) ss += (acc[eb].x * acc[eb].x + acc[eb].y * acc[eb].y) + (acc[eb].z * acc[eb].z + acc[eb].w * acc[eb].w);
        ss += __shfl_xor(ss, 16); ss += __shfl_xor(ss, 32);
        const float rn = rsqrtf(ss * (1.0f / 64) + EPS);
#pragma unroll
        for (int eb = 0; eb < 4; ++eb) { const int e = 16 * eb + 4 * g;
            const u32x2 brw = *(const u32x2*)(Z + (tok0 + t) * ZW + ZC_BR + h * 64 + e);
            const f32x4 gn = *(const f32x4*)(gnorm + h * 64 + e);
            const float b0 = bflo(brw.x), b1 = bfhi(brw.x), b2 = bflo(brw.y), b3 = bfhi(brw.y);
            const float o0 = acc[eb].x * rn * gn.x * (b0 / (1.f + __expf(-b0))), o1 = acc[eb].y * rn * gn.y * (b1 / (1.f + __expf(-b1)));
            const float o2 = acc[eb].z * rn * gn.z * (b2 / (1.f + __expf(-b2))), o3 = acc[eb].w * rn * gn.w * (b3 / (1.f + __expf(-b3)));
            u32x2 w; w.x = cvt_pk_bf16(o0, o1); w.y = cvt_pk_bf16(o2, o3);
            *(u32x2*)(MIX + (tok0 + t) * D + 512 + h * 64 + e) = w; }
    }
    __syncthreads();
}

__device__ __forceinline__ void ret1_item(const bf16_t* __restrict__ Z, bf16_t* __restrict__ RS, const float* __restrict__ lgam, int item) {
    const int tid = opaque_tid();
    __syncthreads();
    const int wave = tid >> 6, lane = tid & 63, qi = lane & 15, g = lane >> 4;
    const int ci = item >> 1, hp = item & 1;
    const size_t tok0 = (size_t)ci * 128;
    bf16_t* Vt = (bf16_t*)g_lds;
    bf16_t* Kt = Vt + 2 * 128 * 68;
    for (int idx = tid; idx < 128 * 16 * 2; idx += NTHR) {
        const int which = idx >> 11, r = idx & 2047, t = r >> 4, ch = r & 15, hh = ch >> 3, c8 = ch & 7;
        const u32x4 v = *(const u32x4*)(Z + (tok0 + t) * ZW + (which ? ZC_CK : ZC_CV) + hp * 128 + ch * 8);
        bf16_t* d = (which ? Kt : Vt) + ((size_t)hh * 128 + t) * 68 + c8 * 8;
        *(u32x2*)d = (u32x2){v.x, v.y}; *(u32x2*)(d + 4) = (u32x2){v.z, v.w};
    }
    __syncthreads();
    const int hh = wave >> 2, dir = (wave >> 1) & 1, eh = wave & 1, head = 2 * hp + hh;
    const float lg = lgam[dir * 4 + head];
    f32x4 acc[2][4] = {};
#pragma unroll 1
    for (int ks = 0; ks < 4; ++ks) {
        float w[8];
#pragma unroll
        for (int j = 0; j < 8; ++j) { const int s = 32 * ks + 8 * g + j; w[j] = __expf(lg * (float)(dir ? s : 127 - s)); }
        bf16x8 bfr[4];
#pragma unroll
        for (int db = 0; db < 4; ++db) { float kv[8]; unpack8(gather8(Kt + ((size_t)hh * 128 + 32 * ks + 8 * g) * 68 + 16 * db , 68, qi), kv);
#pragma unroll
            for (int j = 0; j < 8; ++j) kv[j] *= w[j];
            bfr[db] = pack8(kv); }
#pragma unroll
        for (int ebi = 0; ebi < 2; ++ebi) { const bf16x8 af = gather8(Vt + ((size_t)hh * 128 + 32 * ks + 8 * g) * 68 + 16 * (2 * eh + ebi) , 68, qi);
#pragma unroll
            for (int db = 0; db < 4; ++db) acc[ebi][db] = MFMA16(bfr[db], af, acc[ebi][db]); }
    }
    bf16_t* dst = RS + (((size_t)dir * NCR + ci) * 4 + head) * 4096;
#pragma unroll
    for (int ebi = 0; ebi < 2; ++ebi)
#pragma unroll
        for (int db = 0; db < 4; ++db) st4_bf16(dst + (16 * (2 * eh + ebi) + qi) * 64 + 16 * db + 4 * g, acc[ebi][db].x, acc[ebi][db].y, acc[ebi][db].z, acc[ebi][db].w);
    __syncthreads();
}

__device__ __forceinline__ void ret3_item(const bf16_t* __restrict__ Z, const bf16_t* __restrict__ RS, bf16_t* __restrict__ MIX, const float* __restrict__ rnorm, const float* __restrict__ lgam, int ci) {
    const int tid = opaque_tid();
    __syncthreads();
    const int wave = tid >> 6, lane = tid & 63, qi = lane & 15, g = lane >> 4;
    const size_t tok0 = (size_t)ci * 128;
    bf16_t* Vt = (bf16_t*)g_lds;
    stage_v4(Z, tok0, ZC_CV, Vt, 128);
    __syncthreads();
    const int h = wave >> 1;
    const float lg0 = lgam[h], lg1 = lgam[4 + h];
    const bf16_t* rF = RS + (((size_t)0 * NCR + ci) * 4 + h) * 4096; const bf16_t* rB = RS + (((size_t)1 * NCR + ci) * 4 + h) * 4096;
    bf16x8 RF[4][2], RB[4][2];
#pragma unroll
    for (int eb = 0; eb < 4; ++eb) { const bf16_t* pf = rF + (16 * eb + qi) * 64 + 8 * g; const bf16_t* pb = rB + (16 * eb + qi) * 64 + 8 * g;
        RF[eb][0] = *(const bf16x8*)pf; RF[eb][1] = *(const bf16x8*)(pf + 32); RB[eb][0] = *(const bf16x8*)pb; RB[eb][1] = *(const bf16x8*)(pb + 32); }
#pragma unroll 1
    for (int tbi = 0; tbi < 4; ++tbi) {
        const int t = 16 * (4 * (wave & 1) + tbi) + qi;
        const bf16_t* qp = Z + (tok0 + t) * ZW + ZC_CQ + h * 64 + 8 * g;
        const bf16x8 q0 = *(const bf16x8*)qp, q1 = *(const bf16x8*)(qp + 32);
        f32x4 aI[4] = {}, aF[4] = {}, aB[4] = {};
#pragma unroll
        for (int eb = 0; eb < 4; ++eb) {
            aF[eb] = MFMA16(RF[eb][0], q0, aF[eb]); aF[eb] = MFMA16(RF[eb][1], q1, aF[eb]);
            aB[eb] = MFMA16(RB[eb][0], q0, aB[eb]); aB[eb] = MFMA16(RB[eb][1], q1, aB[eb]);
        }
#pragma unroll 1
        for (int sg = 0; sg < 4; ++sg) {
            f32x4 sc[2];
#pragma unroll
            for (int blk = 0; blk < 2; ++blk) {
                const int s = 32 * sg + 8 * (qi >> 2) + (qi & 3) + 4 * blk;
                const bf16_t* kp = Z + (tok0 + s) * ZW + ZC_CK + h * 64 + 8 * g;
                f32x4 z4 = {0.f, 0.f, 0.f, 0.f};
                z4 = MFMA16(*(const bf16x8*)kp, q0, z4); z4 = MFMA16(*(const bf16x8*)(kp + 32), q1, z4); sc[blk] = z4;
            }
            float pj[8];
#pragma unroll
            for (int j = 0; j < 8; ++j) { const int s = 32 * sg + 8 * g + j; const int dd = t - s;
                const float dec = (dd >= 0) ? __expf(lg0 * (float)dd) : __expf(lg1 * (float)(-dd));
                pj[j] = (j < 4 ? sc[0][j] : sc[1][j - 4]) * dec; }
            const bf16x8 P = pack8(pj);
#pragma unroll
            for (int eb = 0; eb < 4; ++eb) aI[eb] = MFMA16(gather8(Vt + ((size_t)h * 128 + 32 * sg + 8 * g) * 68 + 16 * eb , 68, qi), P, aI[eb]);
        }
        const float wf = __expf(lg0 * (float)(t + 1)), wb = __expf(lg1 * (float)(128 - t));
        float ss = 0.f;
#pragma unroll
        for (int eb = 0; eb < 4; ++eb) { aI[eb] = aI[eb] + aF[eb] * wf + aB[eb] * wb;
            ss += (aI[eb].x * aI[eb].x + aI[eb].y * aI[eb].y) + (aI[eb].z * aI[eb].z + aI[eb].w * aI[eb].w); }
        ss += __shfl_xor(ss, 16); ss += __shfl_xor(ss, 32);
        const float rn = rsqrtf(ss * (1.0f / 64) + EPS);
#pragma unroll
        for (int eb = 0; eb < 4; ++eb) { const int e = 16 * eb + 4 * g;
            const u32x2 gw = *(const u32x2*)(Z + (tok0 + t) * ZW + ZC_CG + h * 64 + e);
            const f32x4 gn = *(const f32x4*)(rnorm + h * 64 + e);
            const float b0 = bflo(gw.x), b1 = bfhi(gw.x), b2 = bflo(gw.y), b3 = bfhi(gw.y);
            const float o0 = aI[eb].x * rn * gn.x * (b0 / (1.f + __expf(-b0))), o1 = aI[eb].y * rn * gn.y * (b1 / (1.f + __expf(-b1)));
            const float o2 = aI[eb].z * rn * gn.z * (b2 / (1.f + __expf(-b2))), o3 = aI[eb].w * rn * gn.w * (b3 / (1.f + __expf(-b3)));
            u32x2 w; w.x = cvt_pk_bf16(o0, o1); w.y = cvt_pk_bf16(o2, o3);
            *(u32x2*)(MIX + (tok0 + t) * D + 768 + h * 64 + e) = w; }
    }
    __syncthreads();
}

__device__ __forceinline__ void phase_scan(bf16_t* __restrict__ GS, const float* __restrict__ GD, bf16_t* __restrict__ RS, const float* __restrict__ lgam, int S) {
    const int tid = opaque_tid();
    const int lgn = (S == 16384) ? 1 : 4, nseq = 1 << lgn, ncg = S / 64, ncr = S / 128;
    const int gtid = blockIdx.x * NTHR + tid, gth = gridDim.x * NTHR;
    const int n_gla = 2 * nseq * 4 * 1024, n_ret = 2 * nseq * 4 * 2048;
    for (int idx = gtid; idx < n_gla + n_ret; idx += gth) {
        if (idx < n_gla) {
            const int el = 2 * (idx & 1023), hh = (idx >> 10) & 3, sq = (idx >> 12) & (nseq - 1), dir = (idx >> 12) >> lgn, kk = el & 31;
            float s0 = 0.f, s1 = 0.f;
#pragma unroll 16
            for (int i = 0; i < ncg; ++i) { const int c = dir ? ncg - 1 - i : i; const size_t cgi = (size_t)sq * ncg + c;
                unsigned* a = (unsigned*)(GS + (((size_t)dir * NCH + cgi) * 4 + hh) * 2048 + el);
                const f32x2_t dec = *(const f32x2_t*)(GD + (((size_t)dir * NCH + cgi) * 4 + hh) * 32 + kk);
                const unsigned tmp = *a; *a = cvt_pk_bf16(s0, s1); s0 = dec.x * s0 + bflo(tmp); s1 = dec.y * s1 + bfhi(tmp); }
        } else {
            const int j = idx - n_gla; const int el = 2 * (j & 2047), hh = (j >> 11) & 3, sq = (j >> 13) & (nseq - 1), dir = (j >> 13) >> lgn;
            const float dec = __expf(128.f * lgam[dir * 4 + hh]);
            float s0 = 0.f, s1 = 0.f;
#pragma unroll 16
            for (int i = 0; i < ncr; ++i) { const int c = dir ? ncr - 1 - i : i; const size_t cgi = (size_t)sq * ncr + c;
                unsigned* a = (unsigned*)(RS + (((size_t)dir * NCR + cgi) * 4 + hh) * 4096 + el);
                const unsigned tmp = *a; *a = cvt_pk_bf16(s0, s1); s0 = dec * s0 + bflo(tmp); s1 = dec * s1 + bfhi(tmp); }
        }
    }
}

#define XB_TMO      128
#define XB_XCNT(j)  (256  + 64 * (j))
#define XB_XSUB(j)  (1280 + 64 * (j))
#define XB_XGEN(j)  (2304 + 64 * (j))
#define XB_TOP      3328
#define XB_TOPGEN   3392
#define XCD_BAR_WORDS 3456
#define XB_SPIN_CAP (1u << 22)
#define LAS __attribute__((address_space(3)))
__device__ __forceinline__ unsigned xb_ld(unsigned* p)              { return __hip_atomic_load(p, __ATOMIC_RELAXED, __HIP_MEMORY_SCOPE_AGENT); }
__device__ __forceinline__ unsigned xb_add(unsigned* p, unsigned v) { return __hip_atomic_fetch_add(p, v, __ATOMIC_RELAXED, __HIP_MEMORY_SCOPE_AGENT); }
__device__ __forceinline__ unsigned xb_xcc_id() { return (unsigned)__builtin_amdgcn_s_getreg((3 << 11) | 20) & 0xFu; }
#define XB_SPIN(cond, bar) do { unsigned _sp = 0; while (cond) { __builtin_amdgcn_s_sleep(1); \
    if ((++_sp & 255u) == 0u) { if (xb_ld(&(bar)[XB_TMO])) break; if (_sp > XB_SPIN_CAP) { atomicAdd(&(bar)[XB_TMO], 1u); break; } } } } while (0)
struct XcdBarrier { unsigned* bar; unsigned x; volatile LAS unsigned* st; };
__device__ __forceinline__ XcdBarrier xcd_barrier_post(unsigned* bar, volatile LAS unsigned* st) {
    XcdBarrier b; b.bar = bar; b.x = xb_xcc_id(); b.st = st;
    if (threadIdx.x == 0) (void)xb_add(&bar[XB_XCNT(b.x)], 1u);
    return b;
}
__device__ __forceinline__ void xcd_barrier_complete(unsigned* bar, unsigned x, unsigned& nloc, unsigned& nx) {
    const unsigned G = gridDim.x * gridDim.y * gridDim.z;
    unsigned sum, cnt, mine, sp = 0u;
    for (;;) {
        sum = 0u; cnt = 0u; mine = 0u;
#pragma unroll
        for (unsigned j = 0; j < 16; ++j) { const unsigned c = xb_ld(&bar[XB_XCNT(j)]); sum += c; cnt += (c > 0u) ? 1u : 0u; mine = (j == x) ? c : mine; }
        if (sum == G) break;
        __builtin_amdgcn_s_sleep(1);
        if ((++sp & 255u) == 0u) { if (xb_ld(&bar[XB_TMO])) break; if (sp > XB_SPIN_CAP) { atomicAdd(&bar[XB_TMO], 1u); break; } }
    }
    nloc = mine > 0u ? mine : 1u; nx = cnt > 0u ? cnt : 1u;
}
__device__ __forceinline__ void xcd_barrier(const XcdBarrier& b) {
    asm volatile("s_waitcnt vmcnt(0)" ::: "memory");
    __syncthreads();
    if (threadIdx.x == 0) {
        unsigned* bar = b.bar;
        __builtin_amdgcn_s_waitcnt(0);
        unsigned nloc = b.st[0], nx = b.st[1];
        if (nloc == 0u) { xcd_barrier_complete(bar, b.x, nloc, nx); b.st[0] = nloc; b.st[1] = nx; }
        const unsigned old = xb_add(&bar[XB_XSUB(b.x)], 1u);
        const unsigned gen = old / nloc;
        if (old + 1u == (gen + 1u) * nloc) {
            __builtin_amdgcn_fence(__ATOMIC_RELEASE, "agent");
            asm volatile("s_waitcnt vmcnt(0)" ::: "memory");
            const unsigned og = xb_add(&bar[XB_TOP], 1u);
            const unsigned tg = og / nx;
            if (og + 1u == (tg + 1u) * nx) xb_add(&bar[XB_TOPGEN], 1u);
            else XB_SPIN(xb_ld(&bar[XB_TOPGEN]) == tg, bar);
            __builtin_amdgcn_fence(__ATOMIC_ACQUIRE, "agent");
            xb_add(&bar[XB_XGEN(b.x)], 1u);
            asm volatile("s_waitcnt vmcnt(0)" ::: "memory");
        } else {
            XB_SPIN(xb_ld(&bar[XB_XGEN(b.x)]) == gen, bar);
            __builtin_amdgcn_fence(__ATOMIC_ACQUIRE, "agent");
            asm volatile("s_waitcnt vmcnt(0)" ::: "memory");
        }
    }
    __syncthreads();
}

__global__ void __launch_bounds__(NTHR, 2) fwd_mega(Params p) {
    cg::grid_group grid = cg::this_grid();
    unsigned char* ws = p.ws;
    bf16_t* WT = (bf16_t*)(ws + WS_WT); const float* tab = (const float*)(ws + WS_TAB);
    bf16_t* HB0 = (bf16_t*)(ws + WS_HB); bf16_t* HB1 = (bf16_t*)(ws + WS_HB1);
    float* SSQ0 = (float*)(ws + WS_SSQ); float* SSQ1 = SSQ0 + (size_t)MG * 16; float* SSQ2 = SSQ1 + (size_t)MG * 16;
    bf16_t* Z = (bf16_t*)(ws + WS_Z); bf16_t* MIX = (bf16_t*)(ws + WS_MIX); bf16_t* HID = (bf16_t*)(ws + WS_HID);
    bf16_t* PB = (bf16_t*)(ws + WS_PB); bf16_t* PL = (bf16_t*)(ws + WS_PLE);
    bf16_t* GS = (bf16_t*)(ws + WS_GS); float* GD = (float*)(ws + WS_GD); bf16_t* RS = (bf16_t*)(ws + WS_RS);
    float* lgam = (float*)(g_lds + LDS_BYTES - 64);

#ifndef NO_P0
    phase_weights(p);
#endif
    unsigned* barw = (unsigned*)(ws + WS_BAR);
    volatile LAS unsigned* bst = (volatile LAS unsigned*)(g_lds + LDS_BYTES - 32);
    if (blockIdx.x == 0) for (int i = threadIdx.x; i < XCD_BAR_WORDS; i += NTHR) barw[i] = 0u;
    if (threadIdx.x < 2) bst[threadIdx.x] = 0u;
    grid.sync();
    const XcdBarrier xb = xcd_barrier_post(barw, bst);
#pragma unroll 1
    for (int g = 0; g < NGROUPS; ++g) {
        const int S = (g == 0) ? 16384 : 2048;
        float* H = p.out + (size_t)g * MG * D;
#ifndef NO_PI
        phase_init(p, g);
#endif
        xcd_barrier(xb);
#pragma unroll 1
        for (int l = 0; l < NLAYER; ++l) {
            const bf16_t* W = WT + (size_t)l * W_LAYER;
            { const int t8 = opaque_tid(); if (t8 < 8) { const float x = p.ret_decay_raw[l * 8 + t8]; lgam[t8] = fminf(x, 0.f) - __logf(1.0f + __expf(-fabsf(x))); } }
            __syncthreads();
            { EpiIn e{Z, SSQ0, p.attn_q_norm + l * 64, p.attn_k_norm + l * 64, p.gla_gate_bias + l * 256, tab, S - 1};
#ifndef NO_P1
#ifndef REP_P1
#define REP_P1 1
#endif
              gemm_phase(HB0, D, W + WO_IN, D, MG, ZW, D, e);
#if REP_P1 > 1
              xcd_barrier(xb); gemm_phase(HB0, D, W + WO_IN, D, MG, ZW, D, e);
#endif
#endif
 }
            xcd_barrier(xb);
#ifndef REP_MIX
#define REP_MIX 1
#endif
            for (int rep_mix = 0; rep_mix < REP_MIX; ++rep_mix) {
            { const int nA = 1024, nG = NCH, nR = 2 * NCR;
#ifndef NO_AT
              if ((gridDim.x & 7) == 0) {
                  const int per = nA / 8, slots = gridDim.x / 8;
                  for (int k = blockIdx.x / 8; k < per; k += slots) attn_item(Z, MIX, S, per * (blockIdx.x & 7) + k);
              } else { for (int it = blockIdx.x; it < nA; it += gridDim.x) attn_item(Z, MIX, S, it); }
#endif
              for (int it = nA + blockIdx.x; it < nA + nG + nR; it += gridDim.x) {
#ifndef NO_G1
                  if (it >= nA && it < nA + nG) gla1_item(Z, GS, GD, it - nA);
#endif
#ifndef NO_R1
                  if (it >= nA + nG) ret1_item(Z, RS, lgam, it - nA - nG);
#endif
              } }
            xcd_barrier(xb);
#ifndef NO_P3
            phase_scan(GS, GD, RS, lgam, S);
#endif
            xcd_barrier(xb);
            { for (int it = blockIdx.x; it < NCH + NCR; it += gridDim.x) {
#ifndef NO_G3
                  if (it < NCH) gla3_item(Z, GS, MIX, p.gla_out_norm + l * 256, it);
#endif
#ifndef NO_R3
                  if (it >= NCH) ret3_item(Z, RS, MIX, p.ret_out_norm + l * 256, lgam, it - NCH);
#endif
              } }
            xcd_barrier(xb);
            }
#ifndef NO_P5
            { EpiRes e{HB0, HB1, SSQ1}; gemm_phase(MIX, D, W + WO_OUT, D, MG, D, D, e); }
#endif
            xcd_barrier(xb);
#ifndef NO_P6
            { EpiMlpIn e{HID, SSQ1}; gemm_phase_t<true>(HB1, D, W + WO_MI, D, MG, DFF, D, e); }
#endif
#ifndef NO_P6B
            { EpiPlain e{PB, D}; gemm_phase(PL + (size_t)l * MG * PLE, PLE, W + WO_PP, PLE, MG, D, PLE, e); }
#endif
            xcd_barrier(xb);
#ifndef NO_P7
            { EpiRes e{HB1, HB1, SSQ2}; gemm_phase(HID, DFF, W + WO_MO, DFF, MG, D, DFF, e); }
#endif
            xcd_barrier(xb);
#ifndef NO_P9
            { EpiPeGate e{H, HB1, HB0, SSQ0, SSQ2, PB, l == NLAYER - 1}; gemm_phase(HB1, D, W + WO_PG, D, MG, D, D, e); }
#endif
            xcd_barrier(xb);
        }
    }
}

extern "C" void kernel_launch(void* const* d_in, const int* in_sizes, int n_in, void* d_out, int out_size, void* d_ws, size_t ws_size, hipStream_t stream) {
    static int grid_blocks = 0;
    if (!grid_blocks) {
        int dev = 0, cus = 0, per_cu = 0;
        hipGetDevice(&dev);
        hipDeviceGetAttribute(&cus, hipDeviceAttributeMultiprocessorCount, dev);
        hipFuncSetAttribute((const void*)fwd_mega, hipFuncAttributeMaxDynamicSharedMemorySize, LDS_BYTES);
        hipOccupancyMaxActiveBlocksPerMultiprocessor(&per_cu, (const void*)fwd_mega, NTHR, LDS_BYTES);
        if (per_cu < 1) per_cu = 1;
        grid_blocks = cus * 1;
        if (ws_size < WS_END) fprintf(stderr, "kernel_launch: workspace too small: %zu < %zu\n", ws_size, (size_t)WS_END);
    }
    Params p{};
    p.x_prompt = (const float*)d_in[0]; p.x_sample = (const float*)d_in[1]; p.p_prompt = (const float*)d_in[2]; p.p_sample = (const float*)d_in[3];
    p.ln_mix = (const float*)d_in[4]; p.w_in = (const float*)d_in[5]; p.attn_q_norm = (const float*)d_in[6]; p.attn_k_norm = (const float*)d_in[7];
    p.gla_gate_up = (const float*)d_in[8]; p.gla_gate_bias = (const float*)d_in[9]; p.gla_out_norm = (const float*)d_in[10]; p.ret_decay_raw = (const float*)d_in[11];
    p.ret_out_norm = (const float*)d_in[12]; p.w_out = (const float*)d_in[13]; p.ln_mlp = (const float*)d_in[14]; p.w_mlp_in = (const float*)d_in[15]; p.w_mlp_out = (const float*)d_in[16];
    p.ln_pe = (const float*)d_in[17]; p.w_pe_gate = (const float*)d_in[18]; p.w_pe_proj = (const float*)d_in[19];
    p.out = (float*)d_out; p.ws = (unsigned char*)d_ws;
    void* args[] = {&p};
    hipError_t e = hipLaunchCooperativeKernel((const void*)fwd_mega, dim3(grid_blocks), dim3(NTHR), args, LDS_BYTES, stream);
    if (e != hipSuccess) fprintf(stderr, "cooperative launch failed: %s (grid %d)\n", hipGetErrorString(e), grid_blocks);
}
```

```cpp
#include <hip/hip_runtime.h>
#include <hip/hip_cooperative_groups.h>
#include <cstdio>
#include <cstdint>
namespace cg = cooperative_groups;

typedef unsigned short bf16_t;
typedef short bf16x8 __attribute__((ext_vector_type(8)));
typedef float f32x4 __attribute__((ext_vector_type(4)));
typedef unsigned u32x4 __attribute__((ext_vector_type(4)));
typedef unsigned u32x2 __attribute__((ext_vector_type(2)));

constexpr int D = 1024, MG = 32768, NGROUPS = 3, NLAYER = 2;
constexpr int ZW = 3584, DFF = 4096, PLE = 256, NIN = 3360;
constexpr int NTHR = 512;
constexpr int NCH = MG / 64;
constexpr int NCR = MG / 128;
constexpr float EPS = 1e-6f;
constexpr int ZC_AQ = 0, ZC_AK = 512, ZC_AV = 1024, ZC_BQ = 1536, ZC_BK = 1664, ZC_BV = 1792, ZC_BR = 2048,
              ZC_GF = 2304, ZC_GB = 2432, ZC_CQ = 2560, ZC_CK = 2816, ZC_CV = 3072, ZC_CG = 3328;
constexpr size_t WO_IN = 0, WO_OUT = WO_IN + (size_t)ZW * D, WO_MI = WO_OUT + (size_t)D * D, WO_MO = WO_MI + (size_t)DFF * D,
                 WO_PG = WO_MO + (size_t)D * DFF, WO_PP = WO_PG + (size_t)D * D, W_LAYER = WO_PP + (size_t)D * PLE;
constexpr size_t WS_WT = 0;
constexpr size_t WS_TAB = WS_WT + W_LAYER * 2 * NLAYER;
constexpr size_t WS_HB = WS_TAB + (size_t)16384 * 40 * 2 * 4;
constexpr size_t WS_HB1 = WS_HB + (size_t)MG * D * 2;
constexpr size_t WS_SSQ = WS_HB1 + (size_t)MG * D * 2;
constexpr size_t WS_Z = WS_SSQ + (size_t)3 * MG * 16 * 4;
constexpr size_t WS_MIX = WS_Z + (size_t)MG * ZW * 2;
constexpr size_t WS_HID = WS_MIX + (size_t)MG * D * 2;
constexpr size_t WS_PB = WS_HID + (size_t)MG * DFF * 2;
constexpr size_t WS_PLE = WS_PB + (size_t)MG * D * 2;
constexpr size_t WS_GS = WS_PLE + (size_t)NLAYER * MG * PLE * 2;
constexpr size_t WS_GD = WS_GS + (size_t)2 * NCH * 4 * 2048 * 4;
constexpr size_t WS_RS = WS_GD + (size_t)2 * NCH * 4 * 32 * 4;
constexpr size_t WS_BAR = WS_RS + (size_t)2 * NCR * 4 * 4096 * 4;
constexpr size_t WS_END = WS_BAR + 16384;

constexpr int LDS_BYTES = 139264;

extern __shared__ __attribute__((aligned(16))) unsigned char g_lds[];

struct Params {
    const float* x_prompt; const float* x_sample; const float* p_prompt; const float* p_sample;
    const float* ln_mix; const float* w_in; const float* attn_q_norm; const float* attn_k_norm;
    const float* gla_gate_up; const float* gla_gate_bias; const float* gla_out_norm; const float* ret_decay_raw;
    const float* ret_out_norm; const float* w_out; const float* ln_mlp; const float* w_mlp_in; const float* w_mlp_out;
    const float* ln_pe; const float* w_pe_gate; const float* w_pe_proj;
    float* out; unsigned char* ws;
};

typedef float f32x2_t __attribute__((ext_vector_type(2)));
typedef __bf16 bf16x2_t __attribute__((ext_vector_type(2)));
__device__ __forceinline__ unsigned cvt_pk_bf16(float lo, float hi) { const f32x2_t v = {lo, hi}; return __builtin_bit_cast(unsigned, __builtin_convertvector(v, bf16x2_t)); }
__device__ __forceinline__ float bf2f(unsigned short b) { return __uint_as_float(((unsigned)b) << 16); }
__device__ __forceinline__ float bflo(unsigned w) { return __uint_as_float(w << 16); }
__device__ __forceinline__ float bfhi(unsigned w) { return __uint_as_float(w & 0xffff0000u); }
__device__ __forceinline__ bf16x8 pack8(const float (&v)[8]) {
    u32x4 w; w.x = cvt_pk_bf16(v[0], v[1]); w.y = cvt_pk_bf16(v[2], v[3]); w.z = cvt_pk_bf16(v[4], v[5]); w.w = cvt_pk_bf16(v[6], v[7]);
    return __builtin_bit_cast(bf16x8, w);
}
__device__ __forceinline__ void unpack8(bf16x8 b, float (&v)[8]) {
    u32x4 w = __builtin_bit_cast(u32x4, b);
    v[0] = bflo(w.x); v[1] = bfhi(w.x); v[2] = bflo(w.y); v[3] = bfhi(w.y); v[4] = bflo(w.z); v[5] = bfhi(w.z); v[6] = bflo(w.w); v[7] = bfhi(w.w);
}
typedef short v4i16_t __attribute__((ext_vector_type(4)));
__device__ __forceinline__ bf16x8 gather8(const bf16_t* tile  , int stride, int qi) {
    const bf16_t* p = tile + (qi >> 2) * stride + 4 * (qi & 3);
    const v4i16_t lo = __builtin_amdgcn_ds_read_tr16_b64_v4i16((__attribute__((address_space(3))) v4i16_t*)p);
    const v4i16_t hi = __builtin_amdgcn_ds_read_tr16_b64_v4i16((__attribute__((address_space(3))) v4i16_t*)(p + 4 * stride));
    bf16x8 r; r[0] = lo[0]; r[1] = lo[1]; r[2] = lo[2]; r[3] = lo[3]; r[4] = hi[0]; r[5] = hi[1]; r[6] = hi[2]; r[7] = hi[3];
    return r;
}
__device__ __forceinline__ bf16x8 ld8f_pack(const float* p) {
    f32x4 a = *(const f32x4*)p, b = *(const f32x4*)(p + 4);
    u32x4 w; w.x = cvt_pk_bf16(a.x, a.y); w.y = cvt_pk_bf16(a.z, a.w); w.z = cvt_pk_bf16(b.x, b.y); w.w = cvt_pk_bf16(b.z, b.w);
    return __builtin_bit_cast(bf16x8, w);
}
__device__ __forceinline__ int opaque_tid() { int t = threadIdx.x; asm volatile("" : "+v"(t)); return t; }
#define LDS_FENCE() asm volatile("s_waitcnt lgkmcnt(0)" ::: "memory")
#define MFMA16(a, b, c) __builtin_amdgcn_mfma_f32_16x16x32_bf16((a), (b), (c), 0, 0, 0)

constexpr int BM = 256, BK = 64, HALF = 128, HT = HALF * BK;
__device__ __forceinline__ int lds_byte(int r, int c) {
    int st = (r >> 4) * 2 + (c >> 5), rr = r & 15, cc = c & 31, ob = rr * 64 + cc * 2;
    return st * 1024 + (ob ^ (((ob >> 9) & 1) << 5));
}
__device__ __forceinline__ void stage_rc(int b, int& R, int& C) {
    int st = b / 1024, sb = b % 1024, swz = sb ^ (((sb >> 9) & 1) << 5);
    R = (st >> 1) * 16 + swz / 64; C = (st & 1) * 32 + (swz % 64) / 2;
}
__device__ __forceinline__ bool tile_of(int L, int nM, int nN, int& pm, int& pn) {
    const int nwg = nM * nN; if (L >= nwg) return false;
    int wgid = L; { const int q = nwg / 8, r = nwg % 8, xcd = wgid % 8, off = wgid / 8; wgid = (xcd < r ? xcd * (q + 1) : r * (q + 1) + (xcd - r) * q) + off; }
    const int nig = 8 * nN, gid = wgid / nig, fm = gid * 8, gsz = (nM - fm) < 8 ? (nM - fm) : 8;
    pm = fm + ((wgid % nig) % gsz); pn = (wgid % nig) / gsz; return true;
}

template <bool TR, class Epi>
__device__ __forceinline__ void gemm_tile(const bf16_t* __restrict__ A, int lda, const bf16_t* __restrict__ Bt, int ldb, int K, int brow, int bcol, const Epi& epi, int parity, bool pre, int nbrow, int nbcol) {
    const int tid = opaque_tid();
    bf16_t* shm = (bf16_t*)g_lds;
#define SA(b, h) (shm + ((b) * 2 + (h)) * HT)
#define SB(b, h) (shm + (4 + (b) * 2 + (h)) * HT)
#define STAGE(P, BASE, LD, br, kt) do { const int _so = ((br) * (LD) + (kt) * BK) * 2; \
    for (int _i = 0; _i < 2; ++_i) { \
      __builtin_amdgcn_raw_ptr_buffer_load_lds(((&(LD) == &lda) ? rsA : rsB), (__attribute__((address_space(3))) void*)((char*)(P) + wid * 1024 + _i * 8192), 16, \
          ((&(LD) == &lda) ? offA[_i] : offB[_i]), _so, 0, 0); } } while (0)
#define LDA(dst, b, h) for (int m = 0; m < 4; ++m) for (int k = 0; k < 2; ++k) \
    dst[m][k] = *reinterpret_cast<const bf16x8*>((char*)SA(b, h) + lds_byte(wr * 64 + m * 16 + fr, k * 32 + fq * 8))
#define LDB(dst, b, h) for (int n = 0; n < 2; ++n) for (int k = 0; k < 2; ++k) \
    dst[n][k] = *reinterpret_cast<const bf16x8*>((char*)SB(b, h) + lds_byte(wc * 32 + n * 16 + fr, k * 32 + fq * 8))
#define MMA(ai, bj, At, Bt_) do { __builtin_amdgcn_s_setprio(1); \
    for (int m = 0; m < 4; ++m) for (int n = 0; n < 2; ++n) for (int k = 0; k < 2; ++k) \
      acc[ai][bj][m][n] = TR ? __builtin_amdgcn_mfma_f32_16x16x32_bf16(Bt_[n][k], At[m][k], acc[ai][bj][m][n], 0, 0, 0) \
                            : __builtin_amdgcn_mfma_f32_16x16x32_bf16(At[m][k], Bt_[n][k], acc[ai][bj][m][n], 0, 0, 0); \
    __builtin_amdgcn_s_setprio(0); } while (0)
#define WAIT_V(n) asm volatile("s_waitcnt vmcnt(" #n ")" ::: "memory")
#define WAIT_L(n) asm volatile("s_waitcnt lgkmcnt(" #n ")" ::: "memory")
#define BAR __builtin_amdgcn_s_barrier()
#define SCHED __builtin_amdgcn_sched_barrier(0)
    const int wid = __builtin_amdgcn_readfirstlane(tid >> 6), lane = tid & 63, wr = wid >> 2, wc = wid & 3, fr = lane & 15, fq = lane >> 4;
    f32x4 acc[2][2][4][2] = {};
    bf16x8 At[4][2], B0[2][2], B1[2][2];
    const int nt = K / BK;
    const __amdgpu_buffer_rsrc_t rsA = __builtin_amdgcn_make_buffer_rsrc((void*)A, (short)0, 0x7ffffff0, 0x00020000);
    const __amdgpu_buffer_rsrc_t rsB = __builtin_amdgcn_make_buffer_rsrc((void*)Bt, (short)0, 0x7ffffff0, 0x00020000);
    unsigned offA[2], offB[2];
    for (int _i = 0; _i < 2; ++_i) { int _r, _c; stage_rc(tid * 16 + _i * 8192, _r, _c); offA[_i] = (unsigned)(_r * lda + _c) * 2u; offB[_i] = (unsigned)(_r * ldb + _c) * 2u; }
    if (!(TR && pre)) {
    STAGE(SB(0, 0), Bt, ldb, bcol, 0); STAGE(SA(0, 0), A, lda, brow, 0);
    STAGE(SB(0, 1), Bt, ldb, bcol + HALF, 0); STAGE(SA(0, 1), A, lda, brow + HALF, 0);
    }
    float* RT = (float*)(g_lds + 131072 + (parity & 1) * 1024);
    if (TR) { if (tid < 256) RT[tid] = epi.rstd_row(brow + tid); }
    if (wr == 1) BAR;
    if (TR && pre) { WAIT_V(8); } else { WAIT_V(4); }
    BAR;
    STAGE(SB(1, 0), Bt, ldb, bcol, 1); STAGE(SA(1, 0), A, lda, brow, 1); STAGE(SB(1, 1), Bt, ldb, bcol + HALF, 1);
    WAIT_V(6); BAR;
#pragma unroll 1
    for (int t = 0; t < nt - 2; t += 2) {
        LDB(B0, 0, 0); SCHED; LDA(At, 0, 0); STAGE(SA(1, 1), A, lda, brow + HALF, t + 1);
        WAIT_L(8); BAR; WAIT_L(0); MMA(0, 0, At, B0); BAR; SCHED;
        LDB(B1, 0, 1); STAGE(SB(0, 0), Bt, ldb, bcol, t + 2);
        BAR; WAIT_L(0); MMA(0, 1, At, B1); BAR;
        LDA(At, 0, 1); STAGE(SA(0, 0), A, lda, brow, t + 2);
        BAR; WAIT_L(0); MMA(1, 0, At, B0); BAR; SCHED;
        STAGE(SB(0, 1), Bt, ldb, bcol + HALF, t + 2);
        WAIT_V(6); BAR; MMA(1, 1, At, B1); BAR;
        LDB(B0, 1, 0); SCHED; LDA(At, 1, 0); STAGE(SA(0, 1), A, lda, brow + HALF, t + 2);
        WAIT_L(8); BAR; WAIT_L(0); MMA(0, 0, At, B0); BAR; SCHED;
        LDB(B1, 1, 1); STAGE(SB(1, 0), Bt, ldb, bcol, t + 3);
        BAR; WAIT_L(0); MMA(0, 1, At, B1); BAR;
        LDA(At, 1, 1); STAGE(SA(1, 0), A, lda, brow, t + 3);
        BAR; WAIT_L(0); MMA(1, 0, At, B0); BAR; SCHED;
        STAGE(SB(1, 1), Bt, ldb, bcol + HALF, t + 3);
        WAIT_V(6); BAR; MMA(1, 1, At, B1); BAR;
    }
    { LDB(B0, 0, 0); LDA(At, 0, 0); STAGE(SA(1, 1), A, lda, brow + HALF, nt - 1);
      BAR; WAIT_L(0); MMA(0, 0, At, B0); BAR;
      LDB(B1, 0, 1); BAR; WAIT_L(0); MMA(0, 1, At, B1); BAR;
      LDA(At, 0, 1); WAIT_V(4); BAR; WAIT_L(0); MMA(1, 0, At, B0); MMA(1, 1, At, B1); BAR; }
    { LDB(B0, 1, 0); LDA(At, 1, 0); WAIT_V(2); BAR; WAIT_L(0); MMA(0, 0, At, B0); BAR;
      LDB(B1, 1, 1); WAIT_V(0); BAR; WAIT_L(0); MMA(0, 1, At, B1); BAR;
      LDA(At, 1, 1); BAR; WAIT_L(0); MMA(1, 0, At, B0); MMA(1, 1, At, B1); BAR; }
    if (wr == 0) BAR;
    if (TR && nbrow >= 0) {
        STAGE(SB(0, 0), Bt, ldb, nbcol, 0); STAGE(SA(0, 0), A, lda, nbrow, 0);
        STAGE(SB(0, 1), Bt, ldb, nbcol + HALF, 0); STAGE(SA(0, 1), A, lda, nbrow + HALF, 0);
        asm volatile("" ::: "memory"); SCHED;
    }
    if (TR) {
        epi.regs(acc, RT, brow, bcol, wr, wc, fr, fq);
        return;
    }
    float* ep = (float*)g_lds;
    __syncthreads();
#pragma unroll
    for (int ai = 0; ai < 2; ++ai) {
        if (ai) __syncthreads();
#pragma unroll
        for (int bj = 0; bj < 2; ++bj)
#pragma unroll
            for (int m = 0; m < 4; ++m)
#pragma unroll
                for (int n = 0; n < 2; ++n)
#pragma unroll
                    for (int j = 0; j < 4; ++j)
                        ep[(wr * 64 + m * 16 + fq * 4 + j) * 260 + bj * HALF + wc * 32 + n * 16 + fr] = acc[ai][bj][m][n][j];
        __syncthreads();
        int lane_e = tid & 63; asm volatile("" : "+v"(lane_e));
        const int row0 = brow + ai * HALF + wid * 16;
        epi.rows(ep, wid, lane_e, row0, bcol);
    }
    __syncthreads();
#undef SA
#undef SB
#undef STAGE
#undef LDA
#undef LDB
#undef MMA
}

template <bool TR, class Epi>
__device__ __forceinline__ void gemm_phase_t(const bf16_t* A, int lda, const bf16_t* Bt, int ldb, int M, int N, int K, const Epi& epi) {
    const int nM = M / BM, nN = N / BM;
    int pm, pn; bool have = tile_of((int)blockIdx.x, nM, nN, pm, pn), pre = false;
    for (int i = 0; have; ++i) {
        int npm = 0, npn = 0; const bool nhave = tile_of((i + 1) * (int)gridDim.x + (int)blockIdx.x, nM, nN, npm, npn);
        gemm_tile<TR>(A, lda, Bt, ldb, K, pm * BM, pn * BM, epi, i, pre, (TR && nhave) ? npm * BM : -1, npn * BM);
        pre = TR && nhave; pm = npm; pn = npn; have = nhave;
    }
    if (TR) __syncthreads();
}
template <class Epi>
__device__ __forceinline__ void gemm_phase(const bf16_t* A, int lda, const bf16_t* Bt, int ldb, int M, int N, int K, const Epi& epi) { gemm_phase_t<false>(A, lda, Bt, ldb, M, N, K, epi); }

__device__ __forceinline__ float row_rstd(const float* ssq, int row) {
    const f32x4* p = (const f32x4*)(ssq + (size_t)row * 16);
    const f32x4 a = p[0], b = p[1], c = p[2], d = p[3];
    const float s = ((a.x + a.y) + (a.z + a.w)) + ((b.x + b.y) + (b.z + b.w)) + ((c.x + c.y) + (c.z + c.w)) + ((d.x + d.y) + (d.z + d.w));
    return rsqrtf(s * (1.0f / D) + EPS);
}
__device__ __forceinline__ float rstd16(const float* ssq, int row0, int lane) {
    const f32x4 q = *(const f32x4*)(ssq + (size_t)(row0 + (lane >> 2)) * 16 + 4 * (lane & 3));
    float s = (q.x + q.y) + (q.z + q.w); s += __shfl_xor(s, 1); s += __shfl_xor(s, 2);
    return rsqrtf(s * (1.0f / D) + EPS);
}
__device__ __forceinline__ float seg_sum16(float s) { s += __shfl_xor(s, 1); s += __shfl_xor(s, 2); s += __shfl_xor(s, 4); s += __shfl_xor(s, 8); return s; }
__device__ __forceinline__ void st4_bf16(bf16_t* d, float a, float b, float c, float e) { u32x2 w; w.x = cvt_pk_bf16(a, b); w.y = cvt_pk_bf16(c, e); *(u32x2*)d = w; }

template <class E> __device__ __forceinline__ void epi_rows_generic(const E& e, const float* ep, int wid, int lane, int row0, int bcol) {
    const float rsv = e.begin(row0, lane);
    const int col = bcol + 4 * lane;
#pragma unroll 1
    for (int i0 = 0; i0 < 16; i0 += 4) {
        typename E::Ld L[4]; f32x4 v[4];
#pragma unroll
        for (int u = 0; u < 4; ++u) { L[u] = e.load(row0 + i0 + u, col); v[u] = *(const f32x4*)(ep + (wid * 16 + i0 + u) * 260 + 4 * lane); }
#pragma unroll
        for (int u = 0; u < 4; ++u) e.finish(v[u], L[u], row0 + i0 + u, col, lane, __shfl(rsv, 4 * (i0 + u)));
    }
}

struct EpiIn {
    bf16_t* Z; const float* ssq; const float* qn; const float* kn; const float* gbias; const float* tab; int smask;
    __device__ __forceinline__ float rstd_row(int) const { return 0.f; }
    __device__ __forceinline__ void regs(const f32x4 (&)[2][2][4][2], const float*, int, int, int, int, int, int) const {}
    template <int T> __device__ __forceinline__ void rows_t(const float* ep, int wid, int lane, int row0, int bcol) const {
        const float rsv = rstd16(ssq, row0, lane);
        const int col = bcol + 4 * lane, c = col & 63, sl = lane & 15;
        f32x4 gn = {1.f, 1.f, 1.f, 1.f}, bb = {0.f, 0.f, 0.f, 0.f};
        if (T == 0) gn = *(const f32x4*)(qn + c);
        if (T == 1) gn = *(const f32x4*)(kn + c);
        if (T == 4) bb = *(const f32x4*)(gbias + (col - ZC_GF));
        const bool rot = (T <= 1) ? (sl < 4) : true;
        const float sgn = (T <= 1) ? (sl < 2 ? -1.f : 1.f) : (sl < 8 ? -1.f : 1.f);
        const int toff = (T <= 1) ? 2 * (c & 7) : 16 + 2 * (c & 31);
        const float psc = (T == 2) ? ((col >= ZC_BQ && col < ZC_BK) ? 0.17677669529663687f : 1.0f) : (T == 0 ? 0.125f * 1.4426950408889634f : (T == 6 ? 0.125f : 1.0f));
#pragma unroll 1
        for (int i0 = 0; i0 < 16; i0 += 4) {
            f32x4 vv[4], tt0[4], tt1[4];
#pragma unroll
            for (int u = 0; u < 4; ++u) {
                vv[u] = *(const f32x4*)(ep + (wid * 16 + i0 + u) * 260 + 4 * lane);
                if (T == 0 || T == 1 || T == 5 || T == 6) { const float* cs = tab + (size_t)((row0 + i0 + u) & smask) * 80 + toff; tt0[u] = *(const f32x4*)cs; tt1[u] = *(const f32x4*)(cs + 4); }
            }
#pragma unroll
            for (int u = 0; u < 4; ++u) {
            f32x4 v = vv[u];
            const int row = row0 + i0 + u; const float rstd = __shfl(rsv, 4 * (i0 + u));
            bf16_t* dst = Z + (size_t)row * ZW + col;
            if (T == 0 || T == 1 || T == 5 || T == 6) {
                const f32x4 t0 = tt0[u], t1 = tt1[u];
                float r = rstd * psc;
                if (T <= 1) { const float ss = seg_sum16((v.x * v.x + v.y * v.y) + (v.z * v.z + v.w * v.w)); r *= rsqrtf(ss * rstd * rstd * (1.0f / 64) + EPS); }
                v.x *= r * gn.x; v.y *= r * gn.y; v.z *= r * gn.z; v.w *= r * gn.w;
                f32x4 pv;
                if (T <= 1) { pv.x = __shfl_xor(v.x, 2); pv.y = __shfl_xor(v.y, 2); pv.z = __shfl_xor(v.z, 2); pv.w = __shfl_xor(v.w, 2); }
                else        { pv.x = __shfl_xor(v.x, 8); pv.y = __shfl_xor(v.y, 8); pv.z = __shfl_xor(v.z, 8); pv.w = __shfl_xor(v.w, 8); }
                const float nx = v.x * t0.x + sgn * pv.x * t0.y, ny = v.y * t0.z + sgn * pv.y * t0.w, nz = v.z * t1.x + sgn * pv.z * t1.y, nw = v.w * t1.z + sgn * pv.w * t1.w;
                st4_bf16(dst, rot ? nx : v.x, rot ? ny : v.y, rot ? nz : v.z, rot ? nw : v.w);
            } else if (T == 4) {
                float x[4] = {v.x * rstd + bb.x, v.y * rstd + bb.y, v.z * rstd + bb.z, v.w * rstd + bb.w}; unsigned short hb[4];
#pragma unroll
                for (int k = 0; k < 4; ++k) { const float ls = fminf(x[k], 0.f) - __logf(1.0f + __expf(-fabsf(x[k]))); const _Float16 hv = (_Float16)(ls * 0.0625f); hb[k] = __builtin_bit_cast(unsigned short, hv); }
                u32x2 w; w.x = hb[0] | ((unsigned)hb[1] << 16); w.y = hb[2] | ((unsigned)hb[3] << 16);
                *(u32x2*)dst = w;
            } else {
                const float sc = rstd * psc;
                st4_bf16(dst, v.x * sc, v.y * sc, v.z * sc, v.w * sc);
            }
            }
        }
    }
    __device__ __forceinline__ void rows(const float* ep, int wid, int lane, int row0, int bcol) const {
        if (bcol < ZC_AK) rows_t<0>(ep, wid, lane, row0, bcol);
        else if (bcol < ZC_AV) rows_t<1>(ep, wid, lane, row0, bcol);
        else if (bcol == ZC_GF) rows_t<4>(ep, wid, lane, row0, bcol);
        else if (bcol == ZC_CQ) rows_t<5>(ep, wid, lane, row0, bcol);
        else if (bcol == ZC_CK) rows_t<6>(ep, wid, lane, row0, bcol);
        else rows_t<2>(ep, wid, lane, row0, bcol);
    }
};

struct EpiRes {
    const bf16_t* HBin; bf16_t* HBout; float* ssq;
    typedef u32x2 Ld;
    __device__ __forceinline__ float rstd_row(int) const { return 0.f; }
    __device__ __forceinline__ void regs(const f32x4 (&)[2][2][4][2], const float*, int, int, int, int, int, int) const {}
    __device__ __forceinline__ void rows(const float* ep, int wid, int lane, int row0, int bcol) const { epi_rows_generic(*this, ep, wid, lane, row0, bcol); }
    __device__ __forceinline__ float begin(int, int) const { return 0.f; }
    __device__ __forceinline__ Ld load(int row, int col) const { return *(const u32x2*)(HBin + (size_t)row * D + col); }
    __device__ __forceinline__ void finish(f32x4 v, Ld hw, int row, int col, int lane, float) const {
        f32x4 h = {bflo(hw.x) + v.x, bfhi(hw.x) + v.y, bflo(hw.y) + v.z, bfhi(hw.y) + v.w};
        u32x2 w; w.x = cvt_pk_bf16(h.x, h.y); w.y = cvt_pk_bf16(h.z, h.w);
        *(u32x2*)(HBout + (size_t)row * D + col) = w;
        h.x = bflo(w.x); h.y = bfhi(w.x); h.z = bflo(w.y); h.w = bfhi(w.y);
        const float ss = seg_sum16((h.x * h.x + h.y * h.y) + (h.z * h.z + h.w * h.w));
        if ((lane & 15) == 0) ssq[(size_t)row * 16 + (col >> 6)] = ss;
    }
};

struct EpiMlpIn {
    bf16_t* HID; const float* ssq;
    __device__ __forceinline__ float rstd_row(int row) const { return row_rstd(ssq, row); }
    __device__ __forceinline__ void regs(const f32x4 (&acc)[2][2][4][2], const float* RT, int brow, int bcol, int wr, int wc, int fr, int fq) const {
#pragma unroll
        for (int ai = 0; ai < 2; ++ai)
#pragma unroll
            for (int m = 0; m < 4; ++m) {
                const int rl = ai * HALF + wr * 64 + m * 16 + fr; const float rstd = RT[rl];
                bf16_t* dst = HID + (size_t)(brow + rl) * DFF + bcol + wc * 32 + 8 * fq;
#pragma unroll
                for (int bj = 0; bj < 2; ++bj) { float t[8];
#pragma unroll
                    for (int n = 0; n < 2; ++n)
#pragma unroll
                        for (int j = 0; j < 4; ++j) { const float x = fmaxf(acc[ai][bj][m][n][j] * rstd, 0.f); t[4 * n + j] = x * x; }
                    *(bf16x8*)(dst + bj * HALF) = pack8(t); }
            }
    }
    __device__ __forceinline__ void rows(const float* ep, int wid, int lane, int row0, int bcol) const { epi_rows_generic(*this, ep, wid, lane, row0, bcol); }
    __device__ __forceinline__ float begin(int row0, int lane) const { return rstd16(ssq, row0, lane); }
    typedef int Ld;
    __device__ __forceinline__ Ld load(int, int) const { return 0; }
    __device__ __forceinline__ void finish(f32x4 v, Ld, int row, int col, int lane, float rstd) const { this->row(v, row, col, lane, rstd); }
    __device__ __forceinline__ void row(f32x4 v, int row, int col, int, float rstd) const {
        const float a = fmaxf(v.x * rstd, 0.f), b = fmaxf(v.y * rstd, 0.f), c = fmaxf(v.z * rstd, 0.f), e = fmaxf(v.w * rstd, 0.f);
        st4_bf16(HID + (size_t)row * DFF + col, a * a, b * b, c * c, e * e);
    }
};

struct EpiPlain {
    bf16_t* O; int ldo;
    __device__ __forceinline__ float rstd_row(int) const { return 0.f; }
    __device__ __forceinline__ void regs(const f32x4 (&)[2][2][4][2], const float*, int, int, int, int, int, int) const {}
    __device__ __forceinline__ void rows(const float* ep, int wid, int lane, int row0, int bcol) const { epi_rows_generic(*this, ep, wid, lane, row0, bcol); }
    __device__ __forceinline__ float begin(int, int) const { return 0.f; }
    typedef int Ld;
    __device__ __forceinline__ Ld load(int, int) const { return 0; }
    __device__ __forceinline__ void finish(f32x4 v, Ld, int row, int col, int lane, float rstd) const { this->row(v, row, col, lane, rstd); }
    __device__ __forceinline__ void row(f32x4 v, int row, int col, int, float) const { st4_bf16(O + (size_t)row * ldo + col, v.x, v.y, v.z, v.w); }
};

struct EpiPeGate {
    float* Hout; const bf16_t* HBin; bf16_t* HBout; float* ssq_out; const float* ssq_in; const bf16_t* PB; int write_f32;
    struct Ld { u32x2 pw, hw; };
    __device__ __forceinline__ float rstd_row(int) const { return 0.f; }
    __device__ __forceinline__ void regs(const f32x4 (&)[2][2][4][2], const float*, int, int, int, int, int, int) const {}
    __device__ __forceinline__ void rows(const float* ep, int wid, int lane, int row0, int bcol) const { epi_rows_generic(*this, ep, wid, lane, row0, bcol); }
    __device__ __forceinline__ float begin(int row0, int lane) const { return rstd16(ssq_in, row0, lane); }
    __device__ __forceinline__ Ld load(int row, int col) const { Ld l; l.pw = *(const u32x2*)(PB + (size_t)row * D + col); l.hw = *(const u32x2*)(HBin + (size_t)row * D + col); return l; }
    __device__ __forceinline__ void finish(f32x4 v, Ld l, int row, int col, int lane, float rstd) const {
        const u32x2 pw = l.pw, hw = l.hw;
        f32x4 h;
        h.x = bflo(hw.x) + bflo(pw.x) / (1.0f + __expf(-v.x * rstd)); h.y = bfhi(hw.x) + bfhi(pw.x) / (1.0f + __expf(-v.y * rstd));
        h.z = bflo(hw.y) + bflo(pw.y) / (1.0f + __expf(-v.z * rstd)); h.w = bfhi(hw.y) + bfhi(pw.y) / (1.0f + __expf(-v.w * rstd));
        if (write_f32) *(f32x4*)(Hout + (size_t)row * D + col) = h;
        u32x2 w; w.x = cvt_pk_bf16(h.x, h.y); w.y = cvt_pk_bf16(h.z, h.w);
        *(u32x2*)(HBout + (size_t)row * D + col) = w;
        h.x = bflo(w.x); h.y = bfhi(w.x); h.z = bflo(w.y); h.w = bfhi(w.y);
        const float ss = seg_sum16((h.x * h.x + h.y * h.y) + (h.z * h.z + h.w * h.w));
        if ((lane & 15) == 0) ssq_out[(size_t)row * 16 + (col >> 6)] = ss;
    }
};

template <class F>
__device__ __forceinline__ void transpose_item(bf16_t* Wt, int K, int k0, int n0, const F& src) {
    const int tid = opaque_tid();
    float* tile = (float*)g_lds;
#pragma unroll
    for (int i = 0; i < 8; ++i) { const int kk = (tid >> 6) + 8 * i, nn = tid & 63; tile[kk * 65 + nn] = src(k0 + kk, n0 + nn); }
    __syncthreads();
    { const int nn = tid >> 3, kc = tid & 7; float t[8];
#pragma unroll
      for (int j = 0; j < 8; ++j) t[j] = tile[(8 * kc + j) * 65 + nn];
      *(bf16x8*)(Wt + (size_t)(n0 + nn) * K + k0 + 8 * kc) = pack8(t); }
    __syncthreads();
}

__device__ __forceinline__ void phase_weights(const Params& p) {
    bf16_t* WT = (bf16_t*)(p.ws + WS_WT);
    constexpr int I_IN = 16 * (ZW / 64), I_OUT = 16 * 16, I_MI = 16 * 64, I_MO = 64 * 16, I_PG = 16 * 16, I_PP = 4 * 16;
    constexpr int I_L = I_IN + I_OUT + I_MI + I_MO + I_PG + I_PP;
    for (int it = blockIdx.x; it < NLAYER * I_L; it += gridDim.x) {
        const int l = it / I_L; int r = it % I_L;
        bf16_t* W = WT + (size_t)l * W_LAYER;
        if (r < I_IN) {
            const int kb = r / (ZW / 64), nb = r % (ZW / 64);
            const float* w = p.w_in + (size_t)l * D * NIN; const float* g = p.ln_mix + l * D; const float* gu = p.gla_gate_up + (size_t)l * 2 * 16 * 128;
            transpose_item(W + WO_IN, D, kb * 64, nb * 64, [&](int k, int c) -> float {
                float v;
                if (c < ZC_GF) v = w[(size_t)k * NIN + c];
                else if (c < ZC_CQ) { const int j = (c - ZC_GF) >> 7, kk = (c - ZC_GF) & 127; float s = 0.f;
                    for (int rr = 0; rr < 16; ++rr) s += w[(size_t)k * NIN + 2304 + 16 * j + rr] * gu[(j * 16 + rr) * 128 + kk];
                    v = s; }
                else v = w[(size_t)k * NIN + (c - 224)];
                return v * g[k]; });
            continue; }
        r -= I_IN;
        if (r < I_OUT) { const float* w = p.w_out + (size_t)l * D * D;
            transpose_item(W + WO_OUT, D, (r / 16) * 64, (r % 16) * 64, [&](int k, int c) -> float { return w[(size_t)k * D + c]; }); continue; }
        r -= I_OUT;
        if (r < I_MI) { const float* w = p.w_mlp_in + (size_t)l * D * DFF; const float* g = p.ln_mlp + l * D;
            transpose_item(W + WO_MI, D, (r / 64) * 64, (r % 64) * 64, [&](int k, int c) -> float { const int rho = c & 31; const int cc = (c & ~31) + 8 * ((rho & 15) >> 2) + 4 * (rho >> 4) + (rho & 3);
                return w[(size_t)k * DFF + cc] * g[k]; }); continue; }
        r -= I_MI;
        if (r < I_MO) { const float* w = p.w_mlp_out + (size_t)l * DFF * D;
            transpose_item(W + WO_MO, DFF, (r / 16) * 64, (r % 16) * 64, [&](int k, int c) -> float { return w[(size_t)k * D + c]; }); continue; }
        r -= I_MO;
        if (r < I_PG) { const float* w = p.w_pe_gate + (size_t)l * D * D; const float* g = p.ln_pe + l * D;
            transpose_item(W + WO_PG, D, (r / 16) * 64, (r % 16) * 64, [&](int k, int c) -> float { return w[(size_t)k * D + c] * g[k]; }); continue; }
        r -= I_PG;
        { const float* w = p.w_pe_proj + (size_t)l * PLE * D;
            transpose_item(W + WO_PP, PLE, (r / 16) * 64, (r % 16) * 64, [&](int k, int c) -> float { return w[(size_t)k * D + c]; }); }
    }
    float* tab = (float*)(p.ws + WS_TAB);
    for (int e = blockIdx.x * NTHR + threadIdx.x; e < 16384 * 40; e += gridDim.x * NTHR) {
        const int pos = e / 40, i = e % 40;
        const double invf = (i < 8) ? exp(-(double)i * (log(500000.0) / 8.0)) : exp(-(double)(i - 8) * (log(10000.0) / 32.0));
        double ang = (double)pos * invf; ang -= 6.283185307179586476925 * floor(ang * 0.15915494309189533577);
        tab[2 * e] = (float)cos(ang); tab[2 * e + 1] = (float)sin(ang);
    }
}

__device__ __forceinline__ void phase_init(const Params& p, int g) {
    const int tid = opaque_tid();
    const float* x = (g == 0) ? p.x_prompt : p.x_sample + (size_t)(g - 1) * MG * D;
    bf16_t* HB = (bf16_t*)(p.ws + WS_HB); float* ssq = (float*)(p.ws + WS_SSQ);
    const int lane = tid & 63, gw = blockIdx.x * 8 + (tid >> 6), NGW = gridDim.x * 8;
    for (int row = gw; row < MG; row += 2 * NGW) {
        f32x4 vv[2][4];
#pragma unroll
        for (int rr = 0; rr < 2; ++rr)
#pragma unroll
            for (int j = 0; j < 4; ++j) vv[rr][j] = *(const f32x4*)(x + (size_t)(row + rr * NGW) * D + 256 * j + 4 * lane);
#pragma unroll
        for (int rr = 0; rr < 2; ++rr)
#pragma unroll
            for (int j = 0; j < 4; ++j) {
                f32x4 v = vv[rr][j]; const int r2 = row + rr * NGW;
                u32x2 w; w.x = cvt_pk_bf16(v.x, v.y); w.y = cvt_pk_bf16(v.z, v.w);
                *(u32x2*)(HB + (size_t)r2 * D + 256 * j + 4 * lane) = w;
                v.x = bflo(w.x); v.y = bfhi(w.x); v.z = bflo(w.y); v.w = bfhi(w.y);
                float s_ = (v.x * v.x + v.y * v.y) + (v.z * v.z + v.w * v.w);
                s_ += __shfl_xor(s_, 1); s_ += __shfl_xor(s_, 2); s_ += __shfl_xor(s_, 4); s_ += __shfl_xor(s_, 8);
                if ((lane & 15) == 0) ssq[(size_t)r2 * 16 + (lane >> 4) + 4 * j] = s_;
            }
    }
    bf16_t* PL = (bf16_t*)(p.ws + WS_PLE);
    for (int l = 0; l < NLAYER; ++l) {
        const float* src = (g == 0) ? p.p_prompt + (size_t)l * MG * PLE : p.p_sample + ((size_t)l * 2 * MG + (size_t)(g - 1) * MG) * PLE;
        bf16_t* dst = PL + (size_t)l * MG * PLE;
        const size_t stride = (size_t)gridDim.x * NTHR * 8;
        for (size_t e = (size_t)(blockIdx.x * NTHR + tid) * 8; e < (size_t)MG * PLE; e += 4 * stride) {
            f32x4 a[4][2];
#pragma unroll
            for (int u = 0; u < 4; ++u) if (e + u * stride < (size_t)MG * PLE) { a[u][0] = *(const f32x4*)(src + e + u * stride); a[u][1] = *(const f32x4*)(src + e + u * stride + 4); }
#pragma unroll
            for (int u = 0; u < 4; ++u) if (e + u * stride < (size_t)MG * PLE) { u32x4 w; w.x = cvt_pk_bf16(a[u][0].x, a[u][0].y); w.y = cvt_pk_bf16(a[u][0].z, a[u][0].w); w.z = cvt_pk_bf16(a[u][1].x, a[u][1].y); w.w = cvt_pk_bf16(a[u][1].z, a[u][1].w);
                *(u32x4*)(dst + e + u * stride) = w; }
        }
    }
}

struct AttnLd { bf16x8 ka0, ka1, kb0, kb1; u32x4 v0, v1, v2, v3; };
__device__ __forceinline__ void attn_geom(int f, int r, int n0, int& dsh, int& cb) {
    const int p = f < 12 ? 0 : (f < 18 ? 1 : 2); const int i2 = f - (p == 0 ? 0 : (p == 1 ? 12 : 18));
    dsh = 2 * p; cb = (r >> dsh) + (16 >> dsh) * n0 - 64 + 32 * i2;
}
__device__ __forceinline__ AttnLd attn_load(const bf16_t* __restrict__ zq, int S, int head, int r, int n0, int lane, int f) {
    int dsh, cb; attn_geom(f, r, n0, dsh, cb);
    const int qi = lane & 15, g = lane >> 4, rd = r & ((1 << dsh) - 1), ncls = S >> dsh;
    const int cA = cb + 8 * (qi >> 2) + (qi & 3), cB = cA + 4;
    const int cAc = min(max(cA, 0), ncls - 1), cBc = min(max(cB, 0), ncls - 1);
    const bf16_t* kA = zq + (size_t)(rd + (cAc << dsh)) * ZW + ZC_AK + head * 64 + 8 * g;
    const bf16_t* kB = zq + (size_t)(rd + (cBc << dsh)) * ZW + ZC_AK + head * 64 + 8 * g;
    AttnLd L;
    L.ka0 = *(const bf16x8*)kA; L.ka1 = *(const bf16x8*)(kA + 32); L.kb0 = *(const bf16x8*)kB; L.kb1 = *(const bf16x8*)(kB + 32);
    const int cv0 = cb + (lane >> 3);
    const bf16_t* vb = zq + ZC_AV + head * 64 + 8 * (lane & 7);
    L.v0 = *(const u32x4*)(vb + (size_t)(rd + (min(max(cv0, 0), ncls - 1) << dsh)) * ZW);
    L.v1 = *(const u32x4*)(vb + (size_t)(rd + (min(max(cv0 + 8, 0), ncls - 1) << dsh)) * ZW);
    L.v2 = *(const u32x4*)(vb + (size_t)(rd + (min(max(cv0 + 16, 0), ncls - 1) << dsh)) * ZW);
    L.v3 = *(const u32x4*)(vb + (size_t)(rd + (min(max(cv0 + 24, 0), ncls - 1) << dsh)) * ZW);
    return L;
}
__device__ __forceinline__ bf16x8 attn_softmax_step(const f32x4& sA, const f32x4& sB, int cb, int cq, int ncls, int g, float& m, float& lsum, f32x4 (&O)[4]) {
    float s[8]; bool ok[8];
    const int c0v = cb + 8 * g, d0 = c0v - cq + 64;
#pragma unroll
    for (int j = 0; j < 8; ++j) {
        ok[j] = ((unsigned)(c0v + j) < (unsigned)ncls) && ((unsigned)(d0 + j) <= 128u);
        s[j] = ok[j] ? (j < 4 ? sA[j] : sB[j - 4]) : -1e30f; }
    float mx = fmaxf(fmaxf(fmaxf(s[0], s[1]), fmaxf(s[2], s[3])), fmaxf(fmaxf(s[4], s[5]), fmaxf(s[6], s[7])));
    mx = fmaxf(mx, __shfl_xor(mx, 16)); mx = fmaxf(mx, __shfl_xor(mx, 32));
    const float mn = fmaxf(m, mx), alpha = __builtin_amdgcn_exp2f(m - mn);
    m = mn;
    float pj[8], ps_ = 0.f;
#pragma unroll
    for (int j = 0; j < 8; ++j) { pj[j] = ok[j] ? __builtin_amdgcn_exp2f(s[j] - mn) : 0.f; ps_ += pj[j]; }
    lsum = lsum * alpha + ps_;
#pragma unroll
    for (int nbk = 0; nbk < 4; ++nbk) O[nbk] *= alpha;
    return pack8(pj);
}
__device__ __forceinline__ void attn_lds_step(const bf16_t* Kt, const bf16_t* Vt, int rowb, const bf16x8& q0, const bf16x8& q1, int cb, int cq, int ncls,
                                              int qi, int g, float& m, float& lsum, f32x4 (&O)[4]) {
    const bf16_t* kA = Kt + (rowb + 8 * (qi >> 2) + (qi & 3)) * 72 + 8 * g;
    const bf16x8 ka0 = *(const bf16x8*)kA, ka1 = *(const bf16x8*)(kA + 32), kb0 = *(const bf16x8*)(kA + 4 * 72), kb1 = *(const bf16x8*)(kA + 4 * 72 + 32);
    f32x4 sA = {0.f, 0.f, 0.f, 0.f}, sB = {0.f, 0.f, 0.f, 0.f};
    sA = MFMA16(ka0, q0, sA); sA = MFMA16(ka1, q1, sA);
    sB = MFMA16(kb0, q0, sB); sB = MFMA16(kb1, q1, sB);
    const bf16x8 P = attn_softmax_step(sA, sB, cb, cq, ncls, g, m, lsum, O);
#pragma unroll
    for (int nbk = 0; nbk < 4; ++nbk) O[nbk] = MFMA16(gather8(Vt + (rowb + 8 * g) * 68 + 16 * nbk, 68, qi), P, O[nbk]);
}
template <int NROWS>
__device__ __forceinline__ void attn_stage(const bf16_t* __restrict__ zq, int head, bf16_t* Kt, bf16_t* Vt, int c0, int ncls, int rd, int dsh, int tid) {
    constexpr int IT = (NROWS * 16 + NTHR - 1) / NTHR;
    u32x4 v[IT];
#pragma unroll
    for (int u = 0; u < IT; ++u) { const int idx = min(tid + u * NTHR, NROWS * 16 - 1);
        const int i = idx >> 4, ch = idx & 15, isv = ch >> 3, c8 = ch & 7; const int c = min(max(c0 + i, 0), ncls - 1);
        v[u] = *(const u32x4*)(zq + (size_t)(rd + (c << dsh)) * ZW + (isv ? ZC_AV : ZC_AK) + head * 64 + 8 * c8); }
#pragma unroll
    for (int u = 0; u < IT; ++u) { const int idx = min(tid + u * NTHR, NROWS * 16 - 1);
        const int i = idx >> 4, ch = idx & 15, isv = ch >> 3, c8 = ch & 7;
        bf16_t* d = isv ? (Vt + i * 68 + 8 * c8) : (Kt + i * 72 + 8 * c8);
        *(u32x2*)d = (u32x2){v[u].x, v[u].y}; *(u32x2*)(d + 4) = (u32x2){v[u].z, v[u].w}; }
}
__device__ __forceinline__ void attn_item(const bf16_t* __restrict__ Z, bf16_t* __restrict__ MIX, int S, int it) {
    const int tid = opaque_tid();
    __syncthreads();
    const int wave = tid >> 6, lane = tid & 63, qi = lane & 15, g = lane >> 4;
    const int nblk = S >> 8;
    const int pb = it % nblk; const int t1 = it / nblk; const int head = t1 & 7, seq = t1 >> 3;
    const int P0 = pb * 256, n0 = pb * 16;
    const bf16_t* zq = Z + (size_t)seq * S * ZW;
    bf16_t* Kt = (bf16_t*)g_lds;
    bf16_t* Vt = (bf16_t*)(g_lds + 57600);
    bf16_t* Vs = (bf16_t*)g_lds + wave * (32 * 68);
    int rt[2]; rt[0] = 4 * (wave >> 1) + (wave & 1); rt[1] = rt[0] + 2;
    bf16x8 q0[2], q1[2]; float m[2] = {-1e30f, -1e30f}, lsum[2] = {0.f, 0.f}; f32x4 O[2][4] = {};
#pragma unroll
    for (int ti = 0; ti < 2; ++ti) { const bf16_t* qp = zq + (size_t)(P0 + rt[ti] + 16 * qi) * ZW + ZC_AQ + head * 64 + 8 * g; q0[ti] = *(const bf16x8*)qp; q1[ti] = *(const bf16x8*)(qp + 32); }
    {
        bf16_t* Vs1 = Vs + 8 * (32 * 68);
        AttnLd cur0 = attn_load(zq, S, head, rt[0], n0, lane, 18), cur1 = attn_load(zq, S, head, rt[1], n0, lane, 18);
#pragma unroll 1
        for (int f = 18; f < 23; ++f) {
            const AttnLd nxt0 = attn_load(zq, S, head, rt[0], n0, lane, f < 22 ? f + 1 : 22), nxt1 = attn_load(zq, S, head, rt[1], n0, lane, f < 22 ? f + 1 : 22);
            const int cb = n0 - 64 + 32 * (f - 18), ncls = S >> 4, cq = n0 + qi;
            f32x4 sA0 = {0.f, 0.f, 0.f, 0.f}, sB0 = {0.f, 0.f, 0.f, 0.f}, sA1 = {0.f, 0.f, 0.f, 0.f}, sB1 = {0.f, 0.f, 0.f, 0.f};
            sA0 = MFMA16(cur0.ka0, q0[0], sA0); sA1 = MFMA16(cur1.ka0, q0[1], sA1); sB0 = MFMA16(cur0.kb0, q0[0], sB0); sB1 = MFMA16(cur1.kb0, q0[1], sB1);
            sA0 = MFMA16(cur0.ka1, q1[0], sA0); sA1 = MFMA16(cur1.ka1, q1[1], sA1); sB0 = MFMA16(cur0.kb1, q1[0], sB0); sB1 = MFMA16(cur1.kb1, q1[1], sB1);
            LDS_FENCE();
            { bf16_t* d = Vs + (lane >> 3) * 68 + 8 * (lane & 7);
              *(u32x2*)d = (u32x2){cur0.v0.x, cur0.v0.y}; *(u32x2*)(d + 4) = (u32x2){cur0.v0.z, cur0.v0.w};
              *(u32x2*)(d + 8 * 68) = (u32x2){cur0.v1.x, cur0.v1.y}; *(u32x2*)(d + 8 * 68 + 4) = (u32x2){cur0.v1.z, cur0.v1.w};
              *(u32x2*)(d + 16 * 68) = (u32x2){cur0.v2.x, cur0.v2.y}; *(u32x2*)(d + 16 * 68 + 4) = (u32x2){cur0.v2.z, cur0.v2.w};
              *(u32x2*)(d + 24 * 68) = (u32x2){cur0.v3.x, cur0.v3.y}; *(u32x2*)(d + 24 * 68 + 4) = (u32x2){cur0.v3.z, cur0.v3.w};
              d = Vs1 + (lane >> 3) * 68 + 8 * (lane & 7);
              *(u32x2*)d = (u32x2){cur1.v0.x, cur1.v0.y}; *(u32x2*)(d + 4) = (u32x2){cur1.v0.z, cur1.v0.w};
              *(u32x2*)(d + 8 * 68) = (u32x2){cur1.v1.x, cur1.v1.y}; *(u32x2*)(d + 8 * 68 + 4) = (u32x2){cur1.v1.z, cur1.v1.w};
              *(u32x2*)(d + 16 * 68) = (u32x2){cur1.v2.x, cur1.v2.y}; *(u32x2*)(d + 16 * 68 + 4) = (u32x2){cur1.v2.z, cur1.v2.w};
              *(u32x2*)(d + 24 * 68) = (u32x2){cur1.v3.x, cur1.v3.y}; *(u32x2*)(d + 24 * 68 + 4) = (u32x2){cur1.v3.z, cur1.v3.w}; }
            const bf16x8 P0_ = attn_softmax_step(sA0, sB0, cb, cq, ncls, g, m[0], lsum[0], O[0]);
            const bf16x8 P1_ = attn_softmax_step(sA1, sB1, cb, cq, ncls, g, m[1], lsum[1], O[1]);
            LDS_FENCE();
#pragma unroll
            for (int nbk = 0; nbk < 4; ++nbk) { O[0][nbk] = MFMA16(gather8(Vs + (8 * g) * 68 + 16 * nbk, 68, qi), P0_, O[0][nbk]); O[1][nbk] = MFMA16(gather8(Vs1 + (8 * g) * 68 + 16 * nbk, 68, qi), P1_, O[1][nbk]); }
            cur0 = nxt0; cur1 = nxt1;
        }
        LDS_FENCE();
    }
    __syncthreads();
    attn_stage<400>(zq, head, Kt, Vt, P0 - 64, S, 0, 0, tid);
    __syncthreads();
#pragma unroll 1
    for (int i2 = 0; i2 < 12; ++i2) {
        attn_lds_step(Kt, Vt, rt[0] + 32 * i2, q0[0], q1[0], P0 + rt[0] - 64 + 32 * i2, P0 + rt[0] + 16 * qi, S, qi, g, m[0], lsum[0], O[0]);
        attn_lds_step(Kt, Vt, rt[1] + 32 * i2, q0[1], q1[1], P0 + rt[1] - 64 + 32 * i2, P0 + rt[1] + 16 * qi, S, qi, g, m[1], lsum[1], O[1]);
    }
#pragma unroll
    for (int rho = 0; rho < 2; ++rho) {
        __syncthreads();
        attn_stage<200>(zq, head, Kt, Vt, (P0 >> 2) - 64, S >> 2, 2 * rho, 2, tid);
        attn_stage<200>(zq, head, Kt + 200 * 72, Vt + 200 * 68, (P0 >> 2) - 64, S >> 2, 2 * rho + 1, 2, tid);
        __syncthreads();
        const int r = rt[rho], cls = (r & 3) - 2 * rho, c0 = (P0 >> 2) + (r >> 2);
#pragma unroll 2
        for (int i2 = 0; i2 < 6; ++i2)
            attn_lds_step(Kt + cls * 200 * 72, Vt + cls * 200 * 68, (r >> 2) + 32 * i2, q0[rho], q1[rho], c0 - 64 + 32 * i2, c0 + 4 * qi, S >> 2, qi, g, m[rho], lsum[rho], O[rho]);
    }
#pragma unroll
    for (int ti = 0; ti < 2; ++ti) {
        float l = lsum[ti]; l += __shfl_xor(l, 16); l += __shfl_xor(l, 32);
        const float inv = 1.0f / l;
        bf16_t* op = MIX + ((size_t)seq * S + P0 + rt[ti] + 16 * qi) * D + head * 64 + 4 * g;
#pragma unroll
        for (int nbk = 0; nbk < 4; ++nbk) st4_bf16(op + 16 * nbk, O[ti][nbk].x * inv, O[ti][nbk].y * inv, O[ti][nbk].z * inv, O[ti][nbk].w * inv);
    }
    __syncthreads();
}

__device__ __forceinline__ float h2f(unsigned short b) { return (float)__builtin_bit_cast(_Float16, b); }

template <int NROWS>
__device__ __forceinline__ void stage_v4(const bf16_t* __restrict__ Z, size_t tok0, int zc, bf16_t* Vt) {
    const int tid = opaque_tid();
    constexpr int IT = NROWS * 32 / NTHR;
    u32x4 v[IT];
#pragma unroll
    for (int u = 0; u < IT; ++u) { const int idx = tid + u * NTHR; const int t = idx >> 5, ch = idx & 31; v[u] = *(const u32x4*)(Z + (tok0 + t) * ZW + zc + ch * 8); }
#pragma unroll
    for (int u = 0; u < IT; ++u) { const int idx = tid + u * NTHR; const int t = idx >> 5, ch = idx & 31, hh = ch >> 3, c8 = ch & 7;
        bf16_t* d = Vt + ((size_t)hh * NROWS + t) * 68 + c8 * 8;
        *(u32x2*)d = (u32x2){v[u].x, v[u].y}; *(u32x2*)(d + 4) = (u32x2){v[u].z, v[u].w}; }
}

__device__ __forceinline__ void gla_cum(const bf16_t* __restrict__ Z, size_t tok0, int h, int dir, int lane, float (&cum)[32], float& tot) {
    const int kk = lane & 31, hf = lane >> 5;
    const bf16_t* src = Z + (tok0 + 32 * hf) * ZW + ZC_GF + dir * 128 + h * 32 + kk;
    float part = 0.f;
#pragma unroll
    for (int i = 0; i < 32; ++i) { cum[i] = h2f(src[(size_t)i * ZW]); part += cum[i]; }
    const float other = __shfl_xor(part, 32);
    tot = part + other;
    if (dir == 0) { float run = hf ? other : 0.f;
#pragma unroll
        for (int i = 0; i < 32; ++i) { run += cum[i]; cum[i] = run; } }
    else { float run = hf ? 0.f : other;
#pragma unroll
        for (int i = 31; i >= 0; --i) { run += cum[i]; cum[i] = run; } }
}

__device__ __forceinline__ void gla1_item(const bf16_t* __restrict__ Z, bf16_t* __restrict__ GS, float* __restrict__ GD, int ci) {
    const int tid = opaque_tid();
    __syncthreads();
    const int wave = tid >> 6, lane = tid & 63, qi = lane & 15, g = lane >> 4;
    const int h = wave >> 1, dir = wave & 1;
    const size_t tok0 = (size_t)ci * 64;
    bf16_t* Vt = (bf16_t*)g_lds;
    bf16_t* Ks = (bf16_t*)g_lds + 4 * 64 * 68 + wave * (64 * 36);
    stage_v4<64>(Z, tok0, ZC_BV, Vt);
    float cum[32], tot;
    gla_cum(Z, tok0, h, dir, lane, cum, tot);
    { const int kk = lane & 31, hf = lane >> 5;
      const bf16_t* ksrc = Z + (tok0 + 32 * hf) * ZW + ZC_BK + h * 32 + kk;
      unsigned short kraw[32];
#pragma unroll
      for (int i = 0; i < 32; ++i) kraw[i] = ksrc[(size_t)i * ZW];
#pragma unroll
      for (int i = 0; i < 32; ++i) { const float kv = bf2f(kraw[i]) * __expf(tot - cum[i]);
          Ks[(32 * hf + i) * 36 + kk] = (bf16_t)(cvt_pk_bf16(kv, 0.f) & 0xffffu); }
      if (hf == 0) GD[(((size_t)dir * NCH + ci) * 4 + h) * 32 + kk] = __expf(tot); }
    __syncthreads();
    f32x4 acc[4][2] = {};
#pragma unroll
    for (int ks = 0; ks < 2; ++ks) {
        bf16x8 bfr[2];
#pragma unroll
        for (int kb = 0; kb < 2; ++kb) bfr[kb] = gather8(Ks + (32 * ks + 8 * g) * 36 + 16 * kb , 36, qi);
#pragma unroll
        for (int eb = 0; eb < 4; ++eb) { const bf16x8 af = gather8(Vt + ((size_t)h * 64 + 32 * ks + 8 * g) * 68 + 16 * eb , 68, qi);
#pragma unroll
            for (int kb = 0; kb < 2; ++kb) acc[eb][kb] = MFMA16(bfr[kb], af, acc[eb][kb]); }
    }
    bf16_t* dst = GS + (((size_t)dir * NCH + ci) * 4 + h) * 2048;
#pragma unroll
    for (int eb = 0; eb < 4; ++eb)
#pragma unroll
        for (int kb = 0; kb < 2; ++kb) st4_bf16(dst + (16 * eb + qi) * 32 + 16 * kb + 4 * g, acc[eb][kb].x, acc[eb][kb].y, acc[eb][kb].z, acc[eb][kb].w);
    __syncthreads();
}

__device__ __forceinline__ void gla3_item(const bf16_t* __restrict__ Z, const bf16_t* __restrict__ GS, bf16_t* __restrict__ MIX, const float* __restrict__ gnorm, int ci) {
    const int tid = opaque_tid();
    __syncthreads();
    const int wave = tid >> 6, lane = tid & 63, qi = lane & 15, g = lane >> 4;
    const size_t tok0 = (size_t)ci * 64;
    bf16_t* Vt = (bf16_t*)g_lds;
    float* CUM = (float*)(g_lds + 4 * 64 * 68 * 2);
    stage_v4<64>(Z, tok0, ZC_BV, Vt);
    { const int h = wave >> 1, dir = wave & 1; float cum[32], tot;
      gla_cum(Z, tok0, h, dir, lane, cum, tot);
      const int kk = lane & 31, hf = lane >> 5; float* cd = CUM + ((size_t)(h * 2 + dir) * 64 + 32 * hf) * 32 + kk;
#pragma unroll
      for (int i = 0; i < 32; ++i) cd[i * 32] = cum[i]; }
    __syncthreads();
    const int h = wave >> 1;
    const float* cF = CUM + (size_t)(h * 2 + 0) * 64 * 32; const float* cB = CUM + (size_t)(h * 2 + 1) * 64 * 32;
    const bf16_t* sF = GS + (((size_t)0 * NCH + ci) * 4 + h) * 2048; const bf16_t* sB = GS + (((size_t)1 * NCH + ci) * 4 + h) * 2048;
    bf16x8 SFf[4], SBf[4];
#pragma unroll
    for (int eb = 0; eb < 4; ++eb) { SFf[eb] = *(const bf16x8*)(sF + (16 * eb + qi) * 32 + 8 * g); SBf[eb] = *(const bf16x8*)(sB + (16 * eb + qi) * 32 + 8 * g); }
    bf16x8 KFf[2][2], KBf[2][2];
#pragma unroll
    for (int sg = 0; sg < 2; ++sg)
#pragma unroll
        for (int blk = 0; blk < 2; ++blk) {
            const int s = 32 * sg + 8 * (qi >> 2) + (qi & 3) + 4 * blk;
            float kv[8], a[8], b[8]; unpack8(*(const bf16x8*)(Z + (tok0 + s) * ZW + ZC_BK + h * 32 + 8 * g), kv);
#pragma unroll
            for (int j = 0; j < 8; ++j) { a[j] = kv[j] * __expf(-cF[s * 32 + 8 * g + j]); b[j] = kv[j] * __expf(-cB[s * 32 + 8 * g + j]); }
            KFf[sg][blk] = pack8(a); KBf[sg][blk] = pack8(b);
        }
#pragma unroll 1
    for (int tbi = 0; tbi < 2; ++tbi) {
        const int t = 16 * (2 * (wave & 1) + tbi) + qi;
        bf16x8 Qf, Qb;
        { float qv[8], a[8], b[8]; unpack8(*(const bf16x8*)(Z + (tok0 + t) * ZW + ZC_BQ + h * 32 + 8 * g), qv);
#pragma unroll
          for (int j = 0; j < 8; ++j) { a[j] = qv[j] * __expf(cF[t * 32 + 8 * g + j]); b[j] = qv[j] * __expf(cB[t * 32 + 8 * g + j]); }
          Qf = pack8(a); Qb = pack8(b); }
        f32x4 acc[4] = {};
#pragma unroll
        for (int eb = 0; eb < 4; ++eb) { acc[eb] = MFMA16(SFf[eb], Qf, acc[eb]); acc[eb] = MFMA16(SBf[eb], Qb, acc[eb]); }
#pragma unroll
        for (int sg = 0; sg < 2; ++sg) {
            f32x4 aF[2], aB[2];
#pragma unroll
            for (int blk = 0; blk < 2; ++blk) {
                const f32x4 z4 = {0.f, 0.f, 0.f, 0.f};
                aF[blk] = MFMA16(KFf[sg][blk], Qf, z4); aB[blk] = MFMA16(KBf[sg][blk], Qb, z4);
            }
            float pj[8];
#pragma unroll
            for (int j = 0; j < 8; ++j) { const int s = 32 * sg + 8 * g + j; pj[j] = (s <= t) ? (j < 4 ? aF[0][j] : aF[1][j - 4]) : (j < 4 ? aB[0][j] : aB[1][j - 4]); }
            const bf16x8 P = pack8(pj);
#pragma unroll
            for (int eb = 0; eb < 4; ++eb) acc[eb] = MFMA16(gather8(Vt + ((size_t)h * 64 + 32 * sg + 8 * g) * 68 + 16 * eb , 68, qi), P, acc[eb]);
        }
        float ss = 0.f;
#pragma unroll
        for (int eb = 0; eb < 4; ++eb) ss += (acc[eb].x * acc[eb].x + acc[eb].y * acc[eb].y) + (acc[eb].z * acc[eb].z + acc[eb].w * acc[eb].w);
        ss += __shfl_xor(ss, 16); ss += __shfl_xor(ss, 32);
        const float rn = rsqrtf(ss * (1.0f / 64) + EPS);
        u32x2 brw4[4]; f32x4 gn4[4];
#pragma unroll
        for (int eb = 0; eb < 4; ++eb) { const int e = 16 * eb + 4 * g; brw4[eb] = *(const u32x2*)(Z + (tok0 + t) * ZW + ZC_BR + h * 64 + e); gn4[eb] = *(const f32x4*)(gnorm + h * 64 + e); }
#pragma unroll
        for (int eb = 0; eb < 4; ++eb) { const int e = 16 * eb + 4 * g;
            const u32x2 brw = brw4[eb]; const f32x4 gn = gn4[eb];
            const float b0 = bflo(brw.x), b1 = bfhi(brw.x), b2 = bflo(brw.y), b3 = bfhi(brw.y);
            const float o0 = acc[eb].x * rn * gn.x * (b0 / (1.f + __expf(-b0))), o1 = acc[eb].y * rn * gn.y * (b1 / (1.f + __expf(-b1)));
            const float o2 = acc[eb].z * rn * gn.z * (b2 / (1.f + __expf(-b2))), o3 = acc[eb].w * rn * gn.w * (b3 / (1.f + __expf(-b3)));
            u32x2 w; w.x = cvt_pk_bf16(o0, o1); w.y = cvt_pk_bf16(o2, o3);
            *(u32x2*)(MIX + (tok0 + t) * D + 512 + h * 64 + e) = w; }
    }
    __syncthreads();
}

__device__ __forceinline__ void ret1_item(const bf16_t* __restrict__ Z, bf16_t* __restrict__ RS, const float* __restrict__ lgam, int item) {
    const int tid = opaque_tid();
    __syncthreads();
    const int wave = tid >> 6, lane = tid & 63, qi = lane & 15, g = lane >> 4;
    const int ci = item >> 1, hp = item & 1;
    const size_t tok0 = (size_t)ci * 128;
    bf16_t* Vt = (bf16_t*)g_lds;
    bf16_t* Kt = Vt + 2 * 128 * 68;
    { u32x4 v[8];
#pragma unroll
      for (int u = 0; u < 8; ++u) { const int idx = tid + u * NTHR; const int which = idx >> 11, r = idx & 2047, t = r >> 4, ch = r & 15;
          v[u] = *(const u32x4*)(Z + (tok0 + t) * ZW + (which ? ZC_CK : ZC_CV) + hp * 128 + ch * 8); }
#pragma unroll
      for (int u = 0; u < 8; ++u) { const int idx = tid + u * NTHR; const int which = idx >> 11, r = idx & 2047, t = r >> 4, ch = r & 15, hh = ch >> 3, c8 = ch & 7;
          bf16_t* d = (which ? Kt : Vt) + ((size_t)hh * 128 + t) * 68 + c8 * 8;
          *(u32x2*)d = (u32x2){v[u].x, v[u].y}; *(u32x2*)(d + 4) = (u32x2){v[u].z, v[u].w}; } }
    __syncthreads();
    const int hh = wave >> 2, dir = (wave >> 1) & 1, eh = wave & 1, head = 2 * hp + hh;
    const float lg = lgam[dir * 4 + head];
    f32x4 acc[2][4] = {};
#pragma unroll 1
    for (int ks = 0; ks < 4; ++ks) {
        float w[8];
#pragma unroll
        for (int j = 0; j < 8; ++j) { const int s = 32 * ks + 8 * g + j; w[j] = __expf(lg * (float)(dir ? s : 127 - s)); }
        bf16x8 bfr[4];
#pragma unroll
        for (int db = 0; db < 4; ++db) { float kv[8]; unpack8(gather8(Kt + ((size_t)hh * 128 + 32 * ks + 8 * g) * 68 + 16 * db , 68, qi), kv);
#pragma unroll
            for (int j = 0; j < 8; ++j) kv[j] *= w[j];
            bfr[db] = pack8(kv); }
#pragma unroll
        for (int ebi = 0; ebi < 2; ++ebi) { const bf16x8 af = gather8(Vt + ((size_t)hh * 128 + 32 * ks + 8 * g) * 68 + 16 * (2 * eh + ebi) , 68, qi);
#pragma unroll
            for (int db = 0; db < 4; ++db) acc[ebi][db] = MFMA16(bfr[db], af, acc[ebi][db]); }
    }
    bf16_t* dst = RS + (((size_t)dir * NCR + ci) * 4 + head) * 4096;
#pragma unroll
    for (int ebi = 0; ebi < 2; ++ebi)
#pragma unroll
        for (int db = 0; db < 4; ++db) st4_bf16(dst + (16 * (2 * eh + ebi) + qi) * 64 + 16 * db + 4 * g, acc[ebi][db].x, acc[ebi][db].y, acc[ebi][db].z, acc[ebi][db].w);
    __syncthreads();
}

__device__ __forceinline__ void ret3_item(const bf16_t* __restrict__ Z, const bf16_t* __restrict__ RS, bf16_t* __restrict__ MIX, const float* __restrict__ rnorm, const float* __restrict__ lgam, int ci) {
    const int tid = opaque_tid();
    __syncthreads();
    const int wave = tid >> 6, lane = tid & 63, qi = lane & 15, g = lane >> 4;
    const size_t tok0 = (size_t)ci * 128;
    bf16_t* Vt = (bf16_t*)g_lds;
    stage_v4<128>(Z, tok0, ZC_CV, Vt);
    __syncthreads();
    const int h = wave >> 1;
    const float lg0 = lgam[h], lg1 = lgam[4 + h];
    const bf16_t* rF = RS + (((size_t)0 * NCR + ci) * 4 + h) * 4096; const bf16_t* rB = RS + (((size_t)1 * NCR + ci) * 4 + h) * 4096;
    bf16x8 RF[4][2], RB[4][2];
#pragma unroll
    for (int eb = 0; eb < 4; ++eb) { const bf16_t* pf = rF + (16 * eb + qi) * 64 + 8 * g; const bf16_t* pb = rB + (16 * eb + qi) * 64 + 8 * g;
        RF[eb][0] = *(const bf16x8*)pf; RF[eb][1] = *(const bf16x8*)(pf + 32); RB[eb][0] = *(const bf16x8*)pb; RB[eb][1] = *(const bf16x8*)(pb + 32); }
#pragma unroll 1
    for (int tbi = 0; tbi < 4; ++tbi) {
        const int t = 16 * (4 * (wave & 1) + tbi) + qi;
        const bf16_t* qp = Z + (tok0 + t) * ZW + ZC_CQ + h * 64 + 8 * g;
        const bf16x8 q0 = *(const bf16x8*)qp, q1 = *(const bf16x8*)(qp + 32);
        f32x4 aI[4] = {}, aF[4] = {}, aB[4] = {};
#pragma unroll
        for (int eb = 0; eb < 4; ++eb) {
            aF[eb] = MFMA16(RF[eb][0], q0, aF[eb]); aF[eb] = MFMA16(RF[eb][1], q1, aF[eb]);
            aB[eb] = MFMA16(RB[eb][0], q0, aB[eb]); aB[eb] = MFMA16(RB[eb][1], q1, aB[eb]);
        }
#pragma unroll 1
        for (int sg = 0; sg < 4; ++sg) {
            f32x4 sc[2];
#pragma unroll
            for (int blk = 0; blk < 2; ++blk) {
                const int s = 32 * sg + 8 * (qi >> 2) + (qi & 3) + 4 * blk;
                const bf16_t* kp = Z + (tok0 + s) * ZW + ZC_CK + h * 64 + 8 * g;
                f32x4 z4 = {0.f, 0.f, 0.f, 0.f};
                z4 = MFMA16(*(const bf16x8*)kp, q0, z4); z4 = MFMA16(*(const bf16x8*)(kp + 32), q1, z4); sc[blk] = z4;
            }
            float pj[8];
#pragma unroll
            for (int j = 0; j < 8; ++j) { const int s = 32 * sg + 8 * g + j; const int dd = t - s;
                const float dec = (dd >= 0) ? __expf(lg0 * (float)dd) : __expf(lg1 * (float)(-dd));
                pj[j] = (j < 4 ? sc[0][j] : sc[1][j - 4]) * dec; }
            const bf16x8 P = pack8(pj);
#pragma unroll
            for (int eb = 0; eb < 4; ++eb) aI[eb] = MFMA16(gather8(Vt + ((size_t)h * 128 + 32 * sg + 8 * g) * 68 + 16 * eb , 68, qi), P, aI[eb]);
        }
        const float wf = __expf(lg0 * (float)(t + 1)), wb = __expf(lg1 * (float)(128 - t));
        float ss = 0.f;
#pragma unroll
        for (int eb = 0; eb < 4; ++eb) { aI[eb] = aI[eb] + aF[eb] * wf + aB[eb] * wb;
            ss += (aI[eb].x * aI[eb].x + aI[eb].y * aI[eb].y) + (aI[eb].z * aI[eb].z + aI[eb].w * aI[eb].w); }
        ss += __shfl_xor(ss, 16); ss += __shfl_xor(ss, 32);
        const float rn = rsqrtf(ss * (1.0f / 64) + EPS);
        u32x2 gw4[4]; f32x4 gn4[4];
#pragma unroll
        for (int eb = 0; eb < 4; ++eb) { const int e = 16 * eb + 4 * g; gw4[eb] = *(const u32x2*)(Z + (tok0 + t) * ZW + ZC_CG + h * 64 + e); gn4[eb] = *(const f32x4*)(rnorm + h * 64 + e); }
#pragma unroll
        for (int eb = 0; eb < 4; ++eb) { const int e = 16 * eb + 4 * g;
            const u32x2 gw = gw4[eb]; const f32x4 gn = gn4[eb];
            const float b0 = bflo(gw.x), b1 = bfhi(gw.x), b2 = bflo(gw.y), b3 = bfhi(gw.y);
            const float o0 = aI[eb].x * rn * gn.x * (b0 / (1.f + __expf(-b0))), o1 = aI[eb].y * rn * gn.y * (b1 / (1.f + __expf(-b1)));
            const float o2 = aI[eb].z * rn * gn.z * (b2 / (1.f + __expf(-b2))), o3 = aI[eb].w * rn * gn.w * (b3 / (1.f + __expf(-b3)));
            u32x2 w; w.x = cvt_pk_bf16(o0, o1); w.y = cvt_pk_bf16(o2, o3);
            *(u32x2*)(MIX + (tok0 + t) * D + 768 + h * 64 + e) = w; }
    }
    __syncthreads();
}

__device__ __forceinline__ void phase_scan(bf16_t* __restrict__ GS, const float* __restrict__ GD, bf16_t* __restrict__ RS, const float* __restrict__ lgam, int S) {
    const int tid = opaque_tid();
    const int lgn = (S == 16384) ? 1 : 4, nseq = 1 << lgn, ncg = S / 64, ncr = S / 128;
    const int gtid = blockIdx.x * NTHR + tid, gth = gridDim.x * NTHR;
    const int n_gla = 2 * nseq * 4 * 1024, n_ret = 2 * nseq * 4 * 2048;
    constexpr int SB_ = 16;
    for (int idx = gtid; idx < n_gla + n_ret; idx += gth) {
        if (idx < n_gla) {
            const int el = 2 * (idx & 1023), hh = (idx >> 10) & 3, sq = (idx >> 12) & (nseq - 1), dir = (idx >> 12) >> lgn, kk = el & 31;
            const size_t cstr = (size_t)4 * 2048;
            unsigned* base = (unsigned*)(GS + (((size_t)dir * NCH + (size_t)sq * ncg) * 4 + hh) * 2048 + el);
            const float* dbase = GD + (((size_t)dir * NCH + (size_t)sq * ncg) * 4 + hh) * 32 + kk;
            const long step = dir ? -1 : 1; const long c0 = dir ? ncg - 1 : 0;
            unsigned cur[SB_], nxt[SB_]; f32x2_t dcur[SB_], dnxt[SB_];
#pragma unroll
            for (int u = 0; u < SB_; ++u) { const long c = c0 + step * u; cur[u] = *(const unsigned*)((const bf16_t*)base + c * (long)cstr); dcur[u] = *(const f32x2_t*)(dbase + c * 128); }
            float s0 = 0.f, s1 = 0.f;
#pragma unroll 1
            for (int i0 = 0; i0 < ncg; i0 += SB_) {
                const bool more = i0 + SB_ < ncg;
#pragma unroll
                for (int u = 0; u < SB_; ++u) { const long c = c0 + step * (more ? i0 + SB_ + u : i0 + u); nxt[u] = *(const unsigned*)((const bf16_t*)base + c * (long)cstr); dnxt[u] = *(const f32x2_t*)(dbase + c * 128); }
#pragma unroll
                for (int u = 0; u < SB_; ++u) { const long c = c0 + step * (i0 + u);
                    *(unsigned*)((bf16_t*)base + c * (long)cstr) = cvt_pk_bf16(s0, s1); s0 = dcur[u].x * s0 + bflo(cur[u]); s1 = dcur[u].y * s1 + bfhi(cur[u]); }
#pragma unroll
                for (int u = 0; u < SB_; ++u) { cur[u] = nxt[u]; dcur[u] = dnxt[u]; }
            }
        } else {
            const int j = idx - n_gla; const int el = 2 * (j & 2047), hh = (j >> 11) & 3, sq = (j >> 13) & (nseq - 1), dir = (j >> 13) >> lgn;
            const float dec = __expf(128.f * lgam[dir * 4 + hh]);
            const size_t cstr = (size_t)4 * 4096;
            unsigned* base = (unsigned*)(RS + (((size_t)dir * NCR + (size_t)sq * ncr) * 4 + hh) * 4096 + el);
            const long step = dir ? -1 : 1; const long c0 = dir ? ncr - 1 : 0;
            unsigned cur[SB_], nxt[SB_];
#pragma unroll
            for (int u = 0; u < SB_; ++u) { const long c = c0 + step * u; cur[u] = *(const unsigned*)((const bf16_t*)base + c * (long)cstr); }
            float s0 = 0.f, s1 = 0.f;
#pragma unroll 1
            for (int i0 = 0; i0 < ncr; i0 += SB_) {
                const bool more = i0 + SB_ < ncr;
#pragma unroll
                for (int u = 0; u < SB_; ++u) { const long c = c0 + step * (more ? i0 + SB_ + u : i0 + u); nxt[u] = *(const unsigned*)((const bf16_t*)base + c * (long)cstr); }
#pragma unroll
                for (int u = 0; u < SB_; ++u) { const long c = c0 + step * (i0 + u);
                    *(unsigned*)((bf16_t*)base + c * (long)cstr) = cvt_pk_bf16(s0, s1); s0 = dec * s0 + bflo(cur[u]); s1 = dec * s1 + bfhi(cur[u]); }
#pragma unroll
                for (int u = 0; u < SB_; ++u) cur[u] = nxt[u];
            }
        }
    }
}

#define XB_TMO      128
#define XB_XCNT(j)  (256  + 64 * (j))
#define XB_XSUB(j)  (1280 + 64 * (j))
#define XB_XGEN(j)  (2304 + 64 * (j))
#define XB_TOP      3328
#define XB_TOPGEN   3392
#define XCD_BAR_WORDS 3456
#define XB_SPIN_CAP (1u << 22)
#define LAS __attribute__((address_space(3)))
__device__ __forceinline__ unsigned xb_ld(unsigned* p)              { return __hip_atomic_load(p, __ATOMIC_RELAXED, __HIP_MEMORY_SCOPE_AGENT); }
__device__ __forceinline__ unsigned xb_add(unsigned* p, unsigned v) { return __hip_atomic_fetch_add(p, v, __ATOMIC_RELAXED, __HIP_MEMORY_SCOPE_AGENT); }
__device__ __forceinline__ unsigned xb_xcc_id() { return (unsigned)__builtin_amdgcn_s_getreg((3 << 11) | 20) & 0xFu; }
#define XB_SPIN(cond, bar) do { unsigned _sp = 0; while (cond) { __builtin_amdgcn_s_sleep(1); \
    if ((++_sp & 255u) == 0u) { if (xb_ld(&(bar)[XB_TMO])) break; if (_sp > XB_SPIN_CAP) { atomicAdd(&(bar)[XB_TMO], 1u); break; } } } } while (0)
struct XcdBarrier { unsigned* bar; unsigned x; volatile LAS unsigned* st; };
__device__ __forceinline__ XcdBarrier xcd_barrier_post(unsigned* bar, volatile LAS unsigned* st) {
    XcdBarrier b; b.bar = bar; b.x = xb_xcc_id(); b.st = st;
    if (threadIdx.x == 0) (void)xb_add(&bar[XB_XCNT(b.x)], 1u);
    return b;
}
__device__ __forceinline__ void xcd_barrier_complete(unsigned* bar, unsigned x, unsigned& nloc, unsigned& nx) {
    const unsigned G = gridDim.x * gridDim.y * gridDim.z;
    unsigned sum, cnt, mine, sp = 0u;
    for (;;) {
        sum = 0u; cnt = 0u; mine = 0u;
#pragma unroll
        for (unsigned j = 0; j < 16; ++j) { const unsigned c = xb_ld(&bar[XB_XCNT(j)]); sum += c; cnt += (c > 0u) ? 1u : 0u; mine = (j == x) ? c : mine; }
        if (sum == G) break;
        __builtin_amdgcn_s_sleep(1);
        if ((++sp & 255u) == 0u) { if (xb_ld(&bar[XB_TMO])) break; if (sp > XB_SPIN_CAP) { atomicAdd(&bar[XB_TMO], 1u); break; } }
    }
    nloc = mine > 0u ? mine : 1u; nx = cnt > 0u ? cnt : 1u;
}
__device__ __forceinline__ void xcd_barrier(const XcdBarrier& b) {
    asm volatile("s_waitcnt vmcnt(0)" ::: "memory");
    __syncthreads();
    if (threadIdx.x == 0) {
        unsigned* bar = b.bar;
        __builtin_amdgcn_s_waitcnt(0);
        unsigned nloc = b.st[0], nx = b.st[1];
        if (nloc == 0u) { xcd_barrier_complete(bar, b.x, nloc, nx); b.st[0] = nloc; b.st[1] = nx; }
        const unsigned old = xb_add(&bar[XB_XSUB(b.x)], 1u);
        const unsigned gen = old / nloc;
        if (old + 1u == (gen + 1u) * nloc) {
            __builtin_amdgcn_fence(__ATOMIC_RELEASE, "agent");
            asm volatile("s_waitcnt vmcnt(0)" ::: "memory");
            const unsigned og = xb_add(&bar[XB_TOP], 1u);
            const unsigned tg = og / nx;
            if (og + 1u == (tg + 1u) * nx) xb_add(&bar[XB_TOPGEN], 1u);
            else XB_SPIN(xb_ld(&bar[XB_TOPGEN]) == tg, bar);
            __builtin_amdgcn_fence(__ATOMIC_ACQUIRE, "agent");
            xb_add(&bar[XB_XGEN(b.x)], 1u);
            asm volatile("s_waitcnt vmcnt(0)" ::: "memory");
        } else {
            XB_SPIN(xb_ld(&bar[XB_XGEN(b.x)]) == gen, bar);
            __builtin_amdgcn_fence(__ATOMIC_ACQUIRE, "agent");
            asm volatile("s_waitcnt vmcnt(0)" ::: "memory");
        }
    }
    __syncthreads();
}

__global__ void __launch_bounds__(NTHR, 2) fwd_mega(Params p) {
    cg::grid_group grid = cg::this_grid();
    unsigned char* ws = p.ws;
    bf16_t* WT = (bf16_t*)(ws + WS_WT); const float* tab = (const float*)(ws + WS_TAB);
    bf16_t* HB0 = (bf16_t*)(ws + WS_HB); bf16_t* HB1 = (bf16_t*)(ws + WS_HB1);
    float* SSQ0 = (float*)(ws + WS_SSQ); float* SSQ1 = SSQ0 + (size_t)MG * 16; float* SSQ2 = SSQ1 + (size_t)MG * 16;
    bf16_t* Z = (bf16_t*)(ws + WS_Z); bf16_t* MIX = (bf16_t*)(ws + WS_MIX); bf16_t* HID = (bf16_t*)(ws + WS_HID);
    bf16_t* PB = (bf16_t*)(ws + WS_PB); bf16_t* PL = (bf16_t*)(ws + WS_PLE);
    bf16_t* GS = (bf16_t*)(ws + WS_GS); float* GD = (float*)(ws + WS_GD); bf16_t* RS = (bf16_t*)(ws + WS_RS);
    float* lgam = (float*)(g_lds + LDS_BYTES - 64);

#ifndef NO_P0
    phase_weights(p);
#endif
    unsigned* barw = (unsigned*)(ws + WS_BAR);
    volatile LAS unsigned* bst = (volatile LAS unsigned*)(g_lds + LDS_BYTES - 32);
    if (blockIdx.x == 0) for (int i = threadIdx.x; i < XCD_BAR_WORDS; i += NTHR) barw[i] = 0u;
    if (threadIdx.x < 2) bst[threadIdx.x] = 0u;
    grid.sync();
    const XcdBarrier xb = xcd_barrier_post(barw, bst);
#pragma unroll 1
    for (int g = 0; g < NGROUPS; ++g) {
        const int S = (g == 0) ? 16384 : 2048;
        float* H = p.out + (size_t)g * MG * D;
#ifndef NO_PI
        phase_init(p, g);
#endif
        xcd_barrier(xb);
#pragma unroll 1
        for (int l = 0; l < NLAYER; ++l) {
            const bf16_t* W = WT + (size_t)l * W_LAYER;
            { const int t8 = opaque_tid(); if (t8 < 8) { const float x = p.ret_decay_raw[l * 8 + t8]; lgam[t8] = fminf(x, 0.f) - __logf(1.0f + __expf(-fabsf(x))); } }
            __syncthreads();
            { EpiIn e{Z, SSQ0, p.attn_q_norm + l * 64, p.attn_k_norm + l * 64, p.gla_gate_bias + l * 256, tab, S - 1};
#ifndef NO_P1
#ifndef REP_P1
#define REP_P1 1
#endif
              gemm_phase(HB0, D, W + WO_IN, D, MG, ZW, D, e);
#if REP_P1 > 1
              xcd_barrier(xb); gemm_phase(HB0, D, W + WO_IN, D, MG, ZW, D, e);
#endif
#endif
 }
            xcd_barrier(xb);
#ifndef REP_MIX
#define REP_MIX 1
#endif
            for (int rep_mix = 0; rep_mix < REP_MIX; ++rep_mix) {
            { const int nA = 1024, nG = NCH, nR = 2 * NCR;
#ifndef NO_AT
              if ((gridDim.x & 7) == 0) {
                  const int per = nA / 8, slots = gridDim.x / 8;
                  for (int k = blockIdx.x / 8; k < per; k += slots) attn_item(Z, MIX, S, per * (blockIdx.x & 7) + k);
              } else { for (int it = blockIdx.x; it < nA; it += gridDim.x) attn_item(Z, MIX, S, it); }
#endif
              for (int it = nA + blockIdx.x; it < nA + nG + nR; it += gridDim.x) {
#ifndef NO_G1
                  if (it >= nA && it < nA + nG) gla1_item(Z, GS, GD, it - nA);
#endif
#ifndef NO_R1
                  if (it >= nA + nG) ret1_item(Z, RS, lgam, it - nA - nG);
#endif
              } }
            xcd_barrier(xb);
#ifndef NO_P3
            phase_scan(GS, GD, RS, lgam, S);
#endif
            xcd_barrier(xb);
            { for (int it = blockIdx.x; it < NCH + NCR; it += gridDim.x) {
#ifndef NO_G3
                  if (it < NCH) gla3_item(Z, GS, MIX, p.gla_out_norm + l * 256, it);
#endif
#ifndef NO_R3
                  if (it >= NCH) ret3_item(Z, RS, MIX, p.ret_out_norm + l * 256, lgam, it - NCH);
#endif
              } }
            xcd_barrier(xb);
            }
#ifndef NO_P5
            { EpiRes e{HB0, HB1, SSQ1}; gemm_phase(MIX, D, W + WO_OUT, D, MG, D, D, e); }
#endif
            xcd_barrier(xb);
#ifndef NO_P6
            { EpiMlpIn e{HID, SSQ1}; gemm_phase_t<true>(HB1, D, W + WO_MI, D, MG, DFF, D, e); }
#endif
#ifndef NO_P6B
            { EpiPlain e{PB, D}; gemm_phase(PL + (size_t)l * MG * PLE, PLE, W + WO_PP, PLE, MG, D, PLE, e); }
#endif
            xcd_barrier(xb);
#ifndef NO_P7
            { EpiRes e{HB1, HB1, SSQ2}; gemm_phase(HID, DFF, W + WO_MO, DFF, MG, D, DFF, e); }
#endif
            xcd_barrier(xb);
#ifndef NO_P9
            { EpiPeGate e{H, HB1, HB0, SSQ0, SSQ2, PB, l == NLAYER - 1}; gemm_phase(HB1, D, W + WO_PG, D, MG, D, D, e); }
#endif
            xcd_barrier(xb);
        }
    }
}

extern "C" void kernel_launch(void* const* d_in, const int* in_sizes, int n_in, void* d_out, int out_size, void* d_ws, size_t ws_size, hipStream_t stream) {
    static int grid_blocks = 0;
    if (!grid_blocks) {
        int dev = 0, cus = 0, per_cu = 0;
        hipGetDevice(&dev);
        hipDeviceGetAttribute(&cus, hipDeviceAttributeMultiprocessorCount, dev);
        hipFuncSetAttribute((const void*)fwd_mega, hipFuncAttributeMaxDynamicSharedMemorySize, LDS_BYTES);
        hipOccupancyMaxActiveBlocksPerMultiprocessor(&per_cu, (const void*)fwd_mega, NTHR, LDS_BYTES);
        if (per_cu < 1) per_cu = 1;
        grid_blocks = cus * 1;
        if (ws_size < WS_END) fprintf(stderr, "kernel_launch: workspace too small: %zu < %zu\n", ws_size, (size_t)WS_END);
    }
    Params p{};
    p.x_prompt = (const float*)d_in[0]; p.x_sample = (const float*)d_in[1]; p.p_prompt = (const float*)d_in[2]; p.p_sample = (const float*)d_in[3];
    p.ln_mix = (const float*)d_in[4]; p.w_in = (const float*)d_in[5]; p.attn_q_norm = (const float*)d_in[6]; p.attn_k_norm = (const float*)d_in[7];
    p.gla_gate_up = (const float*)d_in[8]; p.gla_gate_bias = (const float*)d_in[9]; p.gla_out_norm = (const float*)d_in[10]; p.ret_decay_raw = (const float*)d_in[11];
    p.ret_out_norm = (const float*)d_in[12]; p.w_out = (const float*)d_in[13]; p.ln_mlp = (const float*)d_in[14]; p.w_mlp_in = (const float*)d_in[15]; p.w_mlp_out = (const float*)d_in[16];
    p.ln_pe = (const float*)d_in[17]; p.w_pe_gate = (const float*)d_in[18]; p.w_pe_proj = (const float*)d_in[19];
    p.out = (float*)d_out; p.ws = (unsigned char*)d_ws;
    void* args[] = {&p};
    hipError_t e = hipLaunchCooperativeKernel((const void*)fwd_mega, dim3(grid_blocks), dim3(NTHR), args, LDS_BYTES, stream);
    if (e != hipSuccess) fprintf(stderr, "cooperative launch failed: %s (grid %d)\n", hipGetErrorString(e), grid_blocks);
}
```

```cpp
#include <hip/hip_runtime.h>
#include <hip/hip_cooperative_groups.h>
#include <cstdio>
#include <cstdint>
namespace cg = cooperative_groups;

typedef unsigned short bf16_t;
typedef short bf16x8 __attribute__((ext_vector_type(8)));
typedef float f32x4 __attribute__((ext_vector_type(4)));
typedef unsigned u32x4 __attribute__((ext_vector_type(4)));
typedef unsigned u32x2 __attribute__((ext_vector_type(2)));

constexpr int D = 1024, MG = 32768, NGROUPS = 3, NLAYER = 2;
constexpr int ZW = 3584, DFF = 4096, PLE = 256, NIN = 3360;
constexpr int NTHR = 512;
constexpr int NCH = MG / 64;
constexpr int NCR = MG / 128;
constexpr float EPS = 1e-6f;
constexpr int ZC_AQ = 0, ZC_AK = 512, ZC_AV = 1024, ZC_BQ = 1536, ZC_BK = 1664, ZC_BV = 1792, ZC_BR = 2048,
              ZC_GF = 2304, ZC_GB = 2432, ZC_CQ = 2560, ZC_CK = 2816, ZC_CV = 3072, ZC_CG = 3328;
constexpr size_t WO_IN = 0, WO_OUT = WO_IN + (size_t)ZW * D, WO_MI = WO_OUT + (size_t)D * D, WO_MO = WO_MI + (size_t)DFF * D,
                 WO_PG = WO_MO + (size_t)D * DFF, WO_PP = WO_PG + (size_t)D * D, W_LAYER = WO_PP + (size_t)D * PLE;
constexpr size_t WS_WT = 0;
constexpr size_t WS_TAB = WS_WT + W_LAYER * 2 * NLAYER;
constexpr size_t WS_HB = WS_TAB + (size_t)16384 * 40 * 2 * 4;
constexpr size_t WS_HB1 = WS_HB + (size_t)MG * D * 2;
constexpr size_t WS_SSQ = WS_HB1 + (size_t)MG * D * 2;
constexpr size_t WS_Z = WS_SSQ + (size_t)3 * MG * 16 * 4;
constexpr size_t WS_MIX = WS_Z + (size_t)MG * ZW * 2;
constexpr size_t WS_HID = WS_MIX + (size_t)MG * D * 2;
constexpr size_t WS_PB = WS_HID + (size_t)MG * DFF * 2;
constexpr size_t WS_PLE = WS_PB + (size_t)MG * D * 2;
constexpr size_t WS_GS = WS_PLE + (size_t)NLAYER * MG * PLE * 2;
constexpr size_t WS_GD = WS_GS + (size_t)2 * NCH * 4 * 2048 * 4;
constexpr size_t WS_RS = WS_GD + (size_t)2 * NCH * 4 * 32 * 4;
constexpr size_t WS_BAR = WS_RS + (size_t)2 * NCR * 4 * 4096 * 4;
constexpr size_t WS_END = WS_BAR + 16384;

constexpr int LDS_BYTES = 139264;

extern __shared__ __attribute__((aligned(16))) unsigned char g_lds[];

struct Params {
    const float* x_prompt; const float* x_sample; const float* p_prompt; const float* p_sample;
    const float* ln_mix; const float* w_in; const float* attn_q_norm; const float* attn_k_norm;
    const float* gla_gate_up; const float* gla_gate_bias; const float* gla_out_norm; const float* ret_decay_raw;
    const float* ret_out_norm; const float* w_out; const float* ln_mlp; const float* w_mlp_in; const float* w_mlp_out;
    const float* ln_pe; const float* w_pe_gate; const float* w_pe_proj;
    float* out; unsigned char* ws;
};

typedef float f32x2_t __attribute__((ext_vector_type(2)));
typedef __bf16 bf16x2_t __attribute__((ext_vector_type(2)));
__device__ __forceinline__ unsigned cvt_pk_bf16(float lo, float hi) { const f32x2_t v = {lo, hi}; return __builtin_bit_cast(unsigned, __builtin_convertvector(v, bf16x2_t)); }
__device__ __forceinline__ float bf2f(unsigned short b) { return __uint_as_float(((unsigned)b) << 16); }
__device__ __forceinline__ float bflo(unsigned w) { return __uint_as_float(w << 16); }
__device__ __forceinline__ float bfhi(unsigned w) { return __uint_as_float(w & 0xffff0000u); }
__device__ __forceinline__ bf16x8 pack8(const float (&v)[8]) {
    u32x4 w; w.x = cvt_pk_bf16(v[0], v[1]); w.y = cvt_pk_bf16(v[2], v[3]); w.z = cvt_pk_bf16(v[4], v[5]); w.w = cvt_pk_bf16(v[6], v[7]);
    return __builtin_bit_cast(bf16x8, w);
}
__device__ __forceinline__ void unpack8(bf16x8 b, float (&v)[8]) {
    u32x4 w = __builtin_bit_cast(u32x4, b);
    v[0] = bflo(w.x); v[1] = bfhi(w.x); v[2] = bflo(w.y); v[3] = bfhi(w.y); v[4] = bflo(w.z); v[5] = bfhi(w.z); v[6] = bflo(w.w); v[7] = bfhi(w.w);
}
typedef short v4i16_t __attribute__((ext_vector_type(4)));
__device__ __forceinline__ bf16x8 gather8(const bf16_t* tile  , int stride, int qi) {
    const bf16_t* p = tile + (qi >> 2) * stride + 4 * (qi & 3);
    const v4i16_t lo = __builtin_amdgcn_ds_read_tr16_b64_v4i16((__attribute__((address_space(3))) v4i16_t*)p);
    const v4i16_t hi = __builtin_amdgcn_ds_read_tr16_b64_v4i16((__attribute__((address_space(3))) v4i16_t*)(p + 4 * stride));
    bf16x8 r; r[0] = lo[0]; r[1] = lo[1]; r[2] = lo[2]; r[3] = lo[3]; r[4] = hi[0]; r[5] = hi[1]; r[6] = hi[2]; r[7] = hi[3];
    return r;
}
__device__ __forceinline__ bf16x8 ld8f_pack(const float* p) {
    f32x4 a = *(const f32x4*)p, b = *(const f32x4*)(p + 4);
    u32x4 w; w.x = cvt_pk_bf16(a.x, a.y); w.y = cvt_pk_bf16(a.z, a.w); w.z = cvt_pk_bf16(b.x, b.y); w.w = cvt_pk_bf16(b.z, b.w);
    return __builtin_bit_cast(bf16x8, w);
}
__device__ __forceinline__ int opaque_tid() { int t = threadIdx.x; asm volatile("" : "+v"(t)); return t; }
#define LDS_FENCE() asm volatile("s_waitcnt lgkmcnt(0)" ::: "memory")
#define MFMA16(a, b, c) __builtin_amdgcn_mfma_f32_16x16x32_bf16((a), (b), (c), 0, 0, 0)

constexpr int BM = 256, BK = 64, HALF = 128, HT = HALF * BK;
__device__ __forceinline__ int lds_byte(int r, int c) {
    int st = (r >> 4) * 2 + (c >> 5), rr = r & 15, cc = c & 31, ob = rr * 64 + cc * 2;
    return st * 1024 + (ob ^ (((ob >> 9) & 1) << 5));
}
__device__ __forceinline__ void stage_rc(int b, int& R, int& C) {
    int st = b / 1024, sb = b % 1024, swz = sb ^ (((sb >> 9) & 1) << 5);
    R = (st >> 1) * 16 + swz / 64; C = (st & 1) * 32 + (swz % 64) / 2;
}
__device__ __forceinline__ bool tile_of(int L, int nM, int nN, int& pm, int& pn) {
    const int nwg = nM * nN; if (L >= nwg) return false;
    int wgid = L; { const int q = nwg / 8, r = nwg % 8, xcd = wgid % 8, off = wgid / 8; wgid = (xcd < r ? xcd * (q + 1) : r * (q + 1) + (xcd - r) * q) + off; }
    const int nig = 8 * nN, gid = wgid / nig, fm = gid * 8, gsz = (nM - fm) < 8 ? (nM - fm) : 8;
    pm = fm + ((wgid % nig) % gsz); pn = (wgid % nig) / gsz; return true;
}

template <bool TR, class Epi>
__device__ __forceinline__ void gemm_tile(const bf16_t* __restrict__ A, int lda, const bf16_t* __restrict__ Bt, int ldb, int K, int brow, int bcol, const Epi& epi, int parity, bool pre, int nbrow, int nbcol) {
    const int tid = opaque_tid();
    bf16_t* shm = (bf16_t*)g_lds;
#define SA(b, h) (shm + ((b) * 2 + (h)) * HT)
#define SB(b, h) (shm + (4 + (b) * 2 + (h)) * HT)
#define STAGE(P, BASE, LD, br, kt) do { const int _so = ((br) * (LD) + (kt) * BK) * 2; \
    for (int _i = 0; _i < 2; ++_i) { \
      __builtin_amdgcn_raw_ptr_buffer_load_lds(((&(LD) == &lda) ? rsA : rsB), (__attribute__((address_space(3))) void*)((char*)(P) + wid * 1024 + _i * 8192), 16, \
          ((&(LD) == &lda) ? offA[_i] : offB[_i]), _so, 0, 0); } } while (0)
#define LDA(dst, b, h) for (int m = 0; m < 4; ++m) for (int k = 0; k < 2; ++k) \
    dst[m][k] = *reinterpret_cast<const bf16x8*>((char*)SA(b, h) + lds_byte(wr * 64 + m * 16 + fr, k * 32 + fq * 8))
#define LDB(dst, b, h) for (int n = 0; n < 2; ++n) for (int k = 0; k < 2; ++k) \
    dst[n][k] = *reinterpret_cast<const bf16x8*>((char*)SB(b, h) + lds_byte(wc * 32 + n * 16 + fr, k * 32 + fq * 8))
#define MMA(ai, bj, At, Bt_) do { __builtin_amdgcn_s_setprio(1); \
    for (int m = 0; m < 4; ++m) for (int n = 0; n < 2; ++n) for (int k = 0; k < 2; ++k) \
      acc[ai][bj][m][n] = TR ? __builtin_amdgcn_mfma_f32_16x16x32_bf16(Bt_[n][k], At[m][k], acc[ai][bj][m][n], 0, 0, 0) \
                            : __builtin_amdgcn_mfma_f32_16x16x32_bf16(At[m][k], Bt_[n][k], acc[ai][bj][m][n], 0, 0, 0); \
    __builtin_amdgcn_s_setprio(0); } while (0)
#define WAIT_V(n) asm volatile("s_waitcnt vmcnt(" #n ")" ::: "memory")
#define WAIT_L(n) asm volatile("s_waitcnt lgkmcnt(" #n ")" ::: "memory")
#define BAR __builtin_amdgcn_s_barrier()
#define SCHED __builtin_amdgcn_sched_barrier(0)
    const int wid = __builtin_amdgcn_readfirstlane(tid >> 6), lane = tid & 63, wr = wid >> 2, wc = wid & 3, fr = lane & 15, fq = lane >> 4;
    f32x4 acc[2][2][4][2] = {};
    bf16x8 At[4][2], B0[2][2], B1[2][2];
    const int nt = K / BK;
    const __amdgpu_buffer_rsrc_t rsA = __builtin_amdgcn_make_buffer_rsrc((void*)A, (short)0, 0x7ffffff0, 0x00020000);
    const __amdgpu_buffer_rsrc_t rsB = __builtin_amdgcn_make_buffer_rsrc((void*)Bt, (short)0, 0x7ffffff0, 0x00020000);
    unsigned offA[2], offB[2];
    for (int _i = 0; _i < 2; ++_i) { int _r, _c; stage_rc(tid * 16 + _i * 8192, _r, _c); offA[_i] = (unsigned)(_r * lda + _c) * 2u; offB[_i] = (unsigned)(_r * ldb + _c) * 2u; }
    if (!(TR && pre)) {
    STAGE(SB(0, 0), Bt, ldb, bcol, 0); STAGE(SA(0, 0), A, lda, brow, 0);
    STAGE(SB(0, 1), Bt, ldb, bcol + HALF, 0); STAGE(SA(0, 1), A, lda, brow + HALF, 0);
    }
    float* RT = (float*)(g_lds + 131072 + (parity & 1) * 1024);
    if (TR) { if (tid < 256) RT[tid] = epi.rstd_row(brow + tid); }
    if (wr == 1) BAR;
    if (TR && pre) { WAIT_V(8); } else { WAIT_V(4); }
    BAR;
    STAGE(SB(1, 0), Bt, ldb, bcol, 1); STAGE(SA(1, 0), A, lda, brow, 1); STAGE(SB(1, 1), Bt, ldb, bcol + HALF, 1);
    WAIT_V(6); BAR;
#pragma unroll 1
    for (int t = 0; t < nt - 2; t += 2) {
        LDB(B0, 0, 0); SCHED; LDA(At, 0, 0); STAGE(SA(1, 1), A, lda, brow + HALF, t + 1);
        WAIT_L(8); BAR; WAIT_L(0); MMA(0, 0, At, B0); BAR; SCHED;
        LDB(B1, 0, 1); STAGE(SB(0, 0), Bt, ldb, bcol, t + 2);
        BAR; WAIT_L(0); MMA(0, 1, At, B1); BAR;
        LDA(At, 0, 1); STAGE(SA(0, 0), A, lda, brow, t + 2);
        BAR; WAIT_L(0); MMA(1, 0, At, B0); BAR; SCHED;
        STAGE(SB(0, 1), Bt, ldb, bcol + HALF, t + 2);
        WAIT_V(6); BAR; MMA(1, 1, At, B1); BAR;
        LDB(B0, 1, 0); SCHED; LDA(At, 1, 0); STAGE(SA(0, 1), A, lda, brow + HALF, t + 2);
        WAIT_L(8); BAR; WAIT_L(0); MMA(0, 0, At, B0); BAR; SCHED;
        LDB(B1, 1, 1); STAGE(SB(1, 0), Bt, ldb, bcol, t + 3);
        BAR; WAIT_L(0); MMA(0, 1, At, B1); BAR;
        LDA(At, 1, 1); STAGE(SA(1, 0), A, lda, brow, t + 3);
        BAR; WAIT_L(0); MMA(1, 0, At, B0); BAR; SCHED;
        STAGE(SB(1, 1), Bt, ldb, bcol + HALF, t + 3);
        WAIT_V(6); BAR; MMA(1, 1, At, B1); BAR;
    }
    { LDB(B0, 0, 0); LDA(At, 0, 0); STAGE(SA(1, 1), A, lda, brow + HALF, nt - 1);
      BAR; WAIT_L(0); MMA(0, 0, At, B0); BAR;
      LDB(B1, 0, 1); BAR; WAIT_L(0); MMA(0, 1, At, B1); BAR;
      LDA(At, 0, 1); WAIT_V(4); BAR; WAIT_L(0); MMA(1, 0, At, B0); MMA(1, 1, At, B1); BAR; }
    { LDB(B0, 1, 0); LDA(At, 1, 0); WAIT_V(2); BAR; WAIT_L(0); MMA(0, 0, At, B0); BAR;
      LDB(B1, 1, 1); WAIT_V(0); BAR; WAIT_L(0); MMA(0, 1, At, B1); BAR;
      LDA(At, 1, 1); BAR; WAIT_L(0); MMA(1, 0, At, B0); MMA(1, 1, At, B1); BAR; }
    if (wr == 0) BAR;
    if (TR && nbrow >= 0) {
        STAGE(SB(0, 0), Bt, ldb, nbcol, 0); STAGE(SA(0, 0), A, lda, nbrow, 0);
        STAGE(SB(0, 1), Bt, ldb, nbcol + HALF, 0); STAGE(SA(0, 1), A, lda, nbrow + HALF, 0);
        asm volatile("" ::: "memory"); SCHED;
    }
    if (TR) {
        epi.regs(acc, RT, brow, bcol, wr, wc, fr, fq);
        return;
    }
    float* ep = (float*)g_lds;
    __syncthreads();
#pragma unroll
    for (int ai = 0; ai < 2; ++ai) {
        if (ai) __syncthreads();
#pragma unroll
        for (int bj = 0; bj < 2; ++bj)
#pragma unroll
            for (int m = 0; m < 4; ++m)
#pragma unroll
                for (int n = 0; n < 2; ++n)
#pragma unroll
                    for (int j = 0; j < 4; ++j)
                        ep[(wr * 64 + m * 16 + fq * 4 + j) * 260 + bj * HALF + wc * 32 + n * 16 + fr] = acc[ai][bj][m][n][j];
        __syncthreads();
        int lane_e = tid & 63; asm volatile("" : "+v"(lane_e));
        const int row0 = brow + ai * HALF + wid * 16;
        epi.rows(ep, wid, lane_e, row0, bcol);
    }
    __syncthreads();
#undef SA
#undef SB
#undef STAGE
#undef LDA
#undef LDB
#undef MMA
}

template <bool TR, class Epi>
__device__ __forceinline__ void gemm_phase_t(const bf16_t* A, int lda, const bf16_t* Bt, int ldb, int M, int N, int K, const Epi& epi) {
    const int nM = M / BM, nN = N / BM;
    int pm, pn; bool have = tile_of((int)blockIdx.x, nM, nN, pm, pn), pre = false;
    for (int i = 0; have; ++i) {
        int npm = 0, npn = 0; const bool nhave = tile_of((i + 1) * (int)gridDim.x + (int)blockIdx.x, nM, nN, npm, npn);
        gemm_tile<TR>(A, lda, Bt, ldb, K, pm * BM, pn * BM, epi, i, pre, (TR && nhave) ? npm * BM : -1, npn * BM);
        pre = TR && nhave; pm = npm; pn = npn; have = nhave;
    }
    if (TR) __syncthreads();
}
template <class Epi>
__device__ __forceinline__ void gemm_phase(const bf16_t* A, int lda, const bf16_t* Bt, int ldb, int M, int N, int K, const Epi& epi) { gemm_phase_t<false>(A, lda, Bt, ldb, M, N, K, epi); }

__device__ __forceinline__ float row_rstd(const float* ssq, int row) {
    const f32x4* p = (const f32x4*)(ssq + (size_t)row * 16);
    const f32x4 a = p[0], b = p[1], c = p[2], d = p[3];
    const float s = ((a.x + a.y) + (a.z + a.w)) + ((b.x + b.y) + (b.z + b.w)) + ((c.x + c.y) + (c.z + c.w)) + ((d.x + d.y) + (d.z + d.w));
    return rsqrtf(s * (1.0f / D) + EPS);
}
__device__ __forceinline__ float rstd16(const float* ssq, int row0, int lane) {
    const f32x4 q = *(const f32x4*)(ssq + (size_t)(row0 + (lane >> 2)) * 16 + 4 * (lane & 3));
    float s = (q.x + q.y) + (q.z + q.w); s += __shfl_xor(s, 1); s += __shfl_xor(s, 2);
    return rsqrtf(s * (1.0f / D) + EPS);
}
__device__ __forceinline__ float seg_sum16(float s) { s += __shfl_xor(s, 1); s += __shfl_xor(s, 2); s += __shfl_xor(s, 4); s += __shfl_xor(s, 8); return s; }
__device__ __forceinline__ void st4_bf16(bf16_t* d, float a, float b, float c, float e) { u32x2 w; w.x = cvt_pk_bf16(a, b); w.y = cvt_pk_bf16(c, e); *(u32x2*)d = w; }

template <class E> __device__ __forceinline__ void epi_rows_generic(const E& e, const float* ep, int wid, int lane, int row0, int bcol) {
    const float rsv = e.begin(row0, lane);
    const int col = bcol + 4 * lane;
    typename E::Ld L[16];
#pragma unroll
    for (int u = 0; u < 16; ++u) L[u] = e.load(row0 + u, col);
#pragma unroll
    for (int u = 0; u < 16; ++u) {
        const f32x4 v = *(const f32x4*)(ep + (wid * 16 + u) * 260 + 4 * lane);
        e.finish(v, L[u], row0 + u, col, lane, __shfl(rsv, 4 * u));
    }
}

struct EpiIn {
    bf16_t* Z; const float* ssq; const float* qn; const float* kn; const float* gbias; const float* tab; int smask;
    __device__ __forceinline__ float rstd_row(int) const { return 0.f; }
    __device__ __forceinline__ void regs(const f32x4 (&)[2][2][4][2], const float*, int, int, int, int, int, int) const {}
    template <int T> __device__ __forceinline__ void rows_t(const float* ep, int wid, int lane, int row0, int bcol) const {
        const float rsv = rstd16(ssq, row0, lane);
        const int col = bcol + 4 * lane, c = col & 63, sl = lane & 15;
        f32x4 gn = {1.f, 1.f, 1.f, 1.f}, bb = {0.f, 0.f, 0.f, 0.f};
        if (T == 0) gn = *(const f32x4*)(qn + c);
        if (T == 1) gn = *(const f32x4*)(kn + c);
        if (T == 4) bb = *(const f32x4*)(gbias + (col - ZC_GF));
        const bool rot = (T <= 1) ? (sl < 4) : true;
        const float sgn = (T <= 1) ? (sl < 2 ? -1.f : 1.f) : (sl < 8 ? -1.f : 1.f);
        const int toff = (T <= 1) ? 2 * (c & 7) : 16 + 2 * (c & 31);
        const float psc = (T == 2) ? ((col >= ZC_BQ && col < ZC_BK) ? 0.17677669529663687f : 1.0f) : (T == 0 ? 0.125f * 1.4426950408889634f : (T == 6 ? 0.125f : 1.0f));
#pragma unroll 1
        for (int i0 = 0; i0 < 16; i0 += 4) {
            f32x4 vv[4], tt0[4], tt1[4];
#pragma unroll
            for (int u = 0; u < 4; ++u) {
                vv[u] = *(const f32x4*)(ep + (wid * 16 + i0 + u) * 260 + 4 * lane);
                if (T == 0 || T == 1 || T == 5 || T == 6) { const float* cs = tab + (size_t)((row0 + i0 + u) & smask) * 80 + toff; tt0[u] = *(const f32x4*)cs; tt1[u] = *(const f32x4*)(cs + 4); }
            }
#pragma unroll
            for (int u = 0; u < 4; ++u) {
            f32x4 v = vv[u];
            const int row = row0 + i0 + u; const float rstd = __shfl(rsv, 4 * (i0 + u));
            bf16_t* dst = Z + (size_t)row * ZW + col;
            if (T == 0 || T == 1 || T == 5 || T == 6) {
                const f32x4 t0 = tt0[u], t1 = tt1[u];
                float r = rstd * psc;
                if (T <= 1) { const float ss = seg_sum16((v.x * v.x + v.y * v.y) + (v.z * v.z + v.w * v.w)); r *= rsqrtf(ss * rstd * rstd * (1.0f / 64) + EPS); }
                v.x *= r * gn.x; v.y *= r * gn.y; v.z *= r * gn.z; v.w *= r * gn.w;
                f32x4 pv;
                if (T <= 1) { pv.x = __shfl_xor(v.x, 2); pv.y = __shfl_xor(v.y, 2); pv.z = __shfl_xor(v.z, 2); pv.w = __shfl_xor(v.w, 2); }
                else        { pv.x = __shfl_xor(v.x, 8); pv.y = __shfl_xor(v.y, 8); pv.z = __shfl_xor(v.z, 8); pv.w = __shfl_xor(v.w, 8); }
                const float nx = v.x * t0.x + sgn * pv.x * t0.y, ny = v.y * t0.z + sgn * pv.y * t0.w, nz = v.z * t1.x + sgn * pv.z * t1.y, nw = v.w * t1.z + sgn * pv.w * t1.w;
                st4_bf16(dst, rot ? nx : v.x, rot ? ny : v.y, rot ? nz : v.z, rot ? nw : v.w);
            } else if (T == 4) {
                float x[4] = {v.x * rstd + bb.x, v.y * rstd + bb.y, v.z * rstd + bb.z, v.w * rstd + bb.w}; unsigned short hb[4];
#pragma unroll
                for (int k = 0; k < 4; ++k) { const float ls = fminf(x[k], 0.f) - __logf(1.0f + __expf(-fabsf(x[k]))); const _Float16 hv = (_Float16)(ls * 0.0625f); hb[k] = __builtin_bit_cast(unsigned short, hv); }
                u32x2 w; w.x = hb[0] | ((unsigned)hb[1] << 16); w.y = hb[2] | ((unsigned)hb[3] << 16);
                *(u32x2*)dst = w;
            } else {
                const float sc = rstd * psc;
                st4_bf16(dst, v.x * sc, v.y * sc, v.z * sc, v.w * sc);
            }
            }
        }
    }
    __device__ __forceinline__ void rows(const float* ep, int wid, int lane, int row0, int bcol) const {
        if (bcol < ZC_AK) rows_t<0>(ep, wid, lane, row0, bcol);
        else if (bcol < ZC_AV) rows_t<1>(ep, wid, lane, row0, bcol);
        else if (bcol == ZC_GF) rows_t<4>(ep, wid, lane, row0, bcol);
        else if (bcol == ZC_CQ) rows_t<5>(ep, wid, lane, row0, bcol);
        else if (bcol == ZC_CK) rows_t<6>(ep, wid, lane, row0, bcol);
        else rows_t<2>(ep, wid, lane, row0, bcol);
    }
};

struct EpiRes {
    const bf16_t* HBin; bf16_t* HBout; float* ssq;
    typedef u32x2 Ld;
    __device__ __forceinline__ float rstd_row(int) const { return 0.f; }
    __device__ __forceinline__ void regs(const f32x4 (&)[2][2][4][2], const float*, int, int, int, int, int, int) const {}
    __device__ __forceinline__ void rows(const float* ep, int wid, int lane, int row0, int bcol) const { epi_rows_generic(*this, ep, wid, lane, row0, bcol); }
    __device__ __forceinline__ float begin(int, int) const { return 0.f; }
    __device__ __forceinline__ Ld load(int row, int col) const { return *(const u32x2*)(HBin + (size_t)row * D + col); }
    __device__ __forceinline__ void finish(f32x4 v, Ld hw, int row, int col, int lane, float) const {
        f32x4 h = {bflo(hw.x) + v.x, bfhi(hw.x) + v.y, bflo(hw.y) + v.z, bfhi(hw.y) + v.w};
        u32x2 w; w.x = cvt_pk_bf16(h.x, h.y); w.y = cvt_pk_bf16(h.z, h.w);
        *(u32x2*)(HBout + (size_t)row * D + col) = w;
        h.x = bflo(w.x); h.y = bfhi(w.x); h.z = bflo(w.y); h.w = bfhi(w.y);
        const float ss = seg_sum16((h.x * h.x + h.y * h.y) + (h.z * h.z + h.w * h.w));
        if ((lane & 15) == 0) ssq[(size_t)row * 16 + (col >> 6)] = ss;
    }
};

struct EpiMlpIn {
    bf16_t* HID; const float* ssq;
    __device__ __forceinline__ float rstd_row(int row) const { return row_rstd(ssq, row); }
    __device__ __forceinline__ void regs(const f32x4 (&acc)[2][2][4][2], const float* RT, int brow, int bcol, int wr, int wc, int fr, int fq) const {
#pragma unroll
        for (int ai = 0; ai < 2; ++ai)
#pragma unroll
            for (int m = 0; m < 4; ++m) {
                const int rl = ai * HALF + wr * 64 + m * 16 + fr; const float rstd = RT[rl];
                bf16_t* dst = HID + (size_t)(brow + rl) * DFF + bcol + wc * 32 + 8 * fq;
#pragma unroll
                for (int bj = 0; bj < 2; ++bj) { float t[8];
#pragma unroll
                    for (int n = 0; n < 2; ++n)
#pragma unroll
                        for (int j = 0; j < 4; ++j) { const float x = fmaxf(acc[ai][bj][m][n][j] * rstd, 0.f); t[4 * n + j] = x * x; }
                    *(bf16x8*)(dst + bj * HALF) = pack8(t); }
            }
    }
    __device__ __forceinline__ void rows(const float* ep, int wid, int lane, int row0, int bcol) const { epi_rows_generic(*this, ep, wid, lane, row0, bcol); }
    __device__ __forceinline__ float begin(int row0, int lane) const { return rstd16(ssq, row0, lane); }
    typedef int Ld;
    __device__ __forceinline__ Ld load(int, int) const { return 0; }
    __device__ __forceinline__ void finish(f32x4 v, Ld, int row, int col, int lane, float rstd) const { this->row(v, row, col, lane, rstd); }
    __device__ __forceinline__ void row(f32x4 v, int row, int col, int, float rstd) const {
        const float a = fmaxf(v.x * rstd, 0.f), b = fmaxf(v.y * rstd, 0.f), c = fmaxf(v.z * rstd, 0.f), e = fmaxf(v.w * rstd, 0.f);
        st4_bf16(HID + (size_t)row * DFF + col, a * a, b * b, c * c, e * e);
    }
};

struct EpiPlain {
    bf16_t* O; int ldo;
    __device__ __forceinline__ float rstd_row(int) const { return 0.f; }
    __device__ __forceinline__ void regs(const f32x4 (&)[2][2][4][2], const float*, int, int, int, int, int, int) const {}
    __device__ __forceinline__ void rows(const float* ep, int wid, int lane, int row0, int bcol) const { epi_rows_generic(*this, ep, wid, lane, row0, bcol); }
    __device__ __forceinline__ float begin(int, int) const { return 0.f; }
    typedef int Ld;
    __device__ __forceinline__ Ld load(int, int) const { return 0; }
    __device__ __forceinline__ void finish(f32x4 v, Ld, int row, int col, int lane, float rstd) const { this->row(v, row, col, lane, rstd); }
    __device__ __forceinline__ void row(f32x4 v, int row, int col, int, float) const { st4_bf16(O + (size_t)row * ldo + col, v.x, v.y, v.z, v.w); }
};

struct EpiPeGate {
    float* Hout; const bf16_t* HBin; bf16_t* HBout; float* ssq_out; const float* ssq_in; const bf16_t* PB; int write_f32;
    struct Ld { u32x2 pw, hw; };
    __device__ __forceinline__ float rstd_row(int) const { return 0.f; }
    __device__ __forceinline__ void regs(const f32x4 (&)[2][2][4][2], const float*, int, int, int, int, int, int) const {}
    __device__ __forceinline__ void rows(const float* ep, int wid, int lane, int row0, int bcol) const { epi_rows_generic(*this, ep, wid, lane, row0, bcol); }
    __device__ __forceinline__ float begin(int row0, int lane) const { return rstd16(ssq_in, row0, lane); }
    __device__ __forceinline__ Ld load(int row, int col) const { Ld l; l.pw = *(const u32x2*)(PB + (size_t)row * D + col); l.hw = *(const u32x2*)(HBin + (size_t)row * D + col); return l; }
    __device__ __forceinline__ void finish(f32x4 v, Ld l, int row, int col, int lane, float rstd) const {
        const u32x2 pw = l.pw, hw = l.hw;
        f32x4 h;
        h.x = bflo(hw.x) + bflo(pw.x) / (1.0f + __expf(-v.x * rstd)); h.y = bfhi(hw.x) + bfhi(pw.x) / (1.0f + __expf(-v.y * rstd));
        h.z = bflo(hw.y) + bflo(pw.y) / (1.0f + __expf(-v.z * rstd)); h.w = bfhi(hw.y) + bfhi(pw.y) / (1.0f + __expf(-v.w * rstd));
        if (write_f32) *(f32x4*)(Hout + (size_t)row * D + col) = h;
        u32x2 w; w.x = cvt_pk_bf16(h.x, h.y); w.y = cvt_pk_bf16(h.z, h.w);
        *(u32x2*)(HBout + (size_t)row * D + col) = w;
        h.x = bflo(w.x); h.y = bfhi(w.x); h.z = bflo(w.y); h.w = bfhi(w.y);
        const float ss = seg_sum16((h.x * h.x + h.y * h.y) + (h.z * h.z + h.w * h.w));
        if ((lane & 15) == 0) ssq_out[(size_t)row * 16 + (col >> 6)] = ss;
    }
};

template <class F>
__device__ __forceinline__ void transpose_item(bf16_t* Wt, int K, int k0, int n0, const F& src) {
    const int tid = opaque_tid();
    float* tile = (float*)g_lds;
#pragma unroll
    for (int i = 0; i < 8; ++i) { const int kk = (tid >> 6) + 8 * i, nn = tid & 63; tile[kk * 65 + nn] = src(k0 + kk, n0 + nn); }
    __syncthreads();
    { const int nn = tid >> 3, kc = tid & 7; float t[8];
#pragma unroll
      for (int j = 0; j < 8; ++j) t[j] = tile[(8 * kc + j) * 65 + nn];
      *(bf16x8*)(Wt + (size_t)(n0 + nn) * K + k0 + 8 * kc) = pack8(t); }
    __syncthreads();
}

__device__ __forceinline__ void phase_weights(const Params& p) {
    bf16_t* WT = (bf16_t*)(p.ws + WS_WT);
    constexpr int I_IN = 16 * (ZW / 64), I_OUT = 16 * 16, I_MI = 16 * 64, I_MO = 64 * 16, I_PG = 16 * 16, I_PP = 4 * 16;
    constexpr int I_L = I_IN + I_OUT + I_MI + I_MO + I_PG + I_PP;
    for (int it = blockIdx.x; it < NLAYER * I_L; it += gridDim.x) {
        const int l = it / I_L; int r = it % I_L;
        bf16_t* W = WT + (size_t)l * W_LAYER;
        if (r < I_IN) {
            const int kb = r / (ZW / 64), nb = r % (ZW / 64);
            const float* w = p.w_in + (size_t)l * D * NIN; const float* g = p.ln_mix + l * D; const float* gu = p.gla_gate_up + (size_t)l * 2 * 16 * 128;
            transpose_item(W + WO_IN, D, kb * 64, nb * 64, [&](int k, int c) -> float {
                float v;
                if (c < ZC_GF) v = w[(size_t)k * NIN + c];
                else if (c < ZC_CQ) { const int j = (c - ZC_GF) >> 7, kk = (c - ZC_GF) & 127; float s = 0.f;
                    for (int rr = 0; rr < 16; ++rr) s += w[(size_t)k * NIN + 2304 + 16 * j + rr] * gu[(j * 16 + rr) * 128 + kk];
                    v = s; }
                else v = w[(size_t)k * NIN + (c - 224)];
                return v * g[k]; });
            continue; }
        r -= I_IN;
        if (r < I_OUT) { const float* w = p.w_out + (size_t)l * D * D;
            transpose_item(W + WO_OUT, D, (r / 16) * 64, (r % 16) * 64, [&](int k, int c) -> float { return w[(size_t)k * D + c]; }); continue; }
        r -= I_OUT;
        if (r < I_MI) { const float* w = p.w_mlp_in + (size_t)l * D * DFF; const float* g = p.ln_mlp + l * D;
            transpose_item(W + WO_MI, D, (r / 64) * 64, (r % 64) * 64, [&](int k, int c) -> float { const int rho = c & 31; const int cc = (c & ~31) + 8 * ((rho & 15) >> 2) + 4 * (rho >> 4) + (rho & 3);
                return w[(size_t)k * DFF + cc] * g[k]; }); continue; }
        r -= I_MI;
        if (r < I_MO) { const float* w = p.w_mlp_out + (size_t)l * DFF * D;
            transpose_item(W + WO_MO, DFF, (r / 16) * 64, (r % 16) * 64, [&](int k, int c) -> float { return w[(size_t)k * D + c]; }); continue; }
        r -= I_MO;
        if (r < I_PG) { const float* w = p.w_pe_gate + (size_t)l * D * D; const float* g = p.ln_pe + l * D;
            transpose_item(W + WO_PG, D, (r / 16) * 64, (r % 16) * 64, [&](int k, int c) -> float { return w[(size_t)k * D + c] * g[k]; }); continue; }
        r -= I_PG;
        { const float* w = p.w_pe_proj + (size_t)l * PLE * D;
            transpose_item(W + WO_PP, PLE, (r / 16) * 64, (r % 16) * 64, [&](int k, int c) -> float { return w[(size_t)k * D + c]; }); }
    }
    float* tab = (float*)(p.ws + WS_TAB);
    for (int e = blockIdx.x * NTHR + threadIdx.x; e < 16384 * 40; e += gridDim.x * NTHR) {
        const int pos = e / 40, i = e % 40;
        const double invf = (i < 8) ? exp(-(double)i * (log(500000.0) / 8.0)) : exp(-(double)(i - 8) * (log(10000.0) / 32.0));
        double ang = (double)pos * invf; ang -= 6.283185307179586476925 * floor(ang * 0.15915494309189533577);
        tab[2 * e] = (float)cos(ang); tab[2 * e + 1] = (float)sin(ang);
    }
}

__device__ __forceinline__ void phase_init(const Params& p, int g) {
    const int tid = opaque_tid();
    const float* x = (g == 0) ? p.x_prompt : p.x_sample + (size_t)(g - 1) * MG * D;
    bf16_t* HB = (bf16_t*)(p.ws + WS_HB); float* ssq = (float*)(p.ws + WS_SSQ);
    const int lane = tid & 63, gw = blockIdx.x * 8 + (tid >> 6), NGW = gridDim.x * 8;
    for (int row = gw; row < MG; row += 2 * NGW) {
        f32x4 vv[2][4];
#pragma unroll
        for (int rr = 0; rr < 2; ++rr)
#pragma unroll
            for (int j = 0; j < 4; ++j) vv[rr][j] = *(const f32x4*)(x + (size_t)(row + rr * NGW) * D + 256 * j + 4 * lane);
#pragma unroll
        for (int rr = 0; rr < 2; ++rr)
#pragma unroll
            for (int j = 0; j < 4; ++j) {
                f32x4 v = vv[rr][j]; const int r2 = row + rr * NGW;
                u32x2 w; w.x = cvt_pk_bf16(v.x, v.y); w.y = cvt_pk_bf16(v.z, v.w);
                *(u32x2*)(HB + (size_t)r2 * D + 256 * j + 4 * lane) = w;
                v.x = bflo(w.x); v.y = bfhi(w.x); v.z = bflo(w.y); v.w = bfhi(w.y);
                float s_ = (v.x * v.x + v.y * v.y) + (v.z * v.z + v.w * v.w);
                s_ += __shfl_xor(s_, 1); s_ += __shfl_xor(s_, 2); s_ += __shfl_xor(s_, 4); s_ += __shfl_xor(s_, 8);
                if ((lane & 15) == 0) ssq[(size_t)r2 * 16 + (lane >> 4) + 4 * j] = s_;
            }
    }
    bf16_t* PL = (bf16_t*)(p.ws + WS_PLE);
    for (int l = 0; l < NLAYER; ++l) {
        const float* src = (g == 0) ? p.p_prompt + (size_t)l * MG * PLE : p.p_sample + ((size_t)l * 2 * MG + (size_t)(g - 1) * MG) * PLE;
        bf16_t* dst = PL + (size_t)l * MG * PLE;
        const size_t stride = (size_t)gridDim.x * NTHR * 8;
        for (size_t e = (size_t)(blockIdx.x * NTHR + tid) * 8; e < (size_t)MG * PLE; e += 4 * stride) {
            f32x4 a[4][2];
#pragma unroll
            for (int u = 0; u < 4; ++u) if (e + u * stride < (size_t)MG * PLE) { a[u][0] = *(const f32x4*)(src + e + u * stride); a[u][1] = *(const f32x4*)(src + e + u * stride + 4); }
#pragma unroll
            for (int u = 0; u < 4; ++u) if (e + u * stride < (size_t)MG * PLE) { u32x4 w; w.x = cvt_pk_bf16(a[u][0].x, a[u][0].y); w.y = cvt_pk_bf16(a[u][0].z, a[u][0].w); w.z = cvt_pk_bf16(a[u][1].x, a[u][1].y); w.w = cvt_pk_bf16(a[u][1].z, a[u][1].w);
                *(u32x4*)(dst + e + u * stride) = w; }
        }
    }
}

struct AttnLd { bf16x8 ka0, ka1, kb0, kb1; u32x4 v0, v1, v2, v3; };
__device__ __forceinline__ void attn_geom(int f, int r, int n0, int& dsh, int& cb) {
    const int p = f < 12 ? 0 : (f < 18 ? 1 : 2); const int i2 = f - (p == 0 ? 0 : (p == 1 ? 12 : 18));
    dsh = 2 * p; cb = (r >> dsh) + (16 >> dsh) * n0 - 64 + 32 * i2;
}
__device__ __forceinline__ AttnLd attn_load(const bf16_t* __restrict__ zq, int S, int head, int r, int n0, int lane, int f) {
    int dsh, cb; attn_geom(f, r, n0, dsh, cb);
    const int qi = lane & 15, g = lane >> 4, rd = r & ((1 << dsh) - 1), ncls = S >> dsh;
    const int cA = cb + 8 * (qi >> 2) + (qi & 3), cB = cA + 4;
    const int cAc = min(max(cA, 0), ncls - 1), cBc = min(max(cB, 0), ncls - 1);
    const bf16_t* kA = zq + (size_t)(rd + (cAc << dsh)) * ZW + ZC_AK + head * 64 + 8 * g;
    const bf16_t* kB = zq + (size_t)(rd + (cBc << dsh)) * ZW + ZC_AK + head * 64 + 8 * g;
    AttnLd L;
    L.ka0 = *(const bf16x8*)kA; L.ka1 = *(const bf16x8*)(kA + 32); L.kb0 = *(const bf16x8*)kB; L.kb1 = *(const bf16x8*)(kB + 32);
    const int cv0 = cb + (lane >> 3);
    const bf16_t* vb = zq + ZC_AV + head * 64 + 8 * (lane & 7);
    L.v0 = *(const u32x4*)(vb + (size_t)(rd + (min(max(cv0, 0), ncls - 1) << dsh)) * ZW);
    L.v1 = *(const u32x4*)(vb + (size_t)(rd + (min(max(cv0 + 8, 0), ncls - 1) << dsh)) * ZW);
    L.v2 = *(const u32x4*)(vb + (size_t)(rd + (min(max(cv0 + 16, 0), ncls - 1) << dsh)) * ZW);
    L.v3 = *(const u32x4*)(vb + (size_t)(rd + (min(max(cv0 + 24, 0), ncls - 1) << dsh)) * ZW);
    return L;
}
__device__ __forceinline__ bf16x8 attn_softmax_step(const f32x4& sA, const f32x4& sB, int cb, int cq, int ncls, int g, float& m, float& lsum, f32x4 (&O)[4]) {
    float s[8]; bool ok[8];
    const int c0v = cb + 8 * g, d0 = c0v - cq + 64;
#pragma unroll
    for (int j = 0; j < 8; ++j) {
        ok[j] = ((unsigned)(c0v + j) < (unsigned)ncls) && ((unsigned)(d0 + j) <= 128u);
        s[j] = ok[j] ? (j < 4 ? sA[j] : sB[j - 4]) : -1e30f; }
    float mx = fmaxf(fmaxf(fmaxf(s[0], s[1]), fmaxf(s[2], s[3])), fmaxf(fmaxf(s[4], s[5]), fmaxf(s[6], s[7])));
    mx = fmaxf(mx, __shfl_xor(mx, 16)); mx = fmaxf(mx, __shfl_xor(mx, 32));
    const float mn = fmaxf(m, mx), alpha = __builtin_amdgcn_exp2f(m - mn);
    m = mn;
    float pj[8], ps_ = 0.f;
#pragma unroll
    for (int j = 0; j < 8; ++j) { pj[j] = ok[j] ? __builtin_amdgcn_exp2f(s[j] - mn) : 0.f; ps_ += pj[j]; }
    lsum = lsum * alpha + ps_;
#pragma unroll
    for (int nbk = 0; nbk < 4; ++nbk) O[nbk] *= alpha;
    return pack8(pj);
}
__device__ __forceinline__ void attn_lds_step(const bf16_t* Kt, const bf16_t* Vt, int rowb, const bf16x8& q0, const bf16x8& q1, int cb, int cq, int ncls,
                                              int qi, int g, float& m, float& lsum, f32x4 (&O)[4]) {
    const bf16_t* kA = Kt + (rowb + 8 * (qi >> 2) + (qi & 3)) * 72 + 8 * g;
    const bf16x8 ka0 = *(const bf16x8*)kA, ka1 = *(const bf16x8*)(kA + 32), kb0 = *(const bf16x8*)(kA + 4 * 72), kb1 = *(const bf16x8*)(kA + 4 * 72 + 32);
    f32x4 sA = {0.f, 0.f, 0.f, 0.f}, sB = {0.f, 0.f, 0.f, 0.f};
    sA = MFMA16(ka0, q0, sA); sA = MFMA16(ka1, q1, sA);
    sB = MFMA16(kb0, q0, sB); sB = MFMA16(kb1, q1, sB);
    const bf16x8 P = attn_softmax_step(sA, sB, cb, cq, ncls, g, m, lsum, O);
#pragma unroll
    for (int nbk = 0; nbk < 4; ++nbk) O[nbk] = MFMA16(gather8(Vt + (rowb + 8 * g) * 68 + 16 * nbk, 68, qi), P, O[nbk]);
}
template <int NROWS>
__device__ __forceinline__ void attn_stage(const bf16_t* __restrict__ zq, int head, bf16_t* Kt, bf16_t* Vt, int c0, int ncls, int rd, int dsh, int tid) {
    constexpr int IT = (NROWS * 16 + NTHR - 1) / NTHR;
    u32x4 v[IT];
#pragma unroll
    for (int u = 0; u < IT; ++u) { const int idx = min(tid + u * NTHR, NROWS * 16 - 1);
        const int i = idx >> 4, ch = idx & 15, isv = ch >> 3, c8 = ch & 7; const int c = min(max(c0 + i, 0), ncls - 1);
        v[u] = *(const u32x4*)(zq + (size_t)(rd + (c << dsh)) * ZW + (isv ? ZC_AV : ZC_AK) + head * 64 + 8 * c8); }
#pragma unroll
    for (int u = 0; u < IT; ++u) { const int idx = min(tid + u * NTHR, NROWS * 16 - 1);
        const int i = idx >> 4, ch = idx & 15, isv = ch >> 3, c8 = ch & 7;
        bf16_t* d = isv ? (Vt + i * 68 + 8 * c8) : (Kt + i * 72 + 8 * c8);
        *(u32x2*)d = (u32x2){v[u].x, v[u].y}; *(u32x2*)(d + 4) = (u32x2){v[u].z, v[u].w}; }
}
__device__ __forceinline__ void attn_item(const bf16_t* __restrict__ Z, bf16_t* __restrict__ MIX, int S, int it) {
    const int tid = opaque_tid();
    __syncthreads();
    const int wave = tid >> 6, lane = tid & 63, qi = lane & 15, g = lane >> 4;
    const int nblk = S >> 8;
    const int pb = it % nblk; const int t1 = it / nblk; const int head = t1 & 7, seq = t1 >> 3;
    const int P0 = pb * 256, n0 = pb * 16;
    const bf16_t* zq = Z + (size_t)seq * S * ZW;
    bf16_t* Kt = (bf16_t*)g_lds;
    bf16_t* Vt = (bf16_t*)(g_lds + 57600);
    bf16_t* Vs = (bf16_t*)g_lds + wave * (32 * 68);
    int rt[2]; rt[0] = 4 * (wave >> 1) + (wave & 1); rt[1] = rt[0] + 2;
    bf16x8 q0[2], q1[2]; float m[2] = {-1e30f, -1e30f}, lsum[2] = {0.f, 0.f}; f32x4 O[2][4] = {};
#pragma unroll
    for (int ti = 0; ti < 2; ++ti) { const bf16_t* qp = zq + (size_t)(P0 + rt[ti] + 16 * qi) * ZW + ZC_AQ + head * 64 + 8 * g; q0[ti] = *(const bf16x8*)qp; q1[ti] = *(const bf16x8*)(qp + 32); }
    {
        bf16_t* Vs1 = Vs + 8 * (32 * 68);
        AttnLd cur0 = attn_load(zq, S, head, rt[0], n0, lane, 18), cur1 = attn_load(zq, S, head, rt[1], n0, lane, 18);
#pragma unroll 1
        for (int f = 18; f < 23; ++f) {
            const AttnLd nxt0 = attn_load(zq, S, head, rt[0], n0, lane, f < 22 ? f + 1 : 22), nxt1 = attn_load(zq, S, head, rt[1], n0, lane, f < 22 ? f + 1 : 22);
            const int cb = n0 - 64 + 32 * (f - 18), ncls = S >> 4, cq = n0 + qi;
            f32x4 sA0 = {0.f, 0.f, 0.f, 0.f}, sB0 = {0.f, 0.f, 0.f, 0.f}, sA1 = {0.f, 0.f, 0.f, 0.f}, sB1 = {0.f, 0.f, 0.f, 0.f};
            sA0 = MFMA16(cur0.ka0, q0[0], sA0); sA1 = MFMA16(cur1.ka0, q0[1], sA1); sB0 = MFMA16(cur0.kb0, q0[0], sB0); sB1 = MFMA16(cur1.kb0, q0[1], sB1);
            sA0 = MFMA16(cur0.ka1, q1[0], sA0); sA1 = MFMA16(cur1.ka1, q1[1], sA1); sB0 = MFMA16(cur0.kb1, q1[0], sB0); sB1 = MFMA16(cur1.kb1, q1[1], sB1);
            LDS_FENCE();
            { bf16_t* d = Vs + (lane >> 3) * 68 + 8 * (lane & 7);
              *(u32x2*)d = (u32x2){cur0.v0.x, cur0.v0.y}; *(u32x2*)(d + 4) = (u32x2){cur0.v0.z, cur0.v0.w};
              *(u32x2*)(d + 8 * 68) = (u32x2){cur0.v1.x, cur0.v1.y}; *(u32x2*)(d + 8 * 68 + 4) = (u32x2){cur0.v1.z, cur0.v1.w};
              *(u32x2*)(d + 16 * 68) = (u32x2){cur0.v2.x, cur0.v2.y}; *(u32x2*)(d + 16 * 68 + 4) = (u32x2){cur0.v2.z, cur0.v2.w};
              *(u32x2*)(d + 24 * 68) = (u32x2){cur0.v3.x, cur0.v3.y}; *(u32x2*)(d + 24 * 68 + 4) = (u32x2){cur0.v3.z, cur0.v3.w};
              d = Vs1 + (lane >> 3) * 68 + 8 * (lane & 7);
              *(u32x2*)d = (u32x2){cur1.v0.x, cur1.v0.y}; *(u32x2*)(d + 4) = (u32x2){cur1.v0.z, cur1.v0.w};
              *(u32x2*)(d + 8 * 68) = (u32x2){cur1.v1.x, cur1.v1.y}; *(u32x2*)(d + 8 * 68 + 4) = (u32x2){cur1.v1.z, cur1.v1.w};
              *(u32x2*)(d + 16 * 68) = (u32x2){cur1.v2.x, cur1.v2.y}; *(u32x2*)(d + 16 * 68 + 4) = (u32x2){cur1.v2.z, cur1.v2.w};
              *(u32x2*)(d + 24 * 68) = (u32x2){cur1.v3.x, cur1.v3.y}; *(u32x2*)(d + 24 * 68 + 4) = (u32x2){cur1.v3.z, cur1.v3.w}; }
            const bf16x8 P0_ = attn_softmax_step(sA0, sB0, cb, cq, ncls, g, m[0], lsum[0], O[0]);
            const bf16x8 P1_ = attn_softmax_step(sA1, sB1, cb, cq, ncls, g, m[1], lsum[1], O[1]);
            LDS_FENCE();
#pragma unroll
            for (int nbk = 0; nbk < 4; ++nbk) { O[0][nbk] = MFMA16(gather8(Vs + (8 * g) * 68 + 16 * nbk, 68, qi), P0_, O[0][nbk]); O[1][nbk] = MFMA16(gather8(Vs1 + (8 * g) * 68 + 16 * nbk, 68, qi), P1_, O[1][nbk]); }
            cur0 = nxt0; cur1 = nxt1;
        }
        LDS_FENCE();
    }
    __syncthreads();
    attn_stage<400>(zq, head, Kt, Vt, P0 - 64, S, 0, 0, tid);
    __syncthreads();
#pragma unroll 1
    for (int i2 = 0; i2 < 12; ++i2) {
        attn_lds_step(Kt, Vt, rt[0] + 32 * i2, q0[0], q1[0], P0 + rt[0] - 64 + 32 * i2, P0 + rt[0] + 16 * qi, S, qi, g, m[0], lsum[0], O[0]);
        attn_lds_step(Kt, Vt, rt[1] + 32 * i2, q0[1], q1[1], P0 + rt[1] - 64 + 32 * i2, P0 + rt[1] + 16 * qi, S, qi, g, m[1], lsum[1], O[1]);
    }
#pragma unroll
    for (int rho = 0; rho < 2; ++rho) {
        __syncthreads();
        attn_stage<200>(zq, head, Kt, Vt, (P0 >> 2) - 64, S >> 2, 2 * rho, 2, tid);
        attn_stage<200>(zq, head, Kt + 200 * 72, Vt + 200 * 68, (P0 >> 2) - 64, S >> 2, 2 * rho + 1, 2, tid);
        __syncthreads();
        const int r = rt[rho], cls = (r & 3) - 2 * rho, c0 = (P0 >> 2) + (r >> 2);
#pragma unroll 2
        for (int i2 = 0; i2 < 6; ++i2)
            attn_lds_step(Kt + cls * 200 * 72, Vt + cls * 200 * 68, (r >> 2) + 32 * i2, q0[rho], q1[rho], c0 - 64 + 32 * i2, c0 + 4 * qi, S >> 2, qi, g, m[rho], lsum[rho], O[rho]);
    }
#pragma unroll
    for (int ti = 0; ti < 2; ++ti) {
        float l = lsum[ti]; l += __shfl_xor(l, 16); l += __shfl_xor(l, 32);
        const float inv = 1.0f / l;
        bf16_t* op = MIX + ((size_t)seq * S + P0 + rt[ti] + 16 * qi) * D + head * 64 + 4 * g;
#pragma unroll
        for (int nbk = 0; nbk < 4; ++nbk) st4_bf16(op + 16 * nbk, O[ti][nbk].x * inv, O[ti][nbk].y * inv, O[ti][nbk].z * inv, O[ti][nbk].w * inv);
    }
    __syncthreads();
}

__device__ __forceinline__ float h2f(unsigned short b) { return (float)__builtin_bit_cast(_Float16, b); }

template <int NROWS>
__device__ __forceinline__ void stage_v4(const bf16_t* __restrict__ Z, size_t tok0, int zc, bf16_t* Vt) {
    const int tid = opaque_tid();
    constexpr int IT = NROWS * 32 / NTHR;
    u32x4 v[IT];
#pragma unroll
    for (int u = 0; u < IT; ++u) { const int idx = tid + u * NTHR; const int t = idx >> 5, ch = idx & 31; v[u] = *(const u32x4*)(Z + (tok0 + t) * ZW + zc + ch * 8); }
#pragma unroll
    for (int u = 0; u < IT; ++u) { const int idx = tid + u * NTHR; const int t = idx >> 5, ch = idx & 31, hh = ch >> 3, c8 = ch & 7;
        bf16_t* d = Vt + ((size_t)hh * NROWS + t) * 68 + c8 * 8;
        *(u32x2*)d = (u32x2){v[u].x, v[u].y}; *(u32x2*)(d + 4) = (u32x2){v[u].z, v[u].w}; }
}

__device__ __forceinline__ void gla_cum(const bf16_t* __restrict__ Z, size_t tok0, int h, int dir, int lane, float (&cum)[32], float& tot) {
    const int kk = lane & 31, hf = lane >> 5;
    const bf16_t* src = Z + (tok0 + 32 * hf) * ZW + ZC_GF + dir * 128 + h * 32 + kk;
    float part = 0.f;
#pragma unroll
    for (int i = 0; i < 32; ++i) { cum[i] = h2f(src[(size_t)i * ZW]); part += cum[i]; }
    const float other = __shfl_xor(part, 32);
    tot = part + other;
    if (dir == 0) { float run = hf ? other : 0.f;
#pragma unroll
        for (int i = 0; i < 32; ++i) { run += cum[i]; cum[i] = run; } }
    else { float run = hf ? 0.f : other;
#pragma unroll
        for (int i = 31; i >= 0; --i) { run += cum[i]; cum[i] = run; } }
}

__device__ __forceinline__ void gla1_item(const bf16_t* __restrict__ Z, bf16_t* __restrict__ GS, float* __restrict__ GD, int ci) {
    const int tid = opaque_tid();
    __syncthreads();
    const int wave = tid >> 6, lane = tid & 63, qi = lane & 15, g = lane >> 4;
    const int h = wave >> 1, dir = wave & 1;
    const size_t tok0 = (size_t)ci * 64;
    bf16_t* Vt = (bf16_t*)g_lds;
    bf16_t* Ks = (bf16_t*)g_lds + 4 * 64 * 68 + wave * (64 * 36);
    stage_v4<64>(Z, tok0, ZC_BV, Vt);
    float cum[32], tot;
    gla_cum(Z, tok0, h, dir, lane, cum, tot);
    { const int kk = lane & 31, hf = lane >> 5;
      const bf16_t* ksrc = Z + (tok0 + 32 * hf) * ZW + ZC_BK + h * 32 + kk;
      unsigned short kraw[32];
#pragma unroll
      for (int i = 0; i < 32; ++i) kraw[i] = ksrc[(size_t)i * ZW];
#pragma unroll
      for (int i = 0; i < 32; ++i) { const float kv = bf2f(kraw[i]) * __expf(tot - cum[i]);
          Ks[(32 * hf + i) * 36 + kk] = (bf16_t)(cvt_pk_bf16(kv, 0.f) & 0xffffu); }
      if (hf == 0) GD[(((size_t)dir * NCH + ci) * 4 + h) * 32 + kk] = __expf(tot); }
    __syncthreads();
    f32x4 acc[4][2] = {};
#pragma unroll
    for (int ks = 0; ks < 2; ++ks) {
        bf16x8 bfr[2];
#pragma unroll
        for (int kb = 0; kb < 2; ++kb) bfr[kb] = gather8(Ks + (32 * ks + 8 * g) * 36 + 16 * kb , 36, qi);
#pragma unroll
        for (int eb = 0; eb < 4; ++eb) { const bf16x8 af = gather8(Vt + ((size_t)h * 64 + 32 * ks + 8 * g) * 68 + 16 * eb , 68, qi);
#pragma unroll
            for (int kb = 0; kb < 2; ++kb) acc[eb][kb] = MFMA16(bfr[kb], af, acc[eb][kb]); }
    }
    bf16_t* dst = GS + (((size_t)dir * NCH + ci) * 4 + h) * 2048;
#pragma unroll
    for (int eb = 0; eb < 4; ++eb)
#pragma unroll
        for (int kb = 0; kb < 2; ++kb) st4_bf16(dst + (16 * eb + qi) * 32 + 16 * kb + 4 * g, acc[eb][kb].x, acc[eb][kb].y, acc[eb][kb].z, acc[eb][kb].w);
    __syncthreads();
}

__device__ __forceinline__ void gla3_item(const bf16_t* __restrict__ Z, const bf16_t* __restrict__ GS, bf16_t* __restrict__ MIX, const float* __restrict__ gnorm, int ci) {
    const int tid = opaque_tid();
    __syncthreads();
    const int wave = tid >> 6, lane = tid & 63, qi = lane & 15, g = lane >> 4;
    const size_t tok0 = (size_t)ci * 64;
    bf16_t* Vt = (bf16_t*)g_lds;
    float* CUM = (float*)(g_lds + 4 * 64 * 68 * 2);
    stage_v4<64>(Z, tok0, ZC_BV, Vt);
    { const int h = wave >> 1, dir = wave & 1; float cum[32], tot;
      gla_cum(Z, tok0, h, dir, lane, cum, tot);
      const int kk = lane & 31, hf = lane >> 5; float* cd = CUM + ((size_t)(h * 2 + dir) * 64 + 32 * hf) * 32 + kk;
#pragma unroll
      for (int i = 0; i < 32; ++i) cd[i * 32] = cum[i]; }
    __syncthreads();
    const int h = wave >> 1;
    const float* cF = CUM + (size_t)(h * 2 + 0) * 64 * 32; const float* cB = CUM + (size_t)(h * 2 + 1) * 64 * 32;
    const bf16_t* sF = GS + (((size_t)0 * NCH + ci) * 4 + h) * 2048; const bf16_t* sB = GS + (((size_t)1 * NCH + ci) * 4 + h) * 2048;
    bf16x8 SFf[4], SBf[4];
#pragma unroll
    for (int eb = 0; eb < 4; ++eb) { SFf[eb] = *(const bf16x8*)(sF + (16 * eb + qi) * 32 + 8 * g); SBf[eb] = *(const bf16x8*)(sB + (16 * eb + qi) * 32 + 8 * g); }
    bf16x8 KFf[2][2], KBf[2][2];
#pragma unroll
    for (int sg = 0; sg < 2; ++sg)
#pragma unroll
        for (int blk = 0; blk < 2; ++blk) {
            const int s = 32 * sg + 8 * (qi >> 2) + (qi & 3) + 4 * blk;
            float kv[8], a[8], b[8]; unpack8(*(const bf16x8*)(Z + (tok0 + s) * ZW + ZC_BK + h * 32 + 8 * g), kv);
#pragma unroll
            for (int j = 0; j < 8; ++j) { a[j] = kv[j] * __expf(-cF[s * 32 + 8 * g + j]); b[j] = kv[j] * __expf(-cB[s * 32 + 8 * g + j]); }
            KFf[sg][blk] = pack8(a); KBf[sg][blk] = pack8(b);
        }
#pragma unroll 1
    for (int tbi = 0; tbi < 2; ++tbi) {
        const int t = 16 * (2 * (wave & 1) + tbi) + qi;
        bf16x8 Qf, Qb;
        { float qv[8], a[8], b[8]; unpack8(*(const bf16x8*)(Z + (tok0 + t) * ZW + ZC_BQ + h * 32 + 8 * g), qv);
#pragma unroll
          for (int j = 0; j < 8; ++j) { a[j] = qv[j] * __expf(cF[t * 32 + 8 * g + j]); b[j] = qv[j] * __expf(cB[t * 32 + 8 * g + j]); }
          Qf = pack8(a); Qb = pack8(b); }
        f32x4 acc[4] = {};
#pragma unroll
        for (int eb = 0; eb < 4; ++eb) { acc[eb] = MFMA16(SFf[eb], Qf, acc[eb]); acc[eb] = MFMA16(SBf[eb], Qb, acc[eb]); }
#pragma unroll
        for (int sg = 0; sg < 2; ++sg) {
            f32x4 aF[2], aB[2];
#pragma unroll
            for (int blk = 0; blk < 2; ++blk) {
                const f32x4 z4 = {0.f, 0.f, 0.f, 0.f};
                aF[blk] = MFMA16(KFf[sg][blk], Qf, z4); aB[blk] = MFMA16(KBf[sg][blk], Qb, z4);
            }
            float pj[8];
#pragma unroll
            for (int j = 0; j < 8; ++j) { const int s = 32 * sg + 8 * g + j; pj[j] = (s <= t) ? (j < 4 ? aF[0][j] : aF[1][j - 4]) : (j < 4 ? aB[0][j] : aB[1][j - 4]); }
            const bf16x8 P = pack8(pj);
#pragma unroll
            for (int eb = 0; eb < 4; ++eb) acc[eb] = MFMA16(gather8(Vt + ((size_t)h * 64 + 32 * sg + 8 * g) * 68 + 16 * eb , 68, qi), P, acc[eb]);
        }
        float ss = 0.f;
#pragma unroll
        for (int eb = 0; eb < 4; ++eb) ss += (acc[eb].x * acc[eb].x + acc[eb].y * acc[eb].y) + (acc[eb].z * acc[eb].z + acc[eb].w * acc[eb].w);
        ss += __shfl_xor(ss, 16); ss += __shfl_xor(ss, 32);
        const float rn = rsqrtf(ss * (1.0f / 64) + EPS);
        u32x2 brw4[4]; f32x4 gn4[4];
#pragma unroll
        for (int eb = 0; eb < 4; ++eb) { const int e = 16 * eb + 4 * g; brw4[eb] = *(const u32x2*)(Z + (tok0 + t) * ZW + ZC_BR + h * 64 + e); gn4[eb] = *(const f32x4*)(gnorm + h * 64 + e); }
#pragma unroll
        for (int eb = 0; eb < 4; ++eb) { const int e = 16 * eb + 4 * g;
            const u32x2 brw = brw4[eb]; const f32x4 gn = gn4[eb];
            const float b0 = bflo(brw.x), b1 = bfhi(brw.x), b2 = bflo(brw.y), b3 = bfhi(brw.y);
            const float o0 = acc[eb].x * rn * gn.x * (b0 / (1.f + __expf(-b0))), o1 = acc[eb].y * rn * gn.y * (b1 / (1.f + __expf(-b1)));
            const float o2 = acc[eb].z * rn * gn.z * (b2 / (1.f + __expf(-b2))), o3 = acc[eb].w * rn * gn.w * (b3 / (1.f + __expf(-b3)));
            u32x2 w; w.x = cvt_pk_bf16(o0, o1); w.y = cvt_pk_bf16(o2, o3);
            *(u32x2*)(MIX + (tok0 + t) * D + 512 + h * 64 + e) = w; }
    }
    __syncthreads();
}

__device__ __forceinline__ void ret1_item(const bf16_t* __restrict__ Z, bf16_t* __restrict__ RS, const float* __restrict__ lgam, int item) {
    const int tid = opaque_tid();
    __syncthreads();
    const int wave = tid >> 6, lane = tid & 63, qi = lane & 15, g = lane >> 4;
    const int ci = item >> 1, hp = item & 1;
    const size_t tok0 = (size_t)ci * 128;
    bf16_t* Vt = (bf16_t*)g_lds;
    bf16_t* Kt = Vt + 2 * 128 * 68;
    { u32x4 v[8];
#pragma unroll
      for (int u = 0; u < 8; ++u) { const int idx = tid + u * NTHR; const int which = idx >> 11, r = idx & 2047, t = r >> 4, ch = r & 15;
          v[u] = *(const u32x4*)(Z + (tok0 + t) * ZW + (which ? ZC_CK : ZC_CV) + hp * 128 + ch * 8); }
#pragma unroll
      for (int u = 0; u < 8; ++u) { const int idx = tid + u * NTHR; const int which = idx >> 11, r = idx & 2047, t = r >> 4, ch = r & 15, hh = ch >> 3, c8 = ch & 7;
          bf16_t* d = (which ? Kt : Vt) + ((size_t)hh * 128 + t) * 68 + c8 * 8;
          *(u32x2*)d = (u32x2){v[u].x, v[u].y}; *(u32x2*)(d + 4) = (u32x2){v[u].z, v[u].w}; } }
    __syncthreads();
    const int hh = wave >> 2, dir = (wave >> 1) & 1, eh = wave & 1, head = 2 * hp + hh;
    const float lg = lgam[dir * 4 + head];
    f32x4 acc[2][4] = {};
#pragma unroll 1
    for (int ks = 0; ks < 4; ++ks) {
        float w[8];
#pragma unroll
        for (int j = 0; j < 8; ++j) { const int s = 32 * ks + 8 * g + j; w[j] = __expf(lg * (float)(dir ? s : 127 - s)); }
        bf16x8 bfr[4];
#pragma unroll
        for (int db = 0; db < 4; ++db) { float kv[8]; unpack8(gather8(Kt + ((size_t)hh * 128 + 32 * ks + 8 * g) * 68 + 16 * db , 68, qi), kv);
#pragma unroll
            for (int j = 0; j < 8; ++j) kv[j] *= w[j];
            bfr[db] = pack8(kv); }
#pragma unroll
        for (int ebi = 0; ebi < 2; ++ebi) { const bf16x8 af = gather8(Vt + ((size_t)hh * 128 + 32 * ks + 8 * g) * 68 + 16 * (2 * eh + ebi) , 68, qi);
#pragma unroll
            for (int db = 0; db < 4; ++db) acc[ebi][db] = MFMA16(bfr[db], af, acc[ebi][db]); }
    }
    bf16_t* dst = RS + (((size_t)dir * NCR + ci) * 4 + head) * 4096;
#pragma unroll
    for (int ebi = 0; ebi < 2; ++ebi)
#pragma unroll
        for (int db = 0; db < 4; ++db) st4_bf16(dst + (16 * (2 * eh + ebi) + qi) * 64 + 16 * db + 4 * g, acc[ebi][db].x, acc[ebi][db].y, acc[ebi][db].z, acc[ebi][db].w);
    __syncthreads();
}

__device__ __forceinline__ void ret3_item(const bf16_t* __restrict__ Z, const bf16_t* __restrict__ RS, bf16_t* __restrict__ MIX, const float* __restrict__ rnorm, const float* __restrict__ lgam, int ci) {
    const int tid = opaque_tid();
    __syncthreads();
    const int wave = tid >> 6, lane = tid & 63, qi = lane & 15, g = lane >> 4;
    const size_t tok0 = (size_t)ci * 128;
    bf16_t* Vt = (bf16_t*)g_lds;
    stage_v4<128>(Z, tok0, ZC_CV, Vt);
    __syncthreads();
    const int h = wave >> 1;
    const float lg0 = lgam[h], lg1 = lgam[4 + h];
    const bf16_t* rF = RS + (((size_t)0 * NCR + ci) * 4 + h) * 4096; const bf16_t* rB = RS + (((size_t)1 * NCR + ci) * 4 + h) * 4096;
    bf16x8 RF[4][2], RB[4][2];
#pragma unroll
    for (int eb = 0; eb < 4; ++eb) { const bf16_t* pf = rF + (16 * eb + qi) * 64 + 8 * g; const bf16_t* pb = rB + (16 * eb + qi) * 64 + 8 * g;
        RF[eb][0] = *(const bf16x8*)pf; RF[eb][1] = *(const bf16x8*)(pf + 32); RB[eb][0] = *(const bf16x8*)pb; RB[eb][1] = *(const bf16x8*)(pb + 32); }
#pragma unroll 1
    for (int tbi = 0; tbi < 4; ++tbi) {
        const int t = 16 * (4 * (wave & 1) + tbi) + qi;
        const bf16_t* qp = Z + (tok0 + t) * ZW + ZC_CQ + h * 64 + 8 * g;
        const bf16x8 q0 = *(const bf16x8*)qp, q1 = *(const bf16x8*)(qp + 32);
        f32x4 aI[4] = {}, aF[4] = {}, aB[4] = {};
#pragma unroll
        for (int eb = 0; eb < 4; ++eb) {
            aF[eb] = MFMA16(RF[eb][0], q0, aF[eb]); aF[eb] = MFMA16(RF[eb][1], q1, aF[eb]);
            aB[eb] = MFMA16(RB[eb][0], q0, aB[eb]); aB[eb] = MFMA16(RB[eb][1], q1, aB[eb]);
        }
#pragma unroll 1
        for (int sg = 0; sg < 4; ++sg) {
            f32x4 sc[2];
#pragma unroll
            for (int blk = 0; blk < 2; ++blk) {
                const int s = 32 * sg + 8 * (qi >> 2) + (qi & 3) + 4 * blk;
                const bf16_t* kp = Z + (tok0 + s) * ZW + ZC_CK + h * 64 + 8 * g;
                f32x4 z4 = {0.f, 0.f, 0.f, 0.f};
                z4 = MFMA16(*(const bf16x8*)kp, q0, z4); z4 = MFMA16(*(const bf16x8*)(kp + 32), q1, z4); sc[blk] = z4;
            }
            float pj[8];
#pragma unroll
            for (int j = 0; j < 8; ++j) { const int s = 32 * sg + 8 * g + j; const int dd = t - s;
                const float dec = (dd >= 0) ? __expf(lg0 * (float)dd) : __expf(lg1 * (float)(-dd));
                pj[j] = (j < 4 ? sc[0][j] : sc[1][j - 4]) * dec; }
            const bf16x8 P = pack8(pj);
#pragma unroll
            for (int eb = 0; eb < 4; ++eb) aI[eb] = MFMA16(gather8(Vt + ((size_t)h * 128 + 32 * sg + 8 * g) * 68 + 16 * eb , 68, qi), P, aI[eb]);
        }
        const float wf = __expf(lg0 * (float)(t + 1)), wb = __expf(lg1 * (float)(128 - t));
        float ss = 0.f;
#pragma unroll
        for (int eb = 0; eb < 4; ++eb) { aI[eb] = aI[eb] + aF[eb] * wf + aB[eb] * wb;
            ss += (aI[eb].x * aI[eb].x + aI[eb].y * aI[eb].y) + (aI[eb].z * aI[eb].z + aI[eb].w * aI[eb].w); }
        ss += __shfl_xor(ss, 16); ss += __shfl_xor(ss, 32);
        const float rn = rsqrtf(ss * (1.0f / 64) + EPS);
        u32x2 gw4[4]; f32x4 gn4[4];
#pragma unroll
        for (int eb = 0; eb < 4; ++eb) { const int e = 16 * eb + 4 * g; gw4[eb] = *(const u32x2*)(Z + (tok0 + t) * ZW + ZC_CG + h * 64 + e); gn4[eb] = *(const f32x4*)(rnorm + h * 64 + e); }
#pragma unroll
        for (int eb = 0; eb < 4; ++eb) { const int e = 16 * eb + 4 * g;
            const u32x2 gw = gw4[eb]; const f32x4 gn = gn4[eb];
            const float b0 = bflo(gw.x), b1 = bfhi(gw.x), b2 = bflo(gw.y), b3 = bfhi(gw.y);
            const float o0 = aI[eb].x * rn * gn.x * (b0 / (1.f + __expf(-b0))), o1 = aI[eb].y * rn * gn.y * (b1 / (1.f + __expf(-b1)));
            const float o2 = aI[eb].z * rn * gn.z * (b2 / (1.f + __expf(-b2))), o3 = aI[eb].w * rn * gn.w * (b3 / (1.f + __expf(-b3)));
            u32x2 w; w.x = cvt_pk_bf16(o0, o1); w.y = cvt_pk_bf16(o2, o3);
            *(u32x2*)(MIX + (tok0 + t) * D + 768 + h * 64 + e) = w; }
    }
    __syncthreads();
}

__device__ __forceinline__ void phase_scan(bf16_t* __restrict__ GS, const float* __restrict__ GD, bf16_t* __restrict__ RS, const float* __restrict__ lgam, int S) {
    const int tid = opaque_tid();
    const int lgn = (S == 16384) ? 1 : 4, nseq = 1 << lgn, ncg = S / 64, ncr = S / 128;
    const int gtid = blockIdx.x * NTHR + tid, gth = gridDim.x * NTHR;
    const int n_gla = 2 * nseq * 4 * 1024, n_ret = 2 * nseq * 4 * 2048;
    constexpr int SB_ = 16;
    for (int idx = gtid; idx < n_gla + n_ret; idx += gth) {
        if (idx < n_gla) {
            const int el = 2 * (idx & 1023), hh = (idx >> 10) & 3, sq = (idx >> 12) & (nseq - 1), dir = (idx >> 12) >> lgn, kk = el & 31;
            const size_t cstr = (size_t)4 * 2048;
            unsigned* base = (unsigned*)(GS + (((size_t)dir * NCH + (size_t)sq * ncg) * 4 + hh) * 2048 + el);
            const float* dbase = GD + (((size_t)dir * NCH + (size_t)sq * ncg) * 4 + hh) * 32 + kk;
            const long step = dir ? -1 : 1; const long c0 = dir ? ncg - 1 : 0;
            unsigned cur[SB_], nxt[SB_]; f32x2_t dcur[SB_], dnxt[SB_];
#pragma unroll
            for (int u = 0; u < SB_; ++u) { const long c = c0 + step * u; cur[u] = *(const unsigned*)((const bf16_t*)base + c * (long)cstr); dcur[u] = *(const f32x2_t*)(dbase + c * 128); }
            float s0 = 0.f, s1 = 0.f;
#pragma unroll 1
            for (int i0 = 0; i0 < ncg; i0 += SB_) {
                const bool more = i0 + SB_ < ncg;
#pragma unroll
                for (int u = 0; u < SB_; ++u) { const long c = c0 + step * (more ? i0 + SB_ + u : i0 + u); nxt[u] = *(const unsigned*)((const bf16_t*)base + c * (long)cstr); dnxt[u] = *(const f32x2_t*)(dbase + c * 128); }
#pragma unroll
                for (int u = 0; u < SB_; ++u) { const long c = c0 + step * (i0 + u);
                    *(unsigned*)((bf16_t*)base + c * (long)cstr) = cvt_pk_bf16(s0, s1); s0 = dcur[u].x * s0 + bflo(cur[u]); s1 = dcur[u].y * s1 + bfhi(cur[u]); }
#pragma unroll
                for (int u = 0; u < SB_; ++u) { cur[u] = nxt[u]; dcur[u] = dnxt[u]; }
            }
        } else {
            const int j = idx - n_gla; const int el = 2 * (j & 2047), hh = (j >> 11) & 3, sq = (j >> 13) & (nseq - 1), dir = (j >> 13) >> lgn;
            const float dec = __expf(128.f * lgam[dir * 4 + hh]);
            const size_t cstr = (size_t)4 * 4096;
            unsigned* base = (unsigned*)(RS + (((size_t)dir * NCR + (size_t)sq * ncr) * 4 + hh) * 4096 + el);
            const long step = dir ? -1 : 1; const long c0 = dir ? ncr - 1 : 0;
            unsigned cur[SB_], nxt[SB_];
#pragma unroll
            for (int u = 0; u < SB_; ++u) { const long c = c0 + step * u; cur[u] = *(const unsigned*)((const bf16_t*)base + c * (long)cstr); }
            float s0 = 0.f, s1 = 0.f;
#pragma unroll 1
            for (int i0 = 0; i0 < ncr; i0 += SB_) {
                const bool more = i0 + SB_ < ncr;
#pragma unroll
                for (int u = 0; u < SB_; ++u) { const long c = c0 + step * (more ? i0 + SB_ + u : i0 + u); nxt[u] = *(const unsigned*)((const bf16_t*)base + c * (long)cstr); }
#pragma unroll
                for (int u = 0; u < SB_; ++u) { const long c = c0 + step * (i0 + u);
                    *(unsigned*)((bf16_t*)base + c * (long)cstr) = cvt_pk_bf16(s0, s1); s0 = dec * s0 + bflo(cur[u]); s1 = dec * s1 + bfhi(cur[u]); }
#pragma unroll
                for (int u = 0; u < SB_; ++u) cur[u] = nxt[u];
            }
        }
    }
}

#define XB_TMO      128
#define XB_XCNT(j)  (256  + 64 * (j))
#define XB_XSUB(j)  (1280 + 64 * (j))
#define XB_XGEN(j)  (2304 + 64 * (j))
#define XB_TOP      3328
#define XB_TOPGEN   3392
#define XCD_BAR_WORDS 3456
#define XB_SPIN_CAP (1u << 22)
#define LAS __attribute__((address_space(3)))
__device__ __forceinline__ unsigned xb_ld(unsigned* p)              { return __hip_atomic_load(p, __ATOMIC_RELAXED, __HIP_MEMORY_SCOPE_AGENT); }
__device__ __forceinline__ unsigned xb_add(unsigned* p, unsigned v) { return __hip_atomic_fetch_add(p, v, __ATOMIC_RELAXED, __HIP_MEMORY_SCOPE_AGENT); }
__device__ __forceinline__ unsigned xb_xcc_id() { return (unsigned)__builtin_amdgcn_s_getreg((3 << 11) | 20) & 0xFu; }
#define XB_SPIN(cond, bar) do { unsigned _sp = 0; while (cond) { __builtin_amdgcn_s_sleep(1); \
    if ((++_sp & 255u) == 0u) { if (xb_ld(&(bar)[XB_TMO])) break; if (_sp > XB_SPIN_CAP) { atomicAdd(&(bar)[XB_TMO], 1u); break; } } } } while (0)
struct XcdBarrier { unsigned* bar; unsigned x; volatile LAS unsigned* st; };
__device__ __forceinline__ XcdBarrier xcd_barrier_post(unsigned* bar, volatile LAS unsigned* st) {
    XcdBarrier b; b.bar = bar; b.x = xb_xcc_id(); b.st = st;
    if (threadIdx.x == 0) (void)xb_add(&bar[XB_XCNT(b.x)], 1u);
    return b;
}
__device__ __forceinline__ void xcd_barrier_complete(unsigned* bar, unsigned x, unsigned& nloc, unsigned& nx) {
    const unsigned G = gridDim.x * gridDim.y * gridDim.z;
    unsigned sum, cnt, mine, sp = 0u;
    for (;;) {
        sum = 0u; cnt = 0u; mine = 0u;
#pragma unroll
        for (unsigned j = 0; j < 16; ++j) { const unsigned c = xb_ld(&bar[XB_XCNT(j)]); sum += c; cnt += (c > 0u) ? 1u : 0u; mine = (j == x) ? c : mine; }
        if (sum == G) break;
        __builtin_amdgcn_s_sleep(1);
        if ((++sp & 255u) == 0u) { if (xb_ld(&bar[XB_TMO])) break; if (sp > XB_SPIN_CAP) { atomicAdd(&bar[XB_TMO], 1u); break; } }
    }
    nloc = mine > 0u ? mine : 1u; nx = cnt > 0u ? cnt : 1u;
}
__device__ __forceinline__ void xcd_barrier(const XcdBarrier& b) {
    asm volatile("s_waitcnt vmcnt(0)" ::: "memory");
    __syncthreads();
    if (threadIdx.x == 0) {
        unsigned* bar = b.bar;
        __builtin_amdgcn_s_waitcnt(0);
        unsigned nloc = b.st[0], nx = b.st[1];
        if (nloc == 0u) { xcd_barrier_complete(bar, b.x, nloc, nx); b.st[0] = nloc; b.st[1] = nx; }
        const unsigned old = xb_add(&bar[XB_XSUB(b.x)], 1u);
        const unsigned gen = old / nloc;
        if (old + 1u == (gen + 1u) * nloc) {
            __builtin_amdgcn_fence(__ATOMIC_RELEASE, "agent");
            asm volatile("s_waitcnt vmcnt(0)" ::: "memory");
            const unsigned og = xb_add(&bar[XB_TOP], 1u);
            const unsigned tg = og / nx;
            if (og + 1u == (tg + 1u) * nx) xb_add(&bar[XB_TOPGEN], 1u);
            else XB_SPIN(xb_ld(&bar[XB_TOPGEN]) == tg, bar);
            __builtin_amdgcn_fence(__ATOMIC_ACQUIRE, "agent");
            xb_add(&bar[XB_XGEN(b.x)], 1u);
            asm volatile("s_waitcnt vmcnt(0)" ::: "memory");
        } else {
            XB_SPIN(xb_ld(&bar[XB_XGEN(b.x)]) == gen, bar);
            __builtin_amdgcn_fence(__ATOMIC_ACQUIRE, "agent");
            asm volatile("s_waitcnt vmcnt(0)" ::: "memory");
        }
    }
    __syncthreads();
}

__global__ void __launch_bounds__(NTHR, 2) fwd_mega(Params p) {
    cg::grid_group grid = cg::this_grid();
    unsigned char* ws = p.ws;
    bf16_t* WT = (bf16_t*)(ws + WS_WT); const float* tab = (const float*)(ws + WS_TAB);
    bf16_t* HB0 = (bf16_t*)(ws + WS_HB); bf16_t* HB1 = (bf16_t*)(ws + WS_HB1);
    float* SSQ0 = (float*)(ws + WS_SSQ); float* SSQ1 = SSQ0 + (size_t)MG * 16; float* SSQ2 = SSQ1 + (size_t)MG * 16;
    bf16_t* Z = (bf16_t*)(ws + WS_Z); bf16_t* MIX = (bf16_t*)(ws + WS_MIX); bf16_t* HID = (bf16_t*)(ws + WS_HID);
    bf16_t* PB = (bf16_t*)(ws + WS_PB); bf16_t* PL = (bf16_t*)(ws + WS_PLE);
    bf16_t* GS = (bf16_t*)(ws + WS_GS); float* GD = (float*)(ws + WS_GD); bf16_t* RS = (bf16_t*)(ws + WS_RS);
    float* lgam = (float*)(g_lds + LDS_BYTES - 64);

#ifndef NO_P0
    phase_weights(p);
#endif
    unsigned* barw = (unsigned*)(ws + WS_BAR);
    volatile LAS unsigned* bst = (volatile LAS unsigned*)(g_lds + LDS_BYTES - 32);
    if (blockIdx.x == 0) for (int i = threadIdx.x; i < XCD_BAR_WORDS; i += NTHR) barw[i] = 0u;
    if (threadIdx.x < 2) bst[threadIdx.x] = 0u;
    grid.sync();
    const XcdBarrier xb = xcd_barrier_post(barw, bst);
#pragma unroll 1
    for (int g = 0; g < NGROUPS; ++g) {
        const int S = (g == 0) ? 16384 : 2048;
        float* H = p.out + (size_t)g * MG * D;
#ifndef NO_PI
        phase_init(p, g);
#endif
        xcd_barrier(xb);
#pragma unroll 1
        for (int l = 0; l < NLAYER; ++l) {
            const bf16_t* W = WT + (size_t)l * W_LAYER;
            { const int t8 = opaque_tid(); if (t8 < 8) { const float x = p.ret_decay_raw[l * 8 + t8]; lgam[t8] = fminf(x, 0.f) - __logf(1.0f + __expf(-fabsf(x))); } }
            __syncthreads();
            { EpiIn e{Z, SSQ0, p.attn_q_norm + l * 64, p.attn_k_norm + l * 64, p.gla_gate_bias + l * 256, tab, S - 1};
#ifndef NO_P1
#ifndef REP_P1
#define REP_P1 1
#endif
              gemm_phase(HB0, D, W + WO_IN, D, MG, ZW, D, e);
#if REP_P1 > 1
              xcd_barrier(xb); gemm_phase(HB0, D, W + WO_IN, D, MG, ZW, D, e);
#endif
#endif
 }
            xcd_barrier(xb);
#ifndef REP_MIX
#define REP_MIX 1
#endif
            for (int rep_mix = 0; rep_mix < REP_MIX; ++rep_mix) {
            { const int nA = 1024, nG = NCH, nR = 2 * NCR;
#ifndef NO_AT
              if ((gridDim.x & 7) == 0) {
                  const int per = nA / 8, slots = gridDim.x / 8;
                  for (int k = blockIdx.x / 8; k < per; k += slots) attn_item(Z, MIX, S, per * (blockIdx.x & 7) + k);
              } else { for (int it = blockIdx.x; it < nA; it += gridDim.x) attn_item(Z, MIX, S, it); }
#endif
              for (int it = nA + blockIdx.x; it < nA + nG + nR; it += gridDim.x) {
#ifndef NO_G1
                  if (it >= nA && it < nA + nG) gla1_item(Z, GS, GD, it - nA);
#endif
#ifndef NO_R1
                  if (it >= nA + nG) ret1_item(Z, RS, lgam, it - nA - nG);
#endif
              } }
            xcd_barrier(xb);
#ifndef NO_P3
            phase_scan(GS, GD, RS, lgam, S);
#endif
            xcd_barrier(xb);
            { for (int it = blockIdx.x; it < NCH + NCR; it += gridDim.x) {
#ifndef NO_G3
                  if (it < NCH) gla3_item(Z, GS, MIX, p.gla_out_norm + l * 256, it);
#endif
#ifndef NO_R3
                  if (it >= NCH) ret3_item(Z, RS, MIX, p.ret_out_norm + l * 256, lgam, it - NCH);
#endif
              } }
            xcd_barrier(xb);
            }
#ifndef NO_P5
            { EpiRes e{HB0, HB1, SSQ1}; gemm_phase(MIX, D, W + WO_OUT, D, MG, D, D, e); }
#endif
            xcd_barrier(xb);
#ifndef NO_P6
            { EpiMlpIn e{HID, SSQ1}; gemm_phase_t<true>(HB1, D, W + WO_MI, D, MG, DFF, D, e); }
#endif
#ifndef NO_P6B
            { EpiPlain e{PB, D}; gemm_phase(PL + (size_t)l * MG * PLE, PLE, W + WO_PP, PLE, MG, D, PLE, e); }
#endif
            xcd_barrier(xb);
#ifndef NO_P7
            { EpiRes e{HB1, HB1, SSQ2}; gemm_phase(HID, DFF, W + WO_MO, DFF, MG, D, DFF, e); }
#endif
            xcd_barrier(xb);
#ifndef NO_P9
            { EpiPeGate e{H, HB1, HB0, SSQ0, SSQ2, PB, l == NLAYER - 1}; gemm_phase(HB1, D, W + WO_PG, D, MG, D, D, e); }
#endif
            xcd_barrier(xb);
        }
    }
}

extern "C" void kernel_launch(void* const* d_in, const int* in_sizes, int n_in, void* d_out, int out_size, void* d_ws, size_t ws_size, hipStream_t stream) {
    static int grid_blocks = 0;
    if (!grid_blocks) {
        int dev = 0, cus = 0, per_cu = 0;
        hipGetDevice(&dev);
        hipDeviceGetAttribute(&cus, hipDeviceAttributeMultiprocessorCount, dev);
        hipFuncSetAttribute((const void*)fwd_mega, hipFuncAttributeMaxDynamicSharedMemorySize, LDS_BYTES);
        hipOccupancyMaxActiveBlocksPerMultiprocessor(&per_cu, (const void*)fwd_mega, NTHR, LDS_BYTES);
        if (per_cu < 1) per_cu = 1;
        grid_blocks = cus * 1;
        if (ws_size < WS_END) fprintf(stderr, "kernel_launch: workspace too small: %zu < %zu\n", ws_size, (size_t)WS_END);
    }
    Params p{};
    p.x_prompt = (const float*)d_in[0]; p.x_sample = (const float*)d_in[1]; p.p_prompt = (const float*)d_in[2]; p.p_sample = (const float*)d_in[3];
    p.ln_mix = (const float*)d_in[4]; p.w_in = (const float*)d_in[5]; p.attn_q_norm = (const float*)d_in[6]; p.attn_k_norm = (const float*)d_in[7];
    p.gla_gate_up = (const float*)d_in[8]; p.gla_gate_bias = (const float*)d_in[9]; p.gla_out_norm = (const float*)d_in[10]; p.ret_decay_raw = (const float*)d_in[11];
    p.ret_out_norm = (const float*)d_in[12]; p.w_out = (const float*)d_in[13]; p.ln_mlp = (const float*)d_in[14]; p.w_mlp_in = (const float*)d_in[15]; p.w_mlp_out = (const float*)d_in[16];
    p.ln_pe = (const float*)d_in[17]; p.w_pe_gate = (const float*)d_in[18]; p.w_pe_proj = (const float*)d_in[19];
    p.out = (float*)d_out; p.ws = (unsigned char*)d_ws;
    void* args[] = {&p};
    hipError_t e = hipLaunchCooperativeKernel((const void*)fwd_mega, dim3(grid_blocks), dim3(NTHR), args, LDS_BYTES, stream);
    if (e != hipSuccess) fprintf(stderr, "cooperative launch failed: %s (grid %d)\n", hipGetErrorString(e), grid_blocks);
}
```

```cpp
#include <hip/hip_runtime.h>
#include <hip/hip_cooperative_groups.h>
#include <cstdio>
#include <cstdint>
namespace cg = cooperative_groups;

typedef unsigned short bf16_t;
typedef short bf16x8 __attribute__((ext_vector_type(8)));
typedef float f32x4 __attribute__((ext_vector_type(4)));
typedef unsigned u32x4 __attribute__((ext_vector_type(4)));
typedef unsigned u32x2 __attribute__((ext_vector_type(2)));

constexpr int D = 1024, MG = 32768, NGROUPS = 3, NLAYER = 2;
constexpr int ZW = 3584, DFF = 4096, PLE = 256, NIN = 3360;
constexpr int NTHR = 512;
constexpr int NCH = MG / 64;
constexpr int NCR = MG / 128;
constexpr float EPS = 1e-6f;
constexpr int ZC_AQ = 0, ZC_AK = 512, ZC_AV = 1024, ZC_BQ = 1536, ZC_BK = 1664, ZC_BV = 1792, ZC_BR = 2048,
              ZC_GF = 2304, ZC_GB = 2432, ZC_CQ = 2560, ZC_CK = 2816, ZC_CV = 3072, ZC_CG = 3328;
constexpr size_t WO_IN = 0, WO_OUT = WO_IN + (size_t)ZW * D, WO_MI = WO_OUT + (size_t)D * D, WO_MO = WO_MI + (size_t)DFF * D,
                 WO_PG = WO_MO + (size_t)D * DFF, WO_PP = WO_PG + (size_t)D * D, W_LAYER = WO_PP + (size_t)D * PLE;
constexpr size_t WS_WT = 0;
constexpr size_t WS_TAB = WS_WT + W_LAYER * 2 * NLAYER;
constexpr size_t WS_HB = WS_TAB + (size_t)16384 * 40 * 2 * 4;
constexpr size_t WS_HB1 = WS_HB + (size_t)MG * D * 2;
constexpr size_t WS_SSQ = WS_HB1 + (size_t)MG * D * 2;
constexpr size_t WS_Z = WS_SSQ + (size_t)3 * MG * 16 * 4;
constexpr size_t WS_MIX = WS_Z + (size_t)MG * ZW * 2;
constexpr size_t WS_HID = WS_MIX + (size_t)MG * D * 2;
constexpr size_t WS_PB = WS_HID + (size_t)MG * DFF * 2;
constexpr size_t WS_PLE = WS_PB + (size_t)MG * D * 2;
constexpr size_t WS_GS = WS_PLE + (size_t)NLAYER * MG * PLE * 2;
constexpr size_t WS_GD = WS_GS + (size_t)2 * NCH * 4 * 2048 * 4;
constexpr size_t WS_RS = WS_GD + (size_t)2 * NCH * 4 * 32 * 4;
constexpr size_t WS_BAR = WS_RS + (size_t)2 * NCR * 4 * 4096 * 4;
constexpr size_t WS_END = WS_BAR + 16384;

constexpr int LDS_BYTES = 139264;

extern __shared__ __attribute__((aligned(16))) unsigned char g_lds[];

struct Params {
    const float* x_prompt; const float* x_sample; const float* p_prompt; const float* p_sample;
    const float* ln_mix; const float* w_in; const float* attn_q_norm; const float* attn_k_norm;
    const float* gla_gate_up; const float* gla_gate_bias; const float* gla_out_norm; const float* ret_decay_raw;
    const float* ret_out_norm; const float* w_out; const float* ln_mlp; const float* w_mlp_in; const float* w_mlp_out;
    const float* ln_pe; const float* w_pe_gate; const float* w_pe_proj;
    float* out; unsigned char* ws;
};

typedef float f32x2_t __attribute__((ext_vector_type(2)));
typedef __bf16 bf16x2_t __attribute__((ext_vector_type(2)));
__device__ __forceinline__ unsigned cvt_pk_bf16(float lo, float hi) { const f32x2_t v = {lo, hi}; return __builtin_bit_cast(unsigned, __builtin_convertvector(v, bf16x2_t)); }
__device__ __forceinline__ float bf2f(unsigned short b) { return __uint_as_float(((unsigned)b) << 16); }
__device__ __forceinline__ float bflo(unsigned w) { return __uint_as_float(w << 16); }
__device__ __forceinline__ float bfhi(unsigned w) { return __uint_as_float(w & 0xffff0000u); }
__device__ __forceinline__ bf16x8 pack8(const float (&v)[8]) {
    u32x4 w; w.x = cvt_pk_bf16(v[0], v[1]); w.y = cvt_pk_bf16(v[2], v[3]); w.z = cvt_pk_bf16(v[4], v[5]); w.w = cvt_pk_bf16(v[6], v[7]);
    return __builtin_bit_cast(bf16x8, w);
}
__device__ __forceinline__ void unpack8(bf16x8 b, float (&v)[8]) {
    u32x4 w = __builtin_bit_cast(u32x4, b);
    v[0] = bflo(w.x); v[1] = bfhi(w.x); v[2] = bflo(w.y); v[3] = bfhi(w.y); v[4] = bflo(w.z); v[5] = bfhi(w.z); v[6] = bflo(w.w); v[7] = bfhi(w.w);
}
typedef short v4i16_t __attribute__((ext_vector_type(4)));
__device__ __forceinline__ bf16x8 gather8(const bf16_t* tile  , int stride, int qi) {
    const bf16_t* p = tile + (qi >> 2) * stride + 4 * (qi & 3);
    const v4i16_t lo = __builtin_amdgcn_ds_read_tr16_b64_v4i16((__attribute__((address_space(3))) v4i16_t*)p);
    const v4i16_t hi = __builtin_amdgcn_ds_read_tr16_b64_v4i16((__attribute__((address_space(3))) v4i16_t*)(p + 4 * stride));
    bf16x8 r; r[0] = lo[0]; r[1] = lo[1]; r[2] = lo[2]; r[3] = lo[3]; r[4] = hi[0]; r[5] = hi[1]; r[6] = hi[2]; r[7] = hi[3];
    return r;
}
__device__ __forceinline__ bf16x8 ld8f_pack(const float* p) {
    f32x4 a = *(const f32x4*)p, b = *(const f32x4*)(p + 4);
    u32x4 w; w.x = cvt_pk_bf16(a.x, a.y); w.y = cvt_pk_bf16(a.z, a.w); w.z = cvt_pk_bf16(b.x, b.y); w.w = cvt_pk_bf16(b.z, b.w);
    return __builtin_bit_cast(bf16x8, w);
}
__device__ __forceinline__ int opaque_tid() { int t = threadIdx.x; asm volatile("" : "+v"(t)); return t; }
__device__ __forceinline__ float xmax16(float m) { auto rr = __builtin_amdgcn_permlane16_swap(__float_as_uint(m), __float_as_uint(m), false, false); return fmaxf(__uint_as_float(rr[0]), __uint_as_float(rr[1])); }
__device__ __forceinline__ float xmax32(float m) { auto rr = __builtin_amdgcn_permlane32_swap(__float_as_uint(m), __float_as_uint(m), false, false); return fmaxf(__uint_as_float(rr[0]), __uint_as_float(rr[1])); }
__device__ __forceinline__ float xsum16(float m) { auto rr = __builtin_amdgcn_permlane16_swap(__float_as_uint(m), __float_as_uint(m), false, false); return __uint_as_float(rr[0]) + __uint_as_float(rr[1]); }
__device__ __forceinline__ float xsum32(float m) { auto rr = __builtin_amdgcn_permlane32_swap(__float_as_uint(m), __float_as_uint(m), false, false); return __uint_as_float(rr[0]) + __uint_as_float(rr[1]); }
__device__ __forceinline__ float rsum16(float v) {
    v += __uint_as_float(__builtin_amdgcn_update_dpp(0u, __float_as_uint(v), 0x128, 0xf, 0xf, false));
    v += __uint_as_float(__builtin_amdgcn_update_dpp(0u, __float_as_uint(v), 0x124, 0xf, 0xf, false));
    v += __uint_as_float(__builtin_amdgcn_update_dpp(0u, __float_as_uint(v), 0x122, 0xf, 0xf, false));
    v += __uint_as_float(__builtin_amdgcn_update_dpp(0u, __float_as_uint(v), 0x121, 0xf, 0xf, false));
    return v;
}
#define LDS_FENCE() asm volatile("s_waitcnt lgkmcnt(0)" ::: "memory")
#define MFMA16(a, b, c) __builtin_amdgcn_mfma_f32_16x16x32_bf16((a), (b), (c), 0, 0, 0)

constexpr int BM = 256, BK = 64, HALF = 128, HT = HALF * BK;
__device__ __forceinline__ int lds_byte(int r, int c) {
    int st = (r >> 4) * 2 + (c >> 5), rr = r & 15, cc = c & 31, ob = rr * 64 + cc * 2;
    return st * 1024 + (ob ^ (((ob >> 9) & 1) << 5));
}
__device__ __forceinline__ void stage_rc(int b, int& R, int& C) {
    int st = b / 1024, sb = b % 1024, swz = sb ^ (((sb >> 9) & 1) << 5);
    R = (st >> 1) * 16 + swz / 64; C = (st & 1) * 32 + (swz % 64) / 2;
}
__device__ __forceinline__ bool tile_of(int L, int nM, int nN, int& pm, int& pn) {
    const int nwg = nM * nN; if (L >= nwg) return false;
    int wgid = L; { const int q = nwg / 8, r = nwg % 8, xcd = wgid % 8, off = wgid / 8; wgid = (xcd < r ? xcd * (q + 1) : r * (q + 1) + (xcd - r) * q) + off; }
    const int nig = 8 * nN, gid = wgid / nig, fm = gid * 8, gsz = (nM - fm) < 8 ? (nM - fm) : 8;
    pm = fm + ((wgid % nig) % gsz); pn = (wgid % nig) / gsz; return true;
}

template <bool TR, class Epi>
__device__ __forceinline__ void gemm_tile(const bf16_t* __restrict__ A, int lda, const bf16_t* __restrict__ Bt, int ldb, int K, int brow, int bcol, const Epi& epi, int parity, bool pre, int nbrow, int nbcol) {
    const int tid = opaque_tid();
    bf16_t* shm = (bf16_t*)g_lds;
#define SA(b, h) (shm + ((b) * 2 + (h)) * HT)
#define SB(b, h) (shm + (4 + (b) * 2 + (h)) * HT)
#define STAGE(P, BASE, LD, br, kt) do { const int _so = ((br) * (LD) + (kt) * BK) * 2; \
    for (int _i = 0; _i < 2; ++_i) { \
      __builtin_amdgcn_raw_ptr_buffer_load_lds(((&(LD) == &lda) ? rsA : rsB), (__attribute__((address_space(3))) void*)((char*)(P) + wid * 1024 + _i * 8192), 16, \
          ((&(LD) == &lda) ? offA[_i] : offB[_i]), _so, 0, 0); } } while (0)
#define LDA(dst, b, h) for (int m = 0; m < 4; ++m) for (int k = 0; k < 2; ++k) \
    dst[m][k] = *reinterpret_cast<const bf16x8*>((char*)SA(b, h) + lds_byte(wr * 64 + m * 16 + fr, k * 32 + fq * 8))
#define LDB(dst, b, h) for (int n = 0; n < 2; ++n) for (int k = 0; k < 2; ++k) \
    dst[n][k] = *reinterpret_cast<const bf16x8*>((char*)SB(b, h) + lds_byte(wc * 32 + n * 16 + fr, k * 32 + fq * 8))
#define MMA(ai, bj, At, Bt_) do { __builtin_amdgcn_s_setprio(1); \
    for (int m = 0; m < 4; ++m) for (int n = 0; n < 2; ++n) for (int k = 0; k < 2; ++k) \
      acc[ai][bj][m][n] = TR ? __builtin_amdgcn_mfma_f32_16x16x32_bf16(Bt_[n][k], At[m][k], acc[ai][bj][m][n], 0, 0, 0) \
                            : __builtin_amdgcn_mfma_f32_16x16x32_bf16(At[m][k], Bt_[n][k], acc[ai][bj][m][n], 0, 0, 0); \
    __builtin_amdgcn_s_setprio(0); } while (0)
#define WAIT_V(n) asm volatile("s_waitcnt vmcnt(" #n ")" ::: "memory")
#define WAIT_L(n) asm volatile("s_waitcnt lgkmcnt(" #n ")" ::: "memory")
#define BAR __builtin_amdgcn_s_barrier()
#define SCHED __builtin_amdgcn_sched_barrier(0)
    const int wid = __builtin_amdgcn_readfirstlane(tid >> 6), lane = tid & 63, wr = wid >> 2, wc = wid & 3, fr = lane & 15, fq = lane >> 4;
    f32x4 acc[2][2][4][2] = {};
    bf16x8 At[4][2], B0[2][2], B1[2][2];
    const int nt = K / BK;
    const __amdgpu_buffer_rsrc_t rsA = __builtin_amdgcn_make_buffer_rsrc((void*)A, (short)0, 0x7ffffff0, 0x00020000);
    const __amdgpu_buffer_rsrc_t rsB = __builtin_amdgcn_make_buffer_rsrc((void*)Bt, (short)0, 0x7ffffff0, 0x00020000);
    unsigned offA[2], offB[2];
    for (int _i = 0; _i < 2; ++_i) { int _r, _c; stage_rc(tid * 16 + _i * 8192, _r, _c); offA[_i] = (unsigned)(_r * lda + _c) * 2u; offB[_i] = (unsigned)(_r * ldb + _c) * 2u; }
    if (!(TR && pre)) {
    STAGE(SB(0, 0), Bt, ldb, bcol, 0); STAGE(SA(0, 0), A, lda, brow, 0);
    STAGE(SB(0, 1), Bt, ldb, bcol + HALF, 0); STAGE(SA(0, 1), A, lda, brow + HALF, 0);
    }
    float* RT = (float*)(g_lds + 131072 + (parity & 1) * 1024);
    if (TR) { if (tid < 256) RT[tid] = epi.rstd_row(brow + tid); }
    if (wr == 1) BAR;
    if (TR && pre) { WAIT_V(8); } else { WAIT_V(4); }
    BAR;
    STAGE(SB(1, 0), Bt, ldb, bcol, 1); STAGE(SA(1, 0), A, lda, brow, 1); STAGE(SB(1, 1), Bt, ldb, bcol + HALF, 1);
    WAIT_V(6); BAR;
#pragma unroll 1
    for (int t = 0; t < nt - 2; t += 2) {
        LDB(B0, 0, 0); SCHED; LDA(At, 0, 0); STAGE(SA(1, 1), A, lda, brow + HALF, t + 1);
        WAIT_L(8); BAR; WAIT_L(0); MMA(0, 0, At, B0); BAR; SCHED;
        LDB(B1, 0, 1); STAGE(SB(0, 0), Bt, ldb, bcol, t + 2);
        BAR; WAIT_L(0); MMA(0, 1, At, B1); BAR;
        LDA(At, 0, 1); STAGE(SA(0, 0), A, lda, brow, t + 2);
        BAR; WAIT_L(0); MMA(1, 0, At, B0); BAR; SCHED;
        STAGE(SB(0, 1), Bt, ldb, bcol + HALF, t + 2);
        WAIT_V(6); BAR; MMA(1, 1, At, B1); BAR;
        LDB(B0, 1, 0); SCHED; LDA(At, 1, 0); STAGE(SA(0, 1), A, lda, brow + HALF, t + 2);
        WAIT_L(8); BAR; WAIT_L(0); MMA(0, 0, At, B0); BAR; SCHED;
        LDB(B1, 1, 1); STAGE(SB(1, 0), Bt, ldb, bcol, t + 3);
        BAR; WAIT_L(0); MMA(0, 1, At, B1); BAR;
        LDA(At, 1, 1); STAGE(SA(1, 0), A, lda, brow, t + 3);
        BAR; WAIT_L(0); MMA(1, 0, At, B0); BAR; SCHED;
        STAGE(SB(1, 1), Bt, ldb, bcol + HALF, t + 3);
        WAIT_V(6); BAR; MMA(1, 1, At, B1); BAR;
    }
    { LDB(B0, 0, 0); LDA(At, 0, 0); STAGE(SA(1, 1), A, lda, brow + HALF, nt - 1);
      BAR; WAIT_L(0); MMA(0, 0, At, B0); BAR;
      LDB(B1, 0, 1); BAR; WAIT_L(0); MMA(0, 1, At, B1); BAR;
      LDA(At, 0, 1); WAIT_V(4); BAR; WAIT_L(0); MMA(1, 0, At, B0); MMA(1, 1, At, B1); BAR; }
    { LDB(B0, 1, 0); LDA(At, 1, 0); WAIT_V(2); BAR; WAIT_L(0); MMA(0, 0, At, B0); BAR;
      LDB(B1, 1, 1); WAIT_V(0); BAR; WAIT_L(0); MMA(0, 1, At, B1); BAR;
      LDA(At, 1, 1); BAR; WAIT_L(0); MMA(1, 0, At, B0); MMA(1, 1, At, B1); BAR; }
    if (wr == 0) BAR;
    if (TR && nbrow >= 0) {
        STAGE(SB(0, 0), Bt, ldb, nbcol, 0); STAGE(SA(0, 0), A, lda, nbrow, 0);
        STAGE(SB(0, 1), Bt, ldb, nbcol + HALF, 0); STAGE(SA(0, 1), A, lda, nbrow + HALF, 0);
        asm volatile("" ::: "memory"); SCHED;
    }
    if (TR) {
        epi.regs(acc, RT, brow, bcol, wr, wc, fr, fq);
        return;
    }
    float* ep = (float*)g_lds;
#pragma unroll
    for (int ai = 0; ai < 2; ++ai) {
        if (ai) __syncthreads();
#pragma unroll
        for (int bj = 0; bj < 2; ++bj)
#pragma unroll
            for (int m = 0; m < 4; ++m)
#pragma unroll
                for (int n = 0; n < 2; ++n)
#pragma unroll
                    for (int j = 0; j < 4; ++j)
                        ep[(wr * 64 + m * 16 + fq * 4 + j) * 260 + bj * HALF + wc * 32 + n * 16 + fr] = acc[ai][bj][m][n][j];
        __syncthreads();
        int lane_e = tid & 63; asm volatile("" : "+v"(lane_e));
        const int row0 = brow + ai * HALF + wid * 16;
        epi.rows(ep, wid, lane_e, row0, bcol);
    }
    __syncthreads();
#undef SA
#undef SB
#undef STAGE
#undef LDA
#undef LDB
#undef MMA
}

template <bool TR, class Epi>
__device__ __forceinline__ void gemm_phase_t(const bf16_t* A, int lda, const bf16_t* Bt, int ldb, int M, int N, int K, const Epi& epi) {
    const int nM = M / BM, nN = N / BM;
    int pm, pn; bool have = tile_of((int)blockIdx.x, nM, nN, pm, pn), pre = false;
    for (int i = 0; have; ++i) {
        int npm = 0, npn = 0; const bool nhave = tile_of((i + 1) * (int)gridDim.x + (int)blockIdx.x, nM, nN, npm, npn);
        gemm_tile<TR>(A, lda, Bt, ldb, K, pm * BM, pn * BM, epi, i, pre, (TR && nhave) ? npm * BM : -1, npn * BM);
        pre = TR && nhave; pm = npm; pn = npn; have = nhave;
    }
    if (TR) __syncthreads();
}
template <class Epi>
__device__ __forceinline__ void gemm_phase(const bf16_t* A, int lda, const bf16_t* Bt, int ldb, int M, int N, int K, const Epi& epi) { gemm_phase_t<false>(A, lda, Bt, ldb, M, N, K, epi); }

__device__ __forceinline__ float row_rstd(const float* ssq, int row) {
    const f32x4* p = (const f32x4*)(ssq + (size_t)row * 16);
    const f32x4 a = p[0], b = p[1], c = p[2], d = p[3];
    const float s = ((a.x + a.y) + (a.z + a.w)) + ((b.x + b.y) + (b.z + b.w)) + ((c.x + c.y) + (c.z + c.w)) + ((d.x + d.y) + (d.z + d.w));
    return rsqrtf(s * (1.0f / D) + EPS);
}
__device__ __forceinline__ float rstd16(const float* ssq, int row0, int lane) {
    const f32x4 q = *(const f32x4*)(ssq + (size_t)(row0 + (lane >> 2)) * 16 + 4 * (lane & 3));
    float s = (q.x + q.y) + (q.z + q.w); s += __shfl_xor(s, 1); s += __shfl_xor(s, 2);
    return rsqrtf(s * (1.0f / D) + EPS);
}
__device__ __forceinline__ float seg_sum16(float s) { return rsum16(s); }
__device__ __forceinline__ void st4_bf16(bf16_t* d, float a, float b, float c, float e) { u32x2 w; w.x = cvt_pk_bf16(a, b); w.y = cvt_pk_bf16(c, e); *(u32x2*)d = w; }

template <class E> __device__ __forceinline__ void epi_rows_generic(const E& e, const float* ep, int wid, int lane, int row0, int bcol) {
    const float rsv = e.begin(row0, lane);
    const int col = bcol + 4 * lane;
    typename E::Ld L[16];
#pragma unroll
    for (int u = 0; u < 16; ++u) L[u] = e.load(row0 + u, col);
#pragma unroll
    for (int u = 0; u < 16; ++u) {
        const f32x4 v = *(const f32x4*)(ep + (wid * 16 + u) * 260 + 4 * lane);
        e.finish(v, L[u], row0 + u, col, lane, __shfl(rsv, 4 * u));
    }
}

struct EpiIn {
    bf16_t* Z; const float* ssq; const float* qn; const float* kn; const float* gbias; const float* tab; int smask;
    __device__ __forceinline__ float rstd_row(int) const { return 0.f; }
    __device__ __forceinline__ void regs(const f32x4 (&)[2][2][4][2], const float*, int, int, int, int, int, int) const {}
    template <int T> __device__ __forceinline__ void rows_t(const float* ep, int wid, int lane, int row0, int bcol) const {
        const float rsv = rstd16(ssq, row0, lane);
        const int col = bcol + 4 * lane, c = col & 63, sl = lane & 15;
        f32x4 gn = {1.f, 1.f, 1.f, 1.f}, bb = {0.f, 0.f, 0.f, 0.f};
        if (T == 0) gn = *(const f32x4*)(qn + c);
        if (T == 1) gn = *(const f32x4*)(kn + c);
        if (T == 4) bb = *(const f32x4*)(gbias + (col - ZC_GF));
        const bool rot = (T <= 1) ? (sl < 4) : true;
        const float sgn = (T <= 1) ? (sl < 2 ? -1.f : 1.f) : (sl < 8 ? -1.f : 1.f);
        const int toff = (T <= 1) ? 2 * (c & 7) : 16 + 2 * (c & 31);
        const float psc = (T == 2) ? ((col >= ZC_BQ && col < ZC_BK) ? 0.17677669529663687f : 1.0f) : (T == 0 ? 0.125f * 1.4426950408889634f : (T == 6 ? 0.125f : 1.0f));
#pragma unroll 1
        for (int i0 = 0; i0 < 16; i0 += 4) {
            f32x4 vv[4], tt0[4], tt1[4];
#pragma unroll
            for (int u = 0; u < 4; ++u) {
                vv[u] = *(const f32x4*)(ep + (wid * 16 + i0 + u) * 260 + 4 * lane);
                if (T == 0 || T == 1 || T == 5 || T == 6) { const float* cs = tab + (size_t)((row0 + i0 + u) & smask) * 80 + toff; tt0[u] = *(const f32x4*)cs; tt1[u] = *(const f32x4*)(cs + 4); }
            }
#pragma unroll
            for (int u = 0; u < 4; ++u) {
            f32x4 v = vv[u];
            const int row = row0 + i0 + u; const float rstd = __shfl(rsv, 4 * (i0 + u));
            bf16_t* dst = Z + (size_t)row * ZW + col;
            if (T == 0 || T == 1 || T == 5 || T == 6) {
                const f32x4 t0 = tt0[u], t1 = tt1[u];
                float r = rstd * psc;
                if (T <= 1) { const float ss = seg_sum16((v.x * v.x + v.y * v.y) + (v.z * v.z + v.w * v.w)); r *= rsqrtf(ss * rstd * rstd * (1.0f / 64) + EPS); }
                v.x *= r * gn.x; v.y *= r * gn.y; v.z *= r * gn.z; v.w *= r * gn.w;
                f32x4 pv;
                if (T <= 1) { pv.x = __shfl_xor(v.x, 2); pv.y = __shfl_xor(v.y, 2); pv.z = __shfl_xor(v.z, 2); pv.w = __shfl_xor(v.w, 2); }
                else        { pv.x = __shfl_xor(v.x, 8); pv.y = __shfl_xor(v.y, 8); pv.z = __shfl_xor(v.z, 8); pv.w = __shfl_xor(v.w, 8); }
                const float nx = v.x * t0.x + sgn * pv.x * t0.y, ny = v.y * t0.z + sgn * pv.y * t0.w, nz = v.z * t1.x + sgn * pv.z * t1.y, nw = v.w * t1.z + sgn * pv.w * t1.w;
                st4_bf16(dst, rot ? nx : v.x, rot ? ny : v.y, rot ? nz : v.z, rot ? nw : v.w);
            } else if (T == 4) {
                float x[4] = {v.x * rstd + bb.x, v.y * rstd + bb.y, v.z * rstd + bb.z, v.w * rstd + bb.w}; unsigned short hb[4];
#pragma unroll
                for (int k = 0; k < 4; ++k) { const float ls = fminf(x[k], 0.f) - __logf(1.0f + __expf(-fabsf(x[k]))); const _Float16 hv = (_Float16)(ls * 0.0625f); hb[k] = __builtin_bit_cast(unsigned short, hv); }
                u32x2 w; w.x = hb[0] | ((unsigned)hb[1] << 16); w.y = hb[2] | ((unsigned)hb[3] << 16);
                *(u32x2*)dst = w;
            } else {
                const float sc = rstd * psc;
                st4_bf16(dst, v.x * sc, v.y * sc, v.z * sc, v.w * sc);
            }
            }
        }
    }
    __device__ __forceinline__ void rows(const float* ep, int wid, int lane, int row0, int bcol) const {
        if (bcol < ZC_AK) rows_t<0>(ep, wid, lane, row0, bcol);
        else if (bcol < ZC_AV) rows_t<1>(ep, wid, lane, row0, bcol);
        else if (bcol == ZC_GF) rows_t<4>(ep, wid, lane, row0, bcol);
        else if (bcol == ZC_CQ) rows_t<5>(ep, wid, lane, row0, bcol);
        else if (bcol == ZC_CK) rows_t<6>(ep, wid, lane, row0, bcol);
        else rows_t<2>(ep, wid, lane, row0, bcol);
    }
};

struct EpiRes {
    const bf16_t* HBin; bf16_t* HBout; float* ssq;
    typedef u32x2 Ld;
    __device__ __forceinline__ float rstd_row(int) const { return 0.f; }
    __device__ __forceinline__ void regs(const f32x4 (&)[2][2][4][2], const float*, int, int, int, int, int, int) const {}
    __device__ __forceinline__ void rows(const float* ep, int wid, int lane, int row0, int bcol) const { epi_rows_generic(*this, ep, wid, lane, row0, bcol); }
    __device__ __forceinline__ float begin(int, int) const { return 0.f; }
    __device__ __forceinline__ Ld load(int row, int col) const { return *(const u32x2*)(HBin + (size_t)row * D + col); }
    __device__ __forceinline__ void finish(f32x4 v, Ld hw, int row, int col, int lane, float) const {
        f32x4 h = {bflo(hw.x) + v.x, bfhi(hw.x) + v.y, bflo(hw.y) + v.z, bfhi(hw.y) + v.w};
        u32x2 w; w.x = cvt_pk_bf16(h.x, h.y); w.y = cvt_pk_bf16(h.z, h.w);
        *(u32x2*)(HBout + (size_t)row * D + col) = w;
        h.x = bflo(w.x); h.y = bfhi(w.x); h.z = bflo(w.y); h.w = bfhi(w.y);
        const float ss = seg_sum16((h.x * h.x + h.y * h.y) + (h.z * h.z + h.w * h.w));
        if ((lane & 15) == 0) ssq[(size_t)row * 16 + (col >> 6)] = ss;
    }
};

struct EpiMlpIn {
    bf16_t* HID; const float* ssq;
    __device__ __forceinline__ float rstd_row(int row) const { return row_rstd(ssq, row); }
    __device__ __forceinline__ void regs(const f32x4 (&acc)[2][2][4][2], const float* RT, int brow, int bcol, int wr, int wc, int fr, int fq) const {
#pragma unroll
        for (int ai = 0; ai < 2; ++ai)
#pragma unroll
            for (int m = 0; m < 4; ++m) {
                const int rl = ai * HALF + wr * 64 + m * 16 + fr; const float rstd = RT[rl];
                bf16_t* dst = HID + (size_t)(brow + rl) * DFF + bcol + wc * 32 + 8 * fq;
#pragma unroll
                for (int bj = 0; bj < 2; ++bj) { float t[8];
#pragma unroll
                    for (int n = 0; n < 2; ++n)
#pragma unroll
                        for (int j = 0; j < 4; ++j) { const float x = fmaxf(acc[ai][bj][m][n][j] * rstd, 0.f); t[4 * n + j] = x * x; }
                    *(bf16x8*)(dst + bj * HALF) = pack8(t); }
            }
    }
    __device__ __forceinline__ void rows(const float* ep, int wid, int lane, int row0, int bcol) const { epi_rows_generic(*this, ep, wid, lane, row0, bcol); }
    __device__ __forceinline__ float begin(int row0, int lane) const { return rstd16(ssq, row0, lane); }
    typedef int Ld;
    __device__ __forceinline__ Ld load(int, int) const { return 0; }
    __device__ __forceinline__ void finish(f32x4 v, Ld, int row, int col, int lane, float rstd) const { this->row(v, row, col, lane, rstd); }
    __device__ __forceinline__ void row(f32x4 v, int row, int col, int, float rstd) const {
        const float a = fmaxf(v.x * rstd, 0.f), b = fmaxf(v.y * rstd, 0.f), c = fmaxf(v.z * rstd, 0.f), e = fmaxf(v.w * rstd, 0.f);
        st4_bf16(HID + (size_t)row * DFF + col, a * a, b * b, c * c, e * e);
    }
};

struct EpiPlain {
    bf16_t* O; int ldo;
    __device__ __forceinline__ float rstd_row(int) const { return 0.f; }
    __device__ __forceinline__ void regs(const f32x4 (&)[2][2][4][2], const float*, int, int, int, int, int, int) const {}
    __device__ __forceinline__ void rows(const float* ep, int wid, int lane, int row0, int bcol) const { epi_rows_generic(*this, ep, wid, lane, row0, bcol); }
    __device__ __forceinline__ float begin(int, int) const { return 0.f; }
    typedef int Ld;
    __device__ __forceinline__ Ld load(int, int) const { return 0; }
    __device__ __forceinline__ void finish(f32x4 v, Ld, int row, int col, int lane, float rstd) const { this->row(v, row, col, lane, rstd); }
    __device__ __forceinline__ void row(f32x4 v, int row, int col, int, float) const { st4_bf16(O + (size_t)row * ldo + col, v.x, v.y, v.z, v.w); }
};

struct EpiPeGate {
    float* Hout; const bf16_t* HBin; bf16_t* HBout; float* ssq_out; const float* ssq_in; const bf16_t* PB; int write_f32;
    struct Ld { u32x2 pw, hw; };
    __device__ __forceinline__ float rstd_row(int) const { return 0.f; }
    __device__ __forceinline__ void regs(const f32x4 (&)[2][2][4][2], const float*, int, int, int, int, int, int) const {}
    __device__ __forceinline__ void rows(const float* ep, int wid, int lane, int row0, int bcol) const { epi_rows_generic(*this, ep, wid, lane, row0, bcol); }
    __device__ __forceinline__ float begin(int row0, int lane) const { return rstd16(ssq_in, row0, lane); }
    __device__ __forceinline__ Ld load(int row, int col) const { Ld l; l.pw = *(const u32x2*)(PB + (size_t)row * D + col); l.hw = *(const u32x2*)(HBin + (size_t)row * D + col); return l; }
    __device__ __forceinline__ void finish(f32x4 v, Ld l, int row, int col, int lane, float rstd) const {
        const u32x2 pw = l.pw, hw = l.hw;
        f32x4 h;
        h.x = bflo(hw.x) + bflo(pw.x) / (1.0f + __expf(-v.x * rstd)); h.y = bfhi(hw.x) + bfhi(pw.x) / (1.0f + __expf(-v.y * rstd));
        h.z = bflo(hw.y) + bflo(pw.y) / (1.0f + __expf(-v.z * rstd)); h.w = bfhi(hw.y) + bfhi(pw.y) / (1.0f + __expf(-v.w * rstd));
        if (write_f32) *(f32x4*)(Hout + (size_t)row * D + col) = h;
        u32x2 w; w.x = cvt_pk_bf16(h.x, h.y); w.y = cvt_pk_bf16(h.z, h.w);
        *(u32x2*)(HBout + (size_t)row * D + col) = w;
        h.x = bflo(w.x); h.y = bfhi(w.x); h.z = bflo(w.y); h.w = bfhi(w.y);
        const float ss = seg_sum16((h.x * h.x + h.y * h.y) + (h.z * h.z + h.w * h.w));
        if ((lane & 15) == 0) ssq_out[(size_t)row * 16 + (col >> 6)] = ss;
    }
};

template <class F>
__device__ __forceinline__ void transpose_item(bf16_t* Wt, int K, int k0, int n0, const F& src) {
    const int tid = opaque_tid();
    float* tile = (float*)g_lds;
#pragma unroll
    for (int i = 0; i < 8; ++i) { const int kk = (tid >> 6) + 8 * i, nn = tid & 63; tile[kk * 65 + nn] = src(k0 + kk, n0 + nn); }
    __syncthreads();
    { const int nn = tid >> 3, kc = tid & 7; float t[8];
#pragma unroll
      for (int j = 0; j < 8; ++j) t[j] = tile[(8 * kc + j) * 65 + nn];
      *(bf16x8*)(Wt + (size_t)(n0 + nn) * K + k0 + 8 * kc) = pack8(t); }
    __syncthreads();
}

__device__ __forceinline__ void phase_weights(const Params& p) {
    bf16_t* WT = (bf16_t*)(p.ws + WS_WT);
    constexpr int I_IN = 16 * (ZW / 64), I_OUT = 16 * 16, I_MI = 16 * 64, I_MO = 64 * 16, I_PG = 16 * 16, I_PP = 4 * 16;
    constexpr int I_L = I_IN + I_OUT + I_MI + I_MO + I_PG + I_PP;
    for (int it = blockIdx.x; it < NLAYER * I_L; it += gridDim.x) {
        const int l = it / I_L; int r = it % I_L;
        bf16_t* W = WT + (size_t)l * W_LAYER;
        if (r < I_IN) {
            const int kb = r / (ZW / 64), nb = r % (ZW / 64);
            const float* w = p.w_in + (size_t)l * D * NIN; const float* g = p.ln_mix + l * D; const float* gu = p.gla_gate_up + (size_t)l * 2 * 16 * 128;
            transpose_item(W + WO_IN, D, kb * 64, nb * 64, [&](int k, int c) -> float {
                float v;
                if (c < ZC_GF) v = w[(size_t)k * NIN + c];
                else if (c < ZC_CQ) { const int j = (c - ZC_GF) >> 7, kk = (c - ZC_GF) & 127; float s = 0.f;
                    for (int rr = 0; rr < 16; ++rr) s += w[(size_t)k * NIN + 2304 + 16 * j + rr] * gu[(j * 16 + rr) * 128 + kk];
                    v = s; }
                else v = w[(size_t)k * NIN + (c - 224)];
                return v * g[k]; });
            continue; }
        r -= I_IN;
        if (r < I_OUT) { const float* w = p.w_out + (size_t)l * D * D;
            transpose_item(W + WO_OUT, D, (r / 16) * 64, (r % 16) * 64, [&](int k, int c) -> float { return w[(size_t)k * D + c]; }); continue; }
        r -= I_OUT;
        if (r < I_MI) { const float* w = p.w_mlp_in + (size_t)l * D * DFF; const float* g = p.ln_mlp + l * D;
            transpose_item(W + WO_MI, D, (r / 64) * 64, (r % 64) * 64, [&](int k, int c) -> float { const int rho = c & 31; const int cc = (c & ~31) + 8 * ((rho & 15) >> 2) + 4 * (rho >> 4) + (rho & 3);
                return w[(size_t)k * DFF + cc] * g[k]; }); continue; }
        r -= I_MI;
        if (r < I_MO) { const float* w = p.w_mlp_out + (size_t)l * DFF * D;
            transpose_item(W + WO_MO, DFF, (r / 16) * 64, (r % 16) * 64, [&](int k, int c) -> float { return w[(size_t)k * D + c]; }); continue; }
        r -= I_MO;
        if (r < I_PG) { const float* w = p.w_pe_gate + (size_t)l * D * D; const float* g = p.ln_pe + l * D;
            transpose_item(W + WO_PG, D, (r / 16) * 64, (r % 16) * 64, [&](int k, int c) -> float { return w[(size_t)k * D + c] * g[k]; }); continue; }
        r -= I_PG;
        { const float* w = p.w_pe_proj + (size_t)l * PLE * D;
            transpose_item(W + WO_PP, PLE, (r / 16) * 64, (r % 16) * 64, [&](int k, int c) -> float { return w[(size_t)k * D + c]; }); }
    }
    float* tab = (float*)(p.ws + WS_TAB);
    for (int e = blockIdx.x * NTHR + threadIdx.x; e < 16384 * 40; e += gridDim.x * NTHR) {
        const int pos = e / 40, i = e % 40;
        const double invf = (i < 8) ? exp(-(double)i * (log(500000.0) / 8.0)) : exp(-(double)(i - 8) * (log(10000.0) / 32.0));
        double ang = (double)pos * invf; ang -= 6.283185307179586476925 * floor(ang * 0.15915494309189533577);
        tab[2 * e] = (float)cos(ang); tab[2 * e + 1] = (float)sin(ang);
    }
}

__device__ __forceinline__ void phase_init(const Params& p, int g) {
    const int tid = opaque_tid();
    const float* x = (g == 0) ? p.x_prompt : p.x_sample + (size_t)(g - 1) * MG * D;
    bf16_t* HB = (bf16_t*)(p.ws + WS_HB); float* ssq = (float*)(p.ws + WS_SSQ);
    const int lane = tid & 63, gw = blockIdx.x * 8 + (tid >> 6), NGW = gridDim.x * 8;
    for (int row = gw; row < MG; row += 2 * NGW) {
        f32x4 vv[2][4];
#pragma unroll
        for (int rr = 0; rr < 2; ++rr)
#pragma unroll
            for (int j = 0; j < 4; ++j) vv[rr][j] = *(const f32x4*)(x + (size_t)(row + rr * NGW) * D + 256 * j + 4 * lane);
#pragma unroll
        for (int rr = 0; rr < 2; ++rr)
#pragma unroll
            for (int j = 0; j < 4; ++j) {
                f32x4 v = vv[rr][j]; const int r2 = row + rr * NGW;
                u32x2 w; w.x = cvt_pk_bf16(v.x, v.y); w.y = cvt_pk_bf16(v.z, v.w);
                *(u32x2*)(HB + (size_t)r2 * D + 256 * j + 4 * lane) = w;
                v.x = bflo(w.x); v.y = bfhi(w.x); v.z = bflo(w.y); v.w = bfhi(w.y);
                float s_ = (v.x * v.x + v.y * v.y) + (v.z * v.z + v.w * v.w);
                s_ += __shfl_xor(s_, 1); s_ += __shfl_xor(s_, 2); s_ += __shfl_xor(s_, 4); s_ += __shfl_xor(s_, 8);
                if ((lane & 15) == 0) ssq[(size_t)r2 * 16 + (lane >> 4) + 4 * j] = s_;
            }
    }
    bf16_t* PL = (bf16_t*)(p.ws + WS_PLE);
    for (int l = 0; l < NLAYER; ++l) {
        const float* src = (g == 0) ? p.p_prompt + (size_t)l * MG * PLE : p.p_sample + ((size_t)l * 2 * MG + (size_t)(g - 1) * MG) * PLE;
        bf16_t* dst = PL + (size_t)l * MG * PLE;
        const size_t stride = (size_t)gridDim.x * NTHR * 8;
        for (size_t e = (size_t)(blockIdx.x * NTHR + tid) * 8; e < (size_t)MG * PLE; e += 4 * stride) {
            f32x4 a[4][2];
#pragma unroll
            for (int u = 0; u < 4; ++u) if (e + u * stride < (size_t)MG * PLE) { a[u][0] = *(const f32x4*)(src + e + u * stride); a[u][1] = *(const f32x4*)(src + e + u * stride + 4); }
#pragma unroll
            for (int u = 0; u < 4; ++u) if (e + u * stride < (size_t)MG * PLE) { u32x4 w; w.x = cvt_pk_bf16(a[u][0].x, a[u][0].y); w.y = cvt_pk_bf16(a[u][0].z, a[u][0].w); w.z = cvt_pk_bf16(a[u][1].x, a[u][1].y); w.w = cvt_pk_bf16(a[u][1].z, a[u][1].w);
                *(u32x4*)(dst + e + u * stride) = w; }
        }
    }
}

struct AttnLd { bf16x8 ka0, ka1, kb0, kb1; u32x4 v0, v1, v2, v3; };
__device__ __forceinline__ void attn_geom(int f, int r, int n0, int& dsh, int& cb) {
    const int p = f < 12 ? 0 : (f < 18 ? 1 : 2); const int i2 = f - (p == 0 ? 0 : (p == 1 ? 12 : 18));
    dsh = 2 * p; cb = (r >> dsh) + (16 >> dsh) * n0 - 64 + 32 * i2;
}
__device__ __forceinline__ AttnLd attn_load(const bf16_t* __restrict__ zq, int S, int head, int r, int n0, int lane, int f) {
    int dsh, cb; attn_geom(f, r, n0, dsh, cb);
    const int qi = lane & 15, g = lane >> 4, rd = r & ((1 << dsh) - 1), ncls = S >> dsh;
    const int cA = cb + 8 * (qi >> 2) + (qi & 3), cB = cA + 4;
    const int cAc = min(max(cA, 0), ncls - 1), cBc = min(max(cB, 0), ncls - 1);
    const bf16_t* kA = zq + (size_t)(rd + (cAc << dsh)) * ZW + ZC_AK + head * 64 + 8 * g;
    const bf16_t* kB = zq + (size_t)(rd + (cBc << dsh)) * ZW + ZC_AK + head * 64 + 8 * g;
    AttnLd L;
    L.ka0 = *(const bf16x8*)kA; L.ka1 = *(const bf16x8*)(kA + 32); L.kb0 = *(const bf16x8*)kB; L.kb1 = *(const bf16x8*)(kB + 32);
    const int cv0 = cb + (lane >> 3);
    const bf16_t* vb = zq + ZC_AV + head * 64 + 8 * (lane & 7);
    L.v0 = *(const u32x4*)(vb + (size_t)(rd + (min(max(cv0, 0), ncls - 1) << dsh)) * ZW);
    L.v1 = *(const u32x4*)(vb + (size_t)(rd + (min(max(cv0 + 8, 0), ncls - 1) << dsh)) * ZW);
    L.v2 = *(const u32x4*)(vb + (size_t)(rd + (min(max(cv0 + 16, 0), ncls - 1) << dsh)) * ZW);
    L.v3 = *(const u32x4*)(vb + (size_t)(rd + (min(max(cv0 + 24, 0), ncls - 1) << dsh)) * ZW);
    return L;
}
__device__ __forceinline__ bf16x8 attn_softmax_step(const f32x4& sA, const f32x4& sB, int cb, int cq, int ncls, int g, float& m, float& lsum, f32x4 (&O)[4]) {
    float s[8]; bool ok[8];
    const int c0v = cb + 8 * g, d0 = c0v - cq + 64;
#pragma unroll
    for (int j = 0; j < 8; ++j) {
        ok[j] = ((unsigned)(c0v + j) < (unsigned)ncls) && ((unsigned)(d0 + j) <= 128u);
        s[j] = ok[j] ? (j < 4 ? sA[j] : sB[j - 4]) : -__builtin_inff(); }
    float mx = fmaxf(fmaxf(fmaxf(s[0], s[1]), fmaxf(s[2], s[3])), fmaxf(fmaxf(s[4], s[5]), fmaxf(s[6], s[7])));
    mx = xmax32(xmax16(mx));
    const float mn = fmaxf(m, mx), alpha = __builtin_amdgcn_exp2f(m - mn);
    m = mn;
    float pj[8], ps_ = 0.f;
#pragma unroll
    for (int j = 0; j < 8; ++j) { pj[j] = __builtin_amdgcn_exp2f(s[j] - mn); ps_ += pj[j]; }
    lsum = lsum * alpha + ps_;
#pragma unroll
    for (int nbk = 0; nbk < 4; ++nbk) O[nbk] *= alpha;
    return pack8(pj);
}
__device__ __forceinline__ void attn_lds_step(const bf16_t* Kt, const bf16_t* Vt, int rowb, const bf16x8& q0, const bf16x8& q1, int cb, int cq, int ncls,
                                              int qi, int g, float& m, float& lsum, f32x4 (&O)[4]) {
    const bf16_t* kA = Kt + (rowb + 8 * (qi >> 2) + (qi & 3)) * 72 + 8 * g;
    const bf16x8 ka0 = *(const bf16x8*)kA, ka1 = *(const bf16x8*)(kA + 32), kb0 = *(const bf16x8*)(kA + 4 * 72), kb1 = *(const bf16x8*)(kA + 4 * 72 + 32);
    f32x4 sA = {0.f, 0.f, 0.f, 0.f}, sB = {0.f, 0.f, 0.f, 0.f};
    sA = MFMA16(ka0, q0, sA); sA = MFMA16(ka1, q1, sA);
    sB = MFMA16(kb0, q0, sB); sB = MFMA16(kb1, q1, sB);
    const bf16x8 P = attn_softmax_step(sA, sB, cb, cq, ncls, g, m, lsum, O);
#pragma unroll
    for (int nbk = 0; nbk < 4; ++nbk) O[nbk] = MFMA16(gather8(Vt + (rowb + 8 * g) * 68 + 16 * nbk, 68, qi), P, O[nbk]);
}
template <int NROWS>
__device__ __forceinline__ void attn_stage(const bf16_t* __restrict__ zq, int head, bf16_t* Kt, bf16_t* Vt, int c0, int ncls, int rd, int dsh, int tid) {
    constexpr int IT = (NROWS * 16 + NTHR - 1) / NTHR;
    u32x4 v[IT];
#pragma unroll
    for (int u = 0; u < IT; ++u) { const int idx = min(tid + u * NTHR, NROWS * 16 - 1);
        const int i = idx >> 4, ch = idx & 15, isv = ch >> 3, c8 = ch & 7; const int c = min(max(c0 + i, 0), ncls - 1);
        v[u] = *(const u32x4*)(zq + (size_t)(rd + (c << dsh)) * ZW + (isv ? ZC_AV : ZC_AK) + head * 64 + 8 * c8); }
#pragma unroll
    for (int u = 0; u < IT; ++u) { const int idx = min(tid + u * NTHR, NROWS * 16 - 1);
        const int i = idx >> 4, ch = idx & 15, isv = ch >> 3, c8 = ch & 7;
        bf16_t* d = isv ? (Vt + i * 68 + 8 * c8) : (Kt + i * 72 + 8 * c8);
        *(u32x2*)d = (u32x2){v[u].x, v[u].y}; *(u32x2*)(d + 4) = (u32x2){v[u].z, v[u].w}; }
}
__device__ __forceinline__ void attn_item(const bf16_t* __restrict__ Z, bf16_t* __restrict__ MIX, int S, int it) {
    const int tid = opaque_tid();
    __syncthreads();
    const int wave = tid >> 6, lane = tid & 63, qi = lane & 15, g = lane >> 4;
    const int nblk = S >> 8;
    const int pb = it % nblk; const int t1 = it / nblk; const int head = t1 & 7, seq = t1 >> 3;
    const int P0 = pb * 256, n0 = pb * 16;
    const bf16_t* zq = Z + (size_t)seq * S * ZW;
    bf16_t* Kt = (bf16_t*)g_lds;
    bf16_t* Vt = (bf16_t*)(g_lds + 57600);
    bf16_t* Vs = (bf16_t*)g_lds + wave * (32 * 68);
    int rt[2]; rt[0] = 4 * (wave >> 1) + (wave & 1); rt[1] = rt[0] + 2;
    bf16x8 q0[2], q1[2]; float m[2] = {-1e30f, -1e30f}, lsum[2] = {0.f, 0.f}; f32x4 O[2][4] = {};
#pragma unroll
    for (int ti = 0; ti < 2; ++ti) { const bf16_t* qp = zq + (size_t)(P0 + rt[ti] + 16 * qi) * ZW + ZC_AQ + head * 64 + 8 * g; q0[ti] = *(const bf16x8*)qp; q1[ti] = *(const bf16x8*)(qp + 32); }
    {
        bf16_t* Vs1 = Vs + 8 * (32 * 68);
        AttnLd cur0 = attn_load(zq, S, head, rt[0], n0, lane, 18), cur1 = attn_load(zq, S, head, rt[1], n0, lane, 18);
#pragma unroll 1
        for (int f = 18; f < 23; ++f) {
            const AttnLd nxt0 = attn_load(zq, S, head, rt[0], n0, lane, f < 22 ? f + 1 : 22), nxt1 = attn_load(zq, S, head, rt[1], n0, lane, f < 22 ? f + 1 : 22);
            const int cb = n0 - 64 + 32 * (f - 18), ncls = S >> 4, cq = n0 + qi;
            f32x4 sA0 = {0.f, 0.f, 0.f, 0.f}, sB0 = {0.f, 0.f, 0.f, 0.f}, sA1 = {0.f, 0.f, 0.f, 0.f}, sB1 = {0.f, 0.f, 0.f, 0.f};
            sA0 = MFMA16(cur0.ka0, q0[0], sA0); sA1 = MFMA16(cur1.ka0, q0[1], sA1); sB0 = MFMA16(cur0.kb0, q0[0], sB0); sB1 = MFMA16(cur1.kb0, q0[1], sB1);
            sA0 = MFMA16(cur0.ka1, q1[0], sA0); sA1 = MFMA16(cur1.ka1, q1[1], sA1); sB0 = MFMA16(cur0.kb1, q1[0], sB0); sB1 = MFMA16(cur1.kb1, q1[1], sB1);
            LDS_FENCE();
            { bf16_t* d = Vs + (lane >> 3) * 68 + 8 * (lane & 7);
              *(u32x2*)d = (u32x2){cur0.v0.x, cur0.v0.y}; *(u32x2*)(d + 4) = (u32x2){cur0.v0.z, cur0.v0.w};
              *(u32x2*)(d + 8 * 68) = (u32x2){cur0.v1.x, cur0.v1.y}; *(u32x2*)(d + 8 * 68 + 4) = (u32x2){cur0.v1.z, cur0.v1.w};
              *(u32x2*)(d + 16 * 68) = (u32x2){cur0.v2.x, cur0.v2.y}; *(u32x2*)(d + 16 * 68 + 4) = (u32x2){cur0.v2.z, cur0.v2.w};
              *(u32x2*)(d + 24 * 68) = (u32x2){cur0.v3.x, cur0.v3.y}; *(u32x2*)(d + 24 * 68 + 4) = (u32x2){cur0.v3.z, cur0.v3.w};
              d = Vs1 + (lane >> 3) * 68 + 8 * (lane & 7);
              *(u32x2*)d = (u32x2){cur1.v0.x, cur1.v0.y}; *(u32x2*)(d + 4) = (u32x2){cur1.v0.z, cur1.v0.w};
              *(u32x2*)(d + 8 * 68) = (u32x2){cur1.v1.x, cur1.v1.y}; *(u32x2*)(d + 8 * 68 + 4) = (u32x2){cur1.v1.z, cur1.v1.w};
              *(u32x2*)(d + 16 * 68) = (u32x2){cur1.v2.x, cur1.v2.y}; *(u32x2*)(d + 16 * 68 + 4) = (u32x2){cur1.v2.z, cur1.v2.w};
              *(u32x2*)(d + 24 * 68) = (u32x2){cur1.v3.x, cur1.v3.y}; *(u32x2*)(d + 24 * 68 + 4) = (u32x2){cur1.v3.z, cur1.v3.w}; }
            const bf16x8 P0_ = attn_softmax_step(sA0, sB0, cb, cq, ncls, g, m[0], lsum[0], O[0]);
            const bf16x8 P1_ = attn_softmax_step(sA1, sB1, cb, cq, ncls, g, m[1], lsum[1], O[1]);
            LDS_FENCE();
#pragma unroll
            for (int nbk = 0; nbk < 4; ++nbk) { O[0][nbk] = MFMA16(gather8(Vs + (8 * g) * 68 + 16 * nbk, 68, qi), P0_, O[0][nbk]); O[1][nbk] = MFMA16(gather8(Vs1 + (8 * g) * 68 + 16 * nbk, 68, qi), P1_, O[1][nbk]); }
            cur0 = nxt0; cur1 = nxt1;
        }
        LDS_FENCE();
    }
    __syncthreads();
    attn_stage<400>(zq, head, Kt, Vt, P0 - 64, S, 0, 0, tid);
    __syncthreads();
#pragma unroll 1
    for (int i2 = 0; i2 < 12; ++i2) {
        attn_lds_step(Kt, Vt, rt[0] + 32 * i2, q0[0], q1[0], P0 + rt[0] - 64 + 32 * i2, P0 + rt[0] + 16 * qi, S, qi, g, m[0], lsum[0], O[0]);
        attn_lds_step(Kt, Vt, rt[1] + 32 * i2, q0[1], q1[1], P0 + rt[1] - 64 + 32 * i2, P0 + rt[1] + 16 * qi, S, qi, g, m[1], lsum[1], O[1]);
    }
#pragma unroll
    for (int rho = 0; rho < 2; ++rho) {
        __syncthreads();
        attn_stage<200>(zq, head, Kt, Vt, (P0 >> 2) - 64, S >> 2, 2 * rho, 2, tid);
        attn_stage<200>(zq, head, Kt + 200 * 72, Vt + 200 * 68, (P0 >> 2) - 64, S >> 2, 2 * rho + 1, 2, tid);
        __syncthreads();
        const int r = rt[rho], cls = (r & 3) - 2 * rho, c0 = (P0 >> 2) + (r >> 2);
#pragma unroll 2
        for (int i2 = 0; i2 < 6; ++i2)
            attn_lds_step(Kt + cls * 200 * 72, Vt + cls * 200 * 68, (r >> 2) + 32 * i2, q0[rho], q1[rho], c0 - 64 + 32 * i2, c0 + 4 * qi, S >> 2, qi, g, m[rho], lsum[rho], O[rho]);
    }
#pragma unroll
    for (int ti = 0; ti < 2; ++ti) {
        float l = lsum[ti]; l = xsum32(xsum16(l));
        const float inv = 1.0f / l;
        bf16_t* op = MIX + ((size_t)seq * S + P0 + rt[ti] + 16 * qi) * D + head * 64 + 4 * g;
#pragma unroll
        for (int nbk = 0; nbk < 4; ++nbk) st4_bf16(op + 16 * nbk, O[ti][nbk].x * inv, O[ti][nbk].y * inv, O[ti][nbk].z * inv, O[ti][nbk].w * inv);
    }
    __syncthreads();
}

__device__ __forceinline__ float h2f(unsigned short b) { return (float)__builtin_bit_cast(_Float16, b); }

template <int NROWS>
__device__ __forceinline__ void stage_v4(const bf16_t* __restrict__ Z, size_t tok0, int zc, bf16_t* Vt) {
    const int tid = opaque_tid();
    constexpr int IT = NROWS * 32 / NTHR;
    u32x4 v[IT];
#pragma unroll
    for (int u = 0; u < IT; ++u) { const int idx = tid + u * NTHR; const int t = idx >> 5, ch = idx & 31; v[u] = *(const u32x4*)(Z + (tok0 + t) * ZW + zc + ch * 8); }
#pragma unroll
    for (int u = 0; u < IT; ++u) { const int idx = tid + u * NTHR; const int t = idx >> 5, ch = idx & 31, hh = ch >> 3, c8 = ch & 7;
        bf16_t* d = Vt + ((size_t)hh * NROWS + t) * 68 + c8 * 8;
        *(u32x2*)d = (u32x2){v[u].x, v[u].y}; *(u32x2*)(d + 4) = (u32x2){v[u].z, v[u].w}; }
}

__device__ __forceinline__ void gla_cum(const bf16_t* __restrict__ Z, size_t tok0, int h, int dir, int lane, float (&cum)[32], float& tot) {
    const int kk = lane & 31, hf = lane >> 5;
    const bf16_t* src = Z + (tok0 + 32 * hf) * ZW + ZC_GF + dir * 128 + h * 32 + kk;
    float part = 0.f;
#pragma unroll
    for (int i = 0; i < 32; ++i) { cum[i] = h2f(src[(size_t)i * ZW]); part += cum[i]; }
    const float other = __shfl_xor(part, 32);
    tot = part + other;
    if (dir == 0) { float run = hf ? other : 0.f;
#pragma unroll
        for (int i = 0; i < 32; ++i) { run += cum[i]; cum[i] = run; } }
    else { float run = hf ? 0.f : other;
#pragma unroll
        for (int i = 31; i >= 0; --i) { run += cum[i]; cum[i] = run; } }
}

__device__ __forceinline__ void gla1_item(const bf16_t* __restrict__ Z, bf16_t* __restrict__ GS, float* __restrict__ GD, int ci) {
    const int tid = opaque_tid();
    __syncthreads();
    const int wave = tid >> 6, lane = tid & 63, qi = lane & 15, g = lane >> 4;
    const int h = wave >> 1, dir = wave & 1;
    const size_t tok0 = (size_t)ci * 64;
    bf16_t* Vt = (bf16_t*)g_lds;
    bf16_t* Ks = (bf16_t*)g_lds + 4 * 64 * 68 + wave * (64 * 36);
    stage_v4<64>(Z, tok0, ZC_BV, Vt);
    float cum[32], tot;
    gla_cum(Z, tok0, h, dir, lane, cum, tot);
    { const int kk = lane & 31, hf = lane >> 5;
      const bf16_t* ksrc = Z + (tok0 + 32 * hf) * ZW + ZC_BK + h * 32 + kk;
      unsigned short kraw[32];
#pragma unroll
      for (int i = 0; i < 32; ++i) kraw[i] = ksrc[(size_t)i * ZW];
#pragma unroll
      for (int i = 0; i < 32; ++i) { const float kv = bf2f(kraw[i]) * __expf(tot - cum[i]);
          Ks[(32 * hf + i) * 36 + kk] = (bf16_t)(cvt_pk_bf16(kv, 0.f) & 0xffffu); }
      if (hf == 0) GD[(((size_t)dir * NCH + ci) * 4 + h) * 32 + kk] = __expf(tot); }
    __syncthreads();
    f32x4 acc[4][2] = {};
#pragma unroll
    for (int ks = 0; ks < 2; ++ks) {
        bf16x8 bfr[2];
#pragma unroll
        for (int kb = 0; kb < 2; ++kb) bfr[kb] = gather8(Ks + (32 * ks + 8 * g) * 36 + 16 * kb , 36, qi);
#pragma unroll
        for (int eb = 0; eb < 4; ++eb) { const bf16x8 af = gather8(Vt + ((size_t)h * 64 + 32 * ks + 8 * g) * 68 + 16 * eb , 68, qi);
#pragma unroll
            for (int kb = 0; kb < 2; ++kb) acc[eb][kb] = MFMA16(bfr[kb], af, acc[eb][kb]); }
    }
    bf16_t* dst = GS + (((size_t)dir * NCH + ci) * 4 + h) * 2048;
#pragma unroll
    for (int eb = 0; eb < 4; ++eb)
#pragma unroll
        for (int kb = 0; kb < 2; ++kb) st4_bf16(dst + (16 * eb + qi) * 32 + 16 * kb + 4 * g, acc[eb][kb].x, acc[eb][kb].y, acc[eb][kb].z, acc[eb][kb].w);
    __syncthreads();
}

__device__ __forceinline__ void gla3_item(const bf16_t* __restrict__ Z, const bf16_t* __restrict__ GS, bf16_t* __restrict__ MIX, const float* __restrict__ gnorm, int ci) {
    const int tid = opaque_tid();
    __syncthreads();
    const int wave = tid >> 6, lane = tid & 63, qi = lane & 15, g = lane >> 4;
    const size_t tok0 = (size_t)ci * 64;
    bf16_t* Vt = (bf16_t*)g_lds;
    float* CUM = (float*)(g_lds + 4 * 64 * 68 * 2);
    stage_v4<64>(Z, tok0, ZC_BV, Vt);
    { const int h = wave >> 1, dir = wave & 1; float cum[32], tot;
      gla_cum(Z, tok0, h, dir, lane, cum, tot);
      const int kk = lane & 31, hf = lane >> 5; float* cd = CUM + ((size_t)(h * 2 + dir) * 64 + 32 * hf) * 32 + kk;
#pragma unroll
      for (int i = 0; i < 32; ++i) cd[i * 32] = cum[i]; }
    __syncthreads();
    const int h = wave >> 1;
    const float* cF = CUM + (size_t)(h * 2 + 0) * 64 * 32; const float* cB = CUM + (size_t)(h * 2 + 1) * 64 * 32;
    const bf16_t* sF = GS + (((size_t)0 * NCH + ci) * 4 + h) * 2048; const bf16_t* sB = GS + (((size_t)1 * NCH + ci) * 4 + h) * 2048;
    bf16x8 SFf[4], SBf[4];
#pragma unroll
    for (int eb = 0; eb < 4; ++eb) { SFf[eb] = *(const bf16x8*)(sF + (16 * eb + qi) * 32 + 8 * g); SBf[eb] = *(const bf16x8*)(sB + (16 * eb + qi) * 32 + 8 * g); }
    bf16x8 KFf[2][2], KBf[2][2];
#pragma unroll
    for (int sg = 0; sg < 2; ++sg)
#pragma unroll
        for (int blk = 0; blk < 2; ++blk) {
            const int s = 32 * sg + 8 * (qi >> 2) + (qi & 3) + 4 * blk;
            float kv[8], a[8], b[8]; unpack8(*(const bf16x8*)(Z + (tok0 + s) * ZW + ZC_BK + h * 32 + 8 * g), kv);
#pragma unroll
            for (int j = 0; j < 8; ++j) { a[j] = kv[j] * __expf(-cF[s * 32 + 8 * g + j]); b[j] = kv[j] * __expf(-cB[s * 32 + 8 * g + j]); }
            KFf[sg][blk] = pack8(a); KBf[sg][blk] = pack8(b);
        }
#pragma unroll 1
    for (int tbi = 0; tbi < 2; ++tbi) {
        const int t = 16 * (2 * (wave & 1) + tbi) + qi;
        bf16x8 Qf, Qb;
        { float qv[8], a[8], b[8]; unpack8(*(const bf16x8*)(Z + (tok0 + t) * ZW + ZC_BQ + h * 32 + 8 * g), qv);
#pragma unroll
          for (int j = 0; j < 8; ++j) { a[j] = qv[j] * __expf(cF[t * 32 + 8 * g + j]); b[j] = qv[j] * __expf(cB[t * 32 + 8 * g + j]); }
          Qf = pack8(a); Qb = pack8(b); }
        f32x4 acc[4] = {};
#pragma unroll
        for (int eb = 0; eb < 4; ++eb) { acc[eb] = MFMA16(SFf[eb], Qf, acc[eb]); acc[eb] = MFMA16(SBf[eb], Qb, acc[eb]); }
#pragma unroll
        for (int sg = 0; sg < 2; ++sg) {
            f32x4 aF[2], aB[2];
#pragma unroll
            for (int blk = 0; blk < 2; ++blk) {
                const f32x4 z4 = {0.f, 0.f, 0.f, 0.f};
                aF[blk] = MFMA16(KFf[sg][blk], Qf, z4); aB[blk] = MFMA16(KBf[sg][blk], Qb, z4);
            }
            float pj[8];
#pragma unroll
            for (int j = 0; j < 8; ++j) { const int s = 32 * sg + 8 * g + j; pj[j] = (s <= t) ? (j < 4 ? aF[0][j] : aF[1][j - 4]) : (j < 4 ? aB[0][j] : aB[1][j - 4]); }
            const bf16x8 P = pack8(pj);
#pragma unroll
            for (int eb = 0; eb < 4; ++eb) acc[eb] = MFMA16(gather8(Vt + ((size_t)h * 64 + 32 * sg + 8 * g) * 68 + 16 * eb , 68, qi), P, acc[eb]);
        }
        float ss = 0.f;
#pragma unroll
        for (int eb = 0; eb < 4; ++eb) ss += (acc[eb].x * acc[eb].x + acc[eb].y * acc[eb].y) + (acc[eb].z * acc[eb].z + acc[eb].w * acc[eb].w);
        ss = xsum32(xsum16(ss));
        const float rn = rsqrtf(ss * (1.0f / 64) + EPS);
        u32x2 brw4[4]; f32x4 gn4[4];
#pragma unroll
        for (int eb = 0; eb < 4; ++eb) { const int e = 16 * eb + 4 * g; brw4[eb] = *(const u32x2*)(Z + (tok0 + t) * ZW + ZC_BR + h * 64 + e); gn4[eb] = *(const f32x4*)(gnorm + h * 64 + e); }
#pragma unroll
        for (int eb = 0; eb < 4; ++eb) { const int e = 16 * eb + 4 * g;
            const u32x2 brw = brw4[eb]; const f32x4 gn = gn4[eb];
            const float b0 = bflo(brw.x), b1 = bfhi(brw.x), b2 = bflo(brw.y), b3 = bfhi(brw.y);
            const float o0 = acc[eb].x * rn * gn.x * (b0 / (1.f + __expf(-b0))), o1 = acc[eb].y * rn * gn.y * (b1 / (1.f + __expf(-b1)));
            const float o2 = acc[eb].z * rn * gn.z * (b2 / (1.f + __expf(-b2))), o3 = acc[eb].w * rn * gn.w * (b3 / (1.f + __expf(-b3)));
            u32x2 w; w.x = cvt_pk_bf16(o0, o1); w.y = cvt_pk_bf16(o2, o3);
            *(u32x2*)(MIX + (tok0 + t) * D + 512 + h * 64 + e) = w; }
    }
    __syncthreads();
}

__device__ __forceinline__ void ret1_item(const bf16_t* __restrict__ Z, bf16_t* __restrict__ RS, const float* __restrict__ lgam, int item) {
    const int tid = opaque_tid();
    __syncthreads();
    const int wave = tid >> 6, lane = tid & 63, qi = lane & 15, g = lane >> 4;
    const int ci = item >> 1, hp = item & 1;
    const size_t tok0 = (size_t)ci * 128;
    bf16_t* Vt = (bf16_t*)g_lds;
    bf16_t* Kt = Vt + 2 * 128 * 68;
    { u32x4 v[8];
#pragma unroll
      for (int u = 0; u < 8; ++u) { const int idx = tid + u * NTHR; const int which = idx >> 11, r = idx & 2047, t = r >> 4, ch = r & 15;
          v[u] = *(const u32x4*)(Z + (tok0 + t) * ZW + (which ? ZC_CK : ZC_CV) + hp * 128 + ch * 8); }
#pragma unroll
      for (int u = 0; u < 8; ++u) { const int idx = tid + u * NTHR; const int which = idx >> 11, r = idx & 2047, t = r >> 4, ch = r & 15, hh = ch >> 3, c8 = ch & 7;
          bf16_t* d = (which ? Kt : Vt) + ((size_t)hh * 128 + t) * 68 + c8 * 8;
          *(u32x2*)d = (u32x2){v[u].x, v[u].y}; *(u32x2*)(d + 4) = (u32x2){v[u].z, v[u].w}; } }
    __syncthreads();
    const int hh = wave >> 2, dir = (wave >> 1) & 1, eh = wave & 1, head = 2 * hp + hh;
    const float lg = lgam[dir * 4 + head];
    f32x4 acc[2][4] = {};
#pragma unroll 1
    for (int ks = 0; ks < 4; ++ks) {
        float w[8];
#pragma unroll
        for (int j = 0; j < 8; ++j) { const int s = 32 * ks + 8 * g + j; w[j] = __expf(lg * (float)(dir ? s : 127 - s)); }
        bf16x8 bfr[4];
#pragma unroll
        for (int db = 0; db < 4; ++db) { float kv[8]; unpack8(gather8(Kt + ((size_t)hh * 128 + 32 * ks + 8 * g) * 68 + 16 * db , 68, qi), kv);
#pragma unroll
            for (int j = 0; j < 8; ++j) kv[j] *= w[j];
            bfr[db] = pack8(kv); }
#pragma unroll
        for (int ebi = 0; ebi < 2; ++ebi) { const bf16x8 af = gather8(Vt + ((size_t)hh * 128 + 32 * ks + 8 * g) * 68 + 16 * (2 * eh + ebi) , 68, qi);
#pragma unroll
            for (int db = 0; db < 4; ++db) acc[ebi][db] = MFMA16(bfr[db], af, acc[ebi][db]); }
    }
    bf16_t* dst = RS + (((size_t)dir * NCR + ci) * 4 + head) * 4096;
#pragma unroll
    for (int ebi = 0; ebi < 2; ++ebi)
#pragma unroll
        for (int db = 0; db < 4; ++db) st4_bf16(dst + (16 * (2 * eh + ebi) + qi) * 64 + 16 * db + 4 * g, acc[ebi][db].x, acc[ebi][db].y, acc[ebi][db].z, acc[ebi][db].w);
    __syncthreads();
}

__device__ __forceinline__ void ret3_item(const bf16_t* __restrict__ Z, const bf16_t* __restrict__ RS, bf16_t* __restrict__ MIX, const float* __restrict__ rnorm, const float* __restrict__ lgam, int ci) {
    const int tid = opaque_tid();
    __syncthreads();
    const int wave = tid >> 6, lane = tid & 63, qi = lane & 15, g = lane >> 4;
    const size_t tok0 = (size_t)ci * 128;
    bf16_t* Vt = (bf16_t*)g_lds;
    stage_v4<128>(Z, tok0, ZC_CV, Vt);
    __syncthreads();
    const int h = wave >> 1;
    const float lg0 = lgam[h], lg1 = lgam[4 + h];
    const bf16_t* rF = RS + (((size_t)0 * NCR + ci) * 4 + h) * 4096; const bf16_t* rB = RS + (((size_t)1 * NCR + ci) * 4 + h) * 4096;
    bf16x8 RF[4][2], RB[4][2];
#pragma unroll
    for (int eb = 0; eb < 4; ++eb) { const bf16_t* pf = rF + (16 * eb + qi) * 64 + 8 * g; const bf16_t* pb = rB + (16 * eb + qi) * 64 + 8 * g;
        RF[eb][0] = *(const bf16x8*)pf; RF[eb][1] = *(const bf16x8*)(pf + 32); RB[eb][0] = *(const bf16x8*)pb; RB[eb][1] = *(const bf16x8*)(pb + 32); }
#pragma unroll 1
    for (int tbi = 0; tbi < 4; ++tbi) {
        const int t = 16 * (4 * (wave & 1) + tbi) + qi;
        const bf16_t* qp = Z + (tok0 + t) * ZW + ZC_CQ + h * 64 + 8 * g;
        const bf16x8 q0 = *(const bf16x8*)qp, q1 = *(const bf16x8*)(qp + 32);
        f32x4 aI[4] = {}, aF[4] = {}, aB[4] = {};
#pragma unroll
        for (int eb = 0; eb < 4; ++eb) {
            aF[eb] = MFMA16(RF[eb][0], q0, aF[eb]); aF[eb] = MFMA16(RF[eb][1], q1, aF[eb]);
            aB[eb] = MFMA16(RB[eb][0], q0, aB[eb]); aB[eb] = MFMA16(RB[eb][1], q1, aB[eb]);
        }
#pragma unroll 1
        for (int sg = 0; sg < 4; ++sg) {
            f32x4 sc[2];
#pragma unroll
            for (int blk = 0; blk < 2; ++blk) {
                const int s = 32 * sg + 8 * (qi >> 2) + (qi & 3) + 4 * blk;
                const bf16_t* kp = Z + (tok0 + s) * ZW + ZC_CK + h * 64 + 8 * g;
                f32x4 z4 = {0.f, 0.f, 0.f, 0.f};
                z4 = MFMA16(*(const bf16x8*)kp, q0, z4); z4 = MFMA16(*(const bf16x8*)(kp + 32), q1, z4); sc[blk] = z4;
            }
            float pj[8];
#pragma unroll
            for (int j = 0; j < 8; ++j) { const int s = 32 * sg + 8 * g + j; const int dd = t - s;
                const float dec = (dd >= 0) ? __expf(lg0 * (float)dd) : __expf(lg1 * (float)(-dd));
                pj[j] = (j < 4 ? sc[0][j] : sc[1][j - 4]) * dec; }
            const bf16x8 P = pack8(pj);
#pragma unroll
            for (int eb = 0; eb < 4; ++eb) aI[eb] = MFMA16(gather8(Vt + ((size_t)h * 128 + 32 * sg + 8 * g) * 68 + 16 * eb , 68, qi), P, aI[eb]);
        }
        const float wf = __expf(lg0 * (float)(t + 1)), wb = __expf(lg1 * (float)(128 - t));
        float ss = 0.f;
#pragma unroll
        for (int eb = 0; eb < 4; ++eb) { aI[eb] = aI[eb] + aF[eb] * wf + aB[eb] * wb;
            ss += (aI[eb].x * aI[eb].x + aI[eb].y * aI[eb].y) + (aI[eb].z * aI[eb].z + aI[eb].w * aI[eb].w); }
        ss = xsum32(xsum16(ss));
        const float rn = rsqrtf(ss * (1.0f / 64) + EPS);
        u32x2 gw4[4]; f32x4 gn4[4];
#pragma unroll
        for (int eb = 0; eb < 4; ++eb) { const int e = 16 * eb + 4 * g; gw4[eb] = *(const u32x2*)(Z + (tok0 + t) * ZW + ZC_CG + h * 64 + e); gn4[eb] = *(const f32x4*)(rnorm + h * 64 + e); }
#pragma unroll
        for (int eb = 0; eb < 4; ++eb) { const int e = 16 * eb + 4 * g;
            const u32x2 gw = gw4[eb]; const f32x4 gn = gn4[eb];
            const float b0 = bflo(gw.x), b1 = bfhi(gw.x), b2 = bflo(gw.y), b3 = bfhi(gw.y);
            const float o0 = aI[eb].x * rn * gn.x * (b0 / (1.f + __expf(-b0))), o1 = aI[eb].y * rn * gn.y * (b1 / (1.f + __expf(-b1)));
            const float o2 = aI[eb].z * rn * gn.z * (b2 / (1.f + __expf(-b2))), o3 = aI[eb].w * rn * gn.w * (b3 / (1.f + __expf(-b3)));
            u32x2 w; w.x = cvt_pk_bf16(o0, o1); w.y = cvt_pk_bf16(o2, o3);
            *(u32x2*)(MIX + (tok0 + t) * D + 768 + h * 64 + e) = w; }
    }
    __syncthreads();
}

__device__ __forceinline__ void phase_scan(bf16_t* __restrict__ GS, const float* __restrict__ GD, bf16_t* __restrict__ RS, const float* __restrict__ lgam, int S) {
    const int tid = opaque_tid();
    const int lgn = (S == 16384) ? 1 : 4, nseq = 1 << lgn, ncg = S / 64, ncr = S / 128;
    const int gtid = blockIdx.x * NTHR + tid, gth = gridDim.x * NTHR;
    const int n_gla = 2 * nseq * 4 * 1024, n_ret = 2 * nseq * 4 * 2048;
    constexpr int SB_ = 16;
    for (int idx = gtid; idx < n_gla + n_ret; idx += gth) {
        if (idx < n_gla) {
            const int el = 2 * (idx & 1023), hh = (idx >> 10) & 3, sq = (idx >> 12) & (nseq - 1), dir = (idx >> 12) >> lgn, kk = el & 31;
            const size_t cstr = (size_t)4 * 2048;
            unsigned* base = (unsigned*)(GS + (((size_t)dir * NCH + (size_t)sq * ncg) * 4 + hh) * 2048 + el);
            const float* dbase = GD + (((size_t)dir * NCH + (size_t)sq * ncg) * 4 + hh) * 32 + kk;
            const long step = dir ? -1 : 1; const long c0 = dir ? ncg - 1 : 0;
            unsigned cur[SB_], nxt[SB_]; f32x2_t dcur[SB_], dnxt[SB_];
#pragma unroll
            for (int u = 0; u < SB_; ++u) { const long c = c0 + step * u; cur[u] = *(const unsigned*)((const bf16_t*)base + c * (long)cstr); dcur[u] = *(const f32x2_t*)(dbase + c * 128); }
            float s0 = 0.f, s1 = 0.f;
#pragma unroll 1
            for (int i0 = 0; i0 < ncg; i0 += SB_) {
                const bool more = i0 + SB_ < ncg;
#pragma unroll
                for (int u = 0; u < SB_; ++u) { const long c = c0 + step * (more ? i0 + SB_ + u : i0 + u); nxt[u] = *(const unsigned*)((const bf16_t*)base + c * (long)cstr); dnxt[u] = *(const f32x2_t*)(dbase + c * 128); }
#pragma unroll
                for (int u = 0; u < SB_; ++u) { const long c = c0 + step * (i0 + u);
                    *(unsigned*)((bf16_t*)base + c * (long)cstr) = cvt_pk_bf16(s0, s1); s0 = dcur[u].x * s0 + bflo(cur[u]); s1 = dcur[u].y * s1 + bfhi(cur[u]); }
#pragma unroll
                for (int u = 0; u < SB_; ++u) { cur[u] = nxt[u]; dcur[u] = dnxt[u]; }
            }
        } else {
            const int j = idx - n_gla; const int el = 2 * (j & 2047), hh = (j >> 11) & 3, sq = (j >> 13) & (nseq - 1), dir = (j >> 13) >> lgn;
            const float dec = __expf(128.f * lgam[dir * 4 + hh]);
            const size_t cstr = (size_t)4 * 4096;
            unsigned* base = (unsigned*)(RS + (((size_t)dir * NCR + (size_t)sq * ncr) * 4 + hh) * 4096 + el);
            const long step = dir ? -1 : 1; const long c0 = dir ? ncr - 1 : 0;
            unsigned cur[SB_], nxt[SB_];
#pragma unroll
            for (int u = 0; u < SB_; ++u) { const long c = c0 + step * u; cur[u] = *(const unsigned*)((const bf16_t*)base + c * (long)cstr); }
            float s0 = 0.f, s1 = 0.f;
#pragma unroll 1
            for (int i0 = 0; i0 < ncr; i0 += SB_) {
                const bool more = i0 + SB_ < ncr;
#pragma unroll
                for (int u = 0; u < SB_; ++u) { const long c = c0 + step * (more ? i0 + SB_ + u : i0 + u); nxt[u] = *(const unsigned*)((const bf16_t*)base + c * (long)cstr); }
#pragma unroll
                for (int u = 0; u < SB_; ++u) { const long c = c0 + step * (i0 + u);
                    *(unsigned*)((bf16_t*)base + c * (long)cstr) = cvt_pk_bf16(s0, s1); s0 = dec * s0 + bflo(cur[u]); s1 = dec * s1 + bfhi(cur[u]); }
#pragma unroll
                for (int u = 0; u < SB_; ++u) cur[u] = nxt[u];
            }
        }
    }
}

#define XB_TMO      128
#define XB_XCNT(j)  (256  + 64 * (j))
#define XB_XSUB(j)  (1280 + 64 * (j))
#define XB_XGEN(j)  (2304 + 64 * (j))
#define XB_TOP      3328
#define XB_TOPGEN   3392
#define XCD_BAR_WORDS 3456
#define XB_SPIN_CAP (1u << 22)
#define LAS __attribute__((address_space(3)))
__device__ __forceinline__ unsigned xb_ld(unsigned* p)              { return __hip_atomic_load(p, __ATOMIC_RELAXED, __HIP_MEMORY_SCOPE_AGENT); }
__device__ __forceinline__ unsigned xb_add(unsigned* p, unsigned v) { return __hip_atomic_fetch_add(p, v, __ATOMIC_RELAXED, __HIP_MEMORY_SCOPE_AGENT); }
__device__ __forceinline__ unsigned xb_xcc_id() { return (unsigned)__builtin_amdgcn_s_getreg((3 << 11) | 20) & 0xFu; }
#define XB_SPIN(cond, bar) do { unsigned _sp = 0; while (cond) { __builtin_amdgcn_s_sleep(1); \
    if ((++_sp & 255u) == 0u) { if (xb_ld(&(bar)[XB_TMO])) break; if (_sp > XB_SPIN_CAP) { atomicAdd(&(bar)[XB_TMO], 1u); break; } } } } while (0)
struct XcdBarrier { unsigned* bar; unsigned x; volatile LAS unsigned* st; };
__device__ __forceinline__ XcdBarrier xcd_barrier_post(unsigned* bar, volatile LAS unsigned* st) {
    XcdBarrier b; b.bar = bar; b.x = xb_xcc_id(); b.st = st;
    if (threadIdx.x == 0) (void)xb_add(&bar[XB_XCNT(b.x)], 1u);
    return b;
}
__device__ __forceinline__ void xcd_barrier_complete(unsigned* bar, unsigned x, unsigned& nloc, unsigned& nx) {
    const unsigned G = gridDim.x * gridDim.y * gridDim.z;
    unsigned sum, cnt, mine, sp = 0u;
    for (;;) {
        sum = 0u; cnt = 0u; mine = 0u;
#pragma unroll
        for (unsigned j = 0; j < 16; ++j) { const unsigned c = xb_ld(&bar[XB_XCNT(j)]); sum += c; cnt += (c > 0u) ? 1u : 0u; mine = (j == x) ? c : mine; }
        if (sum == G) break;
        __builtin_amdgcn_s_sleep(1);
        if ((++sp & 255u) == 0u) { if (xb_ld(&bar[XB_TMO])) break; if (sp > XB_SPIN_CAP) { atomicAdd(&bar[XB_TMO], 1u); break; } }
    }
    nloc = mine > 0u ? mine : 1u; nx = cnt > 0u ? cnt : 1u;
}
__device__ __forceinline__ void xcd_barrier(const XcdBarrier& b) {
    asm volatile("s_waitcnt vmcnt(0)" ::: "memory");
    __syncthreads();
    if (threadIdx.x == 0) {
        unsigned* bar = b.bar;
        __builtin_amdgcn_s_waitcnt(0);
        unsigned nloc = b.st[0], nx = b.st[1];
        if (nloc == 0u) { xcd_barrier_complete(bar, b.x, nloc, nx); b.st[0] = nloc; b.st[1] = nx; }
        const unsigned old = xb_add(&bar[XB_XSUB(b.x)], 1u);
        const unsigned gen = old / nloc;
        if (old + 1u == (gen + 1u) * nloc) {
            __builtin_amdgcn_fence(__ATOMIC_RELEASE, "agent");
            asm volatile("s_waitcnt vmcnt(0)" ::: "memory");
            const unsigned og = xb_add(&bar[XB_TOP], 1u);
            const unsigned tg = og / nx;
            if (og + 1u == (tg + 1u) * nx) xb_add(&bar[XB_TOPGEN], 1u);
            else XB_SPIN(xb_ld(&bar[XB_TOPGEN]) == tg, bar);
            __builtin_amdgcn_fence(__ATOMIC_ACQUIRE, "agent");
            xb_add(&bar[XB_XGEN(b.x)], 1u);
            asm volatile("s_waitcnt vmcnt(0)" ::: "memory");
        } else {
            XB_SPIN(xb_ld(&bar[XB_XGEN(b.x)]) == gen, bar);
            __builtin_amdgcn_fence(__ATOMIC_ACQUIRE, "agent");
            asm volatile("s_waitcnt vmcnt(0)" ::: "memory");
        }
    }
    __syncthreads();
}

__global__ void __launch_bounds__(NTHR, 2) fwd_mega(Params p) {
    cg::grid_group grid = cg::this_grid();
    unsigned char* ws = p.ws;
    bf16_t* WT = (bf16_t*)(ws + WS_WT); const float* tab = (const float*)(ws + WS_TAB);
    bf16_t* HB0 = (bf16_t*)(ws + WS_HB); bf16_t* HB1 = (bf16_t*)(ws + WS_HB1);
    float* SSQ0 = (float*)(ws + WS_SSQ); float* SSQ1 = SSQ0 + (size_t)MG * 16; float* SSQ2 = SSQ1 + (size_t)MG * 16;
    bf16_t* Z = (bf16_t*)(ws + WS_Z); bf16_t* MIX = (bf16_t*)(ws + WS_MIX); bf16_t* HID = (bf16_t*)(ws + WS_HID);
    bf16_t* PB = (bf16_t*)(ws + WS_PB); bf16_t* PL = (bf16_t*)(ws + WS_PLE);
    bf16_t* GS = (bf16_t*)(ws + WS_GS); float* GD = (float*)(ws + WS_GD); bf16_t* RS = (bf16_t*)(ws + WS_RS);
    float* lgam = (float*)(g_lds + LDS_BYTES - 64);

#ifndef NO_P0
    phase_weights(p);
#endif
    unsigned* barw = (unsigned*)(ws + WS_BAR);
    volatile LAS unsigned* bst = (volatile LAS unsigned*)(g_lds + LDS_BYTES - 32);
    if (blockIdx.x == 0) for (int i = threadIdx.x; i < XCD_BAR_WORDS; i += NTHR) barw[i] = 0u;
    if (threadIdx.x < 2) bst[threadIdx.x] = 0u;
    grid.sync();
    const XcdBarrier xb = xcd_barrier_post(barw, bst);
#pragma unroll 1
    for (int g = 0; g < NGROUPS; ++g) {
        const int S = (g == 0) ? 16384 : 2048;
        float* H = p.out + (size_t)g * MG * D;
#ifndef NO_PI
        phase_init(p, g);
#endif
        xcd_barrier(xb);
#pragma unroll 1
        for (int l = 0; l < NLAYER; ++l) {
            const bf16_t* W = WT + (size_t)l * W_LAYER;
            { const int t8 = opaque_tid(); if (t8 < 8) { const float x = p.ret_decay_raw[l * 8 + t8]; lgam[t8] = fminf(x, 0.f) - __logf(1.0f + __expf(-fabsf(x))); } }
            __syncthreads();
            { EpiIn e{Z, SSQ0, p.attn_q_norm + l * 64, p.attn_k_norm + l * 64, p.gla_gate_bias + l * 256, tab, S - 1};
#ifndef NO_P1
#ifndef REP_P1
#define REP_P1 1
#endif
              gemm_phase(HB0, D, W + WO_IN, D, MG, ZW, D, e);
#if REP_P1 > 1
              xcd_barrier(xb); gemm_phase(HB0, D, W + WO_IN, D, MG, ZW, D, e);
#endif
#endif
 }
            xcd_barrier(xb);
#ifndef REP_MIX
#define REP_MIX 1
#endif
            for (int rep_mix = 0; rep_mix < REP_MIX; ++rep_mix) {
            { const int nA = 1024, nG = NCH, nR = 2 * NCR;
#ifndef NO_AT
              if ((gridDim.x & 7) == 0) {
                  const int per = nA / 8, slots = gridDim.x / 8;
                  for (int k = blockIdx.x / 8; k < per; k += slots) attn_item(Z, MIX, S, per * (blockIdx.x & 7) + k);
              } else { for (int it = blockIdx.x; it < nA; it += gridDim.x) attn_item(Z, MIX, S, it); }
#endif
              for (int it = nA + blockIdx.x; it < nA + nG + nR; it += gridDim.x) {
#ifndef NO_G1
                  if (it >= nA && it < nA + nG) gla1_item(Z, GS, GD, it - nA);
#endif
#ifndef NO_R1
                  if (it >= nA + nG) ret1_item(Z, RS, lgam, it - nA - nG);
#endif
              } }
            xcd_barrier(xb);
#ifndef NO_P3
            phase_scan(GS, GD, RS, lgam, S);
#endif
            xcd_barrier(xb);
            { for (int it = blockIdx.x; it < NCH + NCR; it += gridDim.x) {
#ifndef NO_G3
                  if (it < NCH) gla3_item(Z, GS, MIX, p.gla_out_norm + l * 256, it);
#endif
#ifndef NO_R3
                  if (it >= NCH) ret3_item(Z, RS, MIX, p.ret_out_norm + l * 256, lgam, it - NCH);
#endif
              } }
            xcd_barrier(xb);
            }
#ifndef NO_P5
            { EpiRes e{HB0, HB1, SSQ1}; gemm_phase(MIX, D, W + WO_OUT, D, MG, D, D, e); }
#endif
            xcd_barrier(xb);
#ifndef NO_P6
            { EpiMlpIn e{HID, SSQ1}; gemm_phase_t<true>(HB1, D, W + WO_MI, D, MG, DFF, D, e); }
#endif
#ifndef NO_P6B
            { EpiPlain e{PB, D}; gemm_phase(PL + (size_t)l * MG * PLE, PLE, W + WO_PP, PLE, MG, D, PLE, e); }
#endif
            xcd_barrier(xb);
#ifndef NO_P7
            { EpiRes e{HB1, HB1, SSQ2}; gemm_phase(HID, DFF, W + WO_MO, DFF, MG, D, DFF, e); }
#endif
            xcd_barrier(xb);
#ifndef NO_P9
            { EpiPeGate e{H, HB1, HB0, SSQ0, SSQ2, PB, l == NLAYER - 1}; gemm_phase(HB1, D, W + WO_PG, D, MG, D, D, e); }
#endif
            xcd_barrier(xb);
        }
    }
}

extern "C" void kernel_launch(void* const* d_in, const int* in_sizes, int n_in, void* d_out, int out_size, void* d_ws, size_t ws_size, hipStream_t stream) {
    static int grid_blocks = 0;
    if (!grid_blocks) {
        int dev = 0, cus = 0, per_cu = 0;
        hipGetDevice(&dev);
        hipDeviceGetAttribute(&cus, hipDeviceAttributeMultiprocessorCount, dev);
        hipFuncSetAttribute((const void*)fwd_mega, hipFuncAttributeMaxDynamicSharedMemorySize, LDS_BYTES);
        hipOccupancyMaxActiveBlocksPerMultiprocessor(&per_cu, (const void*)fwd_mega, NTHR, LDS_BYTES);
        if (per_cu < 1) per_cu = 1;
        grid_blocks = cus * 1;
        if (ws_size < WS_END) fprintf(stderr, "kernel_launch: workspace too small: %zu < %zu\n", ws_size, (size_t)WS_END);
    }
    Params p{};
    p.x_prompt = (const float*)d_in[0]; p.x_sample = (const float*)d_in[1]; p.p_prompt = (const float*)d_in[2]; p.p_sample = (const float*)d_in[3];
    p.ln_mix = (const float*)d_in[4]; p.w_in = (const float*)d_in[5]; p.attn_q_norm = (const float*)d_in[6]; p.attn_k_norm = (const float*)d_in[7];
    p.gla_gate_up = (const float*)d_in[8]; p.gla_gate_bias = (const float*)d_in[9]; p.gla_out_norm = (const float*)d_in[10]; p.ret_decay_raw = (const float*)d_in[11];
    p.ret_out_norm = (const float*)d_in[12]; p.w_out = (const float*)d_in[13]; p.ln_mlp = (const float*)d_in[14]; p.w_mlp_in = (const float*)d_in[15]; p.w_mlp_out = (const float*)d_in[16];
    p.ln_pe = (const float*)d_in[17]; p.w_pe_gate = (const float*)d_in[18]; p.w_pe_proj = (const float*)d_in[19];
    p.out = (float*)d_out; p.ws = (unsigned char*)d_ws;
    void* args[] = {&p};
    hipError_t e = hipLaunchCooperativeKernel((const void*)fwd_mega, dim3(grid_blocks), dim3(NTHR), args, LDS_BYTES, stream);
    if (e != hipSuccess) fprintf(stderr, "cooperative launch failed: %s (grid %d)\n", hipGetErrorString(e), grid_blocks);
}
```

```cpp
#include <hip/hip_runtime.h>
#include <hip/hip_cooperative_groups.h>
#include <cstdio>
#include <cstdint>
namespace cg = cooperative_groups;

typedef unsigned short bf16_t;
typedef short bf16x8 __attribute__((ext_vector_type(8)));
typedef float f32x4 __attribute__((ext_vector_type(4)));
typedef unsigned u32x4 __attribute__((ext_vector_type(4)));
typedef unsigned u32x2 __attribute__((ext_vector_type(2)));

constexpr int D = 1024, MG = 32768, NGROUPS = 3, NLAYER = 2;
constexpr int ZW = 3584, DFF = 4096, PLE = 256, NIN = 3360;
constexpr int NTHR = 512;
constexpr int NCH = MG / 64;
constexpr int NCR = MG / 128;
constexpr float EPS = 1e-6f;
constexpr int ZC_AQ = 0, ZC_AK = 512, ZC_AV = 1024, ZC_BQ = 1536, ZC_BK = 1664, ZC_BV = 1792, ZC_BR = 2048,
              ZC_GF = 2304, ZC_GB = 2432, ZC_CQ = 2560, ZC_CK = 2816, ZC_CV = 3072, ZC_CG = 3328;
constexpr size_t WO_IN = 0, WO_OUT = WO_IN + (size_t)ZW * D, WO_MI = WO_OUT + (size_t)D * D, WO_MO = WO_MI + (size_t)DFF * D,
                 WO_PG = WO_MO + (size_t)D * DFF, WO_PP = WO_PG + (size_t)D * D, W_LAYER = WO_PP + (size_t)D * PLE;
constexpr size_t WS_WT = 0;
constexpr size_t WS_TAB = WS_WT + W_LAYER * 2 * NLAYER;
constexpr size_t WS_HB = WS_TAB + (size_t)16384 * 40 * 2 * 4;
constexpr size_t WS_HB1 = WS_HB + (size_t)MG * D * 2;
constexpr size_t WS_SSQ = WS_HB1 + (size_t)MG * D * 2;
constexpr size_t WS_Z = WS_SSQ + (size_t)3 * MG * 16 * 4;
constexpr size_t WS_MIX = WS_Z + (size_t)MG * ZW * 2;
constexpr size_t WS_HID = WS_MIX + (size_t)MG * D * 2;
constexpr size_t WS_PB = WS_HID + (size_t)MG * DFF * 2;
constexpr size_t WS_PLE = WS_PB + (size_t)MG * D * 2;
constexpr size_t WS_GS = WS_PLE + (size_t)NLAYER * MG * PLE * 2;
constexpr size_t WS_GD = WS_GS + (size_t)2 * NCH * 4 * 2048 * 4;
constexpr size_t WS_RS = WS_GD + (size_t)2 * NCH * 4 * 32 * 4;
constexpr size_t WS_BAR = WS_RS + (size_t)2 * NCR * 4 * 4096 * 4;
constexpr size_t WS_KA = WS_BAR + 16384;
constexpr size_t WS_VA = WS_KA + (size_t)8 * MG * 64 * 2;
constexpr size_t WS_END = WS_VA + (size_t)8 * MG * 64 * 2;

constexpr int LDS_BYTES = 139264;

extern __shared__ __attribute__((aligned(16))) unsigned char g_lds[];

struct Params {
    const float* x_prompt; const float* x_sample; const float* p_prompt; const float* p_sample;
    const float* ln_mix; const float* w_in; const float* attn_q_norm; const float* attn_k_norm;
    const float* gla_gate_up; const float* gla_gate_bias; const float* gla_out_norm; const float* ret_decay_raw;
    const float* ret_out_norm; const float* w_out; const float* ln_mlp; const float* w_mlp_in; const float* w_mlp_out;
    const float* ln_pe; const float* w_pe_gate; const float* w_pe_proj;
    float* out; unsigned char* ws;
};

typedef float f32x2_t __attribute__((ext_vector_type(2)));
typedef __bf16 bf16x2_t __attribute__((ext_vector_type(2)));
__device__ __forceinline__ unsigned cvt_pk_bf16(float lo, float hi) { const f32x2_t v = {lo, hi}; return __builtin_bit_cast(unsigned, __builtin_convertvector(v, bf16x2_t)); }
__device__ __forceinline__ float bf2f(unsigned short b) { return __uint_as_float(((unsigned)b) << 16); }
__device__ __forceinline__ float bflo(unsigned w) { return __uint_as_float(w << 16); }
__device__ __forceinline__ float bfhi(unsigned w) { return __uint_as_float(w & 0xffff0000u); }
__device__ __forceinline__ bf16x8 pack8(const float (&v)[8]) {
    u32x4 w; w.x = cvt_pk_bf16(v[0], v[1]); w.y = cvt_pk_bf16(v[2], v[3]); w.z = cvt_pk_bf16(v[4], v[5]); w.w = cvt_pk_bf16(v[6], v[7]);
    return __builtin_bit_cast(bf16x8, w);
}
__device__ __forceinline__ void unpack8(bf16x8 b, float (&v)[8]) {
    u32x4 w = __builtin_bit_cast(u32x4, b);
    v[0] = bflo(w.x); v[1] = bfhi(w.x); v[2] = bflo(w.y); v[3] = bfhi(w.y); v[4] = bflo(w.z); v[5] = bfhi(w.z); v[6] = bflo(w.w); v[7] = bfhi(w.w);
}
typedef short v4i16_t __attribute__((ext_vector_type(4)));
__device__ __forceinline__ bf16x8 gather8(const bf16_t* tile  , int stride, int qi) {
    const bf16_t* p = tile + (qi >> 2) * stride + 4 * (qi & 3);
    const v4i16_t lo = __builtin_amdgcn_ds_read_tr16_b64_v4i16((__attribute__((address_space(3))) v4i16_t*)p);
    const v4i16_t hi = __builtin_amdgcn_ds_read_tr16_b64_v4i16((__attribute__((address_space(3))) v4i16_t*)(p + 4 * stride));
    bf16x8 r; r[0] = lo[0]; r[1] = lo[1]; r[2] = lo[2]; r[3] = lo[3]; r[4] = hi[0]; r[5] = hi[1]; r[6] = hi[2]; r[7] = hi[3];
    return r;
}
__device__ __forceinline__ bf16x8 ld8f_pack(const float* p) {
    f32x4 a = *(const f32x4*)p, b = *(const f32x4*)(p + 4);
    u32x4 w; w.x = cvt_pk_bf16(a.x, a.y); w.y = cvt_pk_bf16(a.z, a.w); w.z = cvt_pk_bf16(b.x, b.y); w.w = cvt_pk_bf16(b.z, b.w);
    return __builtin_bit_cast(bf16x8, w);
}
__device__ __forceinline__ int opaque_tid() { int t = threadIdx.x; asm volatile("" : "+v"(t)); return t; }
__device__ __forceinline__ float xmax16(float m) { auto rr = __builtin_amdgcn_permlane16_swap(__float_as_uint(m), __float_as_uint(m), false, false); return fmaxf(__uint_as_float(rr[0]), __uint_as_float(rr[1])); }
__device__ __forceinline__ float xmax32(float m) { auto rr = __builtin_amdgcn_permlane32_swap(__float_as_uint(m), __float_as_uint(m), false, false); return fmaxf(__uint_as_float(rr[0]), __uint_as_float(rr[1])); }
__device__ __forceinline__ float xsum16(float m) { auto rr = __builtin_amdgcn_permlane16_swap(__float_as_uint(m), __float_as_uint(m), false, false); return __uint_as_float(rr[0]) + __uint_as_float(rr[1]); }
__device__ __forceinline__ float xsum32(float m) { auto rr = __builtin_amdgcn_permlane32_swap(__float_as_uint(m), __float_as_uint(m), false, false); return __uint_as_float(rr[0]) + __uint_as_float(rr[1]); }
__device__ __forceinline__ float rsum16(float v) {
    v += __uint_as_float(__builtin_amdgcn_update_dpp(0u, __float_as_uint(v), 0x128, 0xf, 0xf, false));
    v += __uint_as_float(__builtin_amdgcn_update_dpp(0u, __float_as_uint(v), 0x124, 0xf, 0xf, false));
    v += __uint_as_float(__builtin_amdgcn_update_dpp(0u, __float_as_uint(v), 0x122, 0xf, 0xf, false));
    v += __uint_as_float(__builtin_amdgcn_update_dpp(0u, __float_as_uint(v), 0x121, 0xf, 0xf, false));
    return v;
}
#define LDS_FENCE() asm volatile("s_waitcnt lgkmcnt(0)" ::: "memory")
#define MFMA16(a, b, c) __builtin_amdgcn_mfma_f32_16x16x32_bf16((a), (b), (c), 0, 0, 0)

constexpr int BM = 256, BK = 64, HALF = 128, HT = HALF * BK;
__device__ __forceinline__ int lds_byte(int r, int c) {
    int st = (r >> 4) * 2 + (c >> 5), rr = r & 15, cc = c & 31, ob = rr * 64 + cc * 2;
    return st * 1024 + (ob ^ (((ob >> 9) & 1) << 5));
}
__device__ __forceinline__ void stage_rc(int b, int& R, int& C) {
    int st = b / 1024, sb = b % 1024, swz = sb ^ (((sb >> 9) & 1) << 5);
    R = (st >> 1) * 16 + swz / 64; C = (st & 1) * 32 + (swz % 64) / 2;
}
__device__ __forceinline__ bool tile_of(int L, int nM, int nN, int& pm, int& pn) {
    const int nwg = nM * nN; if (L >= nwg) return false;
    int wgid = L; { const int q = nwg / 8, r = nwg % 8, xcd = wgid % 8, off = wgid / 8; wgid = (xcd < r ? xcd * (q + 1) : r * (q + 1) + (xcd - r) * q) + off; }
    const int nig = 8 * nN, gid = wgid / nig, fm = gid * 8, gsz = (nM - fm) < 8 ? (nM - fm) : 8;
    pm = fm + ((wgid % nig) % gsz); pn = (wgid % nig) / gsz; return true;
}

template <bool TR, class Epi>
__device__ __forceinline__ void gemm_tile(const bf16_t* __restrict__ A, int lda, const bf16_t* __restrict__ Bt, int ldb, int K, int brow, int bcol, const Epi& epi, int parity, bool pre, int nbrow, int nbcol) {
    const int tid = opaque_tid();
    bf16_t* shm = (bf16_t*)g_lds;
#define SA(b, h) (shm + ((b) * 2 + (h)) * HT)
#define SB(b, h) (shm + (4 + (b) * 2 + (h)) * HT)
#define STAGE(P, BASE, LD, br, kt) do { const int _so = ((br) * (LD) + (kt) * BK) * 2; \
    for (int _i = 0; _i < 2; ++_i) { \
      __builtin_amdgcn_raw_ptr_buffer_load_lds(((&(LD) == &lda) ? rsA : rsB), (__attribute__((address_space(3))) void*)((char*)(P) + wid * 1024 + _i * 8192), 16, \
          ((&(LD) == &lda) ? offA[_i] : offB[_i]), _so, 0, 0); } } while (0)
#define LDA(dst, b, h) for (int m = 0; m < 4; ++m) for (int k = 0; k < 2; ++k) \
    dst[m][k] = *reinterpret_cast<const bf16x8*>((char*)SA(b, h) + lds_byte(wr * 64 + m * 16 + fr, k * 32 + fq * 8))
#define LDB(dst, b, h) for (int n = 0; n < 2; ++n) for (int k = 0; k < 2; ++k) \
    dst[n][k] = *reinterpret_cast<const bf16x8*>((char*)SB(b, h) + lds_byte(wc * 32 + n * 16 + fr, k * 32 + fq * 8))
#define MMA(ai, bj, At, Bt_) do { __builtin_amdgcn_s_setprio(1); \
    for (int m = 0; m < 4; ++m) for (int n = 0; n < 2; ++n) for (int k = 0; k < 2; ++k) \
      acc[ai][bj][m][n] = TR ? __builtin_amdgcn_mfma_f32_16x16x32_bf16(Bt_[n][k], At[m][k], acc[ai][bj][m][n], 0, 0, 0) \
                            : __builtin_amdgcn_mfma_f32_16x16x32_bf16(At[m][k], Bt_[n][k], acc[ai][bj][m][n], 0, 0, 0); \
    __builtin_amdgcn_s_setprio(0); } while (0)
#define WAIT_V(n) asm volatile("s_waitcnt vmcnt(" #n ")" ::: "memory")
#define WAIT_L(n) asm volatile("s_waitcnt lgkmcnt(" #n ")" ::: "memory")
#define BAR __builtin_amdgcn_s_barrier()
#define SCHED __builtin_amdgcn_sched_barrier(0)
    const int wid = __builtin_amdgcn_readfirstlane(tid >> 6), lane = tid & 63, wr = wid >> 2, wc = wid & 3, fr = lane & 15, fq = lane >> 4;
    f32x4 acc[2][2][4][2] = {};
    bf16x8 At[4][2], B0[2][2], B1[2][2];
    const int nt = K / BK;
    const __amdgpu_buffer_rsrc_t rsA = __builtin_amdgcn_make_buffer_rsrc((void*)A, (short)0, 0x7ffffff0, 0x00020000);
    const __amdgpu_buffer_rsrc_t rsB = __builtin_amdgcn_make_buffer_rsrc((void*)Bt, (short)0, 0x7ffffff0, 0x00020000);
    unsigned offA[2], offB[2];
    for (int _i = 0; _i < 2; ++_i) { int _r, _c; stage_rc(tid * 16 + _i * 8192, _r, _c); offA[_i] = (unsigned)(_r * lda + _c) * 2u; offB[_i] = (unsigned)(_r * ldb + _c) * 2u; }
    if (!(TR && pre)) {
    STAGE(SB(0, 0), Bt, ldb, bcol, 0); STAGE(SA(0, 0), A, lda, brow, 0);
    STAGE(SB(0, 1), Bt, ldb, bcol + HALF, 0); STAGE(SA(0, 1), A, lda, brow + HALF, 0);
    }
    float* RT = (float*)(g_lds + 131072 + (parity & 1) * 1024);
    if (TR) { if (tid < 256) RT[tid] = epi.rstd_row(brow + tid); }
    if (wr == 1) BAR;
    if (TR && pre) { WAIT_V(8); } else { WAIT_V(4); }
    BAR;
    STAGE(SB(1, 0), Bt, ldb, bcol, 1); STAGE(SA(1, 0), A, lda, brow, 1); STAGE(SB(1, 1), Bt, ldb, bcol + HALF, 1);
    WAIT_V(6); BAR;
#pragma unroll 1
    for (int t = 0; t < nt - 2; t += 2) {
        LDB(B0, 0, 0); SCHED; LDA(At, 0, 0); STAGE(SA(1, 1), A, lda, brow + HALF, t + 1);
        WAIT_L(8); BAR; WAIT_L(0); MMA(0, 0, At, B0); BAR; SCHED;
        LDB(B1, 0, 1); STAGE(SB(0, 0), Bt, ldb, bcol, t + 2);
        BAR; WAIT_L(0); MMA(0, 1, At, B1); BAR;
        LDA(At, 0, 1); STAGE(SA(0, 0), A, lda, brow, t + 2);
        BAR; WAIT_L(0); MMA(1, 0, At, B0); BAR; SCHED;
        STAGE(SB(0, 1), Bt, ldb, bcol + HALF, t + 2);
        WAIT_V(6); BAR; MMA(1, 1, At, B1); BAR;
        LDB(B0, 1, 0); SCHED; LDA(At, 1, 0); STAGE(SA(0, 1), A, lda, brow + HALF, t + 2);
        WAIT_L(8); BAR; WAIT_L(0); MMA(0, 0, At, B0); BAR; SCHED;
        LDB(B1, 1, 1); STAGE(SB(1, 0), Bt, ldb, bcol, t + 3);
        BAR; WAIT_L(0); MMA(0, 1, At, B1); BAR;
        LDA(At, 1, 1); STAGE(SA(1, 0), A, lda, brow, t + 3);
        BAR; WAIT_L(0); MMA(1, 0, At, B0); BAR; SCHED;
        STAGE(SB(1, 1), Bt, ldb, bcol + HALF, t + 3);
        WAIT_V(6); BAR; MMA(1, 1, At, B1); BAR;
    }
    { LDB(B0, 0, 0); LDA(At, 0, 0); STAGE(SA(1, 1), A, lda, brow + HALF, nt - 1);
      BAR; WAIT_L(0); MMA(0, 0, At, B0); BAR;
      LDB(B1, 0, 1); BAR; WAIT_L(0); MMA(0, 1, At, B1); BAR;
      LDA(At, 0, 1); WAIT_V(4); BAR; WAIT_L(0); MMA(1, 0, At, B0); MMA(1, 1, At, B1); BAR; }
    { LDB(B0, 1, 0); LDA(At, 1, 0); WAIT_V(2); BAR; WAIT_L(0); MMA(0, 0, At, B0); BAR;
      LDB(B1, 1, 1); WAIT_V(0); BAR; WAIT_L(0); MMA(0, 1, At, B1); BAR;
      LDA(At, 1, 1); BAR; WAIT_L(0); MMA(1, 0, At, B0); MMA(1, 1, At, B1); BAR; }
    if (wr == 0) BAR;
    if (TR && nbrow >= 0) {
        STAGE(SB(0, 0), Bt, ldb, nbcol, 0); STAGE(SA(0, 0), A, lda, nbrow, 0);
        STAGE(SB(0, 1), Bt, ldb, nbcol + HALF, 0); STAGE(SA(0, 1), A, lda, nbrow + HALF, 0);
        asm volatile("" ::: "memory"); SCHED;
    }
    if (TR) {
        epi.regs(acc, RT, brow, bcol, wr, wc, fr, fq);
        return;
    }
    float* ep = (float*)g_lds;
#pragma unroll
    for (int ai = 0; ai < 2; ++ai) {
        if (ai) __syncthreads();
#pragma unroll
        for (int bj = 0; bj < 2; ++bj)
#pragma unroll
            for (int m = 0; m < 4; ++m)
#pragma unroll
                for (int n = 0; n < 2; ++n)
#pragma unroll
                    for (int j = 0; j < 4; ++j)
                        ep[(wr * 64 + m * 16 + fq * 4 + j) * 260 + bj * HALF + wc * 32 + n * 16 + fr] = acc[ai][bj][m][n][j];
        __syncthreads();
        int lane_e = tid & 63; asm volatile("" : "+v"(lane_e));
        const int row0 = brow + ai * HALF + wid * 16;
        epi.rows(ep, wid, lane_e, row0, bcol);
    }
    __syncthreads();
#undef SA
#undef SB
#undef STAGE
#undef LDA
#undef LDB
#undef MMA
}

template <bool TR, class Epi>
__device__ __forceinline__ void gemm_phase_t(const bf16_t* A, int lda, const bf16_t* Bt, int ldb, int M, int N, int K, const Epi& epi) {
    const int nM = M / BM, nN = N / BM;
    int pm, pn; bool have = tile_of((int)blockIdx.x, nM, nN, pm, pn), pre = false;
    for (int i = 0; have; ++i) {
        int npm = 0, npn = 0; const bool nhave = tile_of((i + 1) * (int)gridDim.x + (int)blockIdx.x, nM, nN, npm, npn);
        gemm_tile<TR>(A, lda, Bt, ldb, K, pm * BM, pn * BM, epi, i, pre, (TR && nhave) ? npm * BM : -1, npn * BM);
        pre = TR && nhave; pm = npm; pn = npn; have = nhave;
    }
    if (TR) __syncthreads();
}
template <class Epi>
__device__ __forceinline__ void gemm_phase(const bf16_t* A, int lda, const bf16_t* Bt, int ldb, int M, int N, int K, const Epi& epi) { gemm_phase_t<false>(A, lda, Bt, ldb, M, N, K, epi); }

__device__ __forceinline__ float row_rstd(const float* ssq, int row) {
    const f32x4* p = (const f32x4*)(ssq + (size_t)row * 16);
    const f32x4 a = p[0], b = p[1], c = p[2], d = p[3];
    const float s = ((a.x + a.y) + (a.z + a.w)) + ((b.x + b.y) + (b.z + b.w)) + ((c.x + c.y) + (c.z + c.w)) + ((d.x + d.y) + (d.z + d.w));
    return rsqrtf(s * (1.0f / D) + EPS);
}
__device__ __forceinline__ float rstd16(const float* ssq, int row0, int lane) {
    const f32x4 q = *(const f32x4*)(ssq + (size_t)(row0 + (lane >> 2)) * 16 + 4 * (lane & 3));
    float s = (q.x + q.y) + (q.z + q.w); s += __shfl_xor(s, 1); s += __shfl_xor(s, 2);
    return rsqrtf(s * (1.0f / D) + EPS);
}
__device__ __forceinline__ float seg_sum16(float s) { return rsum16(s); }
__device__ __forceinline__ void st4_bf16(bf16_t* d, float a, float b, float c, float e) { u32x2 w; w.x = cvt_pk_bf16(a, b); w.y = cvt_pk_bf16(c, e); *(u32x2*)d = w; }

template <class E> __device__ __forceinline__ void epi_rows_generic(const E& e, const float* ep, int wid, int lane, int row0, int bcol) {
    const float rsv = e.begin(row0, lane);
    const int col = bcol + 4 * lane;
    typename E::Ld L[16];
#pragma unroll
    for (int u = 0; u < 16; ++u) L[u] = e.load(row0 + u, col);
#pragma unroll
    for (int u = 0; u < 16; ++u) {
        const f32x4 v = *(const f32x4*)(ep + (wid * 16 + u) * 260 + 4 * lane);
        e.finish(v, L[u], row0 + u, col, lane, __shfl(rsv, 4 * u));
    }
}

struct EpiIn {
    bf16_t* Z; const float* ssq; const float* qn; const float* kn; const float* gbias; const float* tab; int smask; bf16_t* KA; bf16_t* VA;
    __device__ __forceinline__ float rstd_row(int) const { return 0.f; }
    __device__ __forceinline__ void regs(const f32x4 (&)[2][2][4][2], const float*, int, int, int, int, int, int) const {}
    template <int T> __device__ __forceinline__ void rows_t(const float* ep, int wid, int lane, int row0, int bcol) const {
        const float rsv = rstd16(ssq, row0, lane);
        const int col = bcol + 4 * lane, c = col & 63, sl = lane & 15;
        f32x4 gn = {1.f, 1.f, 1.f, 1.f}, bb = {0.f, 0.f, 0.f, 0.f};
        if (T == 0) gn = *(const f32x4*)(qn + c);
        if (T == 1) gn = *(const f32x4*)(kn + c);
        if (T == 4) bb = *(const f32x4*)(gbias + (col - ZC_GF));
        const bool rot = (T <= 1) ? (sl < 4) : true;
        const float sgn = (T <= 1) ? (sl < 2 ? -1.f : 1.f) : (sl < 8 ? -1.f : 1.f);
        const int toff = (T <= 1) ? 2 * (c & 7) : 16 + 2 * (c & 31);
        const float psc = (T == 2) ? ((col >= ZC_BQ && col < ZC_BK) ? 0.17677669529663687f : 1.0f) : (T == 0 ? 0.125f * 1.4426950408889634f : (T == 6 ? 0.125f : 1.0f));
#pragma unroll 1
        for (int i0 = 0; i0 < 16; i0 += 4) {
            f32x4 vv[4], tt0[4], tt1[4];
#pragma unroll
            for (int u = 0; u < 4; ++u) {
                vv[u] = *(const f32x4*)(ep + (wid * 16 + i0 + u) * 260 + 4 * lane);
                if (T == 0 || T == 1 || T == 5 || T == 6) { const float* cs = tab + (size_t)((row0 + i0 + u) & smask) * 80 + toff; tt0[u] = *(const f32x4*)cs; tt1[u] = *(const f32x4*)(cs + 4); }
            }
#pragma unroll
            for (int u = 0; u < 4; ++u) {
            f32x4 v = vv[u];
            const int row = row0 + i0 + u; const float rstd = __shfl(rsv, 4 * (i0 + u));
            bf16_t* dst = Z + (size_t)row * ZW + col;
            if (T == 1) dst = KA + ((size_t)((col - ZC_AK) >> 6) * MG + row) * 64 + c;
            if (T == 2 && col >= ZC_AV && col < ZC_BQ) dst = VA + ((size_t)((col - ZC_AV) >> 6) * MG + row) * 64 + c;
            if (T == 0 || T == 1 || T == 5 || T == 6) {
                const f32x4 t0 = tt0[u], t1 = tt1[u];
                float r = rstd * psc;
                if (T <= 1) { const float ss = seg_sum16((v.x * v.x + v.y * v.y) + (v.z * v.z + v.w * v.w)); r *= rsqrtf(ss * rstd * rstd * (1.0f / 64) + EPS); }
                v.x *= r * gn.x; v.y *= r * gn.y; v.z *= r * gn.z; v.w *= r * gn.w;
                f32x4 pv;
                if (T <= 1) { pv.x = __shfl_xor(v.x, 2); pv.y = __shfl_xor(v.y, 2); pv.z = __shfl_xor(v.z, 2); pv.w = __shfl_xor(v.w, 2); }
                else        { pv.x = __shfl_xor(v.x, 8); pv.y = __shfl_xor(v.y, 8); pv.z = __shfl_xor(v.z, 8); pv.w = __shfl_xor(v.w, 8); }
                const float nx = v.x * t0.x + sgn * pv.x * t0.y, ny = v.y * t0.z + sgn * pv.y * t0.w, nz = v.z * t1.x + sgn * pv.z * t1.y, nw = v.w * t1.z + sgn * pv.w * t1.w;
                st4_bf16(dst, rot ? nx : v.x, rot ? ny : v.y, rot ? nz : v.z, rot ? nw : v.w);
            } else if (T == 4) {
                float x[4] = {v.x * rstd + bb.x, v.y * rstd + bb.y, v.z * rstd + bb.z, v.w * rstd + bb.w}; unsigned short hb[4];
#pragma unroll
                for (int k = 0; k < 4; ++k) { const float ls = fminf(x[k], 0.f) - __logf(1.0f + __expf(-fabsf(x[k]))); const _Float16 hv = (_Float16)(ls * 0.0625f); hb[k] = __builtin_bit_cast(unsigned short, hv); }
                u32x2 w; w.x = hb[0] | ((unsigned)hb[1] << 16); w.y = hb[2] | ((unsigned)hb[3] << 16);
                *(u32x2*)dst = w;
            } else {
                const float sc = rstd * psc;
                st4_bf16(dst, v.x * sc, v.y * sc, v.z * sc, v.w * sc);
            }
            }
        }
    }
    __device__ __forceinline__ void rows(const float* ep, int wid, int lane, int row0, int bcol) const {
        if (bcol < ZC_AK) rows_t<0>(ep, wid, lane, row0, bcol);
        else if (bcol < ZC_AV) rows_t<1>(ep, wid, lane, row0, bcol);
        else if (bcol == ZC_GF) rows_t<4>(ep, wid, lane, row0, bcol);
        else if (bcol == ZC_CQ) rows_t<5>(ep, wid, lane, row0, bcol);
        else if (bcol == ZC_CK) rows_t<6>(ep, wid, lane, row0, bcol);
        else rows_t<2>(ep, wid, lane, row0, bcol);
    }
};

struct EpiRes {
    const bf16_t* HBin; bf16_t* HBout; float* ssq;
    typedef u32x2 Ld;
    __device__ __forceinline__ float rstd_row(int) const { return 0.f; }
    __device__ __forceinline__ void regs(const f32x4 (&)[2][2][4][2], const float*, int, int, int, int, int, int) const {}
    __device__ __forceinline__ void rows(const float* ep, int wid, int lane, int row0, int bcol) const { epi_rows_generic(*this, ep, wid, lane, row0, bcol); }
    __device__ __forceinline__ float begin(int, int) const { return 0.f; }
    __device__ __forceinline__ Ld load(int row, int col) const { return *(const u32x2*)(HBin + (size_t)row * D + col); }
    __device__ __forceinline__ void finish(f32x4 v, Ld hw, int row, int col, int lane, float) const {
        f32x4 h = {bflo(hw.x) + v.x, bfhi(hw.x) + v.y, bflo(hw.y) + v.z, bfhi(hw.y) + v.w};
        u32x2 w; w.x = cvt_pk_bf16(h.x, h.y); w.y = cvt_pk_bf16(h.z, h.w);
        *(u32x2*)(HBout + (size_t)row * D + col) = w;
        h.x = bflo(w.x); h.y = bfhi(w.x); h.z = bflo(w.y); h.w = bfhi(w.y);
        const float ss = seg_sum16((h.x * h.x + h.y * h.y) + (h.z * h.z + h.w * h.w));
        if ((lane & 15) == 0) ssq[(size_t)row * 16 + (col >> 6)] = ss;
    }
};

struct EpiMlpIn {
    bf16_t* HID; const float* ssq;
    __device__ __forceinline__ float rstd_row(int row) const { return row_rstd(ssq, row); }
    __device__ __forceinline__ void regs(const f32x4 (&acc)[2][2][4][2], const float* RT, int brow, int bcol, int wr, int wc, int fr, int fq) const {
#pragma unroll
        for (int ai = 0; ai < 2; ++ai)
#pragma unroll
            for (int m = 0; m < 4; ++m) {
                const int rl = ai * HALF + wr * 64 + m * 16 + fr; const float rstd = RT[rl];
                bf16_t* dst = HID + (size_t)(brow + rl) * DFF + bcol + wc * 32 + 8 * fq;
#pragma unroll
                for (int bj = 0; bj < 2; ++bj) { float t[8];
#pragma unroll
                    for (int n = 0; n < 2; ++n)
#pragma unroll
                        for (int j = 0; j < 4; ++j) { const float x = fmaxf(acc[ai][bj][m][n][j] * rstd, 0.f); t[4 * n + j] = x * x; }
                    *(bf16x8*)(dst + bj * HALF) = pack8(t); }
            }
    }
    __device__ __forceinline__ void rows(const float* ep, int wid, int lane, int row0, int bcol) const { epi_rows_generic(*this, ep, wid, lane, row0, bcol); }
    __device__ __forceinline__ float begin(int row0, int lane) const { return rstd16(ssq, row0, lane); }
    typedef int Ld;
    __device__ __forceinline__ Ld load(int, int) const { return 0; }
    __device__ __forceinline__ void finish(f32x4 v, Ld, int row, int col, int lane, float rstd) const { this->row(v, row, col, lane, rstd); }
    __device__ __forceinline__ void row(f32x4 v, int row, int col, int, float rstd) const {
        const float a = fmaxf(v.x * rstd, 0.f), b = fmaxf(v.y * rstd, 0.f), c = fmaxf(v.z * rstd, 0.f), e = fmaxf(v.w * rstd, 0.f);
        st4_bf16(HID + (size_t)row * DFF + col, a * a, b * b, c * c, e * e);
    }
};

struct EpiPlain {
    bf16_t* O; int ldo;
    __device__ __forceinline__ float rstd_row(int) const { return 0.f; }
    __device__ __forceinline__ void regs(const f32x4 (&)[2][2][4][2], const float*, int, int, int, int, int, int) const {}
    __device__ __forceinline__ void rows(const float* ep, int wid, int lane, int row0, int bcol) const { epi_rows_generic(*this, ep, wid, lane, row0, bcol); }
    __device__ __forceinline__ float begin(int, int) const { return 0.f; }
    typedef int Ld;
    __device__ __forceinline__ Ld load(int, int) const { return 0; }
    __device__ __forceinline__ void finish(f32x4 v, Ld, int row, int col, int lane, float rstd) const { this->row(v, row, col, lane, rstd); }
    __device__ __forceinline__ void row(f32x4 v, int row, int col, int, float) const { st4_bf16(O + (size_t)row * ldo + col, v.x, v.y, v.z, v.w); }
};

struct EpiPeGate {
    float* Hout; const bf16_t* HBin; bf16_t* HBout; float* ssq_out; const float* ssq_in; const bf16_t* PB; int write_f32;
    struct Ld { u32x2 pw, hw; };
    __device__ __forceinline__ float rstd_row(int) const { return 0.f; }
    __device__ __forceinline__ void regs(const f32x4 (&)[2][2][4][2], const float*, int, int, int, int, int, int) const {}
    __device__ __forceinline__ void rows(const float* ep, int wid, int lane, int row0, int bcol) const { epi_rows_generic(*this, ep, wid, lane, row0, bcol); }
    __device__ __forceinline__ float begin(int row0, int lane) const { return rstd16(ssq_in, row0, lane); }
    __device__ __forceinline__ Ld load(int row, int col) const { Ld l; l.pw = *(const u32x2*)(PB + (size_t)row * D + col); l.hw = *(const u32x2*)(HBin + (size_t)row * D + col); return l; }
    __device__ __forceinline__ void finish(f32x4 v, Ld l, int row, int col, int lane, float rstd) const {
        const u32x2 pw = l.pw, hw = l.hw;
        f32x4 h;
        h.x = bflo(hw.x) + bflo(pw.x) / (1.0f + __expf(-v.x * rstd)); h.y = bfhi(hw.x) + bfhi(pw.x) / (1.0f + __expf(-v.y * rstd));
        h.z = bflo(hw.y) + bflo(pw.y) / (1.0f + __expf(-v.z * rstd)); h.w = bfhi(hw.y) + bfhi(pw.y) / (1.0f + __expf(-v.w * rstd));
        if (write_f32) *(f32x4*)(Hout + (size_t)row * D + col) = h;
        u32x2 w; w.x = cvt_pk_bf16(h.x, h.y); w.y = cvt_pk_bf16(h.z, h.w);
        *(u32x2*)(HBout + (size_t)row * D + col) = w;
        h.x = bflo(w.x); h.y = bfhi(w.x); h.z = bflo(w.y); h.w = bfhi(w.y);
        const float ss = seg_sum16((h.x * h.x + h.y * h.y) + (h.z * h.z + h.w * h.w));
        if ((lane & 15) == 0) ssq_out[(size_t)row * 16 + (col >> 6)] = ss;
    }
};

template <class F>
__device__ __forceinline__ void transpose_item(bf16_t* Wt, int K, int k0, int n0, const F& src) {
    const int tid = opaque_tid();
    float* tile = (float*)g_lds;
#pragma unroll
    for (int i = 0; i < 8; ++i) { const int kk = (tid >> 6) + 8 * i, nn = tid & 63; tile[kk * 65 + nn] = src(k0 + kk, n0 + nn); }
    __syncthreads();
    { const int nn = tid >> 3, kc = tid & 7; float t[8];
#pragma unroll
      for (int j = 0; j < 8; ++j) t[j] = tile[(8 * kc + j) * 65 + nn];
      *(bf16x8*)(Wt + (size_t)(n0 + nn) * K + k0 + 8 * kc) = pack8(t); }
    __syncthreads();
}

__device__ __forceinline__ void phase_weights(const Params& p) {
    bf16_t* WT = (bf16_t*)(p.ws + WS_WT);
    constexpr int I_IN = 16 * (ZW / 64), I_OUT = 16 * 16, I_MI = 16 * 64, I_MO = 64 * 16, I_PG = 16 * 16, I_PP = 4 * 16;
    constexpr int I_L = I_IN + I_OUT + I_MI + I_MO + I_PG + I_PP;
    for (int it = blockIdx.x; it < NLAYER * I_L; it += gridDim.x) {
        const int l = it / I_L; int r = it % I_L;
        bf16_t* W = WT + (size_t)l * W_LAYER;
        if (r < I_IN) {
            const int kb = r / (ZW / 64), nb = r % (ZW / 64);
            const float* w = p.w_in + (size_t)l * D * NIN; const float* g = p.ln_mix + l * D; const float* gu = p.gla_gate_up + (size_t)l * 2 * 16 * 128;
            transpose_item(W + WO_IN, D, kb * 64, nb * 64, [&](int k, int c) -> float {
                float v;
                if (c < ZC_GF) v = w[(size_t)k * NIN + c];
                else if (c < ZC_CQ) { const int j = (c - ZC_GF) >> 7, kk = (c - ZC_GF) & 127; float s = 0.f;
                    for (int rr = 0; rr < 16; ++rr) s += w[(size_t)k * NIN + 2304 + 16 * j + rr] * gu[(j * 16 + rr) * 128 + kk];
                    v = s; }
                else v = w[(size_t)k * NIN + (c - 224)];
                return v * g[k]; });
            continue; }
        r -= I_IN;
        if (r < I_OUT) { const float* w = p.w_out + (size_t)l * D * D;
            transpose_item(W + WO_OUT, D, (r / 16) * 64, (r % 16) * 64, [&](int k, int c) -> float { return w[(size_t)k * D + c]; }); continue; }
        r -= I_OUT;
        if (r < I_MI) { const float* w = p.w_mlp_in + (size_t)l * D * DFF; const float* g = p.ln_mlp + l * D;
            transpose_item(W + WO_MI, D, (r / 64) * 64, (r % 64) * 64, [&](int k, int c) -> float { const int rho = c & 31; const int cc = (c & ~31) + 8 * ((rho & 15) >> 2) + 4 * (rho >> 4) + (rho & 3);
                return w[(size_t)k * DFF + cc] * g[k]; }); continue; }
        r -= I_MI;
        if (r < I_MO) { const float* w = p.w_mlp_out + (size_t)l * DFF * D;
            transpose_item(W + WO_MO, DFF, (r / 16) * 64, (r % 16) * 64, [&](int k, int c) -> float { return w[(size_t)k * D + c]; }); continue; }
        r -= I_MO;
        if (r < I_PG) { const float* w = p.w_pe_gate + (size_t)l * D * D; const float* g = p.ln_pe + l * D;
            transpose_item(W + WO_PG, D, (r / 16) * 64, (r % 16) * 64, [&](int k, int c) -> float { return w[(size_t)k * D + c] * g[k]; }); continue; }
        r -= I_PG;
        { const float* w = p.w_pe_proj + (size_t)l * PLE * D;
            transpose_item(W + WO_PP, PLE, (r / 16) * 64, (r % 16) * 64, [&](int k, int c) -> float { return w[(size_t)k * D + c]; }); }
    }
    float* tab = (float*)(p.ws + WS_TAB);
    for (int e = blockIdx.x * NTHR + threadIdx.x; e < 16384 * 40; e += gridDim.x * NTHR) {
        const int pos = e / 40, i = e % 40;
        const double invf = (i < 8) ? exp(-(double)i * (log(500000.0) / 8.0)) : exp(-(double)(i - 8) * (log(10000.0) / 32.0));
        double ang = (double)pos * invf; ang -= 6.283185307179586476925 * floor(ang * 0.15915494309189533577);
        tab[2 * e] = (float)cos(ang); tab[2 * e + 1] = (float)sin(ang);
    }
}

__device__ __forceinline__ void phase_init(const Params& p, int g) {
    const int tid = opaque_tid();
    const float* x = (g == 0) ? p.x_prompt : p.x_sample + (size_t)(g - 1) * MG * D;
    bf16_t* HB = (bf16_t*)(p.ws + WS_HB); float* ssq = (float*)(p.ws + WS_SSQ);
    const int lane = tid & 63, gw = blockIdx.x * 8 + (tid >> 6), NGW = gridDim.x * 8;
    for (int row = gw; row < MG; row += 2 * NGW) {
        f32x4 vv[2][4];
#pragma unroll
        for (int rr = 0; rr < 2; ++rr)
#pragma unroll
            for (int j = 0; j < 4; ++j) vv[rr][j] = *(const f32x4*)(x + (size_t)(row + rr * NGW) * D + 256 * j + 4 * lane);
#pragma unroll
        for (int rr = 0; rr < 2; ++rr)
#pragma unroll
            for (int j = 0; j < 4; ++j) {
                f32x4 v = vv[rr][j]; const int r2 = row + rr * NGW;
                u32x2 w; w.x = cvt_pk_bf16(v.x, v.y); w.y = cvt_pk_bf16(v.z, v.w);
                *(u32x2*)(HB + (size_t)r2 * D + 256 * j + 4 * lane) = w;
                v.x = bflo(w.x); v.y = bfhi(w.x); v.z = bflo(w.y); v.w = bfhi(w.y);
                float s_ = (v.x * v.x + v.y * v.y) + (v.z * v.z + v.w * v.w);
                s_ += __shfl_xor(s_, 1); s_ += __shfl_xor(s_, 2); s_ += __shfl_xor(s_, 4); s_ += __shfl_xor(s_, 8);
                if ((lane & 15) == 0) ssq[(size_t)r2 * 16 + (lane >> 4) + 4 * j] = s_;
            }
    }
    bf16_t* PL = (bf16_t*)(p.ws + WS_PLE);
    for (int l = 0; l < NLAYER; ++l) {
        const float* src = (g == 0) ? p.p_prompt + (size_t)l * MG * PLE : p.p_sample + ((size_t)l * 2 * MG + (size_t)(g - 1) * MG) * PLE;
        bf16_t* dst = PL + (size_t)l * MG * PLE;
        const size_t stride = (size_t)gridDim.x * NTHR * 8;
        for (size_t e = (size_t)(blockIdx.x * NTHR + tid) * 8; e < (size_t)MG * PLE; e += 4 * stride) {
            f32x4 a[4][2];
#pragma unroll
            for (int u = 0; u < 4; ++u) if (e + u * stride < (size_t)MG * PLE) { a[u][0] = *(const f32x4*)(src + e + u * stride); a[u][1] = *(const f32x4*)(src + e + u * stride + 4); }
#pragma unroll
            for (int u = 0; u < 4; ++u) if (e + u * stride < (size_t)MG * PLE) { u32x4 w; w.x = cvt_pk_bf16(a[u][0].x, a[u][0].y); w.y = cvt_pk_bf16(a[u][0].z, a[u][0].w); w.z = cvt_pk_bf16(a[u][1].x, a[u][1].y); w.w = cvt_pk_bf16(a[u][1].z, a[u][1].w);
                *(u32x4*)(dst + e + u * stride) = w; }
        }
    }
}

struct AttnLd { bf16x8 ka0, ka1, kb0, kb1; u32x4 v0, v1, v2, v3; };
__device__ __forceinline__ void attn_geom(int f, int r, int n0, int& dsh, int& cb) {
    const int p = f < 12 ? 0 : (f < 18 ? 1 : 2); const int i2 = f - (p == 0 ? 0 : (p == 1 ? 12 : 18));
    dsh = 2 * p; cb = (r >> dsh) + (16 >> dsh) * n0 - 64 + 32 * i2;
}
__device__ __forceinline__ AttnLd attn_load(const bf16_t* __restrict__ ka, const bf16_t* __restrict__ va, int S, int r, int n0, int lane, int f) {
    int dsh, cb; attn_geom(f, r, n0, dsh, cb);
    const int qi = lane & 15, g = lane >> 4, rd = r & ((1 << dsh) - 1), ncls = S >> dsh;
    const int cA = cb + 8 * (qi >> 2) + (qi & 3), cB = cA + 4;
    const int cAc = min(max(cA, 0), ncls - 1), cBc = min(max(cB, 0), ncls - 1);
    const bf16_t* kA = ka + (size_t)(rd + (cAc << dsh)) * 64 + 8 * g;
    const bf16_t* kB = ka + (size_t)(rd + (cBc << dsh)) * 64 + 8 * g;
    AttnLd L;
    L.ka0 = *(const bf16x8*)kA; L.ka1 = *(const bf16x8*)(kA + 32); L.kb0 = *(const bf16x8*)kB; L.kb1 = *(const bf16x8*)(kB + 32);
    const int cv0 = cb + (lane >> 3);
    const bf16_t* vb = va + 8 * (lane & 7);
    L.v0 = *(const u32x4*)(vb + (size_t)(rd + (min(max(cv0, 0), ncls - 1) << dsh)) * 64);
    L.v1 = *(const u32x4*)(vb + (size_t)(rd + (min(max(cv0 + 8, 0), ncls - 1) << dsh)) * 64);
    L.v2 = *(const u32x4*)(vb + (size_t)(rd + (min(max(cv0 + 16, 0), ncls - 1) << dsh)) * 64);
    L.v3 = *(const u32x4*)(vb + (size_t)(rd + (min(max(cv0 + 24, 0), ncls - 1) << dsh)) * 64);
    return L;
}
__device__ __forceinline__ bf16x8 attn_softmax_step(const f32x4& sA, const f32x4& sB, int cb, int cq, int ncls, int g, float& m, float& lsum, f32x4 (&O)[4]) {
    float s[8]; bool ok[8];
    const int c0v = cb + 8 * g, d0 = c0v - cq + 64;
#pragma unroll
    for (int j = 0; j < 8; ++j) {
        ok[j] = ((unsigned)(c0v + j) < (unsigned)ncls) && ((unsigned)(d0 + j) <= 128u);
        s[j] = ok[j] ? (j < 4 ? sA[j] : sB[j - 4]) : -__builtin_inff(); }
    float mx = fmaxf(fmaxf(fmaxf(s[0], s[1]), fmaxf(s[2], s[3])), fmaxf(fmaxf(s[4], s[5]), fmaxf(s[6], s[7])));
    mx = xmax32(xmax16(mx));
    const float mn = fmaxf(m, mx), alpha = __builtin_amdgcn_exp2f(m - mn);
    m = mn;
    float pj[8], ps_ = 0.f;
#pragma unroll
    for (int j = 0; j < 8; ++j) { pj[j] = __builtin_amdgcn_exp2f(s[j] - mn); ps_ += pj[j]; }
    lsum = lsum * alpha + ps_;
#pragma unroll
    for (int nbk = 0; nbk < 4; ++nbk) O[nbk] *= alpha;
    return pack8(pj);
}
__device__ __forceinline__ void attn_lds_step(const bf16_t* Kt, const bf16_t* Vt, int rowb, const bf16x8& q0, const bf16x8& q1, int cb, int cq, int ncls,
                                              int qi, int g, float& m, float& lsum, f32x4 (&O)[4]) {
    const bf16_t* kA = Kt + (rowb + 8 * (qi >> 2) + (qi & 3)) * 72 + 8 * g;
    const bf16x8 ka0 = *(const bf16x8*)kA, ka1 = *(const bf16x8*)(kA + 32), kb0 = *(const bf16x8*)(kA + 4 * 72), kb1 = *(const bf16x8*)(kA + 4 * 72 + 32);
    f32x4 sA = {0.f, 0.f, 0.f, 0.f}, sB = {0.f, 0.f, 0.f, 0.f};
    sA = MFMA16(ka0, q0, sA); sA = MFMA16(ka1, q1, sA);
    sB = MFMA16(kb0, q0, sB); sB = MFMA16(kb1, q1, sB);
    const bf16x8 P = attn_softmax_step(sA, sB, cb, cq, ncls, g, m, lsum, O);
#pragma unroll
    for (int nbk = 0; nbk < 4; ++nbk) O[nbk] = MFMA16(gather8(Vt + (rowb + 8 * g) * 68 + 16 * nbk, 68, qi), P, O[nbk]);
}
template <int NROWS>
__device__ __forceinline__ void attn_stage(const bf16_t* __restrict__ ka, const bf16_t* __restrict__ va, bf16_t* Kt, bf16_t* Vt, int c0, int ncls, int rd, int dsh, int tid) {
    constexpr int IT = (NROWS * 16 + NTHR - 1) / NTHR;
    u32x4 v[IT];
#pragma unroll
    for (int u = 0; u < IT; ++u) { const int idx = min(tid + u * NTHR, NROWS * 16 - 1);
        const int i = idx >> 4, ch = idx & 15, isv = ch >> 3, c8 = ch & 7; const int c = min(max(c0 + i, 0), ncls - 1);
        v[u] = *(const u32x4*)((isv ? va : ka) + (size_t)(rd + (c << dsh)) * 64 + 8 * c8); }
#pragma unroll
    for (int u = 0; u < IT; ++u) { const int idx = min(tid + u * NTHR, NROWS * 16 - 1);
        const int i = idx >> 4, ch = idx & 15, isv = ch >> 3, c8 = ch & 7;
        bf16_t* d = isv ? (Vt + i * 68 + 8 * c8) : (Kt + i * 72 + 8 * c8);
        *(u32x2*)d = (u32x2){v[u].x, v[u].y}; *(u32x2*)(d + 4) = (u32x2){v[u].z, v[u].w}; }
}
__device__ __forceinline__ void attn_item(const bf16_t* __restrict__ Z, const bf16_t* __restrict__ KA, const bf16_t* __restrict__ VA, bf16_t* __restrict__ MIX, int S, int it) {
    const int tid = opaque_tid();
    __syncthreads();
    const int wave = tid >> 6, lane = tid & 63, qi = lane & 15, g = lane >> 4;
    const int lgb = (S == 16384) ? 6 : 3;
    const int pb = it & ((1 << lgb) - 1); const int t1 = it >> lgb; const int head = t1 & 7, seq = t1 >> 3;
    const int P0 = pb * 256, n0 = pb * 16;
    const bf16_t* zq = Z + (size_t)seq * S * ZW;
    const bf16_t* ka = KA + ((size_t)head * MG + (size_t)seq * S) * 64; const bf16_t* va = VA + ((size_t)head * MG + (size_t)seq * S) * 64;
    bf16_t* Kt = (bf16_t*)g_lds;
    bf16_t* Vt = (bf16_t*)(g_lds + 57600);
    bf16_t* Vs = (bf16_t*)g_lds + wave * (32 * 68);
    int rt[2]; rt[0] = 4 * (wave >> 1) + (wave & 1); rt[1] = rt[0] + 2;
    bf16x8 q0[2], q1[2]; float m[2] = {-1e30f, -1e30f}, lsum[2] = {0.f, 0.f}; f32x4 O[2][4] = {};
#pragma unroll
    for (int ti = 0; ti < 2; ++ti) { const bf16_t* qp = zq + (size_t)(P0 + rt[ti] + 16 * qi) * ZW + ZC_AQ + head * 64 + 8 * g; q0[ti] = *(const bf16x8*)qp; q1[ti] = *(const bf16x8*)(qp + 32); }
    {
        bf16_t* Vs1 = Vs + 8 * (32 * 68);
        AttnLd cur0 = attn_load(ka, va, S, rt[0], n0, lane, 18), cur1 = attn_load(ka, va, S, rt[1], n0, lane, 18);
#pragma unroll 1
        for (int f = 18; f < 23; ++f) {
            const AttnLd nxt0 = attn_load(ka, va, S, rt[0], n0, lane, f < 22 ? f + 1 : 22), nxt1 = attn_load(ka, va, S, rt[1], n0, lane, f < 22 ? f + 1 : 22);
            const int cb = n0 - 64 + 32 * (f - 18), ncls = S >> 4, cq = n0 + qi;
            f32x4 sA0 = {0.f, 0.f, 0.f, 0.f}, sB0 = {0.f, 0.f, 0.f, 0.f}, sA1 = {0.f, 0.f, 0.f, 0.f}, sB1 = {0.f, 0.f, 0.f, 0.f};
            sA0 = MFMA16(cur0.ka0, q0[0], sA0); sA1 = MFMA16(cur1.ka0, q0[1], sA1); sB0 = MFMA16(cur0.kb0, q0[0], sB0); sB1 = MFMA16(cur1.kb0, q0[1], sB1);
            sA0 = MFMA16(cur0.ka1, q1[0], sA0); sA1 = MFMA16(cur1.ka1, q1[1], sA1); sB0 = MFMA16(cur0.kb1, q1[0], sB0); sB1 = MFMA16(cur1.kb1, q1[1], sB1);
            LDS_FENCE();
            { bf16_t* d = Vs + (lane >> 3) * 68 + 8 * (lane & 7);
              *(u32x2*)d = (u32x2){cur0.v0.x, cur0.v0.y}; *(u32x2*)(d + 4) = (u32x2){cur0.v0.z, cur0.v0.w};
              *(u32x2*)(d + 8 * 68) = (u32x2){cur0.v1.x, cur0.v1.y}; *(u32x2*)(d + 8 * 68 + 4) = (u32x2){cur0.v1.z, cur0.v1.w};
              *(u32x2*)(d + 16 * 68) = (u32x2){cur0.v2.x, cur0.v2.y}; *(u32x2*)(d + 16 * 68 + 4) = (u32x2){cur0.v2.z, cur0.v2.w};
              *(u32x2*)(d + 24 * 68) = (u32x2){cur0.v3.x, cur0.v3.y}; *(u32x2*)(d + 24 * 68 + 4) = (u32x2){cur0.v3.z, cur0.v3.w};
              d = Vs1 + (lane >> 3) * 68 + 8 * (lane & 7);
              *(u32x2*)d = (u32x2){cur1.v0.x, cur1.v0.y}; *(u32x2*)(d + 4) = (u32x2){cur1.v0.z, cur1.v0.w};
              *(u32x2*)(d + 8 * 68) = (u32x2){cur1.v1.x, cur1.v1.y}; *(u32x2*)(d + 8 * 68 + 4) = (u32x2){cur1.v1.z, cur1.v1.w};
              *(u32x2*)(d + 16 * 68) = (u32x2){cur1.v2.x, cur1.v2.y}; *(u32x2*)(d + 16 * 68 + 4) = (u32x2){cur1.v2.z, cur1.v2.w};
              *(u32x2*)(d + 24 * 68) = (u32x2){cur1.v3.x, cur1.v3.y}; *(u32x2*)(d + 24 * 68 + 4) = (u32x2){cur1.v3.z, cur1.v3.w}; }
            const bf16x8 P0_ = attn_softmax_step(sA0, sB0, cb, cq, ncls, g, m[0], lsum[0], O[0]);
            const bf16x8 P1_ = attn_softmax_step(sA1, sB1, cb, cq, ncls, g, m[1], lsum[1], O[1]);
            LDS_FENCE();
#pragma unroll
            for (int nbk = 0; nbk < 4; ++nbk) { O[0][nbk] = MFMA16(gather8(Vs + (8 * g) * 68 + 16 * nbk, 68, qi), P0_, O[0][nbk]); O[1][nbk] = MFMA16(gather8(Vs1 + (8 * g) * 68 + 16 * nbk, 68, qi), P1_, O[1][nbk]); }
            cur0 = nxt0; cur1 = nxt1;
        }
        LDS_FENCE();
    }
    __syncthreads();
    attn_stage<400>(ka, va, Kt, Vt, P0 - 64, S, 0, 0, tid);
    __syncthreads();
#pragma unroll 1
    for (int i2 = 0; i2 < 12; ++i2) {
        attn_lds_step(Kt, Vt, rt[0] + 32 * i2, q0[0], q1[0], P0 + rt[0] - 64 + 32 * i2, P0 + rt[0] + 16 * qi, S, qi, g, m[0], lsum[0], O[0]);
        attn_lds_step(Kt, Vt, rt[1] + 32 * i2, q0[1], q1[1], P0 + rt[1] - 64 + 32 * i2, P0 + rt[1] + 16 * qi, S, qi, g, m[1], lsum[1], O[1]);
    }
#pragma unroll
    for (int rho = 0; rho < 2; ++rho) {
        __syncthreads();
        attn_stage<200>(ka, va, Kt, Vt, (P0 >> 2) - 64, S >> 2, 2 * rho, 2, tid);
        attn_stage<200>(ka, va, Kt + 200 * 72, Vt + 200 * 68, (P0 >> 2) - 64, S >> 2, 2 * rho + 1, 2, tid);
        __syncthreads();
        const int r = rt[rho], cls = (r & 3) - 2 * rho, c0 = (P0 >> 2) + (r >> 2);
#pragma unroll 2
        for (int i2 = 0; i2 < 6; ++i2)
            attn_lds_step(Kt + cls * 200 * 72, Vt + cls * 200 * 68, (r >> 2) + 32 * i2, q0[rho], q1[rho], c0 - 64 + 32 * i2, c0 + 4 * qi, S >> 2, qi, g, m[rho], lsum[rho], O[rho]);
    }
#pragma unroll
    for (int ti = 0; ti < 2; ++ti) {
        float l = lsum[ti]; l = xsum32(xsum16(l));
        const float inv = 1.0f / l;
        bf16_t* op = MIX + ((size_t)seq * S + P0 + rt[ti] + 16 * qi) * D + head * 64 + 4 * g;
#pragma unroll
        for (int nbk = 0; nbk < 4; ++nbk) st4_bf16(op + 16 * nbk, O[ti][nbk].x * inv, O[ti][nbk].y * inv, O[ti][nbk].z * inv, O[ti][nbk].w * inv);
    }
    __syncthreads();
}

__device__ __forceinline__ float h2f(unsigned short b) { return (float)__builtin_bit_cast(_Float16, b); }

template <int NROWS>
__device__ __forceinline__ void stage_v4(const bf16_t* __restrict__ Z, size_t tok0, int zc, bf16_t* Vt) {
    const int tid = opaque_tid();
    constexpr int IT = NROWS * 32 / NTHR;
    u32x4 v[IT];
#pragma unroll
    for (int u = 0; u < IT; ++u) { const int idx = tid + u * NTHR; const int t = idx >> 5, ch = idx & 31; v[u] = *(const u32x4*)(Z + (tok0 + t) * ZW + zc + ch * 8); }
#pragma unroll
    for (int u = 0; u < IT; ++u) { const int idx = tid + u * NTHR; const int t = idx >> 5, ch = idx & 31, hh = ch >> 3, c8 = ch & 7;
        bf16_t* d = Vt + ((size_t)hh * NROWS + t) * 68 + c8 * 8;
        *(u32x2*)d = (u32x2){v[u].x, v[u].y}; *(u32x2*)(d + 4) = (u32x2){v[u].z, v[u].w}; }
}

__device__ __forceinline__ void gla_cum(const bf16_t* __restrict__ Z, size_t tok0, int h, int dir, int lane, float (&cum)[32], float& tot) {
    const int kk = lane & 31, hf = lane >> 5;
    const bf16_t* src = Z + (tok0 + 32 * hf) * ZW + ZC_GF + dir * 128 + h * 32 + kk;
    float part = 0.f;
#pragma unroll
    for (int i = 0; i < 32; ++i) { cum[i] = h2f(src[(size_t)i * ZW]); part += cum[i]; }
    const float other = __shfl_xor(part, 32);
    tot = part + other;
    if (dir == 0) { float run = hf ? other : 0.f;
#pragma unroll
        for (int i = 0; i < 32; ++i) { run += cum[i]; cum[i] = run; } }
    else { float run = hf ? 0.f : other;
#pragma unroll
        for (int i = 31; i >= 0; --i) { run += cum[i]; cum[i] = run; } }
}

__device__ __forceinline__ void gla1_item(const bf16_t* __restrict__ Z, bf16_t* __restrict__ GS, float* __restrict__ GD, int ci) {
    const int tid = opaque_tid();
    __syncthreads();
    const int wave = tid >> 6, lane = tid & 63, qi = lane & 15, g = lane >> 4;
    const int h = wave >> 1, dir = wave & 1;
    const size_t tok0 = (size_t)ci * 64;
    bf16_t* Vt = (bf16_t*)g_lds;
    bf16_t* Ks = (bf16_t*)g_lds + 4 * 64 * 68 + wave * (64 * 36);
    stage_v4<64>(Z, tok0, ZC_BV, Vt);
    float cum[32], tot;
    gla_cum(Z, tok0, h, dir, lane, cum, tot);
    { const int kk = lane & 31, hf = lane >> 5;
      const bf16_t* ksrc = Z + (tok0 + 32 * hf) * ZW + ZC_BK + h * 32 + kk;
      unsigned short kraw[32];
#pragma unroll
      for (int i = 0; i < 32; ++i) kraw[i] = ksrc[(size_t)i * ZW];
#pragma unroll
      for (int i = 0; i < 32; ++i) { const float kv = bf2f(kraw[i]) * __expf(tot - cum[i]);
          Ks[(32 * hf + i) * 36 + kk] = (bf16_t)(cvt_pk_bf16(kv, 0.f) & 0xffffu); }
      if (hf == 0) GD[(((size_t)dir * NCH + ci) * 4 + h) * 32 + kk] = __expf(tot); }
    __syncthreads();
    f32x4 acc[4][2] = {};
#pragma unroll
    for (int ks = 0; ks < 2; ++ks) {
        bf16x8 bfr[2];
#pragma unroll
        for (int kb = 0; kb < 2; ++kb) bfr[kb] = gather8(Ks + (32 * ks + 8 * g) * 36 + 16 * kb , 36, qi);
#pragma unroll
        for (int eb = 0; eb < 4; ++eb) { const bf16x8 af = gather8(Vt + ((size_t)h * 64 + 32 * ks + 8 * g) * 68 + 16 * eb , 68, qi);
#pragma unroll
            for (int kb = 0; kb < 2; ++kb) acc[eb][kb] = MFMA16(bfr[kb], af, acc[eb][kb]); }
    }
    bf16_t* dst = GS + (((size_t)dir * NCH + ci) * 4 + h) * 2048;
#pragma unroll
    for (int eb = 0; eb < 4; ++eb)
#pragma unroll
        for (int kb = 0; kb < 2; ++kb) st4_bf16(dst + (16 * eb + qi) * 32 + 16 * kb + 4 * g, acc[eb][kb].x, acc[eb][kb].y, acc[eb][kb].z, acc[eb][kb].w);
    __syncthreads();
}

__device__ __forceinline__ void gla3_item(const bf16_t* __restrict__ Z, const bf16_t* __restrict__ GS, bf16_t* __restrict__ MIX, const float* __restrict__ gnorm, int ci) {
    const int tid = opaque_tid();
    __syncthreads();
    const int wave = tid >> 6, lane = tid & 63, qi = lane & 15, g = lane >> 4;
    const size_t tok0 = (size_t)ci * 64;
    bf16_t* Vt = (bf16_t*)g_lds;
    float* CUM = (float*)(g_lds + 4 * 64 * 68 * 2);
    stage_v4<64>(Z, tok0, ZC_BV, Vt);
    { const int h = wave >> 1, dir = wave & 1; float cum[32], tot;
      gla_cum(Z, tok0, h, dir, lane, cum, tot);
      const int kk = lane & 31, hf = lane >> 5; float* cd = CUM + ((size_t)(h * 2 + dir) * 64 + 32 * hf) * 32 + kk;
#pragma unroll
      for (int i = 0; i < 32; ++i) cd[i * 32] = cum[i]; }
    __syncthreads();
    const int h = wave >> 1;
    const float* cF = CUM + (size_t)(h * 2 + 0) * 64 * 32; const float* cB = CUM + (size_t)(h * 2 + 1) * 64 * 32;
    const bf16_t* sF = GS + (((size_t)0 * NCH + ci) * 4 + h) * 2048; const bf16_t* sB = GS + (((size_t)1 * NCH + ci) * 4 + h) * 2048;
    bf16x8 SFf[4], SBf[4];
#pragma unroll
    for (int eb = 0; eb < 4; ++eb) { SFf[eb] = *(const bf16x8*)(sF + (16 * eb + qi) * 32 + 8 * g); SBf[eb] = *(const bf16x8*)(sB + (16 * eb + qi) * 32 + 8 * g); }
    bf16x8 KFf[2][2], KBf[2][2];
#pragma unroll
    for (int sg = 0; sg < 2; ++sg)
#pragma unroll
        for (int blk = 0; blk < 2; ++blk) {
            const int s = 32 * sg + 8 * (qi >> 2) + (qi & 3) + 4 * blk;
            float kv[8], a[8], b[8]; unpack8(*(const bf16x8*)(Z + (tok0 + s) * ZW + ZC_BK + h * 32 + 8 * g), kv);
#pragma unroll
            for (int j = 0; j < 8; ++j) { a[j] = kv[j] * __expf(-cF[s * 32 + 8 * g + j]); b[j] = kv[j] * __expf(-cB[s * 32 + 8 * g + j]); }
            KFf[sg][blk] = pack8(a); KBf[sg][blk] = pack8(b);
        }
#pragma unroll 1
    for (int tbi = 0; tbi < 2; ++tbi) {
        const int t = 16 * (2 * (wave & 1) + tbi) + qi;
        bf16x8 Qf, Qb;
        { float qv[8], a[8], b[8]; unpack8(*(const bf16x8*)(Z + (tok0 + t) * ZW + ZC_BQ + h * 32 + 8 * g), qv);
#pragma unroll
          for (int j = 0; j < 8; ++j) { a[j] = qv[j] * __expf(cF[t * 32 + 8 * g + j]); b[j] = qv[j] * __expf(cB[t * 32 + 8 * g + j]); }
          Qf = pack8(a); Qb = pack8(b); }
        f32x4 acc[4] = {};
#pragma unroll
        for (int eb = 0; eb < 4; ++eb) { acc[eb] = MFMA16(SFf[eb], Qf, acc[eb]); acc[eb] = MFMA16(SBf[eb], Qb, acc[eb]); }
#pragma unroll
        for (int sg = 0; sg < 2; ++sg) {
            f32x4 aF[2], aB[2];
#pragma unroll
            for (int blk = 0; blk < 2; ++blk) {
                const f32x4 z4 = {0.f, 0.f, 0.f, 0.f};
                aF[blk] = MFMA16(KFf[sg][blk], Qf, z4); aB[blk] = MFMA16(KBf[sg][blk], Qb, z4);
            }
            float pj[8];
#pragma unroll
            for (int j = 0; j < 8; ++j) { const int s = 32 * sg + 8 * g + j; pj[j] = (s <= t) ? (j < 4 ? aF[0][j] : aF[1][j - 4]) : (j < 4 ? aB[0][j] : aB[1][j - 4]); }
            const bf16x8 P = pack8(pj);
#pragma unroll
            for (int eb = 0; eb < 4; ++eb) acc[eb] = MFMA16(gather8(Vt + ((size_t)h * 64 + 32 * sg + 8 * g) * 68 + 16 * eb , 68, qi), P, acc[eb]);
        }
        float ss = 0.f;
#pragma unroll
        for (int eb = 0; eb < 4; ++eb) ss += (acc[eb].x * acc[eb].x + acc[eb].y * acc[eb].y) + (acc[eb].z * acc[eb].z + acc[eb].w * acc[eb].w);
        ss = xsum32(xsum16(ss));
        const float rn = rsqrtf(ss * (1.0f / 64) + EPS);
        u32x2 brw4[4]; f32x4 gn4[4];
#pragma unroll
        for (int eb = 0; eb < 4; ++eb) { const int e = 16 * eb + 4 * g; brw4[eb] = *(const u32x2*)(Z + (tok0 + t) * ZW + ZC_BR + h * 64 + e); gn4[eb] = *(const f32x4*)(gnorm + h * 64 + e); }
#pragma unroll
        for (int eb = 0; eb < 4; ++eb) { const int e = 16 * eb + 4 * g;
            const u32x2 brw = brw4[eb]; const f32x4 gn = gn4[eb];
            const float b0 = bflo(brw.x), b1 = bfhi(brw.x), b2 = bflo(brw.y), b3 = bfhi(brw.y);
            const float o0 = acc[eb].x * rn * gn.x * (b0 / (1.f + __expf(-b0))), o1 = acc[eb].y * rn * gn.y * (b1 / (1.f + __expf(-b1)));
            const float o2 = acc[eb].z * rn * gn.z * (b2 / (1.f + __expf(-b2))), o3 = acc[eb].w * rn * gn.w * (b3 / (1.f + __expf(-b3)));
            u32x2 w; w.x = cvt_pk_bf16(o0, o1); w.y = cvt_pk_bf16(o2, o3);
            *(u32x2*)(MIX + (tok0 + t) * D + 512 + h * 64 + e) = w; }
    }
    __syncthreads();
}

__device__ __forceinline__ void ret1_item(const bf16_t* __restrict__ Z, bf16_t* __restrict__ RS, const float* __restrict__ lgam, int item) {
    const int tid = opaque_tid();
    __syncthreads();
    const int wave = tid >> 6, lane = tid & 63, qi = lane & 15, g = lane >> 4;
    const int ci = item >> 1, hp = item & 1;
    const size_t tok0 = (size_t)ci * 128;
    bf16_t* Vt = (bf16_t*)g_lds;
    bf16_t* Kt = Vt + 2 * 128 * 68;
    { u32x4 v[8];
#pragma unroll
      for (int u = 0; u < 8; ++u) { const int idx = tid + u * NTHR; const int which = idx >> 11, r = idx & 2047, t = r >> 4, ch = r & 15;
          v[u] = *(const u32x4*)(Z + (tok0 + t) * ZW + (which ? ZC_CK : ZC_CV) + hp * 128 + ch * 8); }
#pragma unroll
      for (int u = 0; u < 8; ++u) { const int idx = tid + u * NTHR; const int which = idx >> 11, r = idx & 2047, t = r >> 4, ch = r & 15, hh = ch >> 3, c8 = ch & 7;
          bf16_t* d = (which ? Kt : Vt) + ((size_t)hh * 128 + t) * 68 + c8 * 8;
          *(u32x2*)d = (u32x2){v[u].x, v[u].y}; *(u32x2*)(d + 4) = (u32x2){v[u].z, v[u].w}; } }
    __syncthreads();
    const int hh = wave >> 2, dir = (wave >> 1) & 1, eh = wave & 1, head = 2 * hp + hh;
    const float lg = lgam[dir * 4 + head];
    f32x4 acc[2][4] = {};
#pragma unroll 1
    for (int ks = 0; ks < 4; ++ks) {
        float w[8];
#pragma unroll
        for (int j = 0; j < 8; ++j) { const int s = 32 * ks + 8 * g + j; w[j] = __expf(lg * (float)(dir ? s : 127 - s)); }
        bf16x8 bfr[4];
#pragma unroll
        for (int db = 0; db < 4; ++db) { float kv[8]; unpack8(gather8(Kt + ((size_t)hh * 128 + 32 * ks + 8 * g) * 68 + 16 * db , 68, qi), kv);
#pragma unroll
            for (int j = 0; j < 8; ++j) kv[j] *= w[j];
            bfr[db] = pack8(kv); }
#pragma unroll
        for (int ebi = 0; ebi < 2; ++ebi) { const bf16x8 af = gather8(Vt + ((size_t)hh * 128 + 32 * ks + 8 * g) * 68 + 16 * (2 * eh + ebi) , 68, qi);
#pragma unroll
            for (int db = 0; db < 4; ++db) acc[ebi][db] = MFMA16(bfr[db], af, acc[ebi][db]); }
    }
    bf16_t* dst = RS + (((size_t)dir * NCR + ci) * 4 + head) * 4096;
#pragma unroll
    for (int ebi = 0; ebi < 2; ++ebi)
#pragma unroll
        for (int db = 0; db < 4; ++db) st4_bf16(dst + (16 * (2 * eh + ebi) + qi) * 64 + 16 * db + 4 * g, acc[ebi][db].x, acc[ebi][db].y, acc[ebi][db].z, acc[ebi][db].w);
    __syncthreads();
}

__device__ __forceinline__ void ret3_item(const bf16_t* __restrict__ Z, const bf16_t* __restrict__ RS, bf16_t* __restrict__ MIX, const float* __restrict__ rnorm, const float* __restrict__ lgam, int ci) {
    const int tid = opaque_tid();
    __syncthreads();
    const int wave = tid >> 6, lane = tid & 63, qi = lane & 15, g = lane >> 4;
    const size_t tok0 = (size_t)ci * 128;
    bf16_t* Vt = (bf16_t*)g_lds;
    stage_v4<128>(Z, tok0, ZC_CV, Vt);
    __syncthreads();
    const int h = wave >> 1;
    const float lg0 = lgam[h], lg1 = lgam[4 + h];
    const bf16_t* rF = RS + (((size_t)0 * NCR + ci) * 4 + h) * 4096; const bf16_t* rB = RS + (((size_t)1 * NCR + ci) * 4 + h) * 4096;
    bf16x8 RF[4][2], RB[4][2];
#pragma unroll
    for (int eb = 0; eb < 4; ++eb) { const bf16_t* pf = rF + (16 * eb + qi) * 64 + 8 * g; const bf16_t* pb = rB + (16 * eb + qi) * 64 + 8 * g;
        RF[eb][0] = *(const bf16x8*)pf; RF[eb][1] = *(const bf16x8*)(pf + 32); RB[eb][0] = *(const bf16x8*)pb; RB[eb][1] = *(const bf16x8*)(pb + 32); }
    bf16x8 KF[4][2][2];
#pragma unroll
    for (int sg = 0; sg < 4; ++sg)
#pragma unroll
        for (int blk = 0; blk < 2; ++blk) { const int s = 32 * sg + 8 * (qi >> 2) + (qi & 3) + 4 * blk;
            const bf16_t* kp = Z + (tok0 + s) * ZW + ZC_CK + h * 64 + 8 * g; KF[sg][blk][0] = *(const bf16x8*)kp; KF[sg][blk][1] = *(const bf16x8*)(kp + 32); }
#pragma unroll 1
    for (int tbi = 0; tbi < 4; ++tbi) {
        const int t = 16 * (4 * (wave & 1) + tbi) + qi;
        const bf16_t* qp = Z + (tok0 + t) * ZW + ZC_CQ + h * 64 + 8 * g;
        const bf16x8 q0 = *(const bf16x8*)qp, q1 = *(const bf16x8*)(qp + 32);
        f32x4 aI[4];
        { const float wf = __expf(lg0 * (float)(t + 1)), wb = __expf(lg1 * (float)(128 - t));
#pragma unroll
          for (int eb = 0; eb < 4; ++eb) {
              f32x4 aF = {0.f, 0.f, 0.f, 0.f}, aB = {0.f, 0.f, 0.f, 0.f};
              aF = MFMA16(RF[eb][0], q0, aF); aF = MFMA16(RF[eb][1], q1, aF);
              aB = MFMA16(RB[eb][0], q0, aB); aB = MFMA16(RB[eb][1], q1, aB);
              aI[eb] = aF * wf + aB * wb;
          } }
#pragma unroll
        for (int sg = 0; sg < 4; ++sg) {
            f32x4 sc[2];
#pragma unroll
            for (int blk = 0; blk < 2; ++blk) {
                f32x4 z4 = {0.f, 0.f, 0.f, 0.f};
                z4 = MFMA16(KF[sg][blk][0], q0, z4); z4 = MFMA16(KF[sg][blk][1], q1, z4); sc[blk] = z4;
            }
            float pj[8];
#pragma unroll
            for (int j = 0; j < 8; ++j) { const int s = 32 * sg + 8 * g + j; const int dd = t - s;
                const float dec = (dd >= 0) ? __expf(lg0 * (float)dd) : __expf(lg1 * (float)(-dd));
                pj[j] = (j < 4 ? sc[0][j] : sc[1][j - 4]) * dec; }
            const bf16x8 P = pack8(pj);
#pragma unroll
            for (int eb = 0; eb < 4; ++eb) aI[eb] = MFMA16(gather8(Vt + ((size_t)h * 128 + 32 * sg + 8 * g) * 68 + 16 * eb , 68, qi), P, aI[eb]);
        }
        float ss = 0.f;
#pragma unroll
        for (int eb = 0; eb < 4; ++eb) ss += (aI[eb].x * aI[eb].x + aI[eb].y * aI[eb].y) + (aI[eb].z * aI[eb].z + aI[eb].w * aI[eb].w);
        ss = xsum32(xsum16(ss));
        const float rn = rsqrtf(ss * (1.0f / 64) + EPS);
        u32x2 gw4[4]; f32x4 gn4[4];
#pragma unroll
        for (int eb = 0; eb < 4; ++eb) { const int e = 16 * eb + 4 * g; gw4[eb] = *(const u32x2*)(Z + (tok0 + t) * ZW + ZC_CG + h * 64 + e); gn4[eb] = *(const f32x4*)(rnorm + h * 64 + e); }
#pragma unroll
        for (int eb = 0; eb < 4; ++eb) { const int e = 16 * eb + 4 * g;
            const u32x2 gw = gw4[eb]; const f32x4 gn = gn4[eb];
            const float b0 = bflo(gw.x), b1 = bfhi(gw.x), b2 = bflo(gw.y), b3 = bfhi(gw.y);
            const float o0 = aI[eb].x * rn * gn.x * (b0 / (1.f + __expf(-b0))), o1 = aI[eb].y * rn * gn.y * (b1 / (1.f + __expf(-b1)));
            const float o2 = aI[eb].z * rn * gn.z * (b2 / (1.f + __expf(-b2))), o3 = aI[eb].w * rn * gn.w * (b3 / (1.f + __expf(-b3)));
            u32x2 w; w.x = cvt_pk_bf16(o0, o1); w.y = cvt_pk_bf16(o2, o3);
            *(u32x2*)(MIX + (tok0 + t) * D + 768 + h * 64 + e) = w; }
    }
    __syncthreads();
}

__device__ __forceinline__ void phase_scan(bf16_t* __restrict__ GS, const float* __restrict__ GD, bf16_t* __restrict__ RS, const float* __restrict__ lgam, int S) {
    const int tid = opaque_tid();
    const int lgn = (S == 16384) ? 1 : 4, nseq = 1 << lgn, ncg = S / 64, ncr = S / 128;
    const int gtid = blockIdx.x * NTHR + tid, gth = gridDim.x * NTHR;
    const int n_gla = 2 * nseq * 4 * 1024, n_ret = 2 * nseq * 4 * 2048;
    constexpr int SB_ = 16;
    for (int idx = gtid; idx < n_gla + n_ret; idx += gth) {
        if (idx < n_gla) {
            const int el = 2 * (idx & 1023), hh = (idx >> 10) & 3, sq = (idx >> 12) & (nseq - 1), dir = (idx >> 12) >> lgn, kk = el & 31;
            const size_t cstr = (size_t)4 * 2048;
            unsigned* base = (unsigned*)(GS + (((size_t)dir * NCH + (size_t)sq * ncg) * 4 + hh) * 2048 + el);
            const float* dbase = GD + (((size_t)dir * NCH + (size_t)sq * ncg) * 4 + hh) * 32 + kk;
            const long step = dir ? -1 : 1; const long c0 = dir ? ncg - 1 : 0;
            unsigned cur[SB_], nxt[SB_]; f32x2_t dcur[SB_], dnxt[SB_];
#pragma unroll
            for (int u = 0; u < SB_; ++u) { const long c = c0 + step * u; cur[u] = *(const unsigned*)((const bf16_t*)base + c * (long)cstr); dcur[u] = *(const f32x2_t*)(dbase + c * 128); }
            float s0 = 0.f, s1 = 0.f;
#pragma unroll 1
            for (int i0 = 0; i0 < ncg; i0 += SB_) {
                const bool more = i0 + SB_ < ncg;
#pragma unroll
                for (int u = 0; u < SB_; ++u) { const long c = c0 + step * (more ? i0 + SB_ + u : i0 + u); nxt[u] = *(const unsigned*)((const bf16_t*)base + c * (long)cstr); dnxt[u] = *(const f32x2_t*)(dbase + c * 128); }
#pragma unroll
                for (int u = 0; u < SB_; ++u) { const long c = c0 + step * (i0 + u);
                    *(unsigned*)((bf16_t*)base + c * (long)cstr) = cvt_pk_bf16(s0, s1); s0 = dcur[u].x * s0 + bflo(cur[u]); s1 = dcur[u].y * s1 + bfhi(cur[u]); }
#pragma unroll
                for (int u = 0; u < SB_; ++u) { cur[u] = nxt[u]; dcur[u] = dnxt[u]; }
            }
        } else {
            const int j = idx - n_gla; const int el = 2 * (j & 2047), hh = (j >> 11) & 3, sq = (j >> 13) & (nseq - 1), dir = (j >> 13) >> lgn;
            const float dec = __expf(128.f * lgam[dir * 4 + hh]);
            const size_t cstr = (size_t)4 * 4096;
            unsigned* base = (unsigned*)(RS + (((size_t)dir * NCR + (size_t)sq * ncr) * 4 + hh) * 4096 + el);
            const long step = dir ? -1 : 1; const long c0 = dir ? ncr - 1 : 0;
            unsigned cur[SB_], nxt[SB_];
#pragma unroll
            for (int u = 0; u < SB_; ++u) { const long c = c0 + step * u; cur[u] = *(const unsigned*)((const bf16_t*)base + c * (long)cstr); }
            float s0 = 0.f, s1 = 0.f;
#pragma unroll 1
            for (int i0 = 0; i0 < ncr; i0 += SB_) {
                const bool more = i0 + SB_ < ncr;
#pragma unroll
                for (int u = 0; u < SB_; ++u) { const long c = c0 + step * (more ? i0 + SB_ + u : i0 + u); nxt[u] = *(const unsigned*)((const bf16_t*)base + c * (long)cstr); }
#pragma unroll
                for (int u = 0; u < SB_; ++u) { const long c = c0 + step * (i0 + u);
                    *(unsigned*)((bf16_t*)base + c * (long)cstr) = cvt_pk_bf16(s0, s1); s0 = dec * s0 + bflo(cur[u]); s1 = dec * s1 + bfhi(cur[u]); }
#pragma unroll
                for (int u = 0; u < SB_; ++u) cur[u] = nxt[u];
            }
        }
    }
}

#define XB_TMO      128
#define XB_XCNT(j)  (256  + 64 * (j))
#define XB_XSUB(j)  (1280 + 64 * (j))
#define XB_XGEN(j)  (2304 + 64 * (j))
#define XB_TOP      3328
#define XB_TOPGEN   3392
#define XCD_BAR_WORDS 3456
#define XB_SPIN_CAP (1u << 22)
#define LAS __attribute__((address_space(3)))
__device__ __forceinline__ unsigned xb_ld(unsigned* p)              { return __hip_atomic_load(p, __ATOMIC_RELAXED, __HIP_MEMORY_SCOPE_AGENT); }
__device__ __forceinline__ unsigned xb_add(unsigned* p, unsigned v) { return __hip_atomic_fetch_add(p, v, __ATOMIC_RELAXED, __HIP_MEMORY_SCOPE_AGENT); }
__device__ __forceinline__ unsigned xb_xcc_id() { return (unsigned)__builtin_amdgcn_s_getreg((3 << 11) | 20) & 0xFu; }
#define XB_SPIN(cond, bar) do { unsigned _sp = 0; while (cond) { __builtin_amdgcn_s_sleep(1); \
    if ((++_sp & 255u) == 0u) { if (xb_ld(&(bar)[XB_TMO])) break; if (_sp > XB_SPIN_CAP) { atomicAdd(&(bar)[XB_TMO], 1u); break; } } } } while (0)
struct XcdBarrier { unsigned* bar; unsigned x; volatile LAS unsigned* st; };
__device__ __forceinline__ XcdBarrier xcd_barrier_post(unsigned* bar, volatile LAS unsigned* st) {
    XcdBarrier b; b.bar = bar; b.x = xb_xcc_id(); b.st = st;
    if (threadIdx.x == 0) (void)xb_add(&bar[XB_XCNT(b.x)], 1u);
    return b;
}
__device__ __forceinline__ void xcd_barrier_complete(unsigned* bar, unsigned x, unsigned& nloc, unsigned& nx) {
    const unsigned G = gridDim.x * gridDim.y * gridDim.z;
    unsigned sum, cnt, mine, sp = 0u;
    for (;;) {
        sum = 0u; cnt = 0u; mine = 0u;
#pragma unroll
        for (unsigned j = 0; j < 16; ++j) { const unsigned c = xb_ld(&bar[XB_XCNT(j)]); sum += c; cnt += (c > 0u) ? 1u : 0u; mine = (j == x) ? c : mine; }
        if (sum == G) break;
        __builtin_amdgcn_s_sleep(1);
        if ((++sp & 255u) == 0u) { if (xb_ld(&bar[XB_TMO])) break; if (sp > XB_SPIN_CAP) { atomicAdd(&bar[XB_TMO], 1u); break; } }
    }
    nloc = mine > 0u ? mine : 1u; nx = cnt > 0u ? cnt : 1u;
}
__device__ __forceinline__ void xcd_barrier(const XcdBarrier& b) {
    asm volatile("s_waitcnt vmcnt(0)" ::: "memory");
    __syncthreads();
    if (threadIdx.x == 0) {
        unsigned* bar = b.bar;
        __builtin_amdgcn_s_waitcnt(0);
        unsigned nloc = b.st[0], nx = b.st[1];
        if (nloc == 0u) { xcd_barrier_complete(bar, b.x, nloc, nx); b.st[0] = nloc; b.st[1] = nx; }
        const unsigned old = xb_add(&bar[XB_XSUB(b.x)], 1u);
        const unsigned gen = old / nloc;
        if (old + 1u == (gen + 1u) * nloc) {
            __builtin_amdgcn_fence(__ATOMIC_RELEASE, "agent");
            asm volatile("s_waitcnt vmcnt(0)" ::: "memory");
            const unsigned og = xb_add(&bar[XB_TOP], 1u);
            const unsigned tg = og / nx;
            if (og + 1u == (tg + 1u) * nx) xb_add(&bar[XB_TOPGEN], 1u);
            else XB_SPIN(xb_ld(&bar[XB_TOPGEN]) == tg, bar);
            __builtin_amdgcn_fence(__ATOMIC_ACQUIRE, "agent");
            xb_add(&bar[XB_XGEN(b.x)], 1u);
            asm volatile("s_waitcnt vmcnt(0)" ::: "memory");
        } else {
            XB_SPIN(xb_ld(&bar[XB_XGEN(b.x)]) == gen, bar);
            __builtin_amdgcn_fence(__ATOMIC_ACQUIRE, "agent");
            asm volatile("s_waitcnt vmcnt(0)" ::: "memory");
        }
    }
    __syncthreads();
}

__global__ void __launch_bounds__(NTHR, 2) fwd_mega(Params p) {
    cg::grid_group grid = cg::this_grid();
    unsigned char* ws = p.ws;
    bf16_t* WT = (bf16_t*)(ws + WS_WT); const float* tab = (const float*)(ws + WS_TAB);
    bf16_t* HB0 = (bf16_t*)(ws + WS_HB); bf16_t* HB1 = (bf16_t*)(ws + WS_HB1);
    float* SSQ0 = (float*)(ws + WS_SSQ); float* SSQ1 = SSQ0 + (size_t)MG * 16; float* SSQ2 = SSQ1 + (size_t)MG * 16;
    bf16_t* Z = (bf16_t*)(ws + WS_Z); bf16_t* MIX = (bf16_t*)(ws + WS_MIX); bf16_t* HID = (bf16_t*)(ws + WS_HID);
    bf16_t* PB = (bf16_t*)(ws + WS_PB); bf16_t* PL = (bf16_t*)(ws + WS_PLE);
    bf16_t* KA = (bf16_t*)(ws + WS_KA); bf16_t* VA = (bf16_t*)(ws + WS_VA);
    bf16_t* GS = (bf16_t*)(ws + WS_GS); float* GD = (float*)(ws + WS_GD); bf16_t* RS = (bf16_t*)(ws + WS_RS);
    float* lgam = (float*)(g_lds + LDS_BYTES - 64);

#ifndef NO_P0
    phase_weights(p);
#endif
    unsigned* barw = (unsigned*)(ws + WS_BAR);
    volatile LAS unsigned* bst = (volatile LAS unsigned*)(g_lds + LDS_BYTES - 32);
    if (blockIdx.x == 0) for (int i = threadIdx.x; i < XCD_BAR_WORDS; i += NTHR) barw[i] = 0u;
    if (threadIdx.x < 2) bst[threadIdx.x] = 0u;
    grid.sync();
    const XcdBarrier xb = xcd_barrier_post(barw, bst);
#pragma unroll 1
    for (int g = 0; g < NGROUPS; ++g) {
        const int S = (g == 0) ? 16384 : 2048;
        float* H = p.out + (size_t)g * MG * D;
#ifndef NO_PI
        phase_init(p, g);
#endif
        xcd_barrier(xb);
#pragma unroll 1
        for (int l = 0; l < NLAYER; ++l) {
            const bf16_t* W = WT + (size_t)l * W_LAYER;
            { const int t8 = opaque_tid(); if (t8 < 8) { const float x = p.ret_decay_raw[l * 8 + t8]; lgam[t8] = fminf(x, 0.f) - __logf(1.0f + __expf(-fabsf(x))); } }
            __syncthreads();
            { EpiIn e{Z, SSQ0, p.attn_q_norm + l * 64, p.attn_k_norm + l * 64, p.gla_gate_bias + l * 256, tab, S - 1, KA, VA};
#ifndef NO_P1
#ifndef REP_P1
#define REP_P1 1
#endif
              gemm_phase(HB0, D, W + WO_IN, D, MG, ZW, D, e);
#if REP_P1 > 1
              xcd_barrier(xb); gemm_phase(HB0, D, W + WO_IN, D, MG, ZW, D, e);
#endif
#endif
 }
            xcd_barrier(xb);
#ifndef REP_MIX
#define REP_MIX 1
#endif
            for (int rep_mix = 0; rep_mix < REP_MIX; ++rep_mix) {
            { const int nA = 1024, nG = NCH, nR = 2 * NCR;
#ifndef NO_AT
              if ((gridDim.x & 7) == 0) {
                  const int per = nA / 8, slots = gridDim.x / 8;
                  for (int k = blockIdx.x / 8; k < per; k += slots) attn_item(Z, KA, VA, MIX, S, per * (blockIdx.x & 7) + k);
              } else { for (int it = blockIdx.x; it < nA; it += gridDim.x) attn_item(Z, KA, VA, MIX, S, it); }
#endif
              for (int it = nA + blockIdx.x; it < nA + nG + nR; it += gridDim.x) {
#ifndef NO_G1
                  if (it >= nA && it < nA + nG) gla1_item(Z, GS, GD, it - nA);
#endif
#ifndef NO_R1
                  if (it >= nA + nG) ret1_item(Z, RS, lgam, it - nA - nG);
#endif
              } }
            xcd_barrier(xb);
#ifndef NO_P3
            phase_scan(GS, GD, RS, lgam, S);
#endif
            xcd_barrier(xb);
            { for (int it = blockIdx.x; it < NCH + NCR; it += gridDim.x) {
#ifndef NO_G3
                  if (it < NCH) gla3_item(Z, GS, MIX, p.gla_out_norm + l * 256, it);
#endif
#ifndef NO_R3
                  if (it >= NCH) ret3_item(Z, RS, MIX, p.ret_out_norm + l * 256, lgam, it - NCH);
#endif
              } }
            xcd_barrier(xb);
            }
#ifndef NO_P5
            { EpiRes e{HB0, HB1, SSQ1}; gemm_phase(MIX, D, W + WO_OUT, D, MG, D, D, e); }
#endif
            xcd_barrier(xb);
#ifndef NO_P6
            { EpiMlpIn e{HID, SSQ1}; gemm_phase_t<true>(HB1, D, W + WO_MI, D, MG, DFF, D, e); }
#endif
#ifndef NO_P6B
            { EpiPlain e{PB, D}; gemm_phase(PL + (size_t)l * MG * PLE, PLE, W + WO_PP, PLE, MG, D, PLE, e); }
#endif
            xcd_barrier(xb);
#ifndef NO_P7
            { EpiRes e{HB1, HB1, SSQ2}; gemm_phase(HID, DFF, W + WO_MO, DFF, MG, D, DFF, e); }
#endif
            xcd_barrier(xb);
#ifndef NO_P9
            { EpiPeGate e{H, HB1, HB0, SSQ0, SSQ2, PB, l == NLAYER - 1}; gemm_phase(HB1, D, W + WO_PG, D, MG, D, D, e); }
#endif
            xcd_barrier(xb);
        }
    }
}

extern "C" void kernel_launch(void* const* d_in, const int* in_sizes, int n_in, void* d_out, int out_size, void* d_ws, size_t ws_size, hipStream_t stream) {
    static int grid_blocks = 0;
    if (!grid_blocks) {
        int dev = 0, cus = 0, per_cu = 0;
        hipGetDevice(&dev);
        hipDeviceGetAttribute(&cus, hipDeviceAttributeMultiprocessorCount, dev);
        hipFuncSetAttribute((const void*)fwd_mega, hipFuncAttributeMaxDynamicSharedMemorySize, LDS_BYTES);
        hipOccupancyMaxActiveBlocksPerMultiprocessor(&per_cu, (const void*)fwd_mega, NTHR, LDS_BYTES);
        if (per_cu < 1) per_cu = 1;
        grid_blocks = cus * 1;
        if (ws_size < WS_END) fprintf(stderr, "kernel_launch: workspace too small: %zu < %zu\n", ws_size, (size_t)WS_END);
    }
    Params p{};
    p.x_prompt = (const float*)d_in[0]; p.x_sample = (const float*)d_in[1]; p.p_prompt = (const float*)d_in[2]; p.p_sample = (const float*)d_in[3];
    p.ln_mix = (const float*)d_in[4]; p.w_in = (const float*)d_in[5]; p.attn_q_norm = (const float*)d_in[6]; p.attn_k_norm = (const float*)d_in[7];
    p.gla_gate_up = (const float*)d_in[8]; p.gla_gate_bias = (const float*)d_in[9]; p.gla_out_norm = (const float*)d_in[10]; p.ret_decay_raw = (const float*)d_in[11];
    p.ret_out_norm = (const float*)d_in[12]; p.w_out = (const float*)d_in[13]; p.ln_mlp = (const float*)d_in[14]; p.w_mlp_in = (const float*)d_in[15]; p.w_mlp_out = (const float*)d_in[16];
    p.ln_pe = (const float*)d_in[17]; p.w_pe_gate = (const float*)d_in[18]; p.w_pe_proj = (const float*)d_in[19];
    p.out = (float*)d_out; p.ws = (unsigned char*)d_ws;
    void* args[] = {&p};
    hipError_t e = hipLaunchCooperativeKernel((const void*)fwd_mega, dim3(grid_blocks), dim3(NTHR), args, LDS_BYTES, stream);
    if (e != hipSuccess) fprintf(stderr, "cooperative launch failed: %s (grid %d)\n", hipGetErrorString(e), grid_blocks);
}
```

```cpp
#include <hip/hip_runtime.h>
#include <hip/hip_cooperative_groups.h>
#include <cstdio>
#include <cstdint>
namespace cg = cooperative_groups;

typedef unsigned short bf16_t;
typedef short bf16x8 __attribute__((ext_vector_type(8)));
typedef float f32x4 __attribute__((ext_vector_type(4)));
typedef unsigned u32x4 __attribute__((ext_vector_type(4)));
typedef unsigned u32x2 __attribute__((ext_vector_type(2)));

constexpr int D = 1024, MG = 32768, NGROUPS = 3, NLAYER = 2;
constexpr int ZW = 3584, DFF = 4096, PLE = 256, NIN = 3360;
constexpr int NTHR = 512;
constexpr int NCH = MG / 64;
constexpr int NCR = MG / 128;
constexpr float EPS = 1e-6f;
constexpr int ZC_AQ = 0, ZC_AK = 512, ZC_AV = 1024, ZC_BQ = 1536, ZC_BK = 1664, ZC_BV = 1792, ZC_BR = 2048,
              ZC_GF = 2304, ZC_GB = 2432, ZC_CQ = 2560, ZC_CK = 2816, ZC_CV = 3072, ZC_CG = 3328;
constexpr size_t WO_IN = 0, WO_OUT = WO_IN + (size_t)ZW * D, WO_MI = WO_OUT + (size_t)D * D, WO_MO = WO_MI + (size_t)DFF * D,
                 WO_PG = WO_MO + (size_t)D * DFF, WO_PP = WO_PG + (size_t)D * D, W_LAYER = WO_PP + (size_t)D * PLE;
constexpr size_t WS_WT = 0;
constexpr size_t WS_TAB = WS_WT + W_LAYER * 2 * NLAYER;
constexpr size_t WS_HB = WS_TAB + (size_t)16384 * 40 * 2 * 4;
constexpr size_t WS_HB1 = WS_HB + (size_t)MG * D * 2;
constexpr size_t WS_SSQ = WS_HB1 + (size_t)MG * D * 2;
constexpr size_t WS_Z = WS_SSQ + (size_t)3 * MG * 16 * 4;
constexpr size_t WS_MIX = WS_Z + (size_t)MG * ZW * 2;
constexpr size_t WS_HID = WS_MIX + (size_t)MG * D * 2;
constexpr size_t WS_PB = WS_HID + (size_t)MG * DFF * 2;
constexpr size_t WS_PLE = WS_PB + (size_t)MG * D * 2;
constexpr size_t WS_GS = WS_PLE + (size_t)NLAYER * MG * PLE * 2;
constexpr size_t WS_GD = WS_GS + (size_t)2 * NCH * 4 * 2048 * 4;
constexpr size_t WS_RS = WS_GD + (size_t)2 * NCH * 4 * 32 * 4;
constexpr size_t WS_BAR = WS_RS + (size_t)2 * NCR * 4 * 4096 * 4;
constexpr size_t WS_KA = WS_BAR + 16384;
constexpr size_t WS_VA = WS_KA + (size_t)8 * MG * 64 * 2;
constexpr size_t WS_END = WS_VA + (size_t)8 * MG * 64 * 2;

constexpr int LDS_BYTES = 139264;

extern __shared__ __attribute__((aligned(16))) unsigned char g_lds[];

struct Params {
    const float* x_prompt; const float* x_sample; const float* p_prompt; const float* p_sample;
    const float* ln_mix; const float* w_in; const float* attn_q_norm; const float* attn_k_norm;
    const float* gla_gate_up; const float* gla_gate_bias; const float* gla_out_norm; const float* ret_decay_raw;
    const float* ret_out_norm; const float* w_out; const float* ln_mlp; const float* w_mlp_in; const float* w_mlp_out;
    const float* ln_pe; const float* w_pe_gate; const float* w_pe_proj;
    float* out; unsigned char* ws;
};

typedef float f32x2_t __attribute__((ext_vector_type(2)));
typedef __bf16 bf16x2_t __attribute__((ext_vector_type(2)));
__device__ __forceinline__ unsigned cvt_pk_bf16(float lo, float hi) { const f32x2_t v = {lo, hi}; return __builtin_bit_cast(unsigned, __builtin_convertvector(v, bf16x2_t)); }
__device__ __forceinline__ float bf2f(unsigned short b) { return __uint_as_float(((unsigned)b) << 16); }
__device__ __forceinline__ float bflo(unsigned w) { return __uint_as_float(w << 16); }
__device__ __forceinline__ float bfhi(unsigned w) { return __uint_as_float(w & 0xffff0000u); }
__device__ __forceinline__ bf16x8 pack8(const float (&v)[8]) {
    u32x4 w; w.x = cvt_pk_bf16(v[0], v[1]); w.y = cvt_pk_bf16(v[2], v[3]); w.z = cvt_pk_bf16(v[4], v[5]); w.w = cvt_pk_bf16(v[6], v[7]);
    return __builtin_bit_cast(bf16x8, w);
}
__device__ __forceinline__ void unpack8(bf16x8 b, float (&v)[8]) {
    u32x4 w = __builtin_bit_cast(u32x4, b);
    v[0] = bflo(w.x); v[1] = bfhi(w.x); v[2] = bflo(w.y); v[3] = bfhi(w.y); v[4] = bflo(w.z); v[5] = bfhi(w.z); v[6] = bflo(w.w); v[7] = bfhi(w.w);
}
typedef short v4i16_t __attribute__((ext_vector_type(4)));
__device__ __forceinline__ bf16x8 gather8(const bf16_t* tile  , int stride, int qi) {
    const bf16_t* p = tile + (qi >> 2) * stride + 4 * (qi & 3);
    const v4i16_t lo = __builtin_amdgcn_ds_read_tr16_b64_v4i16((__attribute__((address_space(3))) v4i16_t*)p);
    const v4i16_t hi = __builtin_amdgcn_ds_read_tr16_b64_v4i16((__attribute__((address_space(3))) v4i16_t*)(p + 4 * stride));
    bf16x8 r; r[0] = lo[0]; r[1] = lo[1]; r[2] = lo[2]; r[3] = lo[3]; r[4] = hi[0]; r[5] = hi[1]; r[6] = hi[2]; r[7] = hi[3];
    return r;
}
__device__ __forceinline__ bf16x8 ld8f_pack(const float* p) {
    f32x4 a = *(const f32x4*)p, b = *(const f32x4*)(p + 4);
    u32x4 w; w.x = cvt_pk_bf16(a.x, a.y); w.y = cvt_pk_bf16(a.z, a.w); w.z = cvt_pk_bf16(b.x, b.y); w.w = cvt_pk_bf16(b.z, b.w);
    return __builtin_bit_cast(bf16x8, w);
}
__device__ __forceinline__ int opaque_tid() { int t = threadIdx.x; asm volatile("" : "+v"(t)); return t; }
__device__ __forceinline__ float xmax16(float m) { auto rr = __builtin_amdgcn_permlane16_swap(__float_as_uint(m), __float_as_uint(m), false, false); return fmaxf(__uint_as_float(rr[0]), __uint_as_float(rr[1])); }
__device__ __forceinline__ float xmax32(float m) { auto rr = __builtin_amdgcn_permlane32_swap(__float_as_uint(m), __float_as_uint(m), false, false); return fmaxf(__uint_as_float(rr[0]), __uint_as_float(rr[1])); }
__device__ __forceinline__ float xsum16(float m) { auto rr = __builtin_amdgcn_permlane16_swap(__float_as_uint(m), __float_as_uint(m), false, false); return __uint_as_float(rr[0]) + __uint_as_float(rr[1]); }
__device__ __forceinline__ float xsum32(float m) { auto rr = __builtin_amdgcn_permlane32_swap(__float_as_uint(m), __float_as_uint(m), false, false); return __uint_as_float(rr[0]) + __uint_as_float(rr[1]); }
__device__ __forceinline__ float rsum16(float v) {
    v += __uint_as_float(__builtin_amdgcn_update_dpp(0u, __float_as_uint(v), 0x128, 0xf, 0xf, false));
    v += __uint_as_float(__builtin_amdgcn_update_dpp(0u, __float_as_uint(v), 0x124, 0xf, 0xf, false));
    v += __uint_as_float(__builtin_amdgcn_update_dpp(0u, __float_as_uint(v), 0x122, 0xf, 0xf, false));
    v += __uint_as_float(__builtin_amdgcn_update_dpp(0u, __float_as_uint(v), 0x121, 0xf, 0xf, false));
    return v;
}
#define LDS_FENCE() asm volatile("s_waitcnt lgkmcnt(0)" ::: "memory")
#define MFMA16(a, b, c) __builtin_amdgcn_mfma_f32_16x16x32_bf16((a), (b), (c), 0, 0, 0)

constexpr int BM = 256, BK = 64, HALF = 128, HT = HALF * BK;
__device__ __forceinline__ int lds_byte(int r, int c) {
    int st = (r >> 4) * 2 + (c >> 5), rr = r & 15, cc = c & 31, ob = rr * 64 + cc * 2;
    return st * 1024 + (ob ^ (((ob >> 9) & 1) << 5));
}
__device__ __forceinline__ void stage_rc(int b, int& R, int& C) {
    int st = b / 1024, sb = b % 1024, swz = sb ^ (((sb >> 9) & 1) << 5);
    R = (st >> 1) * 16 + swz / 64; C = (st & 1) * 32 + (swz % 64) / 2;
}
__device__ __forceinline__ bool tile_of(int L, int nM, int nN, int& pm, int& pn) {
    const int nwg = nM * nN; if (L >= nwg) return false;
    int wgid = L; { const int q = nwg / 8, r = nwg % 8, xcd = wgid % 8, off = wgid / 8; wgid = (xcd < r ? xcd * (q + 1) : r * (q + 1) + (xcd - r) * q) + off; }
    const int nig = 8 * nN, gid = wgid / nig, fm = gid * 8, gsz = (nM - fm) < 8 ? (nM - fm) : 8;
    pm = fm + ((wgid % nig) % gsz); pn = (wgid % nig) / gsz; return true;
}

template <bool TR, class Epi>
__device__ __forceinline__ void gemm_tile(const bf16_t* __restrict__ A, int lda, const bf16_t* __restrict__ Bt, int ldb, int K, int brow, int bcol, const Epi& epi, int parity, bool pre, int nbrow, int nbcol) {
    const int tid = opaque_tid();
    bf16_t* shm = (bf16_t*)g_lds;
#define SA(b, h) (shm + ((b) * 2 + (h)) * HT)
#define SB(b, h) (shm + (4 + (b) * 2 + (h)) * HT)
#define STAGE(P, BASE, LD, br, kt) do { const int _so = ((br) * (LD) + (kt) * BK) * 2; \
    for (int _i = 0; _i < 2; ++_i) { \
      __builtin_amdgcn_raw_ptr_buffer_load_lds(((&(LD) == &lda) ? rsA : rsB), (__attribute__((address_space(3))) void*)((char*)(P) + wid * 1024 + _i * 8192), 16, \
          ((&(LD) == &lda) ? offA[_i] : offB[_i]), _so, 0, 0); } } while (0)
#define LDA(dst, b, h) for (int m = 0; m < 4; ++m) for (int k = 0; k < 2; ++k) \
    dst[m][k] = *reinterpret_cast<const bf16x8*>((char*)SA(b, h) + lds_byte(wr * 64 + m * 16 + fr, k * 32 + fq * 8))
#define LDB(dst, b, h) for (int n = 0; n < 2; ++n) for (int k = 0; k < 2; ++k) \
    dst[n][k] = *reinterpret_cast<const bf16x8*>((char*)SB(b, h) + lds_byte(wc * 32 + n * 16 + fr, k * 32 + fq * 8))
#define MMA(ai, bj, At, Bt_) do { __builtin_amdgcn_s_setprio(1); \
    for (int m = 0; m < 4; ++m) for (int n = 0; n < 2; ++n) for (int k = 0; k < 2; ++k) \
      acc[ai][bj][m][n] = TR ? __builtin_amdgcn_mfma_f32_16x16x32_bf16(Bt_[n][k], At[m][k], acc[ai][bj][m][n], 0, 0, 0) \
                            : __builtin_amdgcn_mfma_f32_16x16x32_bf16(At[m][k], Bt_[n][k], acc[ai][bj][m][n], 0, 0, 0); \
    __builtin_amdgcn_s_setprio(0); } while (0)
#define WAIT_V(n) asm volatile("s_waitcnt vmcnt(" #n ")" ::: "memory")
#define WAIT_L(n) asm volatile("s_waitcnt lgkmcnt(" #n ")" ::: "memory")
#define BAR __builtin_amdgcn_s_barrier()
#define SCHED __builtin_amdgcn_sched_barrier(0)
    const int wid = __builtin_amdgcn_readfirstlane(tid >> 6), lane = tid & 63, wr = wid >> 2, wc = wid & 3, fr = lane & 15, fq = lane >> 4;
    f32x4 acc[2][2][4][2] = {};
    bf16x8 At[4][2], B0[2][2], B1[2][2];
    const int nt = K / BK;
    const __amdgpu_buffer_rsrc_t rsA = __builtin_amdgcn_make_buffer_rsrc((void*)A, (short)0, 0x7ffffff0, 0x00020000);
    const __amdgpu_buffer_rsrc_t rsB = __builtin_amdgcn_make_buffer_rsrc((void*)Bt, (short)0, 0x7ffffff0, 0x00020000);
    unsigned offA[2], offB[2];
    for (int _i = 0; _i < 2; ++_i) { int _r, _c; stage_rc(tid * 16 + _i * 8192, _r, _c); offA[_i] = (unsigned)(_r * lda + _c) * 2u; offB[_i] = (unsigned)(_r * ldb + _c) * 2u; }
    if (!(TR && pre)) {
    STAGE(SB(0, 0), Bt, ldb, bcol, 0); STAGE(SA(0, 0), A, lda, brow, 0);
    STAGE(SB(0, 1), Bt, ldb, bcol + HALF, 0); STAGE(SA(0, 1), A, lda, brow + HALF, 0);
    }
    float* RT = (float*)(g_lds + 131072 + (parity & 1) * 1024);
    if (TR) { if (tid < 256) RT[tid] = epi.rstd_row(brow + tid); }
    if (wr == 1) BAR;
    if (TR && pre) { WAIT_V(8); } else { WAIT_V(4); }
    BAR;
    STAGE(SB(1, 0), Bt, ldb, bcol, 1); STAGE(SA(1, 0), A, lda, brow, 1); STAGE(SB(1, 1), Bt, ldb, bcol + HALF, 1);
    WAIT_V(6); BAR;
#pragma unroll 1
    for (int t = 0; t < nt - 2; t += 2) {
        LDB(B0, 0, 0); SCHED; LDA(At, 0, 0); STAGE(SA(1, 1), A, lda, brow + HALF, t + 1);
        WAIT_L(8); BAR; WAIT_L(0); MMA(0, 0, At, B0); BAR; SCHED;
        LDB(B1, 0, 1); STAGE(SB(0, 0), Bt, ldb, bcol, t + 2);
        BAR; WAIT_L(0); MMA(0, 1, At, B1); BAR;
        LDA(At, 0, 1); STAGE(SA(0, 0), A, lda, brow, t + 2);
        BAR; WAIT_L(0); MMA(1, 0, At, B0); BAR; SCHED;
        STAGE(SB(0, 1), Bt, ldb, bcol + HALF, t + 2);
        WAIT_V(6); BAR; MMA(1, 1, At, B1); BAR;
        LDB(B0, 1, 0); SCHED; LDA(At, 1, 0); STAGE(SA(0, 1), A, lda, brow + HALF, t + 2);
        WAIT_L(8); BAR; WAIT_L(0); MMA(0, 0, At, B0); BAR; SCHED;
        LDB(B1, 1, 1); STAGE(SB(1, 0), Bt, ldb, bcol, t + 3);
        BAR; WAIT_L(0); MMA(0, 1, At, B1); BAR;
        LDA(At, 1, 1); STAGE(SA(1, 0), A, lda, brow, t + 3);
        BAR; WAIT_L(0); MMA(1, 0, At, B0); BAR; SCHED;
        STAGE(SB(1, 1), Bt, ldb, bcol + HALF, t + 3);
        WAIT_V(6); BAR; MMA(1, 1, At, B1); BAR;
    }
    { LDB(B0, 0, 0); LDA(At, 0, 0); STAGE(SA(1, 1), A, lda, brow + HALF, nt - 1);
      BAR; WAIT_L(0); MMA(0, 0, At, B0); BAR;
      LDB(B1, 0, 1); BAR; WAIT_L(0); MMA(0, 1, At, B1); BAR;
      LDA(At, 0, 1); WAIT_V(4); BAR; WAIT_L(0); MMA(1, 0, At, B0); MMA(1, 1, At, B1); BAR; }
    { LDB(B0, 1, 0); LDA(At, 1, 0); WAIT_V(2); BAR; WAIT_L(0); MMA(0, 0, At, B0); BAR;
      LDB(B1, 1, 1); WAIT_V(0); BAR; WAIT_L(0); MMA(0, 1, At, B1); BAR;
      LDA(At, 1, 1); BAR; WAIT_L(0); MMA(1, 0, At, B0); MMA(1, 1, At, B1); BAR; }
    if (wr == 0) BAR;
    if (TR && nbrow >= 0) {
        STAGE(SB(0, 0), Bt, ldb, nbcol, 0); STAGE(SA(0, 0), A, lda, nbrow, 0);
        STAGE(SB(0, 1), Bt, ldb, nbcol + HALF, 0); STAGE(SA(0, 1), A, lda, nbrow + HALF, 0);
        asm volatile("" ::: "memory"); SCHED;
    }
    if (TR) {
        epi.regs(acc, RT, brow, bcol, wr, wc, fr, fq);
        return;
    }
    float* ep = (float*)g_lds;
#pragma unroll
    for (int ai = 0; ai < 2; ++ai) {
        if (ai) __syncthreads();
#pragma unroll
        for (int bj = 0; bj < 2; ++bj)
#pragma unroll
            for (int m = 0; m < 4; ++m)
#pragma unroll
                for (int n = 0; n < 2; ++n)
#pragma unroll
                    for (int j = 0; j < 4; ++j)
                        ep[(wr * 64 + m * 16 + fq * 4 + j) * 260 + bj * HALF + wc * 32 + n * 16 + fr] = acc[ai][bj][m][n][j];
        __syncthreads();
        int lane_e = tid & 63; asm volatile("" : "+v"(lane_e));
        const int row0 = brow + ai * HALF + wid * 16;
        epi.rows(ep, wid, lane_e, row0, bcol);
    }
    __syncthreads();
#undef SA
#undef SB
#undef STAGE
#undef LDA
#undef LDB
#undef MMA
}

template <bool TR, class Epi>
__device__ __forceinline__ void gemm_phase_t(const bf16_t* A, int lda, const bf16_t* Bt, int ldb, int M, int N, int K, const Epi& epi) {
    const int nM = M / BM, nN = N / BM;
    int pm, pn; bool have = tile_of((int)blockIdx.x, nM, nN, pm, pn), pre = false;
    for (int i = 0; have; ++i) {
        int npm = 0, npn = 0; const bool nhave = tile_of((i + 1) * (int)gridDim.x + (int)blockIdx.x, nM, nN, npm, npn);
        gemm_tile<TR>(A, lda, Bt, ldb, K, pm * BM, pn * BM, epi, i, pre, (TR && nhave) ? npm * BM : -1, npn * BM);
        pre = TR && nhave; pm = npm; pn = npn; have = nhave;
    }
    if (TR) __syncthreads();
}
template <class Epi>
__device__ __forceinline__ void gemm_phase(const bf16_t* A, int lda, const bf16_t* Bt, int ldb, int M, int N, int K, const Epi& epi) { gemm_phase_t<false>(A, lda, Bt, ldb, M, N, K, epi); }

__device__ __forceinline__ float row_rstd(const float* ssq, int row) {
    const f32x4* p = (const f32x4*)(ssq + (size_t)row * 16);
    const f32x4 a = p[0], b = p[1], c = p[2], d = p[3];
    const float s = ((a.x + a.y) + (a.z + a.w)) + ((b.x + b.y) + (b.z + b.w)) + ((c.x + c.y) + (c.z + c.w)) + ((d.x + d.y) + (d.z + d.w));
    return rsqrtf(s * (1.0f / D) + EPS);
}
__device__ __forceinline__ float rstd16(const float* ssq, int row0, int lane) {
    const f32x4 q = *(const f32x4*)(ssq + (size_t)(row0 + (lane >> 2)) * 16 + 4 * (lane & 3));
    float s = (q.x + q.y) + (q.z + q.w); s += __shfl_xor(s, 1); s += __shfl_xor(s, 2);
    return rsqrtf(s * (1.0f / D) + EPS);
}
__device__ __forceinline__ float seg_sum16(float s) { return rsum16(s); }
__device__ __forceinline__ void st4_bf16(bf16_t* d, float a, float b, float c, float e) { u32x2 w; w.x = cvt_pk_bf16(a, b); w.y = cvt_pk_bf16(c, e); *(u32x2*)d = w; }

template <class E> __device__ __forceinline__ void epi_rows_generic(const E& e, const float* ep, int wid, int lane, int row0, int bcol) {
    const float rsv = e.begin(row0, lane);
    const int col = bcol + 4 * lane;
    typename E::Ld L[16];
#pragma unroll
    for (int u = 0; u < 16; ++u) L[u] = e.load(row0 + u, col);
#pragma unroll
    for (int u = 0; u < 16; ++u) {
        const f32x4 v = *(const f32x4*)(ep + (wid * 16 + u) * 260 + 4 * lane);
        e.finish(v, L[u], row0 + u, col, lane, __shfl(rsv, 4 * u));
    }
}

struct EpiIn {
    bf16_t* Z; const float* ssq; const float* qn; const float* kn; const float* gbias; const float* tab; int smask; bf16_t* KA; bf16_t* VA;
    __device__ __forceinline__ float rstd_row(int) const { return 0.f; }
    __device__ __forceinline__ void regs(const f32x4 (&)[2][2][4][2], const float*, int, int, int, int, int, int) const {}
    template <int T> __device__ __forceinline__ void rows_t(const float* ep, int wid, int lane, int row0, int bcol) const {
        const float rsv = rstd16(ssq, row0, lane);
        const int col = bcol + 4 * lane, c = col & 63, sl = lane & 15;
        f32x4 gn = {1.f, 1.f, 1.f, 1.f}, bb = {0.f, 0.f, 0.f, 0.f};
        if (T == 0) gn = *(const f32x4*)(qn + c);
        if (T == 1) gn = *(const f32x4*)(kn + c);
        if (T == 4) bb = *(const f32x4*)(gbias + (col - ZC_GF));
        const bool rot = (T <= 1) ? (sl < 4) : true;
        const float sgn = (T <= 1) ? (sl < 2 ? -1.f : 1.f) : (sl < 8 ? -1.f : 1.f);
        const int toff = (T <= 1) ? 2 * (c & 7) : 16 + 2 * (c & 31);
        const float psc = (T == 2) ? ((col >= ZC_BQ && col < ZC_BK) ? 0.17677669529663687f : 1.0f) : (T == 0 ? 0.125f * 1.4426950408889634f : (T == 6 ? 0.125f : 1.0f));
#pragma unroll 1
        for (int i0 = 0; i0 < 16; i0 += 4) {
            f32x4 vv[4], tt0[4], tt1[4];
#pragma unroll
            for (int u = 0; u < 4; ++u) {
                vv[u] = *(const f32x4*)(ep + (wid * 16 + i0 + u) * 260 + 4 * lane);
                if (T == 0 || T == 1 || T == 5 || T == 6) { const float* cs = tab + (size_t)((row0 + i0 + u) & smask) * 80 + toff; tt0[u] = *(const f32x4*)cs; tt1[u] = *(const f32x4*)(cs + 4); }
            }
#pragma unroll
            for (int u = 0; u < 4; ++u) {
            f32x4 v = vv[u];
            const int row = row0 + i0 + u; const float rstd = __shfl(rsv, 4 * (i0 + u));
            bf16_t* dst = Z + (size_t)row * ZW + col;
            if (T == 1) dst = KA + ((size_t)((col - ZC_AK) >> 6) * MG + row) * 64 + c;
            if (T == 2 && col >= ZC_AV && col < ZC_BQ) dst = VA + ((size_t)((col - ZC_AV) >> 6) * MG + row) * 64 + c;
            if (T == 0 || T == 1 || T == 5 || T == 6) {
                const f32x4 t0 = tt0[u], t1 = tt1[u];
                float r = rstd * psc;
                if (T <= 1) { const float ss = seg_sum16((v.x * v.x + v.y * v.y) + (v.z * v.z + v.w * v.w)); r *= rsqrtf(ss * rstd * rstd * (1.0f / 64) + EPS); }
                v.x *= r * gn.x; v.y *= r * gn.y; v.z *= r * gn.z; v.w *= r * gn.w;
                f32x4 pv;
                if (T <= 1) { pv.x = __shfl_xor(v.x, 2); pv.y = __shfl_xor(v.y, 2); pv.z = __shfl_xor(v.z, 2); pv.w = __shfl_xor(v.w, 2); }
                else        { pv.x = __shfl_xor(v.x, 8); pv.y = __shfl_xor(v.y, 8); pv.z = __shfl_xor(v.z, 8); pv.w = __shfl_xor(v.w, 8); }
                const float nx = v.x * t0.x + sgn * pv.x * t0.y, ny = v.y * t0.z + sgn * pv.y * t0.w, nz = v.z * t1.x + sgn * pv.z * t1.y, nw = v.w * t1.z + sgn * pv.w * t1.w;
                st4_bf16(dst, rot ? nx : v.x, rot ? ny : v.y, rot ? nz : v.z, rot ? nw : v.w);
            } else if (T == 4) {
                float x[4] = {v.x * rstd + bb.x, v.y * rstd + bb.y, v.z * rstd + bb.z, v.w * rstd + bb.w}; unsigned short hb[4];
#pragma unroll
                for (int k = 0; k < 4; ++k) { const float ls = fminf(x[k], 0.f) - __logf(1.0f + __expf(-fabsf(x[k]))); const _Float16 hv = (_Float16)(ls * 0.0625f); hb[k] = __builtin_bit_cast(unsigned short, hv); }
                u32x2 w; w.x = hb[0] | ((unsigned)hb[1] << 16); w.y = hb[2] | ((unsigned)hb[3] << 16);
                *(u32x2*)dst = w;
            } else {
                const float sc = rstd * psc;
                st4_bf16(dst, v.x * sc, v.y * sc, v.z * sc, v.w * sc);
            }
            }
        }
    }
    __device__ __forceinline__ void rows(const float* ep, int wid, int lane, int row0, int bcol) const {
        if (bcol < ZC_AK) rows_t<0>(ep, wid, lane, row0, bcol);
        else if (bcol < ZC_AV) rows_t<1>(ep, wid, lane, row0, bcol);
        else if (bcol == ZC_GF) rows_t<4>(ep, wid, lane, row0, bcol);
        else if (bcol == ZC_CQ) rows_t<5>(ep, wid, lane, row0, bcol);
        else if (bcol == ZC_CK) rows_t<6>(ep, wid, lane, row0, bcol);
        else rows_t<2>(ep, wid, lane, row0, bcol);
    }
};

struct EpiRes {
    const bf16_t* HBin; bf16_t* HBout; float* ssq;
    typedef u32x2 Ld;
    __device__ __forceinline__ float rstd_row(int) const { return 0.f; }
    __device__ __forceinline__ void regs(const f32x4 (&)[2][2][4][2], const float*, int, int, int, int, int, int) const {}
    __device__ __forceinline__ void rows(const float* ep, int wid, int lane, int row0, int bcol) const { epi_rows_generic(*this, ep, wid, lane, row0, bcol); }
    __device__ __forceinline__ float begin(int, int) const { return 0.f; }
    __device__ __forceinline__ Ld load(int row, int col) const { return *(const u32x2*)(HBin + (size_t)row * D + col); }
    __device__ __forceinline__ void finish(f32x4 v, Ld hw, int row, int col, int lane, float) const {
        f32x4 h = {bflo(hw.x) + v.x, bfhi(hw.x) + v.y, bflo(hw.y) + v.z, bfhi(hw.y) + v.w};
        u32x2 w; w.x = cvt_pk_bf16(h.x, h.y); w.y = cvt_pk_bf16(h.z, h.w);
        *(u32x2*)(HBout + (size_t)row * D + col) = w;
        h.x = bflo(w.x); h.y = bfhi(w.x); h.z = bflo(w.y); h.w = bfhi(w.y);
        const float ss = seg_sum16((h.x * h.x + h.y * h.y) + (h.z * h.z + h.w * h.w));
        if ((lane & 15) == 0) ssq[(size_t)row * 16 + (col >> 6)] = ss;
    }
};

struct EpiMlpIn {
    bf16_t* HID; const float* ssq;
    __device__ __forceinline__ float rstd_row(int row) const { return row_rstd(ssq, row); }
    __device__ __forceinline__ void regs(const f32x4 (&acc)[2][2][4][2], const float* RT, int brow, int bcol, int wr, int wc, int fr, int fq) const {
#pragma unroll
        for (int ai = 0; ai < 2; ++ai)
#pragma unroll
            for (int m = 0; m < 4; ++m) {
                const int rl = ai * HALF + wr * 64 + m * 16 + fr; const float rstd = RT[rl];
                bf16_t* dst = HID + (size_t)(brow + rl) * DFF + bcol + wc * 32 + 8 * fq;
#pragma unroll
                for (int bj = 0; bj < 2; ++bj) { float t[8];
#pragma unroll
                    for (int n = 0; n < 2; ++n)
#pragma unroll
                        for (int j = 0; j < 4; ++j) { const float x = fmaxf(acc[ai][bj][m][n][j] * rstd, 0.f); t[4 * n + j] = x * x; }
                    *(bf16x8*)(dst + bj * HALF) = pack8(t); }
            }
    }
    __device__ __forceinline__ void rows(const float* ep, int wid, int lane, int row0, int bcol) const { epi_rows_generic(*this, ep, wid, lane, row0, bcol); }
    __device__ __forceinline__ float begin(int row0, int lane) const { return rstd16(ssq, row0, lane); }
    typedef int Ld;
    __device__ __forceinline__ Ld load(int, int) const { return 0; }
    __device__ __forceinline__ void finish(f32x4 v, Ld, int row, int col, int lane, float rstd) const { this->row(v, row, col, lane, rstd); }
    __device__ __forceinline__ void row(f32x4 v, int row, int col, int, float rstd) const {
        const float a = fmaxf(v.x * rstd, 0.f), b = fmaxf(v.y * rstd, 0.f), c = fmaxf(v.z * rstd, 0.f), e = fmaxf(v.w * rstd, 0.f);
        st4_bf16(HID + (size_t)row * DFF + col, a * a, b * b, c * c, e * e);
    }
};

struct EpiPlain {
    bf16_t* O; int ldo;
    __device__ __forceinline__ float rstd_row(int) const { return 0.f; }
    __device__ __forceinline__ void regs(const f32x4 (&)[2][2][4][2], const float*, int, int, int, int, int, int) const {}
    __device__ __forceinline__ void rows(const float* ep, int wid, int lane, int row0, int bcol) const { epi_rows_generic(*this, ep, wid, lane, row0, bcol); }
    __device__ __forceinline__ float begin(int, int) const { return 0.f; }
    typedef int Ld;
    __device__ __forceinline__ Ld load(int, int) const { return 0; }
    __device__ __forceinline__ void finish(f32x4 v, Ld, int row, int col, int lane, float rstd) const { this->row(v, row, col, lane, rstd); }
    __device__ __forceinline__ void row(f32x4 v, int row, int col, int, float) const { st4_bf16(O + (size_t)row * ldo + col, v.x, v.y, v.z, v.w); }
};

struct EpiPeGate {
    float* Hout; const bf16_t* HBin; bf16_t* HBout; float* ssq_out; const float* ssq_in; const bf16_t* PB; int write_f32;
    struct Ld { u32x2 pw, hw; };
    __device__ __forceinline__ float rstd_row(int) const { return 0.f; }
    __device__ __forceinline__ void regs(const f32x4 (&)[2][2][4][2], const float*, int, int, int, int, int, int) const {}
    __device__ __forceinline__ void rows(const float* ep, int wid, int lane, int row0, int bcol) const { epi_rows_generic(*this, ep, wid, lane, row0, bcol); }
    __device__ __forceinline__ float begin(int row0, int lane) const { return rstd16(ssq_in, row0, lane); }
    __device__ __forceinline__ Ld load(int row, int col) const { Ld l; l.pw = *(const u32x2*)(PB + (size_t)row * D + col); l.hw = *(const u32x2*)(HBin + (size_t)row * D + col); return l; }
    __device__ __forceinline__ void finish(f32x4 v, Ld l, int row, int col, int lane, float rstd) const {
        const u32x2 pw = l.pw, hw = l.hw;
        f32x4 h;
        h.x = bflo(hw.x) + bflo(pw.x) / (1.0f + __expf(-v.x * rstd)); h.y = bfhi(hw.x) + bfhi(pw.x) / (1.0f + __expf(-v.y * rstd));
        h.z = bflo(hw.y) + bflo(pw.y) / (1.0f + __expf(-v.z * rstd)); h.w = bfhi(hw.y) + bfhi(pw.y) / (1.0f + __expf(-v.w * rstd));
        if (write_f32) *(f32x4*)(Hout + (size_t)row * D + col) = h;
        u32x2 w; w.x = cvt_pk_bf16(h.x, h.y); w.y = cvt_pk_bf16(h.z, h.w);
        *(u32x2*)(HBout + (size_t)row * D + col) = w;
        h.x = bflo(w.x); h.y = bfhi(w.x); h.z = bflo(w.y); h.w = bfhi(w.y);
        const float ss = seg_sum16((h.x * h.x + h.y * h.y) + (h.z * h.z + h.w * h.w));
        if ((lane & 15) == 0) ssq_out[(size_t)row * 16 + (col >> 6)] = ss;
    }
};

template <class F>
__device__ __forceinline__ void transpose_item(bf16_t* Wt, int K, int k0, int n0, const F& src) {
    const int tid = opaque_tid();
    float* tile = (float*)g_lds;
#pragma unroll
    for (int i = 0; i < 8; ++i) { const int kk = (tid >> 6) + 8 * i, nn = tid & 63; tile[kk * 65 + nn] = src(k0 + kk, n0 + nn); }
    __syncthreads();
    { const int nn = tid >> 3, kc = tid & 7; float t[8];
#pragma unroll
      for (int j = 0; j < 8; ++j) t[j] = tile[(8 * kc + j) * 65 + nn];
      *(bf16x8*)(Wt + (size_t)(n0 + nn) * K + k0 + 8 * kc) = pack8(t); }
    __syncthreads();
}

__device__ __forceinline__ void phase_weights(const Params& p) {
    bf16_t* WT = (bf16_t*)(p.ws + WS_WT);
    constexpr int I_IN = 16 * (ZW / 64), I_OUT = 16 * 16, I_MI = 16 * 64, I_MO = 64 * 16, I_PG = 16 * 16, I_PP = 4 * 16;
    constexpr int I_L = I_IN + I_OUT + I_MI + I_MO + I_PG + I_PP;
    for (int it = blockIdx.x; it < NLAYER * I_L; it += gridDim.x) {
        const int l = it / I_L; int r = it % I_L;
        bf16_t* W = WT + (size_t)l * W_LAYER;
        if (r < I_IN) {
            const int kb = r / (ZW / 64), nb = r % (ZW / 64);
            const float* w = p.w_in + (size_t)l * D * NIN; const float* g = p.ln_mix + l * D; const float* gu = p.gla_gate_up + (size_t)l * 2 * 16 * 128;
            transpose_item(W + WO_IN, D, kb * 64, nb * 64, [&](int k, int c) -> float {
                float v;
                if (c < ZC_GF) v = w[(size_t)k * NIN + c];
                else if (c < ZC_CQ) { const int j = (c - ZC_GF) >> 7, kk = (c - ZC_GF) & 127; float s = 0.f;
                    for (int rr = 0; rr < 16; ++rr) s += w[(size_t)k * NIN + 2304 + 16 * j + rr] * gu[(j * 16 + rr) * 128 + kk];
                    v = s; }
                else v = w[(size_t)k * NIN + (c - 224)];
                return v * g[k]; });
            continue; }
        r -= I_IN;
        if (r < I_OUT) { const float* w = p.w_out + (size_t)l * D * D;
            transpose_item(W + WO_OUT, D, (r / 16) * 64, (r % 16) * 64, [&](int k, int c) -> float { return w[(size_t)k * D + c]; }); continue; }
        r -= I_OUT;
        if (r < I_MI) { const float* w = p.w_mlp_in + (size_t)l * D * DFF; const float* g = p.ln_mlp + l * D;
            transpose_item(W + WO_MI, D, (r / 64) * 64, (r % 64) * 64, [&](int k, int c) -> float { const int rho = c & 31; const int cc = (c & ~31) + 8 * ((rho & 15) >> 2) + 4 * (rho >> 4) + (rho & 3);
                return w[(size_t)k * DFF + cc] * g[k]; }); continue; }
        r -= I_MI;
        if (r < I_MO) { const float* w = p.w_mlp_out + (size_t)l * DFF * D;
            transpose_item(W + WO_MO, DFF, (r / 16) * 64, (r % 16) * 64, [&](int k, int c) -> float { return w[(size_t)k * D + c]; }); continue; }
        r -= I_MO;
        if (r < I_PG) { const float* w = p.w_pe_gate + (size_t)l * D * D; const float* g = p.ln_pe + l * D;
            transpose_item(W + WO_PG, D, (r / 16) * 64, (r % 16) * 64, [&](int k, int c) -> float { return w[(size_t)k * D + c] * g[k]; }); continue; }
        r -= I_PG;
        { const float* w = p.w_pe_proj + (size_t)l * PLE * D;
            transpose_item(W + WO_PP, PLE, (r / 16) * 64, (r % 16) * 64, [&](int k, int c) -> float { return w[(size_t)k * D + c]; }); }
    }
    float* tab = (float*)(p.ws + WS_TAB);
    for (int e = blockIdx.x * NTHR + threadIdx.x; e < 16384 * 40; e += gridDim.x * NTHR) {
        const int pos = e / 40, i = e % 40;
        const double invf = (i < 8) ? exp(-(double)i * (log(500000.0) / 8.0)) : exp(-(double)(i - 8) * (log(10000.0) / 32.0));
        double ang = (double)pos * invf; ang -= 6.283185307179586476925 * floor(ang * 0.15915494309189533577);
        tab[2 * e] = (float)cos(ang); tab[2 * e + 1] = (float)sin(ang);
    }
}

__device__ __forceinline__ void phase_init(const Params& p, int g) {
    const int tid = opaque_tid();
    const float* x = (g == 0) ? p.x_prompt : p.x_sample + (size_t)(g - 1) * MG * D;
    bf16_t* HB = (bf16_t*)(p.ws + WS_HB); float* ssq = (float*)(p.ws + WS_SSQ);
    const int lane = tid & 63, gw = blockIdx.x * 8 + (tid >> 6), NGW = gridDim.x * 8;
    for (int row = gw; row < MG; row += 2 * NGW) {
        f32x4 vv[2][4];
#pragma unroll
        for (int rr = 0; rr < 2; ++rr)
#pragma unroll
            for (int j = 0; j < 4; ++j) vv[rr][j] = *(const f32x4*)(x + (size_t)(row + rr * NGW) * D + 256 * j + 4 * lane);
#pragma unroll
        for (int rr = 0; rr < 2; ++rr)
#pragma unroll
            for (int j = 0; j < 4; ++j) {
                f32x4 v = vv[rr][j]; const int r2 = row + rr * NGW;
                u32x2 w; w.x = cvt_pk_bf16(v.x, v.y); w.y = cvt_pk_bf16(v.z, v.w);
                *(u32x2*)(HB + (size_t)r2 * D + 256 * j + 4 * lane) = w;
                v.x = bflo(w.x); v.y = bfhi(w.x); v.z = bflo(w.y); v.w = bfhi(w.y);
                float s_ = (v.x * v.x + v.y * v.y) + (v.z * v.z + v.w * v.w);
                s_ += __shfl_xor(s_, 1); s_ += __shfl_xor(s_, 2); s_ += __shfl_xor(s_, 4); s_ += __shfl_xor(s_, 8);
                if ((lane & 15) == 0) ssq[(size_t)r2 * 16 + (lane >> 4) + 4 * j] = s_;
            }
    }
    bf16_t* PL = (bf16_t*)(p.ws + WS_PLE);
    for (int l = 0; l < NLAYER; ++l) {
        const float* src = (g == 0) ? p.p_prompt + (size_t)l * MG * PLE : p.p_sample + ((size_t)l * 2 * MG + (size_t)(g - 1) * MG) * PLE;
        bf16_t* dst = PL + (size_t)l * MG * PLE;
        const size_t stride = (size_t)gridDim.x * NTHR * 8;
        for (size_t e = (size_t)(blockIdx.x * NTHR + tid) * 8; e < (size_t)MG * PLE; e += 4 * stride) {
            f32x4 a[4][2];
#pragma unroll
            for (int u = 0; u < 4; ++u) if (e + u * stride < (size_t)MG * PLE) { a[u][0] = *(const f32x4*)(src + e + u * stride); a[u][1] = *(const f32x4*)(src + e + u * stride + 4); }
#pragma unroll
            for (int u = 0; u < 4; ++u) if (e + u * stride < (size_t)MG * PLE) { u32x4 w; w.x = cvt_pk_bf16(a[u][0].x, a[u][0].y); w.y = cvt_pk_bf16(a[u][0].z, a[u][0].w); w.z = cvt_pk_bf16(a[u][1].x, a[u][1].y); w.w = cvt_pk_bf16(a[u][1].z, a[u][1].w);
                *(u32x4*)(dst + e + u * stride) = w; }
        }
    }
}

struct AttnLd { bf16x8 ka0, ka1, kb0, kb1; u32x4 v0, v1, v2, v3; };
__device__ __forceinline__ void attn_geom(int f, int r, int n0, int& dsh, int& cb) {
    const int p = f < 12 ? 0 : (f < 18 ? 1 : 2); const int i2 = f - (p == 0 ? 0 : (p == 1 ? 12 : 18));
    dsh = 2 * p; cb = (r >> dsh) + (16 >> dsh) * n0 - 64 + 32 * i2;
}
__device__ __forceinline__ AttnLd attn_load(const bf16_t* __restrict__ ka, const bf16_t* __restrict__ va, int S, int r, int n0, int lane, int f) {
    int dsh, cb; attn_geom(f, r, n0, dsh, cb);
    const int qi = lane & 15, g = lane >> 4, rd = r & ((1 << dsh) - 1), ncls = S >> dsh;
    const int cA = cb + 8 * (qi >> 2) + (qi & 3), cB = cA + 4;
    const int cAc = min(max(cA, 0), ncls - 1), cBc = min(max(cB, 0), ncls - 1);
    const bf16_t* kA = ka + (size_t)(rd + (cAc << dsh)) * 64 + 8 * g;
    const bf16_t* kB = ka + (size_t)(rd + (cBc << dsh)) * 64 + 8 * g;
    AttnLd L;
    L.ka0 = *(const bf16x8*)kA; L.ka1 = *(const bf16x8*)(kA + 32); L.kb0 = *(const bf16x8*)kB; L.kb1 = *(const bf16x8*)(kB + 32);
    const int cv0 = cb + (lane >> 3);
    const bf16_t* vb = va + 8 * (lane & 7);
    L.v0 = *(const u32x4*)(vb + (size_t)(rd + (min(max(cv0, 0), ncls - 1) << dsh)) * 64);
    L.v1 = *(const u32x4*)(vb + (size_t)(rd + (min(max(cv0 + 8, 0), ncls - 1) << dsh)) * 64);
    L.v2 = *(const u32x4*)(vb + (size_t)(rd + (min(max(cv0 + 16, 0), ncls - 1) << dsh)) * 64);
    L.v3 = *(const u32x4*)(vb + (size_t)(rd + (min(max(cv0 + 24, 0), ncls - 1) << dsh)) * 64);
    return L;
}
__device__ __forceinline__ bf16x8 attn_softmax_step(const f32x4& sA, const f32x4& sB, int cb, int cq, int ncls, int g, float& m, float& lsum, f32x4 (&O)[4]) {
    float s[8]; bool ok[8];
    const int c0v = cb + 8 * g, d0 = c0v - cq + 64;
#pragma unroll
    for (int j = 0; j < 8; ++j) {
        ok[j] = ((unsigned)(c0v + j) < (unsigned)ncls) && ((unsigned)(d0 + j) <= 128u);
        s[j] = ok[j] ? (j < 4 ? sA[j] : sB[j - 4]) : -__builtin_inff(); }
    float mx = fmaxf(fmaxf(fmaxf(s[0], s[1]), fmaxf(s[2], s[3])), fmaxf(fmaxf(s[4], s[5]), fmaxf(s[6], s[7])));
    mx = xmax32(xmax16(mx));
    const float mn = fmaxf(m, mx), alpha = __builtin_amdgcn_exp2f(m - mn);
    m = mn;
    float pj[8], ps_ = 0.f;
#pragma unroll
    for (int j = 0; j < 8; ++j) { pj[j] = __builtin_amdgcn_exp2f(s[j] - mn); ps_ += pj[j]; }
    lsum = lsum * alpha + ps_;
#pragma unroll
    for (int nbk = 0; nbk < 4; ++nbk) O[nbk] *= alpha;
    return pack8(pj);
}
__device__ __forceinline__ void attn_lds_step(const bf16_t* Kt, const bf16_t* Vt, int rowb, const bf16x8& q0, const bf16x8& q1, int cb, int cq, int ncls,
                                              int qi, int g, float& m, float& lsum, f32x4 (&O)[4]) {
    const bf16_t* kA = Kt + (rowb + 8 * (qi >> 2) + (qi & 3)) * 72 + 8 * g;
    const bf16x8 ka0 = *(const bf16x8*)kA, ka1 = *(const bf16x8*)(kA + 32), kb0 = *(const bf16x8*)(kA + 4 * 72), kb1 = *(const bf16x8*)(kA + 4 * 72 + 32);
    f32x4 sA = {0.f, 0.f, 0.f, 0.f}, sB = {0.f, 0.f, 0.f, 0.f};
    sA = MFMA16(ka0, q0, sA); sA = MFMA16(ka1, q1, sA);
    sB = MFMA16(kb0, q0, sB); sB = MFMA16(kb1, q1, sB);
    const bf16x8 P = attn_softmax_step(sA, sB, cb, cq, ncls, g, m, lsum, O);
#pragma unroll
    for (int nbk = 0; nbk < 4; ++nbk) O[nbk] = MFMA16(gather8(Vt + (rowb + 8 * g) * 68 + 16 * nbk, 68, qi), P, O[nbk]);
}
template <int NROWS>
__device__ __forceinline__ void attn_stage(const bf16_t* __restrict__ ka, const bf16_t* __restrict__ va, bf16_t* Kt, bf16_t* Vt, int c0, int ncls, int rd, int dsh, int tid) {
    constexpr int IT = (NROWS * 16 + NTHR - 1) / NTHR;
    u32x4 v[IT];
#pragma unroll
    for (int u = 0; u < IT; ++u) { const int idx = min(tid + u * NTHR, NROWS * 16 - 1);
        const int i = idx >> 4, ch = idx & 15, isv = ch >> 3, c8 = ch & 7; const int c = min(max(c0 + i, 0), ncls - 1);
        v[u] = *(const u32x4*)((isv ? va : ka) + (size_t)(rd + (c << dsh)) * 64 + 8 * c8); }
#pragma unroll
    for (int u = 0; u < IT; ++u) { const int idx = min(tid + u * NTHR, NROWS * 16 - 1);
        const int i = idx >> 4, ch = idx & 15, isv = ch >> 3, c8 = ch & 7;
        bf16_t* d = isv ? (Vt + i * 68 + 8 * c8) : (Kt + i * 72 + 8 * c8);
        *(u32x2*)d = (u32x2){v[u].x, v[u].y}; *(u32x2*)(d + 4) = (u32x2){v[u].z, v[u].w}; }
}
__device__ __forceinline__ void attn_item(const bf16_t* __restrict__ Z, const bf16_t* __restrict__ KA, const bf16_t* __restrict__ VA, bf16_t* __restrict__ MIX, int S, int it) {
    const int tid = opaque_tid();
    const int wave = tid >> 6, lane = tid & 63, qi = lane & 15, g = lane >> 4;
    const int lgb = (S == 16384) ? 6 : 3;
    const int pb = it & ((1 << lgb) - 1); const int t1 = it >> lgb; const int head = t1 & 7, seq = t1 >> 3;
    const int P0 = pb * 256, n0 = pb * 16;
    const bf16_t* zq = Z + (size_t)seq * S * ZW;
    const bf16_t* ka = KA + ((size_t)head * MG + (size_t)seq * S) * 64; const bf16_t* va = VA + ((size_t)head * MG + (size_t)seq * S) * 64;
    bf16_t* Kt = (bf16_t*)g_lds;
    bf16_t* Vt = (bf16_t*)(g_lds + 57600);
    bf16_t* Vs = (bf16_t*)g_lds + wave * (32 * 68);
    int rt[2]; rt[0] = 4 * (wave >> 1) + (wave & 1); rt[1] = rt[0] + 2;
    bf16x8 q0[2], q1[2]; float m[2] = {-1e30f, -1e30f}, lsum[2] = {0.f, 0.f}; f32x4 O[2][4] = {};
#pragma unroll
    for (int ti = 0; ti < 2; ++ti) { const bf16_t* qp = zq + (size_t)(P0 + rt[ti] + 16 * qi) * ZW + ZC_AQ + head * 64 + 8 * g; q0[ti] = *(const bf16x8*)qp; q1[ti] = *(const bf16x8*)(qp + 32); }
    {
        bf16_t* Vs1 = Vs + 8 * (32 * 68);
        AttnLd cur0 = attn_load(ka, va, S, rt[0], n0, lane, 18), cur1 = attn_load(ka, va, S, rt[1], n0, lane, 18);
#pragma unroll 1
        for (int f = 18; f < 23; ++f) {
            const AttnLd nxt0 = attn_load(ka, va, S, rt[0], n0, lane, f < 22 ? f + 1 : 22), nxt1 = attn_load(ka, va, S, rt[1], n0, lane, f < 22 ? f + 1 : 22);
            const int cb = n0 - 64 + 32 * (f - 18), ncls = S >> 4, cq = n0 + qi;
            f32x4 sA0 = {0.f, 0.f, 0.f, 0.f}, sB0 = {0.f, 0.f, 0.f, 0.f}, sA1 = {0.f, 0.f, 0.f, 0.f}, sB1 = {0.f, 0.f, 0.f, 0.f};
            sA0 = MFMA16(cur0.ka0, q0[0], sA0); sA1 = MFMA16(cur1.ka0, q0[1], sA1); sB0 = MFMA16(cur0.kb0, q0[0], sB0); sB1 = MFMA16(cur1.kb0, q0[1], sB1);
            sA0 = MFMA16(cur0.ka1, q1[0], sA0); sA1 = MFMA16(cur1.ka1, q1[1], sA1); sB0 = MFMA16(cur0.kb1, q1[0], sB0); sB1 = MFMA16(cur1.kb1, q1[1], sB1);
            LDS_FENCE();
            { bf16_t* d = Vs + (lane >> 3) * 68 + 8 * (lane & 7);
              *(u32x2*)d = (u32x2){cur0.v0.x, cur0.v0.y}; *(u32x2*)(d + 4) = (u32x2){cur0.v0.z, cur0.v0.w};
              *(u32x2*)(d + 8 * 68) = (u32x2){cur0.v1.x, cur0.v1.y}; *(u32x2*)(d + 8 * 68 + 4) = (u32x2){cur0.v1.z, cur0.v1.w};
              *(u32x2*)(d + 16 * 68) = (u32x2){cur0.v2.x, cur0.v2.y}; *(u32x2*)(d + 16 * 68 + 4) = (u32x2){cur0.v2.z, cur0.v2.w};
              *(u32x2*)(d + 24 * 68) = (u32x2){cur0.v3.x, cur0.v3.y}; *(u32x2*)(d + 24 * 68 + 4) = (u32x2){cur0.v3.z, cur0.v3.w};
              d = Vs1 + (lane >> 3) * 68 + 8 * (lane & 7);
              *(u32x2*)d = (u32x2){cur1.v0.x, cur1.v0.y}; *(u32x2*)(d + 4) = (u32x2){cur1.v0.z, cur1.v0.w};
              *(u32x2*)(d + 8 * 68) = (u32x2){cur1.v1.x, cur1.v1.y}; *(u32x2*)(d + 8 * 68 + 4) = (u32x2){cur1.v1.z, cur1.v1.w};
              *(u32x2*)(d + 16 * 68) = (u32x2){cur1.v2.x, cur1.v2.y}; *(u32x2*)(d + 16 * 68 + 4) = (u32x2){cur1.v2.z, cur1.v2.w};
              *(u32x2*)(d + 24 * 68) = (u32x2){cur1.v3.x, cur1.v3.y}; *(u32x2*)(d + 24 * 68 + 4) = (u32x2){cur1.v3.z, cur1.v3.w}; }
            const bf16x8 P0_ = attn_softmax_step(sA0, sB0, cb, cq, ncls, g, m[0], lsum[0], O[0]);
            const bf16x8 P1_ = attn_softmax_step(sA1, sB1, cb, cq, ncls, g, m[1], lsum[1], O[1]);
            LDS_FENCE();
#pragma unroll
            for (int nbk = 0; nbk < 4; ++nbk) { O[0][nbk] = MFMA16(gather8(Vs + (8 * g) * 68 + 16 * nbk, 68, qi), P0_, O[0][nbk]); O[1][nbk] = MFMA16(gather8(Vs1 + (8 * g) * 68 + 16 * nbk, 68, qi), P1_, O[1][nbk]); }
            cur0 = nxt0; cur1 = nxt1;
        }
        LDS_FENCE();
    }
    __syncthreads();
    attn_stage<400>(ka, va, Kt, Vt, P0 - 64, S, 0, 0, tid);
    __syncthreads();
#pragma unroll 1
    for (int i2 = 0; i2 < 12; ++i2) {
        attn_lds_step(Kt, Vt, rt[0] + 32 * i2, q0[0], q1[0], P0 + rt[0] - 64 + 32 * i2, P0 + rt[0] + 16 * qi, S, qi, g, m[0], lsum[0], O[0]);
        attn_lds_step(Kt, Vt, rt[1] + 32 * i2, q0[1], q1[1], P0 + rt[1] - 64 + 32 * i2, P0 + rt[1] + 16 * qi, S, qi, g, m[1], lsum[1], O[1]);
    }
#pragma unroll
    for (int rho = 0; rho < 2; ++rho) {
        __syncthreads();
        attn_stage<200>(ka, va, Kt, Vt, (P0 >> 2) - 64, S >> 2, 2 * rho, 2, tid);
        attn_stage<200>(ka, va, Kt + 200 * 72, Vt + 200 * 68, (P0 >> 2) - 64, S >> 2, 2 * rho + 1, 2, tid);
        __syncthreads();
        const int r = rt[rho], cls = (r & 3) - 2 * rho, c0 = (P0 >> 2) + (r >> 2);
#pragma unroll 2
        for (int i2 = 0; i2 < 6; ++i2)
            attn_lds_step(Kt + cls * 200 * 72, Vt + cls * 200 * 68, (r >> 2) + 32 * i2, q0[rho], q1[rho], c0 - 64 + 32 * i2, c0 + 4 * qi, S >> 2, qi, g, m[rho], lsum[rho], O[rho]);
    }
#pragma unroll
    for (int ti = 0; ti < 2; ++ti) {
        float l = lsum[ti]; l = xsum32(xsum16(l));
        const float inv = 1.0f / l;
        bf16_t* op = MIX + ((size_t)seq * S + P0 + rt[ti] + 16 * qi) * D + head * 64 + 4 * g;
#pragma unroll
        for (int nbk = 0; nbk < 4; ++nbk) st4_bf16(op + 16 * nbk, O[ti][nbk].x * inv, O[ti][nbk].y * inv, O[ti][nbk].z * inv, O[ti][nbk].w * inv);
    }
    __syncthreads();
}

__device__ __forceinline__ float h2f(unsigned short b) { return (float)__builtin_bit_cast(_Float16, b); }

template <int NROWS>
__device__ __forceinline__ void stage_v4(const bf16_t* __restrict__ Z, size_t tok0, int zc, bf16_t* Vt) {
    const int tid = opaque_tid();
    constexpr int IT = NROWS * 32 / NTHR;
    u32x4 v[IT];
#pragma unroll
    for (int u = 0; u < IT; ++u) { const int idx = tid + u * NTHR; const int t = idx >> 5, ch = idx & 31; v[u] = *(const u32x4*)(Z + (tok0 + t) * ZW + zc + ch * 8); }
#pragma unroll
    for (int u = 0; u < IT; ++u) { const int idx = tid + u * NTHR; const int t = idx >> 5, ch = idx & 31, hh = ch >> 3, c8 = ch & 7;
        bf16_t* d = Vt + ((size_t)hh * NROWS + t) * 68 + c8 * 8;
        *(u32x2*)d = (u32x2){v[u].x, v[u].y}; *(u32x2*)(d + 4) = (u32x2){v[u].z, v[u].w}; }
}

__device__ __forceinline__ void gla_cum(const bf16_t* __restrict__ Z, size_t tok0, int h, int dir, int lane, float (&cum)[32], float& tot) {
    const int kk = lane & 31, hf = lane >> 5;
    const bf16_t* src = Z + (tok0 + 32 * hf) * ZW + ZC_GF + dir * 128 + h * 32 + kk;
    float part = 0.f;
#pragma unroll
    for (int i = 0; i < 32; ++i) { cum[i] = h2f(src[(size_t)i * ZW]); part += cum[i]; }
    const float other = __shfl_xor(part, 32);
    tot = part + other;
    if (dir == 0) { float run = hf ? other : 0.f;
#pragma unroll
        for (int i = 0; i < 32; ++i) { run += cum[i]; cum[i] = run; } }
    else { float run = hf ? 0.f : other;
#pragma unroll
        for (int i = 31; i >= 0; --i) { run += cum[i]; cum[i] = run; } }
}

__device__ __forceinline__ void gla1_item(const bf16_t* __restrict__ Z, bf16_t* __restrict__ GS, float* __restrict__ GD, int ci) {
    const int tid = opaque_tid();
    const int wave = tid >> 6, lane = tid & 63, qi = lane & 15, g = lane >> 4;
    const int h = wave >> 1, dir = wave & 1;
    const size_t tok0 = (size_t)ci * 64;
    bf16_t* Vt = (bf16_t*)g_lds;
    bf16_t* Ks = (bf16_t*)g_lds + 4 * 64 * 68 + wave * (64 * 36);
    stage_v4<64>(Z, tok0, ZC_BV, Vt);
    float cum[32], tot;
    gla_cum(Z, tok0, h, dir, lane, cum, tot);
    { const int kk = lane & 31, hf = lane >> 5;
      const bf16_t* ksrc = Z + (tok0 + 32 * hf) * ZW + ZC_BK + h * 32 + kk;
      unsigned short kraw[32];
#pragma unroll
      for (int i = 0; i < 32; ++i) kraw[i] = ksrc[(size_t)i * ZW];
#pragma unroll
      for (int i = 0; i < 32; ++i) { const float kv = bf2f(kraw[i]) * __expf(tot - cum[i]);
          Ks[(32 * hf + i) * 36 + kk] = (bf16_t)(cvt_pk_bf16(kv, 0.f) & 0xffffu); }
      if (hf == 0) GD[(((size_t)dir * NCH + ci) * 4 + h) * 32 + kk] = __expf(tot); }
    __syncthreads();
    f32x4 acc[4][2] = {};
#pragma unroll
    for (int ks = 0; ks < 2; ++ks) {
        bf16x8 bfr[2];
#pragma unroll
        for (int kb = 0; kb < 2; ++kb) bfr[kb] = gather8(Ks + (32 * ks + 8 * g) * 36 + 16 * kb , 36, qi);
#pragma unroll
        for (int eb = 0; eb < 4; ++eb) { const bf16x8 af = gather8(Vt + ((size_t)h * 64 + 32 * ks + 8 * g) * 68 + 16 * eb , 68, qi);
#pragma unroll
            for (int kb = 0; kb < 2; ++kb) acc[eb][kb] = MFMA16(bfr[kb], af, acc[eb][kb]); }
    }
    bf16_t* dst = GS + (((size_t)dir * NCH + ci) * 4 + h) * 2048;
#pragma unroll
    for (int eb = 0; eb < 4; ++eb)
#pragma unroll
        for (int kb = 0; kb < 2; ++kb) st4_bf16(dst + (16 * eb + qi) * 32 + 16 * kb + 4 * g, acc[eb][kb].x, acc[eb][kb].y, acc[eb][kb].z, acc[eb][kb].w);
    __syncthreads();
}

__device__ __forceinline__ void gla3_item(const bf16_t* __restrict__ Z, const bf16_t* __restrict__ GS, bf16_t* __restrict__ MIX, const float* __restrict__ gnorm, int ci) {
    const int tid = opaque_tid();
    const int wave = tid >> 6, lane = tid & 63, qi = lane & 15, g = lane >> 4;
    const size_t tok0 = (size_t)ci * 64;
    bf16_t* Vt = (bf16_t*)g_lds;
    float* CUM = (float*)(g_lds + 4 * 64 * 68 * 2);
    stage_v4<64>(Z, tok0, ZC_BV, Vt);
    { const int h = wave >> 1, dir = wave & 1; float cum[32], tot;
      gla_cum(Z, tok0, h, dir, lane, cum, tot);
      const int kk = lane & 31, hf = lane >> 5; float* cd = CUM + ((size_t)(h * 2 + dir) * 64 + 32 * hf) * 32 + kk;
#pragma unroll
      for (int i = 0; i < 32; ++i) cd[i * 32] = cum[i]; }
    __syncthreads();
    const int h = wave >> 1;
    const float* cF = CUM + (size_t)(h * 2 + 0) * 64 * 32; const float* cB = CUM + (size_t)(h * 2 + 1) * 64 * 32;
    const bf16_t* sF = GS + (((size_t)0 * NCH + ci) * 4 + h) * 2048; const bf16_t* sB = GS + (((size_t)1 * NCH + ci) * 4 + h) * 2048;
    bf16x8 SFf[4], SBf[4];
#pragma unroll
    for (int eb = 0; eb < 4; ++eb) { SFf[eb] = *(const bf16x8*)(sF + (16 * eb + qi) * 32 + 8 * g); SBf[eb] = *(const bf16x8*)(sB + (16 * eb + qi) * 32 + 8 * g); }
    bf16x8 KFf[2][2], KBf[2][2];
#pragma unroll
    for (int sg = 0; sg < 2; ++sg)
#pragma unroll
        for (int blk = 0; blk < 2; ++blk) {
            const int s = 32 * sg + 8 * (qi >> 2) + (qi & 3) + 4 * blk;
            float kv[8], a[8], b[8]; unpack8(*(const bf16x8*)(Z + (tok0 + s) * ZW + ZC_BK + h * 32 + 8 * g), kv);
#pragma unroll
            for (int j = 0; j < 8; ++j) { a[j] = kv[j] * __expf(-cF[s * 32 + 8 * g + j]); b[j] = kv[j] * __expf(-cB[s * 32 + 8 * g + j]); }
            KFf[sg][blk] = pack8(a); KBf[sg][blk] = pack8(b);
        }
#pragma unroll 1
    for (int tbi = 0; tbi < 2; ++tbi) {
        const int t = 16 * (2 * (wave & 1) + tbi) + qi;
        bf16x8 Qf, Qb;
        { float qv[8], a[8], b[8]; unpack8(*(const bf16x8*)(Z + (tok0 + t) * ZW + ZC_BQ + h * 32 + 8 * g), qv);
#pragma unroll
          for (int j = 0; j < 8; ++j) { a[j] = qv[j] * __expf(cF[t * 32 + 8 * g + j]); b[j] = qv[j] * __expf(cB[t * 32 + 8 * g + j]); }
          Qf = pack8(a); Qb = pack8(b); }
        f32x4 acc[4] = {};
#pragma unroll
        for (int eb = 0; eb < 4; ++eb) { acc[eb] = MFMA16(SFf[eb], Qf, acc[eb]); acc[eb] = MFMA16(SBf[eb], Qb, acc[eb]); }
#pragma unroll
        for (int sg = 0; sg < 2; ++sg) {
            f32x4 aF[2], aB[2];
#pragma unroll
            for (int blk = 0; blk < 2; ++blk) {
                const f32x4 z4 = {0.f, 0.f, 0.f, 0.f};
                aF[blk] = MFMA16(KFf[sg][blk], Qf, z4); aB[blk] = MFMA16(KBf[sg][blk], Qb, z4);
            }
            float pj[8];
#pragma unroll
            for (int j = 0; j < 8; ++j) { const int s = 32 * sg + 8 * g + j; pj[j] = (s <= t) ? (j < 4 ? aF[0][j] : aF[1][j - 4]) : (j < 4 ? aB[0][j] : aB[1][j - 4]); }
            const bf16x8 P = pack8(pj);
#pragma unroll
            for (int eb = 0; eb < 4; ++eb) acc[eb] = MFMA16(gather8(Vt + ((size_t)h * 64 + 32 * sg + 8 * g) * 68 + 16 * eb , 68, qi), P, acc[eb]);
        }
        float ss = 0.f;
#pragma unroll
        for (int eb = 0; eb < 4; ++eb) ss += (acc[eb].x * acc[eb].x + acc[eb].y * acc[eb].y) + (acc[eb].z * acc[eb].z + acc[eb].w * acc[eb].w);
        ss = xsum32(xsum16(ss));
        const float rn = rsqrtf(ss * (1.0f / 64) + EPS);
        u32x2 brw4[4]; f32x4 gn4[4];
#pragma unroll
        for (int eb = 0; eb < 4; ++eb) { const int e = 16 * eb + 4 * g; brw4[eb] = *(const u32x2*)(Z + (tok0 + t) * ZW + ZC_BR + h * 64 + e); gn4[eb] = *(const f32x4*)(gnorm + h * 64 + e); }
#pragma unroll
        for (int eb = 0; eb < 4; ++eb) { const int e = 16 * eb + 4 * g;
            const u32x2 brw = brw4[eb]; const f32x4 gn = gn4[eb];
            const float b0 = bflo(brw.x), b1 = bfhi(brw.x), b2 = bflo(brw.y), b3 = bfhi(brw.y);
            const float o0 = acc[eb].x * rn * gn.x * (b0 / (1.f + __expf(-b0))), o1 = acc[eb].y * rn * gn.y * (b1 / (1.f + __expf(-b1)));
            const float o2 = acc[eb].z * rn * gn.z * (b2 / (1.f + __expf(-b2))), o3 = acc[eb].w * rn * gn.w * (b3 / (1.f + __expf(-b3)));
            u32x2 w; w.x = cvt_pk_bf16(o0, o1); w.y = cvt_pk_bf16(o2, o3);
            *(u32x2*)(MIX + (tok0 + t) * D + 512 + h * 64 + e) = w; }
    }
    __syncthreads();
}

__device__ __forceinline__ void ret1_item(const bf16_t* __restrict__ Z, bf16_t* __restrict__ RS, const float* __restrict__ lgam, int item) {
    const int tid = opaque_tid();
    const int wave = tid >> 6, lane = tid & 63, qi = lane & 15, g = lane >> 4;
    const int ci = item >> 1, hp = item & 1;
    const size_t tok0 = (size_t)ci * 128;
    bf16_t* Vt = (bf16_t*)g_lds;
    bf16_t* Kt = Vt + 2 * 128 * 68;
    { u32x4 v[8];
#pragma unroll
      for (int u = 0; u < 8; ++u) { const int idx = tid + u * NTHR; const int which = idx >> 11, r = idx & 2047, t = r >> 4, ch = r & 15;
          v[u] = *(const u32x4*)(Z + (tok0 + t) * ZW + (which ? ZC_CK : ZC_CV) + hp * 128 + ch * 8); }
#pragma unroll
      for (int u = 0; u < 8; ++u) { const int idx = tid + u * NTHR; const int which = idx >> 11, r = idx & 2047, t = r >> 4, ch = r & 15, hh = ch >> 3, c8 = ch & 7;
          bf16_t* d = (which ? Kt : Vt) + ((size_t)hh * 128 + t) * 68 + c8 * 8;
          *(u32x2*)d = (u32x2){v[u].x, v[u].y}; *(u32x2*)(d + 4) = (u32x2){v[u].z, v[u].w}; } }
    __syncthreads();
    const int hh = wave >> 2, dir = (wave >> 1) & 1, eh = wave & 1, head = 2 * hp + hh;
    const float lg = lgam[dir * 4 + head];
    f32x4 acc[2][4] = {};
#pragma unroll 1
    for (int ks = 0; ks < 4; ++ks) {
        float w[8];
#pragma unroll
        for (int j = 0; j < 8; ++j) { const int s = 32 * ks + 8 * g + j; w[j] = __expf(lg * (float)(dir ? s : 127 - s)); }
        bf16x8 bfr[4];
#pragma unroll
        for (int db = 0; db < 4; ++db) { float kv[8]; unpack8(gather8(Kt + ((size_t)hh * 128 + 32 * ks + 8 * g) * 68 + 16 * db , 68, qi), kv);
#pragma unroll
            for (int j = 0; j < 8; ++j) kv[j] *= w[j];
            bfr[db] = pack8(kv); }
#pragma unroll
        for (int ebi = 0; ebi < 2; ++ebi) { const bf16x8 af = gather8(Vt + ((size_t)hh * 128 + 32 * ks + 8 * g) * 68 + 16 * (2 * eh + ebi) , 68, qi);
#pragma unroll
            for (int db = 0; db < 4; ++db) acc[ebi][db] = MFMA16(bfr[db], af, acc[ebi][db]); }
    }
    bf16_t* dst = RS + (((size_t)dir * NCR + ci) * 4 + head) * 4096;
#pragma unroll
    for (int ebi = 0; ebi < 2; ++ebi)
#pragma unroll
        for (int db = 0; db < 4; ++db) st4_bf16(dst + (16 * (2 * eh + ebi) + qi) * 64 + 16 * db + 4 * g, acc[ebi][db].x, acc[ebi][db].y, acc[ebi][db].z, acc[ebi][db].w);
    __syncthreads();
}

__device__ __forceinline__ void ret3_item(const bf16_t* __restrict__ Z, const bf16_t* __restrict__ RS, bf16_t* __restrict__ MIX, const float* __restrict__ rnorm, const float* __restrict__ lgam, int ci) {
    const int tid = opaque_tid();
    const int wave = tid >> 6, lane = tid & 63, qi = lane & 15, g = lane >> 4;
    const size_t tok0 = (size_t)ci * 128;
    bf16_t* Vt = (bf16_t*)g_lds;
    stage_v4<128>(Z, tok0, ZC_CV, Vt);
    __syncthreads();
    const int h = wave >> 1;
    const float lg0 = lgam[h], lg1 = lgam[4 + h];
    const bf16_t* rF = RS + (((size_t)0 * NCR + ci) * 4 + h) * 4096; const bf16_t* rB = RS + (((size_t)1 * NCR + ci) * 4 + h) * 4096;
    bf16x8 RF[4][2], RB[4][2];
#pragma unroll
    for (int eb = 0; eb < 4; ++eb) { const bf16_t* pf = rF + (16 * eb + qi) * 64 + 8 * g; const bf16_t* pb = rB + (16 * eb + qi) * 64 + 8 * g;
        RF[eb][0] = *(const bf16x8*)pf; RF[eb][1] = *(const bf16x8*)(pf + 32); RB[eb][0] = *(const bf16x8*)pb; RB[eb][1] = *(const bf16x8*)(pb + 32); }
    bf16x8 KF[4][2][2];
#pragma unroll
    for (int sg = 0; sg < 4; ++sg)
#pragma unroll
        for (int blk = 0; blk < 2; ++blk) { const int s = 32 * sg + 8 * (qi >> 2) + (qi & 3) + 4 * blk;
            const bf16_t* kp = Z + (tok0 + s) * ZW + ZC_CK + h * 64 + 8 * g; KF[sg][blk][0] = *(const bf16x8*)kp; KF[sg][blk][1] = *(const bf16x8*)(kp + 32); }
#pragma unroll 1
    for (int tbi = 0; tbi < 4; ++tbi) {
        const int t = 16 * (4 * (wave & 1) + tbi) + qi;
        const bf16_t* qp = Z + (tok0 + t) * ZW + ZC_CQ + h * 64 + 8 * g;
        const bf16x8 q0 = *(const bf16x8*)qp, q1 = *(const bf16x8*)(qp + 32);
        f32x4 aI[4];
        { const float wf = __expf(lg0 * (float)(t + 1)), wb = __expf(lg1 * (float)(128 - t));
#pragma unroll
          for (int eb = 0; eb < 4; ++eb) {
              f32x4 aF = {0.f, 0.f, 0.f, 0.f}, aB = {0.f, 0.f, 0.f, 0.f};
              aF = MFMA16(RF[eb][0], q0, aF); aF = MFMA16(RF[eb][1], q1, aF);
              aB = MFMA16(RB[eb][0], q0, aB); aB = MFMA16(RB[eb][1], q1, aB);
              aI[eb] = aF * wf + aB * wb;
          } }
#pragma unroll
        for (int sg = 0; sg < 4; ++sg) {
            f32x4 sc[2];
#pragma unroll
            for (int blk = 0; blk < 2; ++blk) {
                f32x4 z4 = {0.f, 0.f, 0.f, 0.f};
                z4 = MFMA16(KF[sg][blk][0], q0, z4); z4 = MFMA16(KF[sg][blk][1], q1, z4); sc[blk] = z4;
            }
            float pj[8];
#pragma unroll
            for (int j = 0; j < 8; ++j) { const int s = 32 * sg + 8 * g + j; const int dd = t - s;
                const float dec = (dd >= 0) ? __expf(lg0 * (float)dd) : __expf(lg1 * (float)(-dd));
                pj[j] = (j < 4 ? sc[0][j] : sc[1][j - 4]) * dec; }
            const bf16x8 P = pack8(pj);
#pragma unroll
            for (int eb = 0; eb < 4; ++eb) aI[eb] = MFMA16(gather8(Vt + ((size_t)h * 128 + 32 * sg + 8 * g) * 68 + 16 * eb , 68, qi), P, aI[eb]);
        }
        float ss = 0.f;
#pragma unroll
        for (int eb = 0; eb < 4; ++eb) ss += (aI[eb].x * aI[eb].x + aI[eb].y * aI[eb].y) + (aI[eb].z * aI[eb].z + aI[eb].w * aI[eb].w);
        ss = xsum32(xsum16(ss));
        const float rn = rsqrtf(ss * (1.0f / 64) + EPS);
        u32x2 gw4[4]; f32x4 gn4[4];
#pragma unroll
        for (int eb = 0; eb < 4; ++eb) { const int e = 16 * eb + 4 * g; gw4[eb] = *(const u32x2*)(Z + (tok0 + t) * ZW + ZC_CG + h * 64 + e); gn4[eb] = *(const f32x4*)(rnorm + h * 64 + e); }
#pragma unroll
        for (int eb = 0; eb < 4; ++eb) { const int e = 16 * eb + 4 * g;
            const u32x2 gw = gw4[eb]; const f32x4 gn = gn4[eb];
            const float b0 = bflo(gw.x), b1 = bfhi(gw.x), b2 = bflo(gw.y), b3 = bfhi(gw.y);
            const float o0 = aI[eb].x * rn * gn.x * (b0 / (1.f + __expf(-b0))), o1 = aI[eb].y * rn * gn.y * (b1 / (1.f + __expf(-b1)));
            const float o2 = aI[eb].z * rn * gn.z * (b2 / (1.f + __expf(-b2))), o3 = aI[eb].w * rn * gn.w * (b3 / (1.f + __expf(-b3)));
            u32x2 w; w.x = cvt_pk_bf16(o0, o1); w.y = cvt_pk_bf16(o2, o3);
            *(u32x2*)(MIX + (tok0 + t) * D + 768 + h * 64 + e) = w; }
    }
    __syncthreads();
}

__device__ __forceinline__ void phase_scan(bf16_t* __restrict__ GS, const float* __restrict__ GD, bf16_t* __restrict__ RS, const float* __restrict__ lgam, int S) {
    const int tid = opaque_tid();
    const int lgn = (S == 16384) ? 1 : 4, nseq = 1 << lgn, ncg = S / 64, ncr = S / 128;
    const int gtid = blockIdx.x * NTHR + tid, gth = gridDim.x * NTHR;
    const int n_gla = 2 * nseq * 4 * 1024, n_ret = 2 * nseq * 4 * 2048;
    constexpr int SB_ = 16;
    for (int idx = gtid; idx < n_gla + n_ret; idx += gth) {
        if (idx < n_gla) {
            const int el = 2 * (idx & 1023), hh = (idx >> 10) & 3, sq = (idx >> 12) & (nseq - 1), dir = (idx >> 12) >> lgn, kk = el & 31;
            const size_t cstr = (size_t)4 * 2048;
            unsigned* base = (unsigned*)(GS + (((size_t)dir * NCH + (size_t)sq * ncg) * 4 + hh) * 2048 + el);
            const float* dbase = GD + (((size_t)dir * NCH + (size_t)sq * ncg) * 4 + hh) * 32 + kk;
            const long step = dir ? -1 : 1; const long c0 = dir ? ncg - 1 : 0;
            unsigned cur[SB_], nxt[SB_]; f32x2_t dcur[SB_], dnxt[SB_];
#pragma unroll
            for (int u = 0; u < SB_; ++u) { const long c = c0 + step * u; cur[u] = *(const unsigned*)((const bf16_t*)base + c * (long)cstr); dcur[u] = *(const f32x2_t*)(dbase + c * 128); }
            float s0 = 0.f, s1 = 0.f;
#pragma unroll 1
            for (int i0 = 0; i0 < ncg; i0 += SB_) {
                const bool more = i0 + SB_ < ncg;
#pragma unroll
                for (int u = 0; u < SB_; ++u) { const long c = c0 + step * (more ? i0 + SB_ + u : i0 + u); nxt[u] = *(const unsigned*)((const bf16_t*)base + c * (long)cstr); dnxt[u] = *(const f32x2_t*)(dbase + c * 128); }
#pragma unroll
                for (int u = 0; u < SB_; ++u) { const long c = c0 + step * (i0 + u);
                    *(unsigned*)((bf16_t*)base + c * (long)cstr) = cvt_pk_bf16(s0, s1); s0 = dcur[u].x * s0 + bflo(cur[u]); s1 = dcur[u].y * s1 + bfhi(cur[u]); }
#pragma unroll
                for (int u = 0; u < SB_; ++u) { cur[u] = nxt[u]; dcur[u] = dnxt[u]; }
            }
        } else {
            const int j = idx - n_gla; const int el = 2 * (j & 2047), hh = (j >> 11) & 3, sq = (j >> 13) & (nseq - 1), dir = (j >> 13) >> lgn;
            const float dec = __expf(128.f * lgam[dir * 4 + hh]);
            const size_t cstr = (size_t)4 * 4096;
            unsigned* base = (unsigned*)(RS + (((size_t)dir * NCR + (size_t)sq * ncr) * 4 + hh) * 4096 + el);
            const long step = dir ? -1 : 1; const long c0 = dir ? ncr - 1 : 0;
            unsigned cur[SB_], nxt[SB_];
#pragma unroll
            for (int u = 0; u < SB_; ++u) { const long c = c0 + step * u; cur[u] = *(const unsigned*)((const bf16_t*)base + c * (long)cstr); }
            float s0 = 0.f, s1 = 0.f;
#pragma unroll 1
            for (int i0 = 0; i0 < ncr; i0 += SB_) {
                const bool more = i0 + SB_ < ncr;
#pragma unroll
                for (int u = 0; u < SB_; ++u) { const long c = c0 + step * (more ? i0 + SB_ + u : i0 + u); nxt[u] = *(const unsigned*)((const bf16_t*)base + c * (long)cstr); }
#pragma unroll
                for (int u = 0; u < SB_; ++u) { const long c = c0 + step * (i0 + u);
                    *(unsigned*)((bf16_t*)base + c * (long)cstr) = cvt_pk_bf16(s0, s1); s0 = dec * s0 + bflo(cur[u]); s1 = dec * s1 + bfhi(cur[u]); }
#pragma unroll
                for (int u = 0; u < SB_; ++u) cur[u] = nxt[u];
            }
        }
    }
}

#define XB_TMO      128
#define XB_XCNT(j)  (256  + 64 * (j))
#define XB_XSUB(j)  (1280 + 64 * (j))
#define XB_XGEN(j)  (2304 + 64 * (j))
#define XB_TOP      3328
#define XB_TOPGEN   3392
#define XCD_BAR_WORDS 3456
#define XB_SPIN_CAP (1u << 22)
#define LAS __attribute__((address_space(3)))
__device__ __forceinline__ unsigned xb_ld(unsigned* p)              { return __hip_atomic_load(p, __ATOMIC_RELAXED, __HIP_MEMORY_SCOPE_AGENT); }
__device__ __forceinline__ unsigned xb_add(unsigned* p, unsigned v) { return __hip_atomic_fetch_add(p, v, __ATOMIC_RELAXED, __HIP_MEMORY_SCOPE_AGENT); }
__device__ __forceinline__ unsigned xb_xcc_id() { return (unsigned)__builtin_amdgcn_s_getreg((3 << 11) | 20) & 0xFu; }
#define XB_SPIN(cond, bar) do { unsigned _sp = 0; while (cond) { __builtin_amdgcn_s_sleep(1); \
    if ((++_sp & 255u) == 0u) { if (xb_ld(&(bar)[XB_TMO])) break; if (_sp > XB_SPIN_CAP) { atomicAdd(&(bar)[XB_TMO], 1u); break; } } } } while (0)
struct XcdBarrier { unsigned* bar; unsigned x; volatile LAS unsigned* st; };
__device__ __forceinline__ XcdBarrier xcd_barrier_post(unsigned* bar, volatile LAS unsigned* st) {
    XcdBarrier b; b.bar = bar; b.x = xb_xcc_id(); b.st = st;
    if (threadIdx.x == 0) (void)xb_add(&bar[XB_XCNT(b.x)], 1u);
    return b;
}
__device__ __forceinline__ void xcd_barrier_complete(unsigned* bar, unsigned x, unsigned& nloc, unsigned& nx) {
    const unsigned G = gridDim.x * gridDim.y * gridDim.z;
    unsigned sum, cnt, mine, sp = 0u;
    for (;;) {
        sum = 0u; cnt = 0u; mine = 0u;
#pragma unroll
        for (unsigned j = 0; j < 16; ++j) { const unsigned c = xb_ld(&bar[XB_XCNT(j)]); sum += c; cnt += (c > 0u) ? 1u : 0u; mine = (j == x) ? c : mine; }
        if (sum == G) break;
        __builtin_amdgcn_s_sleep(1);
        if ((++sp & 255u) == 0u) { if (xb_ld(&bar[XB_TMO])) break; if (sp > XB_SPIN_CAP) { atomicAdd(&bar[XB_TMO], 1u); break; } }
    }
    nloc = mine > 0u ? mine : 1u; nx = cnt > 0u ? cnt : 1u;
}
__device__ __forceinline__ void xcd_barrier(const XcdBarrier& b) {
    asm volatile("s_waitcnt vmcnt(0)" ::: "memory");
    __syncthreads();
    if (threadIdx.x == 0) {
        unsigned* bar = b.bar;
        __builtin_amdgcn_s_waitcnt(0);
        unsigned nloc = b.st[0], nx = b.st[1];
        if (nloc == 0u) { xcd_barrier_complete(bar, b.x, nloc, nx); b.st[0] = nloc; b.st[1] = nx; }
        const unsigned old = xb_add(&bar[XB_XSUB(b.x)], 1u);
        const unsigned gen = old / nloc;
        if (old + 1u == (gen + 1u) * nloc) {
            __builtin_amdgcn_fence(__ATOMIC_RELEASE, "agent");
            asm volatile("s_waitcnt vmcnt(0)" ::: "memory");
            const unsigned og = xb_add(&bar[XB_TOP], 1u);
            const unsigned tg = og / nx;
            if (og + 1u == (tg + 1u) * nx) xb_add(&bar[XB_TOPGEN], 1u);
            else XB_SPIN(xb_ld(&bar[XB_TOPGEN]) == tg, bar);
            __builtin_amdgcn_fence(__ATOMIC_ACQUIRE, "agent");
            xb_add(&bar[XB_XGEN(b.x)], 1u);
            asm volatile("s_waitcnt vmcnt(0)" ::: "memory");
        } else {
            XB_SPIN(xb_ld(&bar[XB_XGEN(b.x)]) == gen, bar);
            __builtin_amdgcn_fence(__ATOMIC_ACQUIRE, "agent");
            asm volatile("s_waitcnt vmcnt(0)" ::: "memory");
        }
    }
    __syncthreads();
}

__global__ void __launch_bounds__(NTHR, 2) fwd_mega(Params p) {
    cg::grid_group grid = cg::this_grid();
    unsigned char* ws = p.ws;
    bf16_t* WT = (bf16_t*)(ws + WS_WT); const float* tab = (const float*)(ws + WS_TAB);
    bf16_t* HB0 = (bf16_t*)(ws + WS_HB); bf16_t* HB1 = (bf16_t*)(ws + WS_HB1);
    float* SSQ0 = (float*)(ws + WS_SSQ); float* SSQ1 = SSQ0 + (size_t)MG * 16; float* SSQ2 = SSQ1 + (size_t)MG * 16;
    bf16_t* Z = (bf16_t*)(ws + WS_Z); bf16_t* MIX = (bf16_t*)(ws + WS_MIX); bf16_t* HID = (bf16_t*)(ws + WS_HID);
    bf16_t* PB = (bf16_t*)(ws + WS_PB); bf16_t* PL = (bf16_t*)(ws + WS_PLE);
    bf16_t* KA = (bf16_t*)(ws + WS_KA); bf16_t* VA = (bf16_t*)(ws + WS_VA);
    bf16_t* GS = (bf16_t*)(ws + WS_GS); float* GD = (float*)(ws + WS_GD); bf16_t* RS = (bf16_t*)(ws + WS_RS);
    float* lgam = (float*)(g_lds + LDS_BYTES - 64);

#ifndef NO_P0
    phase_weights(p);
#endif
    unsigned* barw = (unsigned*)(ws + WS_BAR);
    volatile LAS unsigned* bst = (volatile LAS unsigned*)(g_lds + LDS_BYTES - 32);
    if (blockIdx.x == 0) for (int i = threadIdx.x; i < XCD_BAR_WORDS; i += NTHR) barw[i] = 0u;
    if (threadIdx.x < 2) bst[threadIdx.x] = 0u;
    grid.sync();
    const XcdBarrier xb = xcd_barrier_post(barw, bst);
#pragma unroll 1
    for (int g = 0; g < NGROUPS; ++g) {
        const int S = (g == 0) ? 16384 : 2048;
        float* H = p.out + (size_t)g * MG * D;
#ifndef NO_PI
        phase_init(p, g);
#endif
        xcd_barrier(xb);
#pragma unroll 1
        for (int l = 0; l < NLAYER; ++l) {
            const bf16_t* W = WT + (size_t)l * W_LAYER;
            { const int t8 = opaque_tid(); if (t8 < 8) { const float x = p.ret_decay_raw[l * 8 + t8]; lgam[t8] = fminf(x, 0.f) - __logf(1.0f + __expf(-fabsf(x))); } }
            __syncthreads();
            { EpiIn e{Z, SSQ0, p.attn_q_norm + l * 64, p.attn_k_norm + l * 64, p.gla_gate_bias + l * 256, tab, S - 1, KA, VA};
#ifndef NO_P1
#ifndef REP_P1
#define REP_P1 1
#endif
              gemm_phase(HB0, D, W + WO_IN, D, MG, ZW, D, e);
#if REP_P1 > 1
              xcd_barrier(xb); gemm_phase(HB0, D, W + WO_IN, D, MG, ZW, D, e);
#endif
#endif
 }
            xcd_barrier(xb);
#ifndef REP_MIX
#define REP_MIX 1
#endif
            for (int rep_mix = 0; rep_mix < REP_MIX; ++rep_mix) {
            { const int nA = 1024, nG = NCH, nR = 2 * NCR;
#ifndef NO_AT
              if ((gridDim.x & 7) == 0) {
                  const int per = nA / 8, slots = gridDim.x / 8;
                  for (int k = blockIdx.x / 8; k < per; k += slots) attn_item(Z, KA, VA, MIX, S, per * (blockIdx.x & 7) + k);
              } else { for (int it = blockIdx.x; it < nA; it += gridDim.x) attn_item(Z, KA, VA, MIX, S, it); }
#endif
              for (int it = nA + blockIdx.x; it < nA + nG + nR; it += gridDim.x) {
#ifndef NO_G1
                  if (it >= nA && it < nA + nG) gla1_item(Z, GS, GD, it - nA);
#endif
#ifndef NO_R1
                  if (it >= nA + nG) ret1_item(Z, RS, lgam, it - nA - nG);
#endif
              } }
            xcd_barrier(xb);
#ifndef NO_P3
            phase_scan(GS, GD, RS, lgam, S);
#endif
            xcd_barrier(xb);
            { for (int it = blockIdx.x; it < NCH + NCR; it += gridDim.x) {
#ifndef NO_G3
                  if (it < NCH) gla3_item(Z, GS, MIX, p.gla_out_norm + l * 256, it);
#endif
#ifndef NO_R3
                  if (it >= NCH) ret3_item(Z, RS, MIX, p.ret_out_norm + l * 256, lgam, it - NCH);
#endif
              } }
            xcd_barrier(xb);
            }
#ifndef NO_P5
            { EpiRes e{HB0, HB1, SSQ1}; gemm_phase(MIX, D, W + WO_OUT, D, MG, D, D, e); }
#endif
            xcd_barrier(xb);
#ifndef NO_P6
            { EpiMlpIn e{HID, SSQ1}; gemm_phase_t<true>(HB1, D, W + WO_MI, D, MG, DFF, D, e); }
#endif
#ifndef NO_P6B
            { EpiPlain e{PB, D}; gemm_phase(PL + (size_t)l * MG * PLE, PLE, W + WO_PP, PLE, MG, D, PLE, e); }
#endif
            xcd_barrier(xb);
#ifndef NO_P7
            { EpiRes e{HB1, HB1, SSQ2}; gemm_phase(HID, DFF, W + WO_MO, DFF, MG, D, DFF, e); }
#endif
            xcd_barrier(xb);
#ifndef NO_P9
            { EpiPeGate e{H, HB1, HB0, SSQ0, SSQ2, PB, l == NLAYER - 1}; gemm_phase(HB1, D, W + WO_PG, D, MG, D, D, e); }
#endif
            xcd_barrier(xb);
        }
    }
}

extern "C" void kernel_launch(void* const* d_in, const int* in_sizes, int n_in, void* d_out, int out_size, void* d_ws, size_t ws_size, hipStream_t stream) {
    static int grid_blocks = 0;
    if (!grid_blocks) {
        int dev = 0, cus = 0, per_cu = 0;
        hipGetDevice(&dev);
        hipDeviceGetAttribute(&cus, hipDeviceAttributeMultiprocessorCount, dev);
        hipFuncSetAttribute((const void*)fwd_mega, hipFuncAttributeMaxDynamicSharedMemorySize, LDS_BYTES);
        hipOccupancyMaxActiveBlocksPerMultiprocessor(&per_cu, (const void*)fwd_mega, NTHR, LDS_BYTES);
        if (per_cu < 1) per_cu = 1;
        grid_blocks = cus * 1;
        if (ws_size < WS_END) fprintf(stderr, "kernel_launch: workspace too small: %zu < %zu\n", ws_size, (size_t)WS_END);
    }
    Params p{};
    p.x_prompt = (const float*)d_in[0]; p.x_sample = (const float*)d_in[1]; p.p_prompt = (const float*)d_in[2]; p.p_sample = (const float*)d_in[3];
    p.ln_mix = (const float*)d_in[4]; p.w_in = (const float*)d_in[5]; p.attn_q_norm = (const float*)d_in[6]; p.attn_k_norm = (const float*)d_in[7];
    p.gla_gate_up = (const float*)d_in[8]; p.gla_gate_bias = (const float*)d_in[9]; p.gla_out_norm = (const float*)d_in[10]; p.ret_decay_raw = (const float*)d_in[11];
    p.ret_out_norm = (const float*)d_in[12]; p.w_out = (const float*)d_in[13]; p.ln_mlp = (const float*)d_in[14]; p.w_mlp_in = (const float*)d_in[15]; p.w_mlp_out = (const float*)d_in[16];
    p.ln_pe = (const float*)d_in[17]; p.w_pe_gate = (const float*)d_in[18]; p.w_pe_proj = (const float*)d_in[19];
    p.out = (float*)d_out; p.ws = (unsigned char*)d_ws;
    void* args[] = {&p};
    hipError_t e = hipLaunchCooperativeKernel((const void*)fwd_mega, dim3(grid_blocks), dim3(NTHR), args, LDS_BYTES, stream);
    if (e != hipSuccess) fprintf(stderr, "cooperative launch failed: %s (grid %d)\n", hipGetErrorString(e), grid_blocks);
}
```
